# Optimizing an MI355X kernel written in HIP

```python
import math
import jax, jax.numpy as jnp
from jax import lax
import numpy as np

D_MODEL = 1024
BATCH = 1
SEQ = 16384
DEPTH = 2

N_RET_HEADS = 4
RET_QK_DIM = D_MODEL // N_RET_HEADS
RET_V_DIM = 2 * RET_QK_DIM
RET_QK_TOTAL = N_RET_HEADS * RET_QK_DIM
RET_V_TOTAL = N_RET_HEADS * RET_V_DIM
RET_IN_WIDTH = 2 * RET_QK_TOTAL + 2 * RET_V_TOTAL
RET_CHUNK = 128
ROPE_BASE = 10000.0
POOL_WINDOWS = (2, 4, 8, 16)
POOL_GROUPS = len(POOL_WINDOWS)
POOL_GROUP_WIDTH = D_MODEL // POOL_GROUPS
D_FF = ((8 * D_MODEL // 3 + 255) // 256) * 256
N_EXPERTS = 8
TOP_K = 2
D_FF_EXPERT = 7 * D_MODEL // 2
MOE_BLOCK = 256
N_MOD = 6
EPS = 1e-6
N_A = (DEPTH + 1) // 2
N_B = DEPTH // 2

kernel_name = 'hybrid_retention_pool_moe_adaln'


def _rmsnorm(x, gain):
    xf = x.astype(jnp.float32)
    y = xf * lax.rsqrt(jnp.mean(xf * xf, axis=-1, keepdims=True) + EPS)
    return (y * gain.astype(jnp.float32)).astype(x.dtype)


def _modulate(h, shift, scale):
    return h * (1.0 + scale) + shift


def _rotary(t, pos):
    half = t.shape[-1] // 2
    inv = ROPE_BASE ** (-jnp.arange(half, dtype=jnp.float32) / half)
    ang = pos.astype(jnp.float32)[:, None] * inv[None, :]
    cos = jnp.cos(ang)[None, :, None, :]
    sin = jnp.sin(ang)[None, :, None, :]
    t1, t2 = t[..., :half], t[..., half:]
    return jnp.concatenate([t1 * cos - t2 * sin, t1 * sin + t2 * cos], axis=-1)


def _retention(h, w_in, gn_gain, w_out):
    bsz, seq, _ = h.shape
    H, DK, DV, C = N_RET_HEADS, RET_QK_DIM, RET_V_DIM, RET_CHUNK
    n_chunks = seq // C
    proj = h @ w_in
    q, k, v, g = jnp.split(proj, [RET_QK_TOTAL, 2 * RET_QK_TOTAL, 2 * RET_QK_TOTAL + RET_V_TOTAL], axis=-1)
    pos = jnp.arange(seq)
    q = _rotary(q.reshape(bsz, seq, H, DK).astype(jnp.float32), pos)
    k = _rotary(k.reshape(bsz, seq, H, DK).astype(jnp.float32), pos) * (DK ** -0.5)
    v = v.reshape(bsz, seq, H, DV).astype(jnp.float32)

    def to_chunks(t):
        return t.reshape(bsz, n_chunks, C, H, t.shape[-1]).transpose(0, 3, 1, 2, 4)

    qc, kc, vc = to_chunks(q), to_chunks(k), to_chunks(v)
    log_gamma = jnp.log1p(-jnp.exp2(-5.0 - jnp.arange(H, dtype=jnp.float32)))
    idx = jnp.arange(C, dtype=jnp.float32)
    diff = idx[:, None] - idx[None, :]
    d_intra = jnp.where(diff >= 0, jnp.exp(log_gamma[:, None, None] * jnp.maximum(diff, 0.0)), 0.0)
    scores = jnp.einsum('bhncd,bhnmd->bhncm', qc, kc) * d_intra[None, :, None]
    intra = jnp.einsum('bhncm,bhnme->bhnce', scores, vc)
    q_dec = jnp.exp(log_gamma[:, None] * (idx + 1.0))
    k_dec = jnp.exp(log_gamma[:, None] * (C - 1.0 - idx))
    chunk_dec = jnp.exp(log_gamma * C)
    qs = (qc * q_dec[None, :, None, :, None]).transpose(2, 0, 1, 3, 4)
    ks = (kc * k_dec[None, :, None, :, None]).transpose(2, 0, 1, 3, 4)
    vs = vc.transpose(2, 0, 1, 3, 4)

    def step(state, inp):
        qn, kn, vn = inp
        out = jnp.einsum('bhcd,bhde->bhce', qn, state)
        state = state * chunk_dec[None, :, None, None] + jnp.einsum('bhcd,bhce->bhde', kn, vn)
        return state, out

    state0 = jnp.zeros((bsz, H, DK, DV), jnp.float32)
    _, cross = lax.scan(step, state0, (qs, ks, vs))
    o = intra + cross.transpose(1, 2, 0, 3, 4)
    o = o.transpose(0, 2, 3, 1, 4).reshape(bsz, seq, H, DV)
    mu = jnp.mean(o, axis=-1, keepdims=True)
    var = jnp.mean(jnp.square(o - mu), axis=-1, keepdims=True)
    o = ((o - mu) * lax.rsqrt(var + EPS)).reshape(bsz, seq, RET_V_TOTAL) * gn_gain.astype(jnp.float32)
    y = jax.nn.silu(g.astype(jnp.float32)) * o
    return y.astype(h.dtype) @ w_out


def _pool_mixer(h, w_pool, b_pool, scale):
    bsz, seq, dm = h.shape
    hf = h.astype(jnp.float32).reshape(bsz, seq, POOL_GROUPS, POOL_GROUP_WIDTH)
    t1 = jnp.arange(1, seq + 1, dtype=jnp.float32)
    outs = []
    for gi, w in enumerate(POOL_WINDOWS):
        xg = hf[:, :, gi]
        cs = jnp.cumsum(jnp.pad(xg, ((0, 0), (w, 0), (0, 0))), axis=1)
        win_sum = cs[:, w:] - cs[:, :seq]
        cnt = jnp.minimum(t1, float(w))
        outs.append(win_sum / cnt[None, :, None] - xg)
    pooled = jnp.stack(outs, axis=2)
    y = jnp.einsum('bsgc,gcd->bsgd', pooled, w_pool.astype(jnp.float32)) + b_pool.astype(jnp.float32)
    return (y.reshape(bsz, seq, dm) * scale.astype(jnp.float32)).astype(h.dtype)


def _swiglu(h, w_gate, w_up, w_down):
    return (jax.nn.silu(h @ w_gate) * (h @ w_up)) @ w_down


def _moe_swiglu(h, w_router, w_gate, w_up, w_down):
    bsz, seq, dm = h.shape
    T = bsz * seq
    xt = h.reshape(T, dm)
    logits = (xt @ w_router).astype(jnp.float32)
    top_logits, top_idx = lax.top_k(logits, TOP_K)
    gates = jax.nn.softmax(top_logits, axis=-1)
    e_flat = top_idx.reshape(-1)
    tok_flat = jnp.repeat(jnp.arange(T, dtype=jnp.int32), TOP_K)
    g_flat = gates.reshape(-1)
    order = jnp.argsort(e_flat)
    e_sorted, tok_sorted, g_sorted = e_flat[order], tok_flat[order], g_flat[order]
    counts = jnp.zeros((N_EXPERTS,), jnp.int32).at[e_flat].add(1)
    padded = ((counts + MOE_BLOCK - 1) // MOE_BLOCK) * MOE_BLOCK
    start_unp = jnp.cumsum(counts) - counts
    pad_end = jnp.cumsum(padded)
    start_pad = pad_end - padded
    n_assign = T * TOP_K
    rank = jnp.arange(n_assign, dtype=jnp.int32) - start_unp[e_sorted]
    dest = start_pad[e_sorted] + rank
    cap = ((n_assign + MOE_BLOCK - 1) // MOE_BLOCK) * MOE_BLOCK + N_EXPERTS * MOE_BLOCK
    n_blocks = cap // MOE_BLOCK
    buf_tok = jnp.full((cap,), T, jnp.int32).at[dest].set(tok_sorted)
    buf_gate = jnp.zeros((cap,), jnp.float32).at[dest].set(g_sorted)
    block_start = jnp.arange(n_blocks, dtype=jnp.int32) * MOE_BLOCK
    block_e = jnp.minimum(jnp.sum(block_start[:, None] >= pad_end[None, :], axis=1), N_EXPERTS - 1)
    x_pad = jnp.concatenate([xt, jnp.zeros((1, dm), xt.dtype)], axis=0)
    xb = x_pad[buf_tok].reshape(n_blocks, MOE_BLOCK, dm)

    def expert_block(args):
        xblk, e = args
        return _swiglu(xblk, w_gate[e], w_up[e], w_down[e])

    yb = lax.map(expert_block, (xb, block_e)).reshape(cap, dm)
    yb = (yb.astype(jnp.float32) * buf_gate[:, None]).astype(h.dtype)
    y = jnp.zeros((T + 1, dm), h.dtype).at[buf_tok].add(yb)
    return y[:T].reshape(bsz, seq, dm)


def setup_inputs(seed: int = 0) -> dict:
    key = jax.random.key(seed)
    ks = jax.random.split(key, 24)
    f32 = jnp.float32
    nrm = lambda k, shape, s: jax.random.normal(k, shape, f32) * s
    D = D_MODEL
    return {
        'x': nrm(ks[0], (BATCH, SEQ, D), 1.0),
        'c': nrm(ks[1], (BATCH, D), 1.0),
        'ada_w': nrm(ks[2], (DEPTH, D, N_MOD * D), 0.5 * D ** -0.5),
        'ada_b': nrm(ks[3], (DEPTH, N_MOD * D), 0.01),
        'norm_gain': 1.0 + nrm(ks[4], (DEPTH, 2, D), 0.05),
        'ret_w_in': nrm(ks[5], (N_A, D, RET_IN_WIDTH), D ** -0.5),
        'ret_gn_gain': 1.0 + nrm(ks[6], (N_A, RET_V_TOTAL), 0.05),
        'ret_w_out': nrm(ks[7], (N_A, RET_V_TOTAL, D), RET_V_TOTAL ** -0.5),
        'ffn_w_gate': nrm(ks[8], (N_A, D, D_FF), D ** -0.5),
        'ffn_w_up': nrm(ks[9], (N_A, D, D_FF), D ** -0.5),
        'ffn_w_down': nrm(ks[10], (N_A, D_FF, D), D_FF ** -0.5),
        'pool_w': nrm(ks[11], (N_B, POOL_GROUPS, POOL_GROUP_WIDTH, POOL_GROUP_WIDTH), POOL_GROUP_WIDTH ** -0.5),
        'pool_b': nrm(ks[12], (N_B, POOL_GROUPS, POOL_GROUP_WIDTH), 0.01),
        'pool_scale': 1.0 + nrm(ks[13], (N_B, D), 0.1),
        'moe_router': nrm(ks[14], (N_B, D, N_EXPERTS), D ** -0.5),
        'moe_w_gate': nrm(ks[15], (N_B, N_EXPERTS, D, D_FF_EXPERT), D ** -0.5),
        'moe_w_up': nrm(ks[16], (N_B, N_EXPERTS, D, D_FF_EXPERT), D ** -0.5),
        'moe_w_down': nrm(ks[17], (N_B, N_EXPERTS, D_FF_EXPERT, D), D_FF_EXPERT ** -0.5),
        'final_norm_gain': 1.0 + nrm(ks[18], (D,), 0.05),
    }


def reference(x, c, ada_w, ada_b, norm_gain, ret_w_in, ret_gn_gain, ret_w_out,
              ffn_w_gate, ffn_w_up, ffn_w_down, pool_w, pool_b, pool_scale,
              moe_router, moe_w_gate, moe_w_up, moe_w_down, final_norm_gain):
    c_act = jax.nn.silu(c)
    for i in range(DEPTH):
        j = i // 2
        mod = (c_act @ ada_w[i] + ada_b[i])[:, None, :]
        sh1, sc1, g1, sh2, sc2, g2 = jnp.split(mod, N_MOD, axis=-1)
        h = _modulate(_rmsnorm(x, norm_gain[i, 0]), sh1, sc1)
        if i % 2 == 0:
            m = _retention(h, ret_w_in[j], ret_gn_gain[j], ret_w_out[j])
        else:
            m = _pool_mixer(h, pool_w[j], pool_b[j], pool_scale[j])
        x = x + g1 * m
        h = _modulate(_rmsnorm(x, norm_gain[i, 1]), sh2, sc2)
        if i % 2 == 0:
            f = _swiglu(h, ffn_w_gate[j], ffn_w_up[j], ffn_w_down[j])
        else:
            f = _moe_swiglu(h, moe_router[j], moe_w_gate[j], moe_w_up[j], moe_w_down[j])
        x = x + g2 * f
    return _rmsnorm(x, final_norm_gain)
```

```cpp
#include <hip/hip_runtime.h>
#include <cstdio>

#define GAS __attribute__((address_space(1)))
#define LAS __attribute__((address_space(3)))
typedef unsigned short bf16_t;
typedef short bf16x8 __attribute__((ext_vector_type(8)));
typedef float f32x4 __attribute__((ext_vector_type(4)));
typedef float f32x2 __attribute__((ext_vector_type(2)));
typedef unsigned u32x4 __attribute__((ext_vector_type(4)));
typedef int i32x4 __attribute__((ext_vector_type(4)));
typedef unsigned u32x2 __attribute__((ext_vector_type(2)));

#ifndef FAST_GEMM
#define FAST_GEMM 1
#endif

constexpr int T = 16384, D = 1024, NH = 4, DK = 256, DV = 512, CH = 128, NCH = 128;
constexpr int NIN = 6144, DFF = 2816, NE = 8, DFE = 3584, CAP = 34816, NBLK = 136;
constexpr float EPS = 1e-6f;
constexpr int NTHR = 512, NWAVE = 8;

constexpr size_t KiB = 1024, MiB = 1u << 20;
constexpr size_t WS_CTL = 0, CTL_BYTES = 1 * MiB;
constexpr size_t CT_BAR = 16 * KiB;
constexpr size_t CT_MOD = 64 * KiB;
constexpr size_t CT_BIAS_R = 158 * KiB;
constexpr size_t WS_ROWSSP = 2 * MiB;
constexpr size_t WS_MODP = 3 * MiB;
constexpr size_t CT_BIAS_IN = 3584 * KiB;
constexpr size_t CT_BIAS_GU = 3584 * KiB + 96 * KiB;
constexpr size_t CT_BIAS_MGU = 36 * MiB + 512 * KiB;
constexpr size_t WS_TABA = 1 * MiB;
constexpr size_t WS_TABB = WS_TABA + 128 * KiB;
constexpr size_t WS_GP = WS_TABB + 128 * KiB;
constexpr size_t WS_WR = WS_GP + 4 * KiB;
constexpr size_t WS_TOPE = WS_WR + 32 * KiB;
constexpr size_t WS_TOPG = WS_TOPE + 128 * KiB;
constexpr size_t WS_CNT = WS_TOPG + 128 * KiB;
constexpr size_t WS_BUFTOK = WS_CNT + 8 * KiB;
constexpr size_t WS_BUFGATE = WS_BUFTOK + 136 * KiB;
constexpr size_t WS_POS = WS_BUFGATE + 136 * KiB;
constexpr size_t WS_BLKE = WS_POS + 128 * KiB;
constexpr size_t WS_RSTD3 = 256 * KiB;
constexpr size_t WS_BUFRS = 320 * KiB;
constexpr size_t WS_WIN = 4 * MiB;
constexpr size_t WS_WOUT = 16 * MiB;
constexpr size_t WS_WGU = 20 * MiB;
constexpr size_t WS_WD = 31 * MiB;
constexpr size_t WS_WP = 37 * MiB;
constexpr size_t WS_XB = 38 * MiB;
constexpr size_t WS_Q = 70 * MiB;
constexpr size_t WS_KN = 102 * MiB;
constexpr size_t WS_KDT = 134 * MiB;
constexpr size_t WS_VT = 166 * MiB;
constexpr size_t WS_G = 230 * MiB;
constexpr size_t WS_SB = 294 * MiB;
constexpr size_t WS_Y = 422 * MiB;
constexpr size_t WS_H1 = 70 * MiB;
constexpr size_t WS_PB = 158 * MiB;
constexpr size_t WS_X2 = 158 * MiB;
constexpr size_t WS_H1M = 70 * MiB;
constexpr size_t WS_WMGU = 308 * MiB;
constexpr size_t WS_WMD = 456 * MiB;
constexpr size_t WS_YB = 308 * MiB;
constexpr size_t WS_YBB = 4 * MiB;
constexpr size_t WS_END = 512 * MiB;
static_assert(WS_BUFRS + 136 * KiB <= WS_TABA && WS_BLKE + 4 * KiB <= WS_ROWSSP && WS_MODP + 8 * 12288 * 4 <= CT_BIAS_IN && CT_BIAS_GU + 4 * 5632 * 4 <= WS_WIN, "small region");
static_assert(WS_YBB + (size_t)224 * 65536 * 4 <= WS_H1M && WS_H1M + (size_t)CAP * DFE * 2 <= WS_WMGU && WS_YB + (size_t)CAP * D * 4 <= WS_WMD && WS_WMD + (size_t)NE * D * DFE * 2 <= WS_END, "moe map");
static_assert(WS_Y + (size_t)T * 2048 * 2 <= WS_END && WS_SB + (size_t)128 * 4 * 512 * 256 * 2 <= WS_Y, "ret map");

constexpr int LDS_BYTES = 147456;

struct Params {
    const float *x, *c, *ada_w, *ada_b, *norm_gain, *ret_w_in, *ret_gn_gain, *ret_w_out, *ffn_w_gate, *ffn_w_up, *ffn_w_down,
        *pool_w, *pool_b, *pool_scale, *moe_router, *moe_w_gate, *moe_w_up, *moe_w_down, *final_norm_gain;
    float* out; unsigned char* ws;
};

__device__ __forceinline__ unsigned f2bf(float f) { unsigned u = __builtin_bit_cast(unsigned, f); return (u + 0x7fffu + ((u >> 16) & 1u)) >> 16; }
typedef __bf16 bf16x2_t __attribute__((ext_vector_type(2)));
__device__ __forceinline__ unsigned pk2(float lo, float hi) { const f32x2 v = {lo, hi}; return __builtin_bit_cast(unsigned, __builtin_convertvector(v, bf16x2_t)); }
constexpr float F8_WSCALE = 32.0f, F8_DSCALE = 64.0f, F8_HSCALE = 4.0f;
__device__ __forceinline__ unsigned pk4f8(float a, float b, float c, float d) { int w = __builtin_amdgcn_cvt_pk_fp8_f32(a, b, 0, false); w = __builtin_amdgcn_cvt_pk_fp8_f32(c, d, w, true); return (unsigned)w; }
__device__ __forceinline__ float bf2f(unsigned b) { return __builtin_bit_cast(float, b << 16); }
__device__ __forceinline__ float bflo(unsigned w) { return __builtin_bit_cast(float, w << 16); }
__device__ __forceinline__ float bfhi(unsigned w) { return __builtin_bit_cast(float, w & 0xffff0000u); }
__device__ __forceinline__ float silu_f(float v) { return v * __builtin_amdgcn_rcpf(1.0f + __expf(-v)); }
__device__ __forceinline__ float rstd_of(float ss) { return __builtin_amdgcn_rsqf(ss * (1.0f / 1024.0f) + EPS); }
__device__ __forceinline__ float rstd_row(const float* rssp, int t) {
    const f32x4* q = (const f32x4*)(rssp + (size_t)t * 16); const f32x4 a = q[0], b = q[1], c = q[2], d = q[3];
    const float s = (((a.x + a.y) + (a.z + a.w)) + ((b.x + b.y) + (b.z + b.w))) + (((c.x + c.y) + (c.z + c.w)) + ((d.x + d.y) + (d.z + d.w)));
    return __builtin_amdgcn_rsqf(s * (1.0f / 1024.0f) + EPS);
}
__device__ __forceinline__ float wave_sum(float v) {
#pragma unroll
    for (int o = 1; o < 64; o <<= 1) v += __shfl_xor(v, o);
    return v;
}
__device__ __forceinline__ float ldv_f(const float* p) { return __builtin_bit_cast(float, __hip_atomic_load((const unsigned*)p, __ATOMIC_RELAXED, __HIP_MEMORY_SCOPE_AGENT)); }
__device__ __forceinline__ int ldv_i(const int* p) { return __hip_atomic_load(p, __ATOMIC_RELAXED, __HIP_MEMORY_SCOPE_AGENT); }
__device__ __forceinline__ float bias_sum(const float* b, int idx, int s1, int s2) { return (ldv_f(b + idx) + ldv_f(b + s1 + idx)) + (ldv_f(b + s2 + idx) + ldv_f(b + s2 + s1 + idx)); }
__device__ __forceinline__ void rstd_row_ld(const float* rssp, int t, float (&r)[16]) { const f32x4* q = (const f32x4*)(rssp + (size_t)t * 16);
#pragma unroll
    for (int i = 0; i < 4; ++i) { const f32x4 v = q[i]; r[4 * i] = v.x; r[4 * i + 1] = v.y; r[4 * i + 2] = v.z; r[4 * i + 3] = v.w; } }
__device__ __forceinline__ float rstd_row_fin(const float (&r)[16]) {
    const float s = (((r[0] + r[1]) + (r[2] + r[3])) + ((r[4] + r[5]) + (r[6] + r[7]))) + (((r[8] + r[9]) + (r[10] + r[11])) + ((r[12] + r[13]) + (r[14] + r[15])));
    return __builtin_amdgcn_rsqf(s * (1.0f / 1024.0f) + EPS); }
__device__ __forceinline__ void bias_sum_ld(const float* b, int idx, int s1, int s2, float (&r)[16]) { r[0] = ldv_f(b + idx); r[1] = ldv_f(b + s1 + idx); r[2] = ldv_f(b + s2 + idx); r[3] = ldv_f(b + s2 + s1 + idx); }
__device__ __forceinline__ float bias_sum_fin(const float (&r)[16]) { return (r[0] + r[1]) + (r[2] + r[3]); }

__device__ __forceinline__ int lane_id() { int l; asm volatile("v_mbcnt_lo_u32_b32 %0, -1, 0\n\tv_mbcnt_hi_u32_b32 %0, -1, %0" : "=v"(l)); return l; }

struct Unit { const bf16_t* A; const bf16_t* B; int pm, pn, aux, rowbase, nt; };

__device__ __forceinline__ void tile_order(int L, int nM, int nN, int& pm, int& pn) {
    const int nwg = nM * nN; int wgid = L;
    { const int q = nwg / 8, r = nwg % 8, xcd = wgid % 8, off = wgid / 8; wgid = (xcd < r ? xcd * (q + 1) : r * (q + 1) + (xcd - r) * q) + off; }
    const int nig = 8 * nN, gid = wgid / nig, fm = gid * 8, gsz = (nM - fm) < 8 ? (nM - fm) : 8;
    pm = fm + ((wgid % nig) % gsz); pn = (wgid % nig) / gsz;
}

template <bool GATE> struct DescG1a {
    static constexpr bool GATHER = false; static constexpr bool FP8 = false;
    const bf16_t* xb; const bf16_t* win; const int* tok; int lda, ldb, nt, ksa, ksb;
    __device__ __forceinline__ bool get(int L, Unit& u) const {
        if (L >= 64 * 8) return false; tile_order(L, 64, 8, u.pm, u.pn); if (GATE) u.pn += 8;
        const int wrow = u.pn < 8 ? u.pn * 256 : (u.pn + 8) * 256;
        u.A = xb + (size_t)u.pm * 256 * 1024; u.B = win + (size_t)wrow * 1024; u.aux = wrow; u.rowbase = u.pm * 256; u.nt = nt; return true; }
};
struct DescG1b {
    static constexpr bool GATHER = false; static constexpr bool FP8 = false;
    const bf16_t* xb; const bf16_t* win; const int* tok; int lda, ldb, nt, ksa, ksb;
    __device__ __forceinline__ bool get(int L, Unit& u) const {
        if (L >= 8 * 64) return false; tile_order(L, 8, 64, u.pm, u.pn); u.pm += 4;
        u.A = win + (size_t)(1024 + 256 * u.pm) * 1024; u.B = xb + (size_t)u.pn * 256 * 1024; u.aux = 0; u.rowbase = 0; u.nt = nt; return true; }
};
struct DescKV {
    static constexpr bool GATHER = false; static constexpr bool FP8 = false;
    const bf16_t* vt; const bf16_t* kdt; const int* tok; int lda, ldb, nt, ksa, ksb;
    __device__ __forceinline__ bool get(int L, Unit& u) const {
        if (L >= 127 * 8) return false; const int mt = L & 1, h = (L >> 1) & 3, n = L >> 3;
        u.A = vt + (size_t)(h * 512 + 256 * mt) * T + n * 128; u.B = kdt + (size_t)(h * 256) * T + n * 128;
        u.pm = mt; u.pn = 0; u.aux = (n * 4 + h) * 2 + mt; u.rowbase = 0; u.nt = nt; return true; }
};
struct DescOut {
    static constexpr bool GATHER = false; static constexpr bool FP8 = false;
    const bf16_t* y; const bf16_t* w; const int* tok; int lda, ldb, nt, ksa, ksb;
    __device__ __forceinline__ bool get(int L, Unit& u) const {
        if (L >= 256) return false; tile_order(L, 64, 4, u.pm, u.pn);
        u.A = y + (size_t)u.pm * 256 * 2048; u.B = w + (size_t)u.pn * 256 * 2048; u.aux = 0; u.rowbase = u.pm * 256; u.nt = nt; return true; }
};
struct DescFfnUp {
    static constexpr bool GATHER = false; static constexpr bool FP8 = false;
    const bf16_t* xb; const bf16_t* w; const int* tok; int lda, ldb, nt, ksa, ksb;
    __device__ __forceinline__ bool get(int L, Unit& u) const {
        if (L >= 64 * 22) return false; tile_order(L, 64, 22, u.pm, u.pn);
        u.A = xb + (size_t)u.pm * 256 * 1024; u.B = w + (size_t)u.pn * 256 * 1024; u.aux = 256 * u.pn; u.rowbase = u.pm * 256; u.nt = nt; return true; }
};
struct DescFfnDown {
    static constexpr bool GATHER = false; static constexpr bool FP8 = true;
    const bf16_t* h1; const bf16_t* w; const int* tok; int lda, ldb, nt, ksa, ksb;
    __device__ __forceinline__ bool get(int L, Unit& u) const {
        if (L >= 256) return false; tile_order(L, 64, 4, u.pm, u.pn);
        u.A = h1 + (size_t)u.pm * 128 * DFF; u.B = w + (size_t)u.pn * 128 * DFF; u.aux = 0; u.rowbase = u.pm * 256; u.nt = nt; return true; }
};
struct DescMoeUp {
    static constexpr bool GATHER = true; static constexpr bool FP8 = true;
    const bf16_t* xb; const bf16_t* w; const int* tok; int lda, ldb, nt, ksa, ksb; const int* blke;
    __device__ __forceinline__ bool get(int L, Unit& u) const {
        const int nused = ldv_i(blke + NBLK); if (L >= nused * 28) return false; tile_order(L, nused, 28, u.pm, u.pn);
        const int e = ldv_i(blke + u.pm);
        u.A = xb; u.B = w + (size_t)(e * 7168 + 256 * u.pn) * 512; u.aux = e * 7168 + 256 * u.pn; u.rowbase = u.pm * 256; u.nt = nt; return true; }
};
__device__ __forceinline__ int moe_tail_spu(int ntail) { const int q = 256 / ntail; return q >= 14 ? 14 : 7; }
struct DescMoeDown {
    static constexpr bool GATHER = false; static constexpr bool FP8 = true;
    const bf16_t* h1; const bf16_t* w; const int* tok; int lda, ldb, nt, ksa, ksb; const int* blke; int G;
    __device__ __forceinline__ bool get(int L, Unit& u) const {
        const int nused = ldv_i(blke + NBLK); int k0 = 0, npair = 14; u.aux = 0;
        if (G != 256) { if (L >= nused * 4) return false; tile_order(L, nused, 4, u.pm, u.pn); }
        else { const int i = L >> 8, c = L & 255;
            if (i < 2) { const int x = c & 7, j = c >> 3; u.pm = (i * 8 + x) * 8 + (j & 7); u.pn = j >> 3; }
            else { const int ntail = (nused - 128) * 4; if (i > 2 || ntail <= 0) return false; const int spu = moe_tail_spu(ntail); if (c >= ntail * spu) return false;
                const int ut = c / spu, sl = c - ut * spu; u.pm = 128 + (ut >> 2); u.pn = ut & 3; npair = 14 / spu; k0 = sl * npair; u.aux = 1 + c; } }
        const int e = ldv_i(blke + u.pm);
        u.A = h1 + (size_t)u.pm * 128 * DFE + (size_t)k0 * 2 * 16384; u.B = w + (size_t)(e * 4 + u.pn) * 128 * DFE + (size_t)k0 * 2 * 16384;
        u.rowbase = u.pm * 256; u.nt = 2 * npair; return true; }
};

typedef f32x4 Acc[2][2][4][2];

__device__ __forceinline__ void store8bf(bf16_t* p, const float* v) {
    u32x4 w; w.x = pk2(v[0], v[1]); w.y = pk2(v[2], v[3]); w.z = pk2(v[4], v[5]); w.w = pk2(v[6], v[7]); *(u32x4*)p = w; }

template <bool GATE> struct EpiG1a {
    static constexpr bool PERM = true;
    const float* rowss; const float* bias; const f32x2* taba; const f32x2* tabb; bf16_t* Q; bf16_t* KN; bf16_t* Gb; const float* gp; bf16_t* KDT;
    __device__ __forceinline__ void pre_load(const Unit& u, int tid, float (&r)[16]) const { if (tid < 256) r[0] = ldv_f(rowss + (size_t)(u.pm * 256 + tid) * 16); else bias_sum_ld(bias, u.aux + tid - 256, NIN, 2 * NIN, r); }
    __device__ __forceinline__ void pre_store(const Unit&, LAS float* aux, int tid, const float (&r)[16]) const { aux[tid] = tid < 256 ? rstd_of(r[0]) : bias_sum_fin(r); }
    __device__ __forceinline__ void init(LAS float* auxb, int tid) const {
        if (!GATE && tid < 256) { const float v = ((const float*)tabb)[16 * 256 + tid]; auxb[512 + tid] = v; auxb[768 + 512 + tid] = v; } }
    __device__ __forceinline__ void operator()(const Acc& acc, const Unit& u, int wr, int wc, int fr, int fq, const LAS float* aux) const {
        asm volatile("" : "+v"(fr), "+v"(fq));
        const int pn = u.pn, d0 = wc * 32 + 8 * fq;
        float b[2][8];
#pragma unroll
        for (int bj = 0; bj < 2; ++bj) { const f32x4 x = *(const LAS f32x4*)(aux + 256 + 128 * bj + d0), y = *(const LAS f32x4*)(aux + 256 + 128 * bj + d0 + 4);
            b[bj][0] = x.x; b[bj][1] = x.y; b[bj][2] = x.z; b[bj][3] = x.w; b[bj][4] = y.x; b[bj][5] = y.y; b[bj][6] = y.z; b[bj][7] = y.w; }
        if constexpr (!GATE) {
            bf16_t* O = pn < 4 ? Q : KN; const int hcol = (pn & 3) * 256;
            f32x2 ta[8], tn[8], tb[8]; float dec[4];
            { const f32x2* tp0 = taba + (2 * u.pm) * 128 + d0; const f32x2* tpb = tabb + (64 * wr + fr) * 128 + d0;
#pragma unroll
              for (int q = 0; q < 8; ++q) { ta[q] = tp0[q]; tb[q] = tpb[q]; }
#pragma unroll
              for (int m = 0; m < 4; ++m) dec[m] = pn >= 4 ? gp[(pn - 4) * 132 + 127 - (64 * wr + 16 * m + fr)] : 0.f; }
#pragma unroll
            for (int it = 0; it < 8; ++it) {
                const int ai = it >> 2, m = ai ? 3 - (it & 3) : (it & 3);
                if (it == 2) { const f32x2* tp1 = taba + (2 * u.pm + 1) * 128 + d0;
#pragma unroll
                    for (int q = 0; q < 8; ++q) tn[q] = tp1[q]; }
                if (it == 4) {
#pragma unroll
                    for (int q = 0; q < 8; ++q) ta[q] = tn[q]; }
                if ((it & 3) != 0) {
                    const float sg = ai ? -1.0f : 1.0f; int dl = 2 * d0; asm volatile("" : "+v"(dl));
#pragma unroll
                    for (int q2 = 0; q2 < 4; ++q2) { const f32x4 R2 = *(const LAS f32x4*)(aux + 512 + dl + 4 * q2);
                        { const f32x2 B = tb[2 * q2]; const float ry = sg * R2.y; tb[2 * q2].x = B.x * R2.x - B.y * ry; tb[2 * q2].y = B.y * R2.x + B.x * ry; }
                        { const f32x2 B = tb[2 * q2 + 1]; const float rw = sg * R2.w; tb[2 * q2 + 1].x = B.x * R2.z - B.y * rw; tb[2 * q2 + 1].y = B.y * R2.z + B.x * rw; } } }
                const int rl = 128 * ai + 64 * wr + 16 * m + fr, t = u.pm * 256 + rl; const float rs = aux[rl];
                float o1[8], o2[8];
#pragma unroll
                for (int q = 0; q < 8; ++q) {
                    const f32x2 A = ta[q], B = tb[q]; const float cs = A.x * B.x - A.y * B.y, sn = A.y * B.x + A.x * B.y;
                    const float v1 = rs * acc[ai][0][m][q >> 2][q & 3] + b[0][q], v2 = rs * acc[ai][1][m][q >> 2][q & 3] + b[1][q];
                    o1[q] = v1 * cs - v2 * sn; o2[q] = v1 * sn + v2 * cs; }
                store8bf(O + (size_t)t * 1024 + hcol + d0, o1); store8bf(O + (size_t)t * 1024 + hcol + 128 + d0, o2);
                if (pn >= 4) {
                    bf16_t* kd = KDT + (size_t)(hcol + d0) * T + t;
#pragma unroll
                    for (int q = 0; q < 8; ++q) { kd[(size_t)q * T] = (bf16_t)(pk2(o1[q] * dec[m], 0.f) & 0xffffu); kd[(size_t)(128 + q) * T] = (bf16_t)(pk2(o2[q] * dec[m], 0.f) & 0xffffu); } }
            }
        } else {
#pragma unroll
            for (int ai = 0; ai < 2; ++ai)
#pragma unroll
                for (int m = 0; m < 4; ++m) {
                    const int rl = 128 * ai + 64 * wr + 16 * m + fr, t = u.pm * 256 + rl; const float rs = aux[rl];
#pragma unroll
                    for (int bj = 0; bj < 2; ++bj) { float o[8];
#pragma unroll
                        for (int q = 0; q < 8; ++q) o[q] = silu_f(rs * acc[ai][bj][m][q >> 2][q & 3] + b[bj][q]);
                        store8bf(Gb + (size_t)t * 2048 + (pn - 8) * 256 + 128 * bj + d0, o); }
                }
        }
    }
};
struct EpiG1b {
    static constexpr bool PERM = true;
    const float* rowss; const float* bias; const f32x2* taba; const f32x2* tabb; const float* gp; bf16_t* KDT; bf16_t* VT;
    __device__ __forceinline__ void pre_load(const Unit& u, int tid, float (&r)[16]) const { if (tid < 256) bias_sum_ld(bias, 1024 + 256 * u.pm + tid, NIN, 2 * NIN, r); else r[0] = ldv_f(rowss + (size_t)(u.pn * 256 + tid - 256) * 16); }
    __device__ __forceinline__ void pre_store(const Unit&, LAS float* aux, int tid, const float (&r)[16]) const { aux[tid] = tid < 256 ? bias_sum_fin(r) : rstd_of(r[0]); }
    __device__ __forceinline__ void init(LAS float*, int) const {}
    __device__ __forceinline__ void operator()(const Acc& acc, const Unit& u, int wr, int wc, int fr, int fq, const LAS float* aux) const {
        asm volatile("" : "+v"(fr), "+v"(fq));
        const int pmf = u.pm, tl0 = 32 * wc + 8 * fq, tk0 = u.pn * 256 + tl0;
        float rs[2][8];
#pragma unroll
        for (int bj = 0; bj < 2; ++bj) { const f32x4 x = *(const LAS f32x4*)(aux + 256 + 128 * bj + tl0), y = *(const LAS f32x4*)(aux + 256 + 128 * bj + tl0 + 4);
            rs[bj][0] = x.x; rs[bj][1] = x.y; rs[bj][2] = x.z; rs[bj][3] = x.w; rs[bj][4] = y.x; rs[bj][5] = y.y; rs[bj][6] = y.z; rs[bj][7] = y.w; }
        if (pmf < 4) {
            const int h = pmf;
#pragma unroll
            for (int m = 0; m < 4; ++m) {
                const int d = 64 * wr + 16 * m + fr; const float b1 = aux[d], b2 = aux[128 + d];
#pragma unroll
                for (int bj = 0; bj < 2; ++bj) { float o1[8], o2[8]; const f32x2 A = taba[(2 * u.pn + bj) * 128 + d]; const float4 dq0 = *(const float4*)(gp + h * 132 + 120 - tl0), dq1 = *(const float4*)(gp + h * 132 + 124 - tl0);
                    const float decs[8] = {dq1.w, dq1.z, dq1.y, dq1.x, dq0.w, dq0.z, dq0.y, dq0.x};
#pragma unroll
                    for (int q = 0; q < 8; ++q) { const f32x2 B = tabb[(tl0 + q) * 128 + d]; const float cs = A.x * B.x - A.y * B.y, sn = A.y * B.x + A.x * B.y;
                        const float v1 = rs[bj][q] * acc[0][bj][m][q >> 2][q & 3] + b1, v2 = rs[bj][q] * acc[1][bj][m][q >> 2][q & 3] + b2;
                        o1[q] = (v1 * cs - v2 * sn) * decs[q]; o2[q] = (v1 * sn + v2 * cs) * decs[q]; }
                    store8bf(KDT + (size_t)(256 * h + d) * T + tk0 + 128 * bj, o1); store8bf(KDT + (size_t)(256 * h + 128 + d) * T + tk0 + 128 * bj, o2); }
            }
        } else {
#pragma unroll
            for (int ai = 0; ai < 2; ++ai)
#pragma unroll
                for (int m = 0; m < 4; ++m) {
                    const int rl = 128 * ai + 64 * wr + 16 * m + fr, f = 256 * (pmf - 4) + rl; const float bs = aux[rl];
#pragma unroll
                    for (int bj = 0; bj < 2; ++bj) { float o[8];
#pragma unroll
                        for (int q = 0; q < 8; ++q) o[q] = rs[bj][q] * acc[ai][bj][m][q >> 2][q & 3] + bs;
                        store8bf(VT + (size_t)f * T + tk0 + 128 * bj, o); }
                }
        }
    }
};
struct EpiKV {
    static constexpr bool PERM = true;
    bf16_t* SB;
    __device__ __forceinline__ void pre_load(const Unit&, int, float (&)[16]) const {}
    __device__ __forceinline__ void pre_store(const Unit&, LAS float*, int, const float (&)[16]) const {}
    __device__ __forceinline__ void init(LAS float*, int) const {}
    __device__ __forceinline__ void operator()(const Acc& acc, const Unit& u, int wr, int wc, int fr, int fq, const LAS float*) const {
        asm volatile("" : "+v"(fr), "+v"(fq));
        const int mt = u.aux & 1, nh = u.aux >> 1; bf16_t* base = SB + ((size_t)nh * 512 + 256 * mt) * 256; const int d0 = wc * 32 + 8 * fq;
#pragma unroll
        for (int ai = 0; ai < 2; ++ai)
#pragma unroll
            for (int m = 0; m < 4; ++m) { const int r = 128 * ai + 64 * wr + 16 * m + fr;
#pragma unroll
                for (int bj = 0; bj < 2; ++bj) { float o[8];
#pragma unroll
                    for (int q = 0; q < 8; ++q) o[q] = acc[ai][bj][m][q >> 2][q & 3];
                    store8bf(base + (size_t)r * 256 + 128 * bj + d0, o); } }
    }
};
struct EpiResid {
    static constexpr bool PERM = false;
    const float* base; float* out; bf16_t* xb; float* rowss; const float* g; const float* cb; const float* cs; float accscale;
    __device__ __forceinline__ void pre_load(const Unit& u, int tid, float (&r)[16]) const {
        if (tid < 256) { const int c = 256 * u.pn + tid; r[0] = ldv_f(g + c); r[1] = cs ? cs[c] : 1.0f; } else { const int c = 256 * u.pn + tid - 256; r[0] = cb ? cb[c] : 0.f; r[1] = 1.0f; } }
    __device__ __forceinline__ void pre_store(const Unit&, LAS float* aux, int tid, const float (&r)[16]) const { aux[256 + tid] = r[0] * r[1] * (tid < 256 ? accscale : 1.0f); }
    __device__ __forceinline__ void init(LAS float*, int) const {}
    __device__ __forceinline__ void operator()(const Acc& acc, const Unit& u, int wr, int wc, int fr, int fq, const LAS float* aux) const {
        asm volatile("" : "+v"(fr), "+v"(fq));
        const int cl0 = 32 * wc + 4 * fq, col0 = 256 * u.pn + cl0;
        f32x4 gv[2][2], cbv[2][2];
#pragma unroll
        for (int bj = 0; bj < 2; ++bj)
#pragma unroll
            for (int n = 0; n < 2; ++n) { gv[bj][n] = *(const LAS f32x4*)(aux + 256 + cl0 + 128 * bj + 16 * n); cbv[bj][n] = *(const LAS f32x4*)(aux + 512 + cl0 + 128 * bj + 16 * n); }
        f32x4 bsv[2][4];
        const size_t o0 = (size_t)(u.pm * 256 + 64 * wr + fr) * 1024 + col0;
#pragma unroll
        for (int j = 0; j < 4; ++j) bsv[0][j] = *(const f32x4*)(base + o0 + 128 * (j >> 1) + 16 * (j & 1));
#pragma unroll
        for (int it = 0; it < 8; ++it) { const int ai = it >> 2, m = it & 3; const int t = u.pm * 256 + 128 * ai + 64 * wr + 16 * m + fr; float s = 0.f;
            if (it < 7) { const int ai2 = (it + 1) >> 2, m2 = (it + 1) & 3; const size_t o2 = o0 + (size_t)(128 * ai2 + 16 * m2) * 1024;
#pragma unroll
                for (int j = 0; j < 4; ++j) bsv[(it + 1) & 1][j] = *(const f32x4*)(base + o2 + 128 * (j >> 1) + 16 * (j & 1)); }
#pragma unroll
            for (int bj = 0; bj < 2; ++bj)
#pragma unroll
                for (int n = 0; n < 2; ++n) { const size_t o = (size_t)t * 1024 + col0 + 128 * bj + 16 * n;
                    const f32x4 xo = bsv[it & 1][2 * bj + n] + (acc[ai][bj][m][n] + cbv[bj][n]) * gv[bj][n];
                    *(f32x4*)(out + o) = xo; s += (xo.x * xo.x + xo.y * xo.y) + (xo.z * xo.z + xo.w * xo.w);
                    if (xb) { u32x2 w; w.x = pk2(xo.x, xo.y); w.y = pk2(xo.z, xo.w); *(u32x2*)(xb + o) = w; } }
            s += __shfl_xor(s, 16); s += __shfl_xor(s, 32);
            if (fq == 0) rowss[(size_t)t * 16 + u.pn * 4 + wc] = s; }
    }
};
template <bool TILED, bool F8OUT = false> struct EpiSwiglu {
    static constexpr bool PERM = true;
    const float* rowss; const float* rowrs; const float* bias; bf16_t* Hout; int ldh, bs1, bs2;
    __device__ __forceinline__ void pre_load(const Unit& u, int tid, float (&r)[16]) const {
        if (tid < 256) { if (rowrs) r[0] = ldv_f(rowrs + u.rowbase + tid); else rstd_row_ld(rowss, u.rowbase + tid, r); } else bias_sum_ld(bias, u.aux + tid - 256, bs1, bs2, r); }
    __device__ __forceinline__ void pre_store(const Unit&, LAS float* aux, int tid, const float (&r)[16]) const { aux[tid] = tid < 256 ? (rowrs ? r[0] : rstd_row_fin(r)) : bias_sum_fin(r); }
    __device__ __forceinline__ void init(LAS float*, int) const {}
    __device__ __forceinline__ void operator()(const Acc& acc, const Unit& u, int wr, int wc, int fr, int fq, const LAS float* aux) const {
        asm volatile("" : "+v"(fr), "+v"(fq));
        const int d0 = wc * 32 + 8 * fq; float bg[8], bu[8];
        { const f32x4 x = *(const LAS f32x4*)(aux + 256 + d0), y = *(const LAS f32x4*)(aux + 256 + d0 + 4), z = *(const LAS f32x4*)(aux + 384 + d0), w = *(const LAS f32x4*)(aux + 384 + d0 + 4);
          bg[0] = x.x; bg[1] = x.y; bg[2] = x.z; bg[3] = x.w; bg[4] = y.x; bg[5] = y.y; bg[6] = y.z; bg[7] = y.w; bu[0] = z.x; bu[1] = z.y; bu[2] = z.z; bu[3] = z.w; bu[4] = w.x; bu[5] = w.y; bu[6] = w.z; bu[7] = w.w; }
        constexpr float KG = -1.4426950408889634f, KU = -0.6931471805599453f * (F8OUT ? F8_HSCALE : 1.0f);
#pragma unroll
        for (int q = 0; q < 8; ++q) { bg[q] *= KG; bu[q] *= KU; }
#pragma unroll
        for (int ai = 0; ai < 2; ++ai)
#pragma unroll
            for (int m = 0; m < 4; ++m) { const int rl = 128 * ai + 64 * wr + 16 * m + fr, row = u.rowbase + rl; const float rs = aux[rl], rsg = rs * KG, rsu = rs * KU; float o[8];
#pragma unroll
                for (int q = 0; q < 8; ++q) {
                    const float x = rsg * acc[ai][0][m][q >> 2][q & 3] + bg[q], y = rsu * acc[ai][1][m][q >> 2][q & 3] + bu[q];
                    o[q] = (x * __builtin_amdgcn_rcpf(1.0f + __builtin_amdgcn_exp2f(x))) * y; }
                if constexpr (F8OUT) {
#pragma unroll
                    for (int q = 0; q < 8; ++q) o[q] = __builtin_amdgcn_fmed3f(o[q], -448.0f, 448.0f);
                    u32x2 w8; w8.x = pk4f8(o[0], o[1], o[2], o[3]); w8.y = pk4f8(o[4], o[5], o[6], o[7]);
                    if (TILED) *(u32x2*)((unsigned char*)Hout + (((size_t)(row >> 8) * (ldh >> 7) + u.pn) * 256 + (row & 255)) * 128 + d0) = w8;
                    else *(u32x2*)((unsigned char*)Hout + (size_t)row * ldh + 128 * u.pn + d0) = w8; }
                else if (TILED) store8bf(Hout + (((size_t)(row >> 8) * (ldh >> 6) + 2 * u.pn + (d0 >> 6)) * 256 + (row & 255)) * 64 + (d0 & 63), o);
                else store8bf(Hout + (size_t)row * ldh + 128 * u.pn + d0, o); }
    }
};
struct EpiMoeDown {
    static constexpr bool PERM = true;
    const float* gate; bf16_t* YB; float* YBB;
    __device__ __forceinline__ void pre_load(const Unit& u, int tid, float (&r)[16]) const { if (tid < 256) r[0] = ldv_f(gate + u.rowbase + tid); }
    __device__ __forceinline__ void pre_store(const Unit&, LAS float* aux, int tid, const float (&r)[16]) const { if (tid < 256) aux[tid] = r[0] * (1.0f / (F8_DSCALE * F8_HSCALE)); }
    __device__ __forceinline__ void init(LAS float*, int) const {}
    __device__ __forceinline__ void operator()(const Acc& acc, const Unit& u, int wr, int wc, int fr, int fq, const LAS float* aux) const {
        asm volatile("" : "+v"(fr), "+v"(fq));
        const int col0 = 256 * u.pn + 32 * wc + 8 * fq;
#pragma unroll
        for (int ai = 0; ai < 2; ++ai)
#pragma unroll
            for (int m = 0; m < 4; ++m) { const int rl = 128 * ai + 64 * wr + 16 * m + fr, row = u.rowbase + rl; const float gt = aux[rl];
#pragma unroll
                for (int bj = 0; bj < 2; ++bj) {
                    if (u.aux == 0) { float o[8];
#pragma unroll
                        for (int q = 0; q < 8; ++q) o[q] = acc[ai][bj][m][q >> 2][q & 3] * gt;
                        store8bf(YB + (size_t)row * 1024 + col0 + 128 * bj, o); }
                    else { float* d = YBB + (size_t)(u.aux - 1) * 65536 + (size_t)rl * 256 + 32 * wc + 8 * fq + 128 * bj;
                        *(f32x4*)d = acc[ai][bj][m][0] * gt; *(f32x4*)(d + 4) = acc[ai][bj][m][1] * gt; } } }
    }
};

namespace pg8 {
constexpr int BM = 256, BK = 64, HALF = 128, HTB = HALF * BK * 2, STAGE_BYTES = 8 * HTB;
__device__ __forceinline__ int lds_byte(int r, int c) { const int st = (r >> 4) * 2 + (c >> 5), rr = r & 15, cc = c & 31, ob = rr * 64 + cc * 2; return st * 1024 + (ob ^ (((ob >> 9) & 1) << 5)); }
__device__ __forceinline__ void stage_rc(int b, int& R, int& C) { const int st = b / 1024, sb = b % 1024, swz = sb ^ (((sb >> 9) & 1) << 5); R = (st >> 1) * 16 + swz / 64; C = (st & 1) * 32 + (swz % 64) / 2; }
__device__ __forceinline__ int perm32(int rho) { const int n = rho >> 4, i = rho & 15; return 8 * (i >> 2) + 4 * n + (i & 3); }
}
typedef int i32x8 __attribute__((ext_vector_type(8)));
__device__ __forceinline__ void mfma_f8_inplace(f32x4& acc, const i32x8 a, const i32x8 b, int sc) {
    asm volatile("v_mfma_scale_f32_16x16x128_f8f6f4 %0, %1, %2, %0, %3, %3 op_sel_hi:[0,0,0]" : "+v"(acc) : "v"(a), "v"(b), "v"(sc)); }
template <class Desc, class Epi>
__device__ __forceinline__ void gemm_fast(LAS unsigned char* lds, const unsigned char* wsb, const Desc& Dc, const Epi& E, int c, int G, int wave_id) {
    using namespace pg8;
    constexpr bool GATHER = Desc::GATHER; constexpr bool FP8 = Desc::FP8;
    int lane_ = lane_id(); asm volatile("" : "+v"(lane_));
    const int wid = wave_id, lane = lane_, tid = wid * 64 + lane, wr = wid >> 2, wc = wid & 3, fr = lane & 15, fq = lane >> 4;
    unsigned vA[2][2], vAn[2][2], vB[2][2];
#pragma unroll
    for (int i = 0; i < 2; ++i) { int R, C; stage_rc(tid * 16 + i * 8192, R, C); const int Rb = Epi::PERM ? ((R & ~31) + perm32(R & 31)) : R;
#pragma unroll
        for (int h = 0; h < 2; ++h) { vA[h][i] = (unsigned)((h * HALF + R) * Dc.lda + C) * 2u; vB[h][i] = (unsigned)((h * HALF + Rb) * Dc.ldb + C) * 2u; vAn[h][i] = vA[h][i]; } }
    const unsigned ksA = (unsigned)Dc.ksa, ksB = (unsigned)Dc.ksb;
    const __amdgpu_buffer_rsrc_t rs = __builtin_amdgcn_make_buffer_rsrc((void*)wsb, (short)0, 0x7fffffff, 0x00020000);
    const unsigned ldsw = (unsigned)wid * 1024u;
    const int aoff = lds_byte(wr * 64 + fr, fq * 8), boff = lds_byte(wc * 32 + fr, fq * 8);
#define PG8_SA(b, h) (((b) * 2 + (h)) * HTB)
#define PG8_SB(b, h) ((4 + (b) * 2 + (h)) * HTB)
#define PG8_STAGE(bufoff, gbase, voff) do { _Pragma("unroll") for (int _i = 0; _i < 2; ++_i) \
        __builtin_amdgcn_raw_ptr_buffer_load_lds(rs, (LAS unsigned*)(lds + (bufoff) + ldsw + _i * 8192), 16, (int)(voff)[_i], (int)(gbase), 0, 0); } while (0)
#define PG8_LDA(dst, b, h) do { _Pragma("unroll") for (int m = 0; m < 4; ++m) _Pragma("unroll") for (int k = 0; k < 2; ++k) dst[m][k] = *(const LAS bf16x8*)(lds + PG8_SA(b, h) + aoff + m * 2048 + k * 1024); } while (0)
#define PG8_LDB(dst, b, h) do { _Pragma("unroll") for (int n = 0; n < 2; ++n) _Pragma("unroll") for (int k = 0; k < 2; ++k) dst[n][k] = *(const LAS bf16x8*)(lds + PG8_SB(b, h) + boff + n * 2048 + k * 1024); } while (0)
#define PG8_CAT(x) __builtin_shufflevector(__builtin_bit_cast(i32x4, x[0]), __builtin_bit_cast(i32x4, x[1]), 0, 1, 2, 3, 4, 5, 6, 7)
#define PG8_MMA(ai, bj, At, Bt) do { __builtin_amdgcn_s_setprio(1); if constexpr (FP8) { _Pragma("unroll") for (int m = 0; m < 4; ++m) _Pragma("unroll") for (int n = 0; n < 2; ++n) \
        mfma_f8_inplace(acc[ai][bj][m][n], PG8_CAT(Bt[n]), PG8_CAT(At[m]), f8sc); } else { \
        _Pragma("unroll") for (int m = 0; m < 4; ++m) _Pragma("unroll") for (int n = 0; n < 2; ++n) _Pragma("unroll") for (int k = 0; k < 2; ++k) \
        acc[ai][bj][m][n] = __builtin_amdgcn_mfma_f32_16x16x32_bf16(Bt[n][k], At[m][k], acc[ai][bj][m][n], 0, 0, 0); } __builtin_amdgcn_s_setprio(0); } while (0)
#define PG8_WAIT_V(n) asm volatile("s_waitcnt vmcnt(" #n ")" ::: "memory")
#define PG8_WAIT_L(n) asm volatile("s_waitcnt lgkmcnt(" #n ")" ::: "memory")
#define PG8_BAR __builtin_amdgcn_s_barrier()
#define PG8_SCHED __builtin_amdgcn_sched_barrier(0)
#define PG8_GATHER_OFFS(dst, un) do { const int _t = wid * 64 + lane_id(); _Pragma("unroll") for (int _i = 0; _i < 2; ++_i) { int _R, _C; stage_rc(_t * 16 + _i * 8192, _R, _C); \
        _Pragma("unroll") for (int _h = 0; _h < 2; ++_h) dst[_h][_i] = (unsigned)(ldv_i(Dc.tok + (un).rowbase + _h * HALF + _R) * Dc.lda + _C) * 2u; } } while (0)
    int f8sc = 0x7f7f7f7f; asm volatile("" : "+v"(f8sc));
    Unit cur, nxt; int ui = 0;
    if (!Dc.get(c, cur)) return;
    LAS float* const auxb = (LAS float*)(lds + 131072 + 1024);
    E.init(auxb, tid);
    { float r0[16]; E.pre_load(cur, tid, r0); E.pre_store(cur, auxb, tid, r0); }
    Acc acc;
#pragma unroll
    for (int a = 0; a < 2; ++a)
#pragma unroll
        for (int b = 0; b < 2; ++b)
#pragma unroll
            for (int m = 0; m < 4; ++m)
#pragma unroll
                for (int n = 0; n < 2; ++n) acc[a][b][m][n] = (f32x4){0.f, 0.f, 0.f, 0.f};
    bf16x8 At[4][2], B0[2][2], B1[2][2];
    unsigned cA = (unsigned)((const unsigned char*)cur.A - wsb), cB = (unsigned)((const unsigned char*)cur.B - wsb);
    if constexpr (GATHER) { PG8_GATHER_OFFS(vA, cur); }
    PG8_STAGE(PG8_SB(0, 0), cB, vB[0]); PG8_STAGE(PG8_SB(0, 1), cB, vB[1]); PG8_STAGE(PG8_SA(0, 0), cA, vA[0]); PG8_STAGE(PG8_SA(0, 1), cA, vA[1]);
    if (wr == 1) PG8_BAR;
    PG8_WAIT_V(2); PG8_BAR;
    PG8_STAGE(PG8_SB(1, 0), cB + ksB, vB[0]); PG8_STAGE(PG8_SA(1, 0), cA + ksA, vA[0]); PG8_STAGE(PG8_SB(1, 1), cB + ksB, vB[1]);
    PG8_WAIT_V(6); PG8_BAR;
    for (;;) {
        const bool has_next = Dc.get((ui + 1) * G + c, nxt);
        const unsigned nA = has_next ? (unsigned)((const unsigned char*)nxt.A - wsb) : cA, nB = has_next ? (unsigned)((const unsigned char*)nxt.B - wsb) : cB;
        if constexpr (GATHER) { if (has_next) { PG8_GATHER_OFFS(vAn, nxt); } else {
#pragma unroll
            for (int h = 0; h < 2; ++h)
#pragma unroll
                for (int i = 0; i < 2; ++i) vAn[h][i] = vA[h][i]; } }
        const int nt = cur.nt;
        for (int t = 0; t < nt; t += 2) {
            const bool last = (t == nt - 2);
            const unsigned a1 = cA + (unsigned)(t + 1) * ksA;
            const unsigned a2 = last ? nA : cA + (unsigned)(t + 2) * ksA, b2 = last ? nB : cB + (unsigned)(t + 2) * ksB;
            const unsigned a3 = a2 + ksA, b3 = b2 + ksB;
            unsigned x0[2], x1[2];
#pragma unroll
            for (int i = 0; i < 2; ++i) { x0[i] = (GATHER && last) ? vAn[0][i] : vA[0][i]; x1[i] = (GATHER && last) ? vAn[1][i] : vA[1][i]; }
            PG8_LDB(B0, 0, 0); PG8_LDB(B1, 0, 1); PG8_SCHED; PG8_LDA(At, 0, 0); PG8_STAGE(PG8_SA(1, 1), a1, vA[1]);
            PG8_WAIT_V(8); PG8_WAIT_L(0); PG8_BAR; PG8_MMA(0, 0, At, B0); PG8_MMA(0, 1, At, B1); PG8_BAR; PG8_SCHED;
            PG8_LDA(At, 0, 1); PG8_STAGE(PG8_SB(0, 0), b2, vB[0]); PG8_STAGE(PG8_SB(0, 1), b2, vB[1]); PG8_STAGE(PG8_SA(0, 0), a2, x0);
            PG8_WAIT_V(8); PG8_WAIT_L(0); PG8_BAR; PG8_MMA(1, 0, At, B0); PG8_MMA(1, 1, At, B1); PG8_BAR; PG8_SCHED;
            PG8_LDB(B0, 1, 0); PG8_LDB(B1, 1, 1); PG8_SCHED; PG8_LDA(At, 1, 0); PG8_STAGE(PG8_SA(0, 1), a2, x1);
            PG8_WAIT_V(8); PG8_WAIT_L(0); PG8_BAR; PG8_MMA(0, 0, At, B0); PG8_MMA(0, 1, At, B1); PG8_BAR; PG8_SCHED;
            PG8_LDA(At, 1, 1); PG8_STAGE(PG8_SB(1, 0), b3, vB[0]); PG8_STAGE(PG8_SB(1, 1), b3, vB[1]); PG8_STAGE(PG8_SA(1, 0), a3, x0);
            PG8_WAIT_V(8); PG8_WAIT_L(0); PG8_BAR; PG8_MMA(1, 0, At, B0); PG8_MMA(1, 1, At, B1); PG8_BAR; PG8_SCHED;
        }
        if constexpr (FP8) asm volatile("s_nop 15\n\ts_nop 15\n\ts_nop 15\n\ts_nop 15\n\ts_nop 15" ::: "memory");
        if (wr == 0) PG8_BAR;
        { const int l2 = lane_id(); float rn[16];
          if (has_next) E.pre_load(nxt, wid * 64 + l2, rn);
          E(acc, cur, wr, wc, l2 & 15, l2 >> 4, auxb + (ui & 1) * 768);
          if (has_next) E.pre_store(nxt, auxb + ((ui + 1) & 1) * 768, wid * 64 + l2, rn); }
        if (!has_next) break;
#pragma unroll
        for (int a = 0; a < 2; ++a)
#pragma unroll
            for (int b = 0; b < 2; ++b)
#pragma unroll
                for (int m = 0; m < 4; ++m)
#pragma unroll
                    for (int n = 0; n < 2; ++n) acc[a][b][m][n] = (f32x4){0.f, 0.f, 0.f, 0.f};
        cur = nxt; cA = nA; cB = nB; ++ui;
        if constexpr (GATHER) {
#pragma unroll
            for (int h = 0; h < 2; ++h)
#pragma unroll
                for (int i = 0; i < 2; ++i) vA[h][i] = vAn[h][i]; }
        if (wr == 1) PG8_BAR;
    }
    PG8_WAIT_V(0);
    PG8_BAR;
#undef PG8_SA
#undef PG8_SB
#undef PG8_STAGE
#undef PG8_LDA
#undef PG8_LDB
#undef PG8_MMA
#undef PG8_CAT
#undef PG8_WAIT_V
#undef PG8_WAIT_L
#undef PG8_BAR
#undef PG8_SCHED
#undef PG8_GATHER_OFFS
}

struct Frame {
    Params p; unsigned char* ws; LAS unsigned char* lds; int tid, lane, wave, c, G;
    __device__ __forceinline__ float* MOD() const { return (float*)(ws + CT_MOD); }
    __device__ __forceinline__ float* BIAS_IN() const { return (float*)(ws + CT_BIAS_IN); }
    __device__ __forceinline__ float* BIAS_GU() const { return (float*)(ws + CT_BIAS_GU); }
    __device__ __forceinline__ float* BIAS_R() const { return (float*)(ws + CT_BIAS_R); }
    __device__ __forceinline__ float* BIAS_MGU() const { return (float*)(ws + CT_BIAS_MGU); }
    __device__ __forceinline__ float* ROWSS() const { return (float*)(ws + WS_ROWSSP); }
    __device__ __forceinline__ float* MODP() const { return (float*)(ws + WS_MODP); }
    __device__ __forceinline__ f32x2* TABA() const { return (f32x2*)(ws + WS_TABA); }
    __device__ __forceinline__ f32x2* TABB() const { return (f32x2*)(ws + WS_TABB); }
    __device__ __forceinline__ float* GP() const { return (float*)(ws + WS_GP); }
    __device__ __forceinline__ float* WR() const { return (float*)(ws + WS_WR); }
    __device__ __forceinline__ int* TOPE() const { return (int*)(ws + WS_TOPE); }
    __device__ __forceinline__ float* TOPG() const { return (float*)(ws + WS_TOPG); }
    __device__ __forceinline__ int* CNT() const { return (int*)(ws + WS_CNT); }
    __device__ __forceinline__ int* BUFTOK() const { return (int*)(ws + WS_BUFTOK); }
    __device__ __forceinline__ float* BUFGATE() const { return (float*)(ws + WS_BUFGATE); }
    __device__ __forceinline__ int* POS() const { return (int*)(ws + WS_POS); }
    __device__ __forceinline__ int* BLKE() const { return (int*)(ws + WS_BLKE); }
    __device__ __forceinline__ float* RSTD3() const { return (float*)(ws + WS_RSTD3); }
    __device__ __forceinline__ float* BUFRS() const { return (float*)(ws + WS_BUFRS); }
    __device__ __forceinline__ bf16_t* WIN() const { return (bf16_t*)(ws + WS_WIN); }
    __device__ __forceinline__ bf16_t* WOUT() const { return (bf16_t*)(ws + WS_WOUT); }
    __device__ __forceinline__ bf16_t* WGU() const { return (bf16_t*)(ws + WS_WGU); }
    __device__ __forceinline__ bf16_t* WD() const { return (bf16_t*)(ws + WS_WD); }
    __device__ __forceinline__ bf16_t* WP() const { return (bf16_t*)(ws + WS_WP); }
    __device__ __forceinline__ bf16_t* XB() const { return (bf16_t*)(ws + WS_XB); }
    __device__ __forceinline__ bf16_t* Q() const { return (bf16_t*)(ws + WS_Q); }
    __device__ __forceinline__ bf16_t* KN() const { return (bf16_t*)(ws + WS_KN); }
    __device__ __forceinline__ bf16_t* KDT() const { return (bf16_t*)(ws + WS_KDT); }
    __device__ __forceinline__ bf16_t* VT() const { return (bf16_t*)(ws + WS_VT); }
    __device__ __forceinline__ bf16_t* Gb() const { return (bf16_t*)(ws + WS_G); }
    __device__ __forceinline__ bf16_t* SB() const { return (bf16_t*)(ws + WS_SB); }
    __device__ __forceinline__ bf16_t* Y() const { return (bf16_t*)(ws + WS_Y); }
    __device__ __forceinline__ bf16_t* H1() const { return (bf16_t*)(ws + WS_H1); }
    __device__ __forceinline__ bf16_t* PB() const { return (bf16_t*)(ws + WS_PB); }
    __device__ __forceinline__ bf16_t* H1M() const { return (bf16_t*)(ws + WS_H1M); }
    __device__ __forceinline__ bf16_t* WMGU() const { return (bf16_t*)(ws + WS_WMGU); }
    __device__ __forceinline__ bf16_t* WMD() const { return (bf16_t*)(ws + WS_WMD); }
    __device__ __forceinline__ bf16_t* YB() const { return (bf16_t*)(ws + WS_YB); }
    __device__ __forceinline__ float* YBB() const { return (float*)(ws + WS_YBB); }
    __device__ __forceinline__ float* X2() const { return (float*)(ws + WS_X2); }
};
__device__ __forceinline__ void frame_fresh(Frame& F) { int l = lane_id(); asm volatile("" : "+v"(l)); F.lane = l; F.tid = F.wave * 64 + l; }
__device__ __forceinline__ void frame_init(Frame& F, const Params& p, LAS unsigned char* lds, int c, int G) {
    F.p = p; F.ws = p.ws; F.lds = lds; F.tid = threadIdx.x; F.lane = F.tid & 63; F.wave = __builtin_amdgcn_readfirstlane(F.tid >> 6); F.c = c; F.G = G;
}

__device__ __forceinline__ void dsincos(double x, double& s, double& c) {
    const double k = rint(x * 0.6366197723675814); double y = fma(-k, 1.5707963267948966, x); y = fma(-k, 6.123233995736766e-17, y);
    const double z = y * y;
    double sp = -7.6471637318198164759e-13; sp = fma(sp, z, 1.6059043836821614599e-10); sp = fma(sp, z, -2.5052108385441718775e-8); sp = fma(sp, z, 2.7557319223985890653e-6);
    sp = fma(sp, z, -1.9841269841269841270e-4); sp = fma(sp, z, 8.3333333333333333333e-3); sp = fma(sp, z, -1.6666666666666666667e-1); const double sy = fma(sp * z, y, y);
    double cp = 4.7794773323873852974e-14; cp = fma(cp, z, -1.1470745597729724714e-11); cp = fma(cp, z, 2.0876756987868098979e-9); cp = fma(cp, z, -2.7557319223985890653e-7);
    cp = fma(cp, z, 2.4801587301587301587e-5); cp = fma(cp, z, -1.3888888888888888889e-3); cp = fma(cp, z, 4.1666666666666666667e-2); cp = fma(cp, z, -0.5); const double cy = fma(cp, z, 1.0);
    const int q = ((int)k) & 3;
    s = (q == 0) ? sy : (q == 1) ? cy : (q == 2) ? -sy : -cy;
    c = (q == 0) ? cy : (q == 1) ? -sy : (q == 2) ? -cy : sy;
}
__device__ __forceinline__ void phase_p0(Frame& F) {
    const Params& p = F.p; const int gw = F.c * NWAVE + F.wave, NGW = F.G * NWAVE, lane = F.lane;
    LAS float* cact = (LAS float*)F.lds;
    __syncthreads();
    for (int k = F.tid; k < 1024; k += NTHR) cact[k] = silu_f(p.c[k]);
    __syncthreads();
    for (int task = gw; task < 1536; task += NGW) {
        const int i = task / 768, rem = task % 768, cb = rem >> 3, ks = rem & 7, n = cb * 64 + lane;
        const float* w = p.ada_w + (size_t)i * 1024 * NIN + (size_t)(ks * 128) * NIN + n; float a = 0.f;
#pragma unroll
        for (int k0 = 0; k0 < 128; k0 += 32) { float wv[32];
#pragma unroll
            for (int k = 0; k < 32; ++k) wv[k] = w[(size_t)(k0 + k) * NIN];
#pragma unroll
            for (int k = 0; k < 32; ++k) a = fmaf(cact[ks * 128 + k0 + k], wv[k], a); }
        if (ks == 0) a += p.ada_b[i * NIN + n];
        F.MODP()[ks * 12288 + i * NIN + n] = a;
    }
    const int gt = F.c * NTHR + F.tid, NGT = F.G * NTHR;
    for (int e = gt; e < 32768 + 4; e += NGT) {
        if (e < 32768) {
            const int which = e >> 14, ab = (e >> 7) & 127, i = e & 127; double inv = 1.0;
            for (int q = 0; q < i; ++q) inv *= 0.93057204092969897929;
            const double ang = (double)(which == 0 ? 128 * ab : ab) * inv; double s, c2; dsincos(ang, s, c2);
            (which == 0 ? F.TABA() : F.TABB())[ab * 128 + i] = (f32x2){(float)c2, (float)s};
        } else {
            const int h = e - 32768; const double g = 1.0 - 1.0 / (double)(32 << h); double v = 1.0;
            for (int j = 0; j <= 128; ++j) { F.GP()[h * 132 + j] = (float)v; v *= g; }
        }
    }
    for (int row = 2 * gw; row < T; row += 2 * NGW) {
        f32x4 v[2][4];
#pragma unroll
        for (int r = 0; r < 2; ++r) { const f32x4* xr = (const f32x4*)(p.x + (size_t)(row + r) * D) + lane;
#pragma unroll
            for (int j = 0; j < 4; ++j) v[r][j] = xr[64 * j]; }
#pragma unroll
        for (int r = 0; r < 2; ++r) { float s = 0.f;
#pragma unroll
            for (int j = 0; j < 4; ++j) s += (v[r][j].x * v[r][j].x + v[r][j].y * v[r][j].y) + (v[r][j].z * v[r][j].z + v[r][j].w * v[r][j].w);
            s = wave_sum(s); if (lane < 16) F.ROWSS()[(size_t)(row + r) * 16 + lane] = (lane == 0) ? s : 0.f;
            u32x2* o = (u32x2*)(F.XB() + (size_t)(row + r) * D) + lane;
#pragma unroll
            for (int j = 0; j < 4; ++j) { u32x2 w; w.x = pk2(v[r][j].x, v[r][j].y); w.y = pk2(v[r][j].z, v[r][j].w); o[64 * j] = w; } }
    }
}

template <bool F8 = false>
__device__ __forceinline__ void conv_strip(const float* W, int ldw, int kb0, int nkb, int n0, bf16_t* WT, int ldt, int drow0, const LAS float* gsl, const LAS float* shl,
                                           float* bias, float cscale, LAS float* scr, int lane, int tiled_nkt = 0, float wmul = 1.0f) {
    f32x4 bacc = (f32x4){0.f, 0.f, 0.f, 0.f}; f32x4 w[8];
    const int lr = lane >> 3, lc = 4 * (lane & 7);
    const float* wp = W + (size_t)(kb0 * 64 + lr) * ldw + n0 + lc;
#pragma unroll
    for (int i = 0; i < 8; ++i) w[i] = *(const f32x4*)(wp + (size_t)(8 * i) * ldw);
    for (int kb = kb0; kb < kb0 + nkb; ++kb) {
        const int k0 = kb * 64; f32x4 wn[8];
        if (kb + 1 < kb0 + nkb) {
#pragma unroll
            for (int i = 0; i < 8; ++i) wn[i] = *(const f32x4*)(wp + (size_t)(64 * (kb + 1 - kb0) + 8 * i) * ldw);
        } else {
#pragma unroll
            for (int i = 0; i < 8; ++i) wn[i] = (f32x4){0.f, 0.f, 0.f, 0.f};
        }
#pragma unroll
        for (int i = 0; i < 8; ++i) { const int kk = lr + 8 * i;
            float gsv = cscale * wmul; if (gsl) { gsv *= gsl[k0 + kk]; const float sv = shl[k0 + kk]; bacc = bacc + w[i] * sv; }
            *(LAS f32x4*)(scr + kk * 36 + 4 * ((lane & 7) ^ i)) = w[i] * gsv; }
        asm volatile("s_waitcnt lgkmcnt(0)" ::: "memory");
        const int cc = lane & 7;
#pragma unroll
        for (int j = 0; j < 4; ++j) { const int n = (lane >> 3) + 8 * j; const LAS float* s = scr + (8 * cc) * 36 + 4 * ((n >> 2) ^ cc) + (n & 3);
            const int nr = drow0 + n;
            if constexpr (F8) { u32x2 o8; o8.x = pk4f8(s[0 * 36], s[1 * 36], s[2 * 36], s[3 * 36]); o8.y = pk4f8(s[4 * 36], s[5 * 36], s[6 * 36], s[7 * 36]);
                if (tiled_nkt) *(u32x2*)((unsigned char*)WT + (((size_t)(nr >> 8) * tiled_nkt + (kb >> 1)) * 256 + (nr & 255)) * 128 + (kb & 1) * 64 + 8 * cc) = o8;
                else *(u32x2*)((unsigned char*)WT + (size_t)nr * ldt + k0 + 8 * cc) = o8;
                continue; }
            u32x4 o; o.x = pk2(s[0 * 36], s[1 * 36]); o.y = pk2(s[2 * 36], s[3 * 36]); o.z = pk2(s[4 * 36], s[5 * 36]); o.w = pk2(s[6 * 36], s[7 * 36]);
            if (tiled_nkt) *(u32x4*)(WT + (((size_t)(nr >> 8) * tiled_nkt + kb) * 256 + (nr & 255)) * 64 + 8 * cc) = o;
            else *(u32x4*)(WT + (size_t)nr * ldt + k0 + 8 * cc) = o; }
        asm volatile("s_waitcnt lgkmcnt(0)" ::: "memory");
#pragma unroll
        for (int i = 0; i < 8; ++i) w[i] = wn[i];
    }
    if (bias) {
#pragma unroll
        for (int o = 8; o < 64; o <<= 1) { bacc.x += __shfl_xor(bacc.x, o); bacc.y += __shfl_xor(bacc.y, o); bacc.z += __shfl_xor(bacc.z, o); bacc.w += __shfl_xor(bacc.w, o); }
        if (lane < 8) *(f32x4*)(bias + drow0 + lc) = bacc * cscale; }
}
__device__ __forceinline__ void phase_p1(Frame& F) {
    const Params& p = F.p; const int gw = F.c * NWAVE + F.wave, NGW = F.G * NWAVE, lane = F.lane;
    LAS float* modl = (LAS float*)F.lds;
    LAS float* scr = (LAS float*)(F.lds + 49152 + F.wave * 9216);
    __syncthreads();
    for (int idx = F.tid; idx < 12288; idx += NTHR) { float v = 0.f;
#pragma unroll
        for (int ks = 0; ks < 8; ++ks) v += F.MODP()[ks * 12288 + idx];
        modl[idx] = v; if ((idx % F.G) == F.c) F.MOD()[idx] = v; }
    __syncthreads();
    const LAS float* MOD0 = modl; const LAS float* MOD1 = modl + NIN; const LAS float* nul = nullptr;
    LAS float* gs_in = modl + 2048; LAS float* gs_ffn = modl + 5120; LAS float* gs_pool = modl + NIN + 2048;
    for (int k = F.tid; k < 1024; k += NTHR) { gs_in[k] = p.norm_gain[k] * (1.0f + MOD0[1024 + k]); gs_ffn[k] = p.norm_gain[1024 + k] * (1.0f + MOD0[4 * 1024 + k]); gs_pool[k] = p.norm_gain[2048 + k] * (1.0f + MOD1[1024 + k]); }
    __syncthreads();
    constexpr int S_IN = 192 * 4, S_G = 88 * 4, I_OUT = 32 * 32, I_D = 44 * 32, I_P = 4 * 4 * 8;
    constexpr int NIT = S_IN + 2 * S_G + I_OUT + I_D + I_P + 1;
    for (int it = gw; it < NIT; it += NGW) {
        int r = it;
        if (r < S_IN) { const int part = r / 192, n0 = (r % 192) * 32; const float cs = (n0 >= 1024 && n0 < 2048) ? 0.0625f : 1.0f;
            conv_strip(p.ret_w_in, NIN, 4 * part, 4, n0, F.WIN(), 1024, n0, gs_in, MOD0, F.BIAS_IN() + part * NIN, cs, scr, lane); continue; } r -= S_IN;
        if (r < 2 * S_G) { const int up = r >= S_G; if (up) r -= S_G; const int part = r / 88, n0 = (r % 88) * 32, drow = (n0 >> 7) * 256 + (up ? 128 : 0) + (n0 & 127);
            conv_strip(up ? p.ffn_w_up : p.ffn_w_gate, DFF, 4 * part, 4, n0, F.WGU(), 1024, drow, gs_ffn, MOD0 + 3 * 1024, F.BIAS_GU() + part * 5632, 1.0f, scr, lane); continue; } r -= 2 * S_G;
        if (r < I_OUT) { const int kb = r / 32, nb = r % 32; conv_strip(p.ret_w_out, 1024, kb, 1, nb * 32, F.WOUT(), 2048, nb * 32, nul, nul, nullptr, 1.0f, scr, lane); continue; } r -= I_OUT;
        if (r < I_D) { const int kb = r / 32, nb = r % 32; conv_strip<true>(p.ffn_w_down, 1024, kb, 1, nb * 32, F.WD(), DFF, nb * 32, nul, nul, nullptr, 1.0f, scr, lane, 0, F8_DSCALE); continue; } r -= I_D;
        if (r < I_P) { const int g = r / 32, q = r % 32, kb = q / 8, nb = q % 8;
            conv_strip(p.pool_w + (size_t)g * 65536, 256, kb, 1, nb * 32, F.WP() + (size_t)g * 65536, 256, nb * 32, gs_pool + g * 256, MOD1 + g * 256, nullptr, 1.0f, scr, lane); continue; }
        { float ba = 0.f; const int e = lane & 7;
            for (int k0 = lane >> 3; k0 < 1024; k0 += 128) { float w[16], gn[16];
#pragma unroll
                for (int j = 0; j < 16; ++j) { const int k = k0 + 8 * j; w[j] = p.moe_router[k * 8 + e]; gn[j] = p.norm_gain[3 * 1024 + k]; }
#pragma unroll
                for (int j = 0; j < 16; ++j) { const int k = k0 + 8 * j; F.WR()[k * 8 + e] = w[j] * (gn[j] * (1.0f + MOD1[4 * 1024 + k])); ba = fmaf(MOD1[3 * 1024 + k], w[j], ba); } }
            ba += __shfl_xor(ba, 8); ba += __shfl_xor(ba, 16); ba += __shfl_xor(ba, 32);
            if (lane < 8) F.BIAS_R()[lane] = ba; }
    }
}
constexpr int PX_SG = 112 * 4, PX_EARLY = 1024;
__device__ __forceinline__ void px_tables(Frame& F) {
    const Params& p = F.p;
    LAS float* gsl = (LAS float*)(F.lds + 8 * 9216 + 1024);
    LAS float* shl = gsl + 1024;
    const float* MOD1 = F.MOD() + NIN;
    for (int k = F.tid; k < 1024; k += NTHR) { gsl[k] = p.norm_gain[3 * 1024 + k] * (1.0f + ldv_f(MOD1 + 4 * 1024 + k)); shl[k] = ldv_f(MOD1 + 3 * 1024 + k); }
    __syncthreads();
}
__device__ __forceinline__ void px_gu_item(Frame& F, int it, int lane) {
    const Params& p = F.p;
    LAS float* scr = (LAS float*)(F.lds + F.wave * 9216);
    LAS float* gsl = (LAS float*)(F.lds + 8 * 9216 + 1024); LAS float* shl = gsl + 1024;
    const int e = it / (2 * PX_SG); int r = it % (2 * PX_SG); const int up = r >= PX_SG; if (up) r -= PX_SG;
    const int part = r / 112, n0 = (r % 112) * 32, drow = e * 7168 + (n0 >> 7) * 256 + (up ? 128 : 0) + (n0 & 127);
    conv_strip<true>((up ? p.moe_w_up : p.moe_w_gate) + (size_t)e * 1024 * DFE, DFE, 4 * part, 4, n0, F.WMGU(), 1024, drow, gsl, shl,
                     F.BIAS_MGU() + (part >> 1) * 262144 + (part & 1) * 57344, 1.0f, scr, lane, 0, F8_WSCALE);
}
__device__ __forceinline__ void phase_px(Frame& F) {
    const Params& p = F.p; const int gw = F.c * NWAVE + F.wave, NGW = F.G * NWAVE, lane = F.lane;
    LAS float* scr = (LAS float*)(F.lds + F.wave * 9216);
    const LAS float* nul = nullptr;
    px_tables(F);
    constexpr int I_D = 14 * 32;
    for (int it = (F.G == 256 ? PX_EARLY : 0) + gw; it < NE * 2 * PX_SG; it += NGW) px_gu_item(F, it, lane);
    const int lane2 = lane_id();
    for (int it = gw; it < NE * I_D; it += NGW) {
        const int e = it / I_D, r = it % I_D, kg = r / 32, nb = r % 32;
        conv_strip<true>(p.moe_w_down + (size_t)e * DFE * 1024, 1024, 4 * kg, 4, nb * 32, (bf16_t*)((unsigned char*)F.WMD() + (size_t)e * 1024 * DFE), DFE, nb * 32, nul, nul, nullptr, 1.0f, scr, lane2, 28, F8_DSCALE);
    }
}

__device__ __forceinline__ void phase_scan(Frame& F) {
    const int gt = F.c * NTHR + F.tid, NGT = F.G * NTHR;
    for (int v = gt; v < 131072; v += NGT) {
        const int h = v >> 15; const float dec = F.GP()[h * 132 + 128]; float s0 = 0.f, s1 = 0.f, s2 = 0.f, s3 = 0.f;
        u32x2* ptr = (u32x2*)(F.SB() + (size_t)v * 4);
        for (int n0 = 0; n0 < 128; n0 += 16) {
            u32x2 kv[16];
#pragma unroll
            for (int j = 0; j < 16; ++j) { kv[j] = (u32x2){0u, 0u}; if (n0 + j < 127) kv[j] = ptr[(size_t)(n0 + j) * 131072]; }
#pragma unroll
            for (int j = 0; j < 16; ++j) {
                u32x2 o; o.x = pk2(s0, s1); o.y = pk2(s2, s3); ptr[(size_t)(n0 + j) * 131072] = o;
                s0 = s0 * dec + bflo(kv[j].x); s1 = s1 * dec + bfhi(kv[j].x); s2 = s2 * dec + bflo(kv[j].y); s3 = s3 * dec + bfhi(kv[j].y); }
        }
    }
}

namespace ret {
constexpr int BUFB = 40960, OFF_B = 8192, OFF_P = 81920, OFF_RED = 114688, OFF_GP = 118784;
__device__ __forceinline__ int swz(int o) { return o ^ (((o >> 9) & 1) << 5); }
}
#define RET_WAITV(n) asm volatile("s_waitcnt vmcnt(" #n ")" ::: "memory")
#define RET_WAITL0() asm volatile("s_waitcnt lgkmcnt(0)" ::: "memory")
#define RET_BAR() do { asm volatile("" ::: "memory"); __builtin_amdgcn_s_barrier(); asm volatile("" ::: "memory"); } while (0)
__device__ __forceinline__ void phase_ret_fast(Frame& F) {
    using namespace ret;
    const Params& p = F.p; LAS unsigned char* lds = F.lds;
    const int tid = F.tid, lane = tid & 63, wid = F.wave, wr = wid >> 2, wc = wid & 3, fr = lane & 15, fq = lane >> 4;
    const int foff = swz(fr * 64 + fq * 16);
    const int srow = lane >> 2, scol = ((lane & 3) * 8) ^ (((lane >> 5) & 1) * 16);
    LAS float* gps = (LAS float*)(lds + OFF_GP); LAS f32x2* red = (LAS f32x2*)(lds + OFF_RED);
    __syncthreads();
    for (int i = tid; i < 4 * 132; i += NTHR) gps[i] = F.GP()[i];
    __syncthreads();
    const __amdgpu_buffer_rsrc_t rs = __builtin_amdgcn_make_buffer_rsrc((void*)F.ws, (short)0, 0x7fffffff, 0x00020000);
    const unsigned qoff = (unsigned)((16 * wid + srow) * 1024 + scol) * 2u;
    unsigned soff[4], voff[4];
#pragma unroll
    for (int i = 0; i < 4; ++i) { soff[i] = (unsigned)((16 * (wid + 8 * i) + srow) * 256 + scol) * 2u; voff[i] = (unsigned)((16 * (wid + 8 * i) + srow) * T + scol) * 2u; }
#define RET_GLDS(uoff, loff, dst) __builtin_amdgcn_raw_ptr_buffer_load_lds(rs, (LAS unsigned*)(lds + (dst)), 16, (int)(loff), (int)(uoff), 0, 0)
#define RET_LOADS(kind, ks, b, hh, nn) do { const unsigned _qk = (unsigned)((nn) * 128 * 1024 + (hh) * 256 + 32 * (ks)) * 2u; \
        if ((kind) != 2) RET_GLDS((unsigned)WS_Q + _qk, qoff, (b) * BUFB + wid * 1024); \
        if ((kind) == 0) RET_GLDS((unsigned)WS_KN + _qk, qoff, (b) * BUFB + OFF_B + wid * 1024); \
        if ((kind) == 1) { const unsigned _sb = (unsigned)WS_SB + (unsigned)(((nn) * 4 + (hh)) * 512 * 256 + 32 * (ks)) * 2u; _Pragma("unroll") for (int _i = 0; _i < 4; ++_i) \
            RET_GLDS(_sb, soff[_i], (b) * BUFB + OFF_B + (wid + 8 * _i) * 1024); } \
        if ((kind) == 2) { const unsigned _vb = (unsigned)WS_VT + (unsigned)((hh) * 512 * T + (nn) * 128 + 32 * (ks)) * 2u; _Pragma("unroll") for (int _i = 0; _i < 4; ++_i) \
            RET_GLDS(_vb, voff[_i], (b) * BUFB + OFF_B + (wid + 8 * _i) * 1024); } } while (0)
    int u = F.c;
    if (u >= 512) return;
    { const int h = u & 3, n = u >> 2; RET_LOADS(0, 0, 0, h, n); }
    for (; u < 512; u += F.G) {
        const int h = u & 3, n = u >> 2, t0 = n * 128; const int un = u + F.G; const bool has_next = un < 512; const int hn = un & 3, nn = un >> 2;
        f32x4 pacc[4][2];
#pragma unroll
        for (int m = 0; m < 4; ++m)
#pragma unroll
            for (int q = 0; q < 2; ++q) pacc[m][q] = (f32x4){0.f, 0.f, 0.f, 0.f};
#pragma unroll
        for (int ks = 0; ks < 8; ++ks) {
            const int b = ks & 1;
            if (ks < 7) { RET_LOADS(0, ks + 1, b ^ 1, h, n); RET_WAITV(2); } else { RET_LOADS(1, 0, b ^ 1, h, n); RET_WAITV(5); }
            RET_BAR();
            bf16x8 af[4], bf[2];
#pragma unroll
            for (int m = 0; m < 4; ++m) af[m] = *(const LAS bf16x8*)(lds + b * BUFB + (4 * wr + m) * 1024 + foff);
#pragma unroll
            for (int q = 0; q < 2; ++q) bf[q] = *(const LAS bf16x8*)(lds + b * BUFB + OFF_B + (2 * wc + q) * 1024 + foff);
            RET_WAITL0(); RET_BAR();
#pragma unroll
            for (int m = 0; m < 4; ++m)
#pragma unroll
                for (int q = 0; q < 2; ++q) pacc[m][q] = __builtin_amdgcn_mfma_f32_16x16x32_bf16(bf[q], af[m], pacc[m][q], 0, 0, 0);
            __builtin_amdgcn_sched_barrier(0);
        }
        { int l2 = lane; asm volatile("" : "+v"(l2)); const int fr = l2 & 15, fq = l2 >> 4;
#pragma unroll
        for (int m = 0; m < 4; ++m)
#pragma unroll
            for (int q = 0; q < 2; ++q) { const int r = 64 * wr + 16 * m + fr, cc = 32 * wc + 16 * q + 4 * fq; float v[4];
#pragma unroll
                for (int j = 0; j < 4; ++j) { const int dd = r - (cc + j); v[j] = dd >= 0 ? pacc[m][q][j] * gps[h * 132 + dd] : 0.f; }
                u32x2 w; w.x = pk2(v[0], v[1]); w.y = pk2(v[2], v[3]);
                *(LAS u32x2*)(lds + OFF_P + wc * 8192 + (4 * wr + m) * 1024 + swz(fr * 64 + 32 * q + 8 * fq)) = w; } }
        f32x4 acc[4][8];
#pragma unroll
        for (int m = 0; m < 4; ++m)
#pragma unroll
            for (int q = 0; q < 8; ++q) acc[m][q] = (f32x4){0.f, 0.f, 0.f, 0.f};
#pragma unroll
        for (int ks = 0; ks < 8; ++ks) {
            const int b = ks & 1;
            if (ks < 7) { RET_LOADS(1, ks + 1, b ^ 1, h, n); RET_WAITV(5); } else { RET_LOADS(2, 0, b ^ 1, h, n); RET_WAITV(4); }
            RET_BAR();
            bf16x8 af[4], bf[8];
#pragma unroll
            for (int m = 0; m < 4; ++m) af[m] = *(const LAS bf16x8*)(lds + b * BUFB + (4 * wr + m) * 1024 + foff);
#pragma unroll
            for (int q = 0; q < 8; ++q) bf[q] = *(const LAS bf16x8*)(lds + b * BUFB + OFF_B + (8 * wc + q) * 1024 + foff);
            RET_WAITL0(); RET_BAR();
#pragma unroll
            for (int m = 0; m < 4; ++m)
#pragma unroll
                for (int q = 0; q < 8; ++q) acc[m][q] = __builtin_amdgcn_mfma_f32_16x16x32_bf16(bf[q], af[m], acc[m][q], 0, 0, 0);
            __builtin_amdgcn_sched_barrier(0);
        }
        { int l3 = lane; asm volatile("" : "+v"(l3)); const int fr = l3 & 15;
#pragma unroll
        for (int m = 0; m < 4; ++m) { const float qd = gps[h * 132 + 64 * wr + 16 * m + fr + 1];
#pragma unroll
            for (int q = 0; q < 8; ++q) acc[m][q] = acc[m][q] * qd; } }
#pragma unroll
        for (int ks = 0; ks < 4; ++ks) {
            const int b = ks & 1;
            if (ks < 3) { RET_LOADS(2, ks + 1, b ^ 1, h, n); RET_WAITV(4); }
            else if (has_next) { RET_LOADS(0, 0, b ^ 1, hn, nn); RET_WAITV(2); }
            else { RET_WAITV(0); }
            RET_BAR();
            bf16x8 af[4], bf[8];
#pragma unroll
            for (int m = 0; m < 4; ++m) af[m] = *(const LAS bf16x8*)(lds + OFF_P + ks * 8192 + (4 * wr + m) * 1024 + foff);
#pragma unroll
            for (int q = 0; q < 8; ++q) bf[q] = *(const LAS bf16x8*)(lds + b * BUFB + OFF_B + (8 * wc + q) * 1024 + foff);
            RET_WAITL0(); RET_BAR();
#pragma unroll
            for (int m = 0; m < 4; ++m)
#pragma unroll
                for (int q = 0; q < 8; ++q) acc[m][q] = __builtin_amdgcn_mfma_f32_16x16x32_bf16(bf[q], af[m], acc[m][q], 0, 0, 0);
            __builtin_amdgcn_sched_barrier(0);
        }
        { int l4 = lane; asm volatile("" : "+v"(l4)); const int fr = l4 & 15, fq = l4 >> 4;
#pragma unroll
        for (int m = 0; m < 4; ++m) { float s1 = 0.f, s2 = 0.f;
#pragma unroll
            for (int q = 0; q < 8; ++q) { const f32x4 v = acc[m][q]; s1 += (v.x + v.y) + (v.z + v.w); s2 += (v.x * v.x + v.y * v.y) + (v.z * v.z + v.w * v.w); }
            s1 += __shfl_xor(s1, 16); s1 += __shfl_xor(s1, 32); s2 += __shfl_xor(s2, 16); s2 += __shfl_xor(s2, 32);
            if (fq == 0) red[(64 * wr + 16 * m + fr) * 4 + wc] = (f32x2){s1, s2}; }
        RET_WAITL0(); RET_BAR();
#pragma unroll
        for (int m = 0; m < 4; ++m) { const int r = 64 * wr + 16 * m + fr; const f32x2 a = red[r * 4 + 0], b2 = red[r * 4 + 1], c2 = red[r * 4 + 2], d2 = red[r * 4 + 3];
            const float mu = ((a.x + b2.x) + (c2.x + d2.x)) * (1.0f / 512.0f), ex2 = ((a.y + b2.y) + (c2.y + d2.y)) * (1.0f / 512.0f);
            const float rs = 1.0f / sqrtf(ex2 - mu * mu + EPS); const size_t rowoff = (size_t)(t0 + r) * 2048 + h * 512 + 128 * wc + 4 * fq;
#pragma unroll
            for (int q = 0; q < 8; ++q) { const u32x2 gw = *(const u32x2*)(F.Gb() + rowoff + 16 * q); const f32x4 gn = *(const f32x4*)(p.ret_gn_gain + h * 512 + 128 * wc + 16 * q + 4 * fq);
                const f32x4 v = acc[m][q]; u32x2 w;
                w.x = pk2((v.x - mu) * rs * gn.x * bflo(gw.x), (v.y - mu) * rs * gn.y * bfhi(gw.x)); w.y = pk2((v.z - mu) * rs * gn.z * bflo(gw.y), (v.w - mu) * rs * gn.w * bfhi(gw.y));
                *(u32x2*)(F.Y() + rowoff + 16 * q) = w; }
             } }
        RET_BAR();
    }
    RET_WAITV(0); RET_BAR();
#undef RET_GLDS
#undef RET_LOADS
}

namespace pf { constexpr int XTP = 132, OFF_RS = 42496, OFF_PT = 43008, OFF_WB = 59392, OFF_END = 124928; }
template <int W>
__device__ __forceinline__ void pf_pool(LAS unsigned char* lds, int t0, int tid) {
    using namespace pf; const LAS float* XT = (const LAS float*)lds; const LAS float* RS = (const LAS float*)(lds + OFF_RS);
    const int cp = tid & 63, tb = tid >> 6, r0 = 8 * tb, ch = 2 * cp; float s0 = 0.f, s1 = 0.f;
#pragma unroll
    for (int i = 1; i < W; ++i) { const int rr = 16 + r0 - i; const f32x2 xv = *(const LAS f32x2*)(XT + rr * XTP + ch); const float rs = RS[rr]; s0 += xv.x * rs; s1 += xv.y * rs; }
#pragma unroll
    for (int j = 0; j < 8; ++j) { const int r = r0 + j, rr = 16 + r; const f32x2 xv = *(const LAS f32x2*)(XT + rr * XTP + ch); const float rs = RS[rr]; const float a0 = xv.x * rs, a1 = xv.y * rs;
        s0 += a0; s1 += a1; const int t = t0 + r; const float ic = 1.0f / (float)((t + 1) < W ? (t + 1) : W);
        *(LAS unsigned*)(lds + OFF_PT + (ch >> 5) * 4096 + (r >> 4) * 1024 + ret::swz((r & 15) * 64 + (ch & 31) * 2)) = pk2(s0 * ic - a0, s1 * ic - a1);
        const int ro = rr - W + 1; const f32x2 xo = *(const LAS f32x2*)(XT + ro * XTP + ch); const float rso = RS[ro]; s0 -= xo.x * rso; s1 -= xo.y * rso; }
}
__device__ __forceinline__ void phase_pool_fused(Frame& F) {
    using namespace pf;
    const Params& p = F.p; LAS unsigned char* lds = F.lds; const int tid = F.tid, lane = F.lane, wid = F.wave;
    const float* X2 = F.X2(); const float* rss = F.ROWSS(); const float* g1 = F.MOD() + NIN + 2 * 1024; const float* WRg = F.WR();
    LAS float* XT = (LAS float*)lds; LAS float* RS = (LAS float*)(lds + OFF_RS);
    const int foff = ret::swz((lane & 15) * 64 + (lane >> 4) * 16);
    const int srow = lane >> 2, scol = ((lane & 3) * 8) ^ (((lane >> 5) & 1) * 16);
    const __amdgpu_buffer_rsrc_t rs_ws = __builtin_amdgcn_make_buffer_rsrc((void*)F.ws, (short)0, 0x7fffffff, 0x00020000);
    unsigned loff[2];
#pragma unroll
    for (int i = 0; i < 2; ++i) loff[i] = (unsigned)((16 * (wid + 8 * i) + srow) * 256 + scol) * 2u;
    for (int seg = F.c; seg < 256; seg += F.G) {
        const int t0 = seg * 64;
        float ss[4], lg[4][8];
#pragma unroll
        for (int m = 0; m < 4; ++m) { ss[m] = 0.f;
#pragma unroll
            for (int e = 0; e < 8; ++e) lg[m][e] = 0.f; }
        __syncthreads();
        if (tid < 80) { const int tt = t0 - 16 + tid; RS[tid] = tt >= 0 ? rstd_row(rss, tt) : 0.f; }
        f32x4 acc[4][2]; f32x4 xv[5];
#define PF_LOADX(gg, kk) do { int _tl = tid; asm volatile("" : "+v"(_tl)); _Pragma("unroll") for (int _i = 0; _i < 5; ++_i) { const int _idx = _tl + 512 * _i, _rr = _idx >> 5, _c4 = (_idx & 31) * 4; const int _tt = t0 - 16 + _rr; \
            xv[_i] = *(const f32x4*)(X2 + (size_t)(_tt < 0 ? 0 : _tt) * 1024 + 256 * (gg) + 128 * (kk) + _c4); } } while (0)
        PF_LOADX(0, 0);
#pragma unroll 1
        for (int it = 0; it < 8; ++it) {
            const int g = it >> 1, kh = it & 1;
            if (kh == 0) {
#pragma unroll
                for (int m = 0; m < 4; ++m) { acc[m][0] = (f32x4){0.f, 0.f, 0.f, 0.f}; acc[m][1] = (f32x4){0.f, 0.f, 0.f, 0.f}; } }
            {
                __syncthreads();
                int tl = tid; asm volatile("" : "+v"(tl));
#pragma unroll
                for (int i = 0; i < 5; ++i) { const int idx = tl + 512 * i, rr = idx >> 5, c4 = (idx & 31) * 4; *(LAS f32x4*)(XT + rr * XTP + c4) = xv[i]; }
#pragma unroll
                for (int kc = 0; kc < 4; ++kc)
#pragma unroll
                    for (int i = 0; i < 2; ++i)
                        __builtin_amdgcn_raw_ptr_buffer_load_lds(rs_ws, (LAS unsigned*)(lds + OFF_WB + kc * 16384 + (wid + 8 * i) * 1024), 16, (int)loff[i], (int)((unsigned)WS_WP + (unsigned)(g * 65536 + kh * 128 + 32 * kc) * 2u), 0, 0);
                { const int itn = it < 7 ? it + 1 : 7; PF_LOADX(itn >> 1, itn & 1); }
                __syncthreads();
                if (g == 0) pf_pool<2>(lds, t0, tl); else if (g == 1) pf_pool<4>(lds, t0, tl); else if (g == 2) pf_pool<8>(lds, t0, tl); else pf_pool<16>(lds, t0, tl);
                asm volatile("s_waitcnt vmcnt(5)" ::: "memory");
                __syncthreads();
#pragma unroll
                for (int kc = 0; kc < 4; ++kc) { bf16x8 af[4], bf[2];
#pragma unroll
                    for (int m = 0; m < 4; ++m) af[m] = *(const LAS bf16x8*)(lds + OFF_PT + kc * 4096 + m * 1024 + foff);
#pragma unroll
                    for (int n = 0; n < 2; ++n) bf[n] = *(const LAS bf16x8*)(lds + OFF_WB + kc * 16384 + (2 * wid + n) * 1024 + foff);
#pragma unroll
                    for (int m = 0; m < 4; ++m)
#pragma unroll
                        for (int n = 0; n < 2; ++n) acc[m][n] = __builtin_amdgcn_mfma_f32_16x16x32_bf16(bf[n], af[m], acc[m][n], 0, 0, 0); }
            }
            if (kh == 0) continue;
            { int l5 = lane; asm volatile("" : "+v"(l5)); const int fr = l5 & 15, fq = l5 >> 4;
              f32x4 x2a[2][4];
#pragma unroll
              for (int n = 0; n < 2; ++n)
#pragma unroll
                for (int m = 0; m < 4; ++m) x2a[n][m] = *(const f32x4*)(X2 + (size_t)(t0 + 16 * m + fr) * 1024 + 256 * g + 32 * wid + 16 * n + 4 * fq);
              f32x4 bva[2], sva[2], gva[2], wra[2][4], wrb[2][4];
#pragma unroll
              for (int n = 0; n < 2; ++n) { const int cg = 256 * g + 32 * wid + 16 * n + 4 * fq;
                bva[n] = *(const f32x4*)(p.pool_b + cg); sva[n] = *(const f32x4*)(p.pool_scale + cg); gva[n].x = ldv_f(g1 + cg); gva[n].y = ldv_f(g1 + cg + 1); gva[n].z = ldv_f(g1 + cg + 2); gva[n].w = ldv_f(g1 + cg + 3);
#pragma unroll
                for (int j = 0; j < 4; ++j) { wra[n][j] = *(const f32x4*)(WRg + (cg + j) * 8); wrb[n][j] = *(const f32x4*)(WRg + (cg + j) * 8 + 4); } }
#pragma unroll
              for (int n = 0; n < 2; ++n) { const int cg = 256 * g + 32 * wid + 16 * n + 4 * fq;
                const f32x4 bv = bva[n], sv = sva[n], gv = gva[n];
                f32x4 wr0[4], wr1[4];
#pragma unroll
                for (int j = 0; j < 4; ++j) { wr0[j] = wra[n][j]; wr1[j] = wrb[n][j]; }
#pragma unroll
                for (int m = 0; m < 4; ++m) { const size_t o = (size_t)(t0 + 16 * m + fr) * 1024 + cg;
                    const f32x4 xo = x2a[n][m] + gv * ((acc[m][n] + bv) * sv);
                    *(f32x4*)(p.out + o) = xo; *(unsigned*)((unsigned char*)F.XB() + o) = pk4f8(xo.x, xo.y, xo.z, xo.w);
                    ss[m] += (xo.x * xo.x + xo.y * xo.y) + (xo.z * xo.z + xo.w * xo.w);
                    lg[m][0] += xo.x * wr0[0].x + xo.y * wr0[1].x + xo.z * wr0[2].x + xo.w * wr0[3].x; lg[m][1] += xo.x * wr0[0].y + xo.y * wr0[1].y + xo.z * wr0[2].y + xo.w * wr0[3].y;
                    lg[m][2] += xo.x * wr0[0].z + xo.y * wr0[1].z + xo.z * wr0[2].z + xo.w * wr0[3].z; lg[m][3] += xo.x * wr0[0].w + xo.y * wr0[1].w + xo.z * wr0[2].w + xo.w * wr0[3].w;
                    lg[m][4] += xo.x * wr1[0].x + xo.y * wr1[1].x + xo.z * wr1[2].x + xo.w * wr1[3].x; lg[m][5] += xo.x * wr1[0].y + xo.y * wr1[1].y + xo.z * wr1[2].y + xo.w * wr1[3].y;
                    lg[m][6] += xo.x * wr1[0].z + xo.y * wr1[1].z + xo.z * wr1[2].z + xo.w * wr1[3].z; lg[m][7] += xo.x * wr1[0].w + xo.y * wr1[1].w + xo.z * wr1[2].w + xo.w * wr1[3].w; } } }
        }
#undef PF_LOADX
#pragma unroll
        for (int m = 0; m < 4; ++m) { ss[m] += __shfl_xor(ss[m], 16); ss[m] += __shfl_xor(ss[m], 32);
#pragma unroll
            for (int e = 0; e < 8; ++e) { lg[m][e] += __shfl_xor(lg[m][e], 16); lg[m][e] += __shfl_xor(lg[m][e], 32); } }
        __syncthreads();
        { LAS float* red = (LAS float*)lds; int l6 = lane; asm volatile("" : "+v"(l6)); const int fr = l6 & 15;
          if ((l6 >> 4) == 0) {
#pragma unroll
            for (int m = 0; m < 4; ++m) { LAS float* q = red + ((16 * m + fr) * 8 + wid) * 12; q[0] = ss[m];
#pragma unroll
                for (int e = 0; e < 8; ++e) q[1 + e] = lg[m][e]; } }
          LAS int* cnt = (LAS int*)(lds + OFF_RS);
          if (tid < 8) cnt[tid] = 0;
          __syncthreads();
          if (tid < 64) { float sq = 0.f, a[8];
#pragma unroll
            for (int e = 0; e < 8; ++e) a[e] = 0.f;
#pragma unroll
            for (int w = 0; w < 8; ++w) { const LAS float* q = red + (tid * 8 + w) * 12; sq += q[0];
#pragma unroll
                for (int e = 0; e < 8; ++e) a[e] += q[1 + e]; }
            const int t = t0 + tid; const float rs = rstd_of(sq); float lgt[8]; F.RSTD3()[t] = rs;
#pragma unroll
            for (int e = 0; e < 8; ++e) lgt[e] = rs * a[e] + ldv_f(F.BIAS_R() + e);
            int e0 = 0; float l0 = lgt[0];
#pragma unroll
            for (int e = 1; e < 8; ++e) if (lgt[e] > l0) { l0 = lgt[e]; e0 = e; }
            int e1 = -1; float l1 = -3.0e38f;
#pragma unroll
            for (int e = 0; e < 8; ++e) if (e != e0 && lgt[e] > l1) { l1 = lgt[e]; e1 = e; }
            const float g0 = 1.0f / (1.0f + __expf(l1 - l0));
            F.TOPE()[t * 2] = e0; F.TOPE()[t * 2 + 1] = e1; F.TOPG()[t * 2] = g0; F.TOPG()[t * 2 + 1] = 1.0f - g0;
            atomicAdd((int*)(cnt + e0), 1); atomicAdd((int*)(cnt + e1), 1); }
          __syncthreads();
          if (tid < 8) F.CNT()[seg * 8 + tid] = cnt[tid]; }
    }
    __syncthreads();
}

__device__ __forceinline__ void phase_route2(Frame& F) {
    const int tid = F.tid;
    LAS int* cn = (LAS int*)F.lds;
    LAS int* part = cn + 2048;
    LAS int* tot = part + 512;
    LAS int* te = tot + 32;
    __syncthreads();
    for (int i = tid; i < 2048; i += NTHR) cn[i] = ldv_i(F.CNT() + i);
    __syncthreads();
    { const int e = tid & 7, pq = tid >> 3; part[pq * 8 + e] = cn[(4 * pq) * 8 + e] + cn[(4 * pq + 1) * 8 + e] + cn[(4 * pq + 2) * 8 + e] + cn[(4 * pq + 3) * 8 + e]; }
    __syncthreads();
    if (tid < 8) { int run = 0; for (int q = 0; q < 64; ++q) { const int v = part[q * 8 + tid]; part[q * 8 + tid] = run; run += v; } tot[tid] = run; }
    __syncthreads();
    { const int e = tid & 7, pq = tid >> 3; int run = part[pq * 8 + e];
#pragma unroll
        for (int j = 0; j < 4; ++j) { const int v = cn[(4 * pq + j) * 8 + e]; cn[(4 * pq + j) * 8 + e] = run; run += v; } }
    if (tid == 0) { int sp = 0; for (int e = 0; e < 8; ++e) { const int pd = (tot[e] + 255) / 256 * 256; tot[8 + e] = sp; tot[16 + e] = pd; sp += pd; } tot[24] = sp / 256; }
    __syncthreads();
    for (int seg = F.c; seg < 256; seg += F.G) {
        int e = -1; if (tid < 128) e = ldv_i(F.TOPE() + seg * 128 + tid);
        int rank = 0;
#pragma unroll
        for (int ee = 0; ee < 8; ++ee) { const unsigned long long m = __ballot(e == ee); if (e == ee) rank = __popcll(m & ((1ull << F.lane) - 1ull)); if (tid == 0) te[ee] = __popcll(m); }
        __syncthreads();
        if (tid < 128) { if (tid >= 64) rank += te[e];
            const int pos = tot[8 + e] + cn[seg * 8 + e] + rank, idx = seg * 128 + tid;
            const float gt = ldv_f(F.TOPG() + idx), rsd = ldv_f(F.RSTD3() + (idx >> 1));
            F.BUFTOK()[pos] = idx >> 1; F.BUFGATE()[pos] = gt; F.BUFRS()[pos] = rsd * (1.0f / F8_WSCALE); F.POS()[idx] = pos; }
        __syncthreads();
    }
    if (F.c < 8) { const int e = F.c; const int b0 = tot[8 + e] + tot[e], b1 = tot[8 + e] + tot[16 + e]; for (int r = b0 + tid; r < b1; r += NTHR) { F.BUFTOK()[r] = 0; F.BUFGATE()[r] = 0.f; F.BUFRS()[r] = 0.f; } }
    if (F.c == (8 % F.G)) { if (tid < NBLK) { int e = 0; for (int q = 0; q < 8; ++q) if (tid * 256 >= tot[8 + q] + tot[16 + q]) ++e; F.BLKE()[tid] = e < 7 ? e : 7; } if (tid == NBLK) F.BLKE()[NBLK] = tot[24]; }
}

__device__ __forceinline__ void phase_final(Frame& F) {
    const Params& p = F.p; const int gw = F.c * NWAVE + F.wave, NGW = F.G * NWAVE, lane = F.lane; const float* g2 = F.MOD() + NIN + 5 * 1024;
    const int nused = ldv_i(F.BLKE() + NBLK); const int ntail = (F.G == 256) ? (nused - 128) * 4 : 0; const int spu = ntail > 0 ? moe_tail_spu(ntail) : 1;
    f32x4 gv[4], fg[4];
#pragma unroll
    for (int j = 0; j < 4; ++j) { gv[j] = *((const f32x4*)g2 + lane + 64 * j); fg[j] = *((const f32x4*)p.final_norm_gain + lane + 64 * j); }
    for (int row = 2 * gw; row < T; row += 2 * NGW) {
        f32x4 xv[2][4]; f32x4 fa[2][4];
#pragma unroll
        for (int r = 0; r < 2; ++r) {
            const f32x4* xr = (const f32x4*)(p.out + (size_t)(row + r) * D) + lane;
#pragma unroll
            for (int j = 0; j < 4; ++j) { xv[r][j] = xr[64 * j]; fa[r][j] = (f32x4){0.f, 0.f, 0.f, 0.f}; }
#pragma unroll
            for (int a = 0; a < 2; ++a) { const int pos = ldv_i(F.POS() + (row + r) * 2 + a); const int blk = pos >> 8;
                if (ntail > 0 && blk >= 128) {
#pragma unroll
                    for (int j = 0; j < 4; ++j) { const float* sl = F.YBB() + (size_t)(((blk - 128) * 4 + j) * spu) * 65536 + (size_t)(pos & 255) * 256 + 4 * lane;
                        for (int q = 0; q < spu; ++q) fa[r][j] = fa[r][j] + *(const f32x4*)(sl + (size_t)q * 65536); }
                } else { const u32x2* y = (const u32x2*)(F.YB() + (size_t)pos * D) + lane;
#pragma unroll
                    for (int j = 0; j < 4; ++j) { const u32x2 w = y[64 * j]; fa[r][j] = fa[r][j] + (f32x4){bflo(w.x), bfhi(w.x), bflo(w.y), bfhi(w.y)}; } } } }
#pragma unroll
        for (int r = 0; r < 2; ++r) { f32x4 v[4]; float s = 0.f;
#pragma unroll
            for (int j = 0; j < 4; ++j) { v[j] = xv[r][j] + gv[j] * fa[r][j]; s += (v[j].x * v[j].x + v[j].y * v[j].y) + (v[j].z * v[j].z + v[j].w * v[j].w); }
            s = wave_sum(s); const float rs = rstd_of(s);
            f32x4* o = (f32x4*)(p.out + (size_t)(row + r) * D) + lane;
#pragma unroll
            for (int j = 0; j < 4; ++j) o[64 * j] = v[j] * rs * fg[j]; }
    }
}

template <class Desc, class Epi> __device__ __forceinline__ void run_gemm(Frame& F, const Desc& Dc, const Epi& E) {
    gemm_fast(F.lds, F.ws, Dc, E, F.c, F.G, F.wave);
}

__device__ __forceinline__ void phase_g1(Frame& F) {
    { DescG1a<false> d{F.XB(), F.WIN(), nullptr, 1024, 1024, 16, 128, 128}; EpiG1a<false> e{F.ROWSS(), F.BIAS_IN(), F.TABA(), F.TABB(), F.Q(), F.KN(), F.Gb(), F.GP(), F.KDT()}; run_gemm(F, d, e); }
    { DescG1a<true> d{F.XB(), F.WIN(), nullptr, 1024, 1024, 16, 128, 128}; EpiG1a<true> e{F.ROWSS(), F.BIAS_IN(), F.TABA(), F.TABB(), F.Q(), F.KN(), F.Gb(), F.GP(), F.KDT()}; run_gemm(F, d, e); }
    { DescG1b d{F.XB(), F.WIN(), nullptr, 1024, 1024, 16, 128, 128}; EpiG1b e{F.ROWSS(), F.BIAS_IN(), F.TABA(), F.TABB(), F.GP(), F.KDT(), F.VT()}; run_gemm(F, d, e); }
}
__device__ __forceinline__ void phase_kv(Frame& F) { DescKV d{F.VT(), F.KDT(), nullptr, T, T, 2, 128, 128}; EpiKV e{F.SB()}; run_gemm(F, d, e); }
__device__ __forceinline__ void phase_outproj(Frame& F) {
    DescOut d{F.Y(), F.WOUT(), nullptr, 2048, 2048, 32, 128, 128}; EpiResid e{F.p.x, F.p.out, F.XB(), F.ROWSS(), F.MOD() + 2 * 1024, nullptr, nullptr, 1.0f}; run_gemm(F, d, e); }
__device__ __forceinline__ void phase_ffn_up(Frame& F) {
    DescFfnUp d{F.XB(), F.WGU(), nullptr, 1024, 1024, 16, 128, 128}; EpiSwiglu<false, true> e{F.ROWSS(), nullptr, F.BIAS_GU(), F.H1(), DFF, 5632, 2 * 5632}; run_gemm(F, d, e);
    if (F.G == 256 && F.c >= 128) {
        frame_fresh(F); px_tables(F); px_gu_item(F, (F.c - 128) * NWAVE + F.wave, F.lane); __syncthreads(); } }
__device__ __forceinline__ void phase_ffn_down(Frame& F) {
    DescFfnDown d{F.H1(), F.WD(), nullptr, DFF / 2, DFF / 2, 22, 128, 128}; EpiResid e{F.p.out, F.X2(), nullptr, F.ROWSS(), F.MOD() + 5 * 1024, nullptr, nullptr, 1.0f / (F8_DSCALE * F8_HSCALE)}; run_gemm(F, d, e); }
__device__ __forceinline__ void phase_moe_up(Frame& F) {
    DescMoeUp d{F.XB(), F.WMGU(), F.BUFTOK(), 512, 512, 8, 128, 128, F.BLKE()}; EpiSwiglu<true, true> e{F.ROWSS(), F.BUFRS(), F.BIAS_MGU(), F.H1M(), DFE, 57344, 262144}; run_gemm(F, d, e); }
__device__ __forceinline__ void phase_moe_down(Frame& F) {
    DescMoeDown d{F.H1M(), F.WMD(), nullptr, 64, 64, 28, 32768, 32768, F.BLKE(), F.G}; EpiMoeDown e{F.BUFGATE(), F.YB(), F.YBB()}; run_gemm(F, d, e); }

#define XB_TMO      128
#define XB_XCNT(j)  (256  + 64 * (j))
#define XB_XSUB(j)  (1280 + 64 * (j))
#define XB_XGEN(j)  (2304 + 64 * (j))
#define XB_TOP      3328
#define XB_TOPGEN   3392
#define XCD_BAR_WORDS 3456
#define XB_SPIN_CAP (1u << 18)
__device__ __forceinline__ unsigned xb_ld(unsigned* p)              { return __hip_atomic_load(p, __ATOMIC_RELAXED, __HIP_MEMORY_SCOPE_AGENT); }
__device__ __forceinline__ unsigned xb_add(unsigned* p, unsigned v) { return __hip_atomic_fetch_add(p, v, __ATOMIC_RELAXED, __HIP_MEMORY_SCOPE_AGENT); }
__device__ __forceinline__ unsigned xb_xcc_id() { return (unsigned)__builtin_amdgcn_s_getreg((3 << 11) | 20) & 0xFu; }
#define XB_SPIN(cond, bar) do { unsigned _sp = 0; while (cond) { __builtin_amdgcn_s_sleep(1); \
    if ((++_sp & 255u) == 0u) { if (xb_ld(&(bar)[XB_TMO])) break; if (_sp > XB_SPIN_CAP) { atomicAdd(&(bar)[XB_TMO], 1u); break; } } } } while (0)
struct XcdBarrier { unsigned* bar; unsigned x; volatile LAS unsigned* st; int wave; };
__device__ __forceinline__ XcdBarrier xcd_barrier_post(unsigned* bar, volatile LAS unsigned* st, int wave) {
    XcdBarrier b; b.bar = bar; b.x = xb_xcc_id(); b.st = st; b.wave = wave;
    if (wave == 0 && lane_id() == 0) (void)xb_add(&bar[XB_XCNT(b.x)], 1u);
    return b;
}
__device__ __forceinline__ void xcd_barrier_complete(unsigned* bar, unsigned x, unsigned& nloc, unsigned& nx) {
    const unsigned G = gridDim.x * gridDim.y * gridDim.z;
    unsigned sum, cnt, mine, sp = 0u;
    for (;;) {
        sum = 0u; cnt = 0u; mine = 0u;
#pragma unroll
        for (unsigned j = 0; j < 16; ++j) { const unsigned c = xb_ld(&bar[XB_XCNT(j)]); sum += c; cnt += (c > 0u) ? 1u : 0u; mine = (j == x) ? c : mine; }
        if (sum == G) break;
        __builtin_amdgcn_s_sleep(1);
        if ((++sp & 255u) == 0u) { if (xb_ld(&bar[XB_TMO])) break; if (sp > XB_SPIN_CAP) { atomicAdd(&bar[XB_TMO], 1u); break; } }
    }
    nloc = mine > 0u ? mine : 1u; nx = cnt > 0u ? cnt : 1u;
}
__device__ __forceinline__ void xcd_barrier(const XcdBarrier& b) {
    asm volatile("s_waitcnt vmcnt(0)" ::: "memory");
    __syncthreads();
    if (b.wave == 0 && lane_id() == 0) {
        unsigned* bar = b.bar;
        __builtin_amdgcn_s_waitcnt(0);
        unsigned nloc = b.st[0], nx = b.st[1];
        if (nloc == 0u) { xcd_barrier_complete(bar, b.x, nloc, nx); b.st[0] = nloc; b.st[1] = nx; }
        const unsigned old = xb_add(&bar[XB_XSUB(b.x)], 1u);
        const unsigned gen = old / nloc;
        if (old + 1u == (gen + 1u) * nloc) {
            __builtin_amdgcn_fence(__ATOMIC_RELEASE, "agent");
            asm volatile("s_waitcnt vmcnt(0)" ::: "memory");
            const unsigned og = xb_add(&bar[XB_TOP], 1u);
            const unsigned tg = og / nx;
            if (og + 1u == (tg + 1u) * nx) xb_add(&bar[XB_TOPGEN], 1u);
            else XB_SPIN(xb_ld(&bar[XB_TOPGEN]) == tg, bar);
            __builtin_amdgcn_fence(__ATOMIC_ACQUIRE, "agent");
            xb_add(&bar[XB_XGEN(b.x)], 1u);
            asm volatile("s_waitcnt vmcnt(0)" ::: "memory");
        } else {
            XB_SPIN(xb_ld(&bar[XB_XGEN(b.x)]) == gen, bar);
            __builtin_amdgcn_fence(__ATOMIC_ACQUIRE, "agent");
            asm volatile("s_waitcnt vmcnt(0)" ::: "memory");
        }
    }
    __syncthreads();
}

constexpr int LDSCTL_OFF = 131072;
__global__ void __launch_bounds__(NTHR, 2) k_mega(Params p) {
    extern __shared__ __attribute__((aligned(16))) unsigned char lds_raw[];
    Frame F; frame_init(F, p, (LAS unsigned char*)lds_raw, (int)blockIdx.x, (int)gridDim.x);
    for (int u = F.tid; u < (LDS_BYTES - LDSCTL_OFF) / 4; u += NTHR) ((LAS unsigned*)(F.lds + LDSCTL_OFF))[u] = 0u;
    __syncthreads();
    const XcdBarrier bar = xcd_barrier_post((unsigned*)(p.ws + CT_BAR), (volatile LAS unsigned*)(F.lds + LDSCTL_OFF + 32), F.wave);
#define GRID_BAR() xcd_barrier(bar)

    frame_fresh(F); phase_p0(F); GRID_BAR();
    frame_fresh(F); phase_p1(F); GRID_BAR();
    frame_fresh(F); phase_g1(F); GRID_BAR();
    frame_fresh(F); phase_kv(F); GRID_BAR();
    frame_fresh(F); phase_scan(F); GRID_BAR();
    frame_fresh(F); phase_ret_fast(F); GRID_BAR();
    frame_fresh(F); phase_outproj(F); GRID_BAR();
    frame_fresh(F); phase_ffn_up(F); GRID_BAR();
    frame_fresh(F); phase_ffn_down(F); GRID_BAR();
    if ((F.c >> 3) & 1) { frame_fresh(F); phase_px(F); __syncthreads(); frame_fresh(F); phase_pool_fused(F); } else { frame_fresh(F); phase_pool_fused(F); frame_fresh(F); phase_px(F); }
    GRID_BAR();
    frame_fresh(F); phase_route2(F); GRID_BAR();
    frame_fresh(F); phase_moe_up(F); GRID_BAR();
    frame_fresh(F); phase_moe_down(F); GRID_BAR();
    frame_fresh(F); phase_final(F);
#undef GRID_BAR
}

extern "C" void kernel_launch(void* const* d_in, const int* in_sizes, int n_in, void* d_out, int out_size, void* d_ws, size_t ws_size, hipStream_t stream) {
    static int grid = 0;
    if (grid == 0) {
        if (n_in != 19 || out_size != T * D || ws_size < WS_END) { fprintf(stderr, "kernel_launch: unexpected shapes (n_in %d out %d ws %zu)\n", n_in, out_size, ws_size); grid = -1; return; }
        int dev = 0, cus = 0, per_cu = 0;
        if (hipGetDevice(&dev) != hipSuccess || hipDeviceGetAttribute(&cus, hipDeviceAttributeMultiprocessorCount, dev) != hipSuccess) { grid = -1; return; }
        if (hipFuncSetAttribute((const void*)k_mega, hipFuncAttributeMaxDynamicSharedMemorySize, LDS_BYTES) != hipSuccess) { fprintf(stderr, "kernel_launch: hipFuncSetAttribute failed\n"); grid = -1; return; }
        if (hipOccupancyMaxActiveBlocksPerMultiprocessor(&per_cu, (const void*)k_mega, NTHR, LDS_BYTES) != hipSuccess || per_cu < 1) { fprintf(stderr, "kernel_launch: occupancy query says %d blocks per CU\n", per_cu); (void)hipGetLastError(); grid = -1; return; }
        grid = cus * (per_cu < 1 ? 1 : 1);
    }
    if (grid < 0) return;
    Params p{};
    const float** pp = (const float**)&p;
    for (int i = 0; i < 19; ++i) pp[i] = (const float*)d_in[i];
    p.out = (float*)d_out; p.ws = (unsigned char*)d_ws;
    (void)hipMemsetAsync((char*)d_ws + WS_CTL, 0, 64 * KiB, stream);
    void* args[] = {&p};
    hipError_t e = hipLaunchCooperativeKernel((const void*)k_mega, dim3(grid), dim3(NTHR), args, LDS_BYTES, stream);
    if (e != hipSuccess) fprintf(stderr, "kernel_launch: cooperative launch failed: %s (grid %d)\n", hipGetErrorString(e), grid);
}
```

```cpp
#include <hip/hip_runtime.h>
#include <cstdio>

#define GAS __attribute__((address_space(1)))
#define LAS __attribute__((address_space(3)))
typedef unsigned short bf16_t;
typedef short bf16x8 __attribute__((ext_vector_type(8)));
typedef float f32x4 __attribute__((ext_vector_type(4)));
typedef float f32x2 __attribute__((ext_vector_type(2)));
typedef unsigned u32x4 __attribute__((ext_vector_type(4)));
typedef int i32x4 __attribute__((ext_vector_type(4)));
typedef unsigned u32x2 __attribute__((ext_vector_type(2)));

#ifndef FAST_GEMM
#define FAST_GEMM 1
#endif

constexpr int T = 16384, D = 1024, NH = 4, DK = 256, DV = 512, CH = 128, NCH = 128;
constexpr int NIN = 6144, DFF = 2816, NE = 8, DFE = 3584, CAP = 34816, NBLK = 136;
constexpr float EPS = 1e-6f;
constexpr int NTHR = 512, NWAVE = 8;

constexpr size_t KiB = 1024, MiB = 1u << 20;
constexpr size_t WS_CTL = 0, CTL_BYTES = 1 * MiB;
constexpr size_t CT_BAR = 16 * KiB;
constexpr size_t CT_MOD = 64 * KiB;
constexpr size_t CT_BIAS_R = 158 * KiB;
constexpr size_t WS_ROWSSP = 2 * MiB;
constexpr size_t WS_MODP = 3 * MiB;
constexpr size_t CT_BIAS_IN = 3584 * KiB;
constexpr size_t CT_BIAS_GU = 3584 * KiB + 96 * KiB;
constexpr size_t CT_BIAS_MGU = 36 * MiB + 512 * KiB;
constexpr size_t WS_TABA = 1 * MiB;
constexpr size_t WS_TABB = WS_TABA + 128 * KiB;
constexpr size_t WS_GP = WS_TABB + 128 * KiB;
constexpr size_t WS_WR = WS_GP + 4 * KiB;
constexpr size_t WS_TOPE = WS_WR + 32 * KiB;
constexpr size_t WS_TOPG = WS_TOPE + 128 * KiB;
constexpr size_t WS_CNT = WS_TOPG + 128 * KiB;
constexpr size_t WS_BUFTOK = WS_CNT + 8 * KiB;
constexpr size_t WS_BUFGATE = WS_BUFTOK + 136 * KiB;
constexpr size_t WS_POS = WS_BUFGATE + 136 * KiB;
constexpr size_t WS_BLKE = WS_POS + 128 * KiB;
constexpr size_t WS_RSTD3 = 256 * KiB;
constexpr size_t WS_BUFRS = 320 * KiB;
constexpr size_t WS_WIN = 4 * MiB;
constexpr size_t WS_WOUT = 16 * MiB;
constexpr size_t WS_WGU = 20 * MiB;
constexpr size_t WS_WD = 31 * MiB;
constexpr size_t WS_WP = 37 * MiB;
constexpr size_t WS_XB = 38 * MiB;
constexpr size_t WS_Q = 70 * MiB;
constexpr size_t WS_KN = 102 * MiB;
constexpr size_t WS_KDT = 134 * MiB;
constexpr size_t WS_VT = 166 * MiB;
constexpr size_t WS_G = 230 * MiB;
constexpr size_t WS_SB = 294 * MiB;
constexpr size_t WS_Y = 422 * MiB;
constexpr size_t WS_H1 = 70 * MiB;
constexpr size_t WS_PB = 158 * MiB;
constexpr size_t WS_X2 = 158 * MiB;
constexpr size_t WS_H1M = 70 * MiB;
constexpr size_t WS_WMGU = 308 * MiB;
constexpr size_t WS_WMD = 456 * MiB;
constexpr size_t WS_YB = 308 * MiB;
constexpr size_t WS_YBB = 4 * MiB;
constexpr size_t WS_END = 512 * MiB;
static_assert(WS_BUFRS + 136 * KiB <= WS_TABA && WS_BLKE + 4 * KiB <= WS_ROWSSP && WS_MODP + 8 * 12288 * 4 <= CT_BIAS_IN && CT_BIAS_GU + 4 * 5632 * 4 <= WS_WIN, "small region");
static_assert(WS_YBB + (size_t)224 * 65536 * 4 <= WS_H1M && WS_H1M + (size_t)CAP * DFE * 2 <= WS_WMGU && WS_YB + (size_t)CAP * D * 4 <= WS_WMD && WS_WMD + (size_t)NE * D * DFE * 2 <= WS_END, "moe map");
static_assert(WS_Y + (size_t)T * 2048 * 2 <= WS_END && WS_SB + (size_t)128 * 4 * 512 * 256 * 2 <= WS_Y, "ret map");

constexpr int LDS_BYTES = 147456;

struct Params {
    const float *x, *c, *ada_w, *ada_b, *norm_gain, *ret_w_in, *ret_gn_gain, *ret_w_out, *ffn_w_gate, *ffn_w_up, *ffn_w_down,
        *pool_w, *pool_b, *pool_scale, *moe_router, *moe_w_gate, *moe_w_up, *moe_w_down, *final_norm_gain;
    float* out; unsigned char* ws;
};

__device__ __forceinline__ unsigned f2bf(float f) { unsigned u = __builtin_bit_cast(unsigned, f); return (u + 0x7fffu + ((u >> 16) & 1u)) >> 16; }
typedef __bf16 bf16x2_t __attribute__((ext_vector_type(2)));
__device__ __forceinline__ unsigned pk2(float lo, float hi) { const f32x2 v = {lo, hi}; return __builtin_bit_cast(unsigned, __builtin_convertvector(v, bf16x2_t)); }
constexpr float F8_WSCALE = 32.0f, F8_DSCALE = 64.0f, F8_HSCALE = 4.0f;
__device__ __forceinline__ unsigned pk4f8(float a, float b, float c, float d) { int w = __builtin_amdgcn_cvt_pk_fp8_f32(a, b, 0, false); w = __builtin_amdgcn_cvt_pk_fp8_f32(c, d, w, true); return (unsigned)w; }
__device__ __forceinline__ float bf2f(unsigned b) { return __builtin_bit_cast(float, b << 16); }
__device__ __forceinline__ float bflo(unsigned w) { return __builtin_bit_cast(float, w << 16); }
__device__ __forceinline__ float bfhi(unsigned w) { return __builtin_bit_cast(float, w & 0xffff0000u); }
__device__ __forceinline__ float silu_f(float v) { return v * __builtin_amdgcn_rcpf(1.0f + __expf(-v)); }
__device__ __forceinline__ float rstd_of(float ss) { return __builtin_amdgcn_rsqf(ss * (1.0f / 1024.0f) + EPS); }
__device__ __forceinline__ float rstd_row(const float* rssp, int t) {
    const f32x4* q = (const f32x4*)(rssp + (size_t)t * 16); const f32x4 a = q[0], b = q[1], c = q[2], d = q[3];
    const float s = (((a.x + a.y) + (a.z + a.w)) + ((b.x + b.y) + (b.z + b.w))) + (((c.x + c.y) + (c.z + c.w)) + ((d.x + d.y) + (d.z + d.w)));
    return __builtin_amdgcn_rsqf(s * (1.0f / 1024.0f) + EPS);
}
__device__ __forceinline__ float wave_sum(float v) {
#pragma unroll
    for (int o = 1; o < 64; o <<= 1) v += __shfl_xor(v, o);
    return v;
}
__device__ __forceinline__ float ldv_f(const float* p) { return __builtin_bit_cast(float, __hip_atomic_load((const unsigned*)p, __ATOMIC_RELAXED, __HIP_MEMORY_SCOPE_AGENT)); }
__device__ __forceinline__ int ldv_i(const int* p) { return __hip_atomic_load(p, __ATOMIC_RELAXED, __HIP_MEMORY_SCOPE_AGENT); }
__device__ __forceinline__ float bias_sum(const float* b, int idx, int s1, int s2) { return (ldv_f(b + idx) + ldv_f(b + s1 + idx)) + (ldv_f(b + s2 + idx) + ldv_f(b + s2 + s1 + idx)); }
__device__ __forceinline__ void rstd_row_ld(const float* rssp, int t, float (&r)[16]) { const f32x4* q = (const f32x4*)(rssp + (size_t)t * 16);
#pragma unroll
    for (int i = 0; i < 4; ++i) { const f32x4 v = q[i]; r[4 * i] = v.x; r[4 * i + 1] = v.y; r[4 * i + 2] = v.z; r[4 * i + 3] = v.w; } }
__device__ __forceinline__ float rstd_row_fin(const float (&r)[16]) {
    const float s = (((r[0] + r[1]) + (r[2] + r[3])) + ((r[4] + r[5]) + (r[6] + r[7]))) + (((r[8] + r[9]) + (r[10] + r[11])) + ((r[12] + r[13]) + (r[14] + r[15])));
    return __builtin_amdgcn_rsqf(s * (1.0f / 1024.0f) + EPS); }
__device__ __forceinline__ void bias_sum_ld(const float* b, int idx, int s1, int s2, float (&r)[16]) { r[0] = ldv_f(b + idx); r[1] = ldv_f(b + s1 + idx); r[2] = ldv_f(b + s2 + idx); r[3] = ldv_f(b + s2 + s1 + idx); }
__device__ __forceinline__ float bias_sum_fin(const float (&r)[16]) { return (r[0] + r[1]) + (r[2] + r[3]); }

__device__ __forceinline__ int lane_id() { int l; asm volatile("v_mbcnt_lo_u32_b32 %0, -1, 0\n\tv_mbcnt_hi_u32_b32 %0, -1, %0" : "=v"(l)); return l; }

struct Unit { const bf16_t* A; const bf16_t* B; int pm, pn, aux, rowbase, nt; };

__device__ __forceinline__ void tile_order(int L, int nM, int nN, int& pm, int& pn) {
    const int nwg = nM * nN; int wgid = L;
    { const int q = nwg / 8, r = nwg % 8, xcd = wgid % 8, off = wgid / 8; wgid = (xcd < r ? xcd * (q + 1) : r * (q + 1) + (xcd - r) * q) + off; }
    const int nig = 8 * nN, gid = wgid / nig, fm = gid * 8, gsz = (nM - fm) < 8 ? (nM - fm) : 8;
    pm = fm + ((wgid % nig) % gsz); pn = (wgid % nig) / gsz;
}

template <bool GATE> struct DescG1a {
    static constexpr bool GATHER = false; static constexpr bool FP8 = false;
    const bf16_t* xb; const bf16_t* win; const int* tok; int lda, ldb, nt, ksa, ksb;
    __device__ __forceinline__ bool get(int L, Unit& u) const {
        if (L >= 64 * 8) return false; tile_order(L, 64, 8, u.pm, u.pn); if (GATE) u.pn += 8;
        const int wrow = u.pn < 8 ? u.pn * 256 : (u.pn + 8) * 256;
        u.A = xb + (size_t)u.pm * 256 * 1024; u.B = win + (size_t)wrow * 1024; u.aux = wrow; u.rowbase = u.pm * 256; u.nt = nt; return true; }
};
struct DescG1b {
    static constexpr bool GATHER = false; static constexpr bool FP8 = false;
    const bf16_t* xb; const bf16_t* win; const int* tok; int lda, ldb, nt, ksa, ksb;
    __device__ __forceinline__ bool get(int L, Unit& u) const {
        if (L >= 8 * 64) return false; tile_order(L, 8, 64, u.pm, u.pn); u.pm += 4;
        u.A = win + (size_t)(1024 + 256 * u.pm) * 1024; u.B = xb + (size_t)u.pn * 256 * 1024; u.aux = 0; u.rowbase = 0; u.nt = nt; return true; }
};
struct DescKV {
    static constexpr bool GATHER = false; static constexpr bool FP8 = false;
    const bf16_t* vt; const bf16_t* kdt; const int* tok; int lda, ldb, nt, ksa, ksb;
    __device__ __forceinline__ bool get(int L, Unit& u) const {
        if (L >= 127 * 8) return false; const int mt = L & 1, h = (L >> 1) & 3, n = L >> 3;
        u.A = vt + (size_t)(h * 512 + 256 * mt) * T + n * 128; u.B = kdt + (size_t)(h * 256) * T + n * 128;
        u.pm = mt; u.pn = 0; u.aux = (n * 4 + h) * 2 + mt; u.rowbase = 0; u.nt = nt; return true; }
};
struct DescOut {
    static constexpr bool GATHER = false; static constexpr bool FP8 = false;
    const bf16_t* y; const bf16_t* w; const int* tok; int lda, ldb, nt, ksa, ksb;
    __device__ __forceinline__ bool get(int L, Unit& u) const {
        if (L >= 256) return false; tile_order(L, 64, 4, u.pm, u.pn);
        u.A = y + (size_t)u.pm * 256 * 2048; u.B = w + (size_t)u.pn * 256 * 2048; u.aux = 0; u.rowbase = u.pm * 256; u.nt = nt; return true; }
};
struct DescFfnUp {
    static constexpr bool GATHER = false; static constexpr bool FP8 = false;
    const bf16_t* xb; const bf16_t* w; const int* tok; int lda, ldb, nt, ksa, ksb;
    __device__ __forceinline__ bool get(int L, Unit& u) const {
        if (L >= 64 * 22) return false; tile_order(L, 64, 22, u.pm, u.pn);
        u.A = xb + (size_t)u.pm * 256 * 1024; u.B = w + (size_t)u.pn * 256 * 1024; u.aux = 256 * u.pn; u.rowbase = u.pm * 256; u.nt = nt; return true; }
};
struct DescFfnDown {
    static constexpr bool GATHER = false; static constexpr bool FP8 = true;
    const bf16_t* h1; const bf16_t* w; const int* tok; int lda, ldb, nt, ksa, ksb;
    __device__ __forceinline__ bool get(int L, Unit& u) const {
        if (L >= 256) return false; tile_order(L, 64, 4, u.pm, u.pn);
        u.A = h1 + (size_t)u.pm * 128 * DFF; u.B = w + (size_t)u.pn * 128 * DFF; u.aux = 0; u.rowbase = u.pm * 256; u.nt = nt; return true; }
};
struct DescMoeUp {
    static constexpr bool GATHER = true; static constexpr bool FP8 = true;
    const bf16_t* xb; const bf16_t* w; const int* tok; int lda, ldb, nt, ksa, ksb; const int* blke;
    __device__ __forceinline__ bool get(int L, Unit& u) const {
        const int nused = ldv_i(blke + NBLK); if (L >= nused * 28) return false; tile_order(L, nused, 28, u.pm, u.pn);
        const int e = ldv_i(blke + u.pm);
        u.A = xb; u.B = w + (size_t)(e * 7168 + 256 * u.pn) * 512; u.aux = e * 7168 + 256 * u.pn; u.rowbase = u.pm * 256; u.nt = nt; return true; }
};
__device__ __forceinline__ int moe_tail_spu(int ntail) { const int q = 256 / ntail; return q >= 14 ? 14 : 7; }
struct DescMoeDown {
    static constexpr bool GATHER = false; static constexpr bool FP8 = true;
    const bf16_t* h1; const bf16_t* w; const int* tok; int lda, ldb, nt, ksa, ksb; const int* blke; int G;
    __device__ __forceinline__ bool get(int L, Unit& u) const {
        const int nused = ldv_i(blke + NBLK); int k0 = 0, npair = 14; u.aux = 0;
        if (G != 256) { if (L >= nused * 4) return false; tile_order(L, nused, 4, u.pm, u.pn); }
        else { const int i = L >> 8, c = L & 255;
            if (i < 2) { const int x = c & 7, j = c >> 3; u.pm = (i * 8 + x) * 8 + (j & 7); u.pn = j >> 3; }
            else { const int ntail = (nused - 128) * 4; if (i > 2 || ntail <= 0) return false; const int spu = moe_tail_spu(ntail); if (c >= ntail * spu) return false;
                const int ut = c / spu, sl = c - ut * spu; u.pm = 128 + (ut >> 2); u.pn = ut & 3; npair = 14 / spu; k0 = sl * npair; u.aux = 1 + c; } }
        const int e = ldv_i(blke + u.pm);
        u.A = h1 + (size_t)u.pm * 128 * DFE + (size_t)k0 * 2 * 16384; u.B = w + (size_t)(e * 4 + u.pn) * 128 * DFE + (size_t)k0 * 2 * 16384;
        u.rowbase = u.pm * 256; u.nt = 2 * npair; return true; }
};

typedef f32x4 Acc[2][2][4][2];

__device__ __forceinline__ void store8bf(bf16_t* p, const float* v) {
    u32x4 w; w.x = pk2(v[0], v[1]); w.y = pk2(v[2], v[3]); w.z = pk2(v[4], v[5]); w.w = pk2(v[6], v[7]); *(u32x4*)p = w; }

template <bool GATE> struct EpiG1a {
    static constexpr bool PERM = true;
    const float* rowss; const float* bias; const f32x2* taba; const f32x2* tabb; bf16_t* Q; bf16_t* KN; bf16_t* Gb; const float* gp; bf16_t* KDT;
    __device__ __forceinline__ void pre_load(const Unit& u, int tid, float (&r)[16]) const { if (tid < 256) r[0] = ldv_f(rowss + (size_t)(u.pm * 256 + tid) * 16); else bias_sum_ld(bias, u.aux + tid - 256, NIN, 2 * NIN, r); }
    __device__ __forceinline__ void pre_store(const Unit&, LAS float* aux, int tid, const float (&r)[16]) const { aux[tid] = tid < 256 ? rstd_of(r[0]) : bias_sum_fin(r); }
    __device__ __forceinline__ void init(LAS float* auxb, int tid) const {
        if (!GATE && tid < 256) { const float v = ((const float*)tabb)[16 * 256 + tid]; auxb[512 + tid] = v; auxb[768 + 512 + tid] = v; } }
    __device__ __forceinline__ void operator()(const Acc& acc, const Unit& u, int wr, int wc, int fr, int fq, const LAS float* aux) const {
        asm volatile("" : "+v"(fr), "+v"(fq));
        const int pn = u.pn, d0 = wc * 32 + 8 * fq;
        float b[2][8];
#pragma unroll
        for (int bj = 0; bj < 2; ++bj) { const f32x4 x = *(const LAS f32x4*)(aux + 256 + 128 * bj + d0), y = *(const LAS f32x4*)(aux + 256 + 128 * bj + d0 + 4);
            b[bj][0] = x.x; b[bj][1] = x.y; b[bj][2] = x.z; b[bj][3] = x.w; b[bj][4] = y.x; b[bj][5] = y.y; b[bj][6] = y.z; b[bj][7] = y.w; }
        if constexpr (!GATE) {
            bf16_t* O = pn < 4 ? Q : KN; const int hcol = (pn & 3) * 256;
            f32x2 ta[8], tn[8], tb[8]; float dec[4];
            { const f32x2* tp0 = taba + (2 * u.pm) * 128 + d0; const f32x2* tpb = tabb + (64 * wr + fr) * 128 + d0;
#pragma unroll
              for (int q = 0; q < 8; ++q) { ta[q] = tp0[q]; tb[q] = tpb[q]; }
#pragma unroll
              for (int m = 0; m < 4; ++m) dec[m] = pn >= 4 ? gp[(pn - 4) * 132 + 127 - (64 * wr + 16 * m + fr)] : 0.f; }
#pragma unroll
            for (int it = 0; it < 8; ++it) {
                const int ai = it >> 2, m = ai ? 3 - (it & 3) : (it & 3);
                if (it == 2) { const f32x2* tp1 = taba + (2 * u.pm + 1) * 128 + d0;
#pragma unroll
                    for (int q = 0; q < 8; ++q) tn[q] = tp1[q]; }
                if (it == 4) {
#pragma unroll
                    for (int q = 0; q < 8; ++q) ta[q] = tn[q]; }
                if ((it & 3) != 0) {
                    const float sg = ai ? -1.0f : 1.0f; int dl = 2 * d0; asm volatile("" : "+v"(dl));
#pragma unroll
                    for (int q2 = 0; q2 < 4; ++q2) { const f32x4 R2 = *(const LAS f32x4*)(aux + 512 + dl + 4 * q2);
                        { const f32x2 B = tb[2 * q2]; const float ry = sg * R2.y; tb[2 * q2].x = B.x * R2.x - B.y * ry; tb[2 * q2].y = B.y * R2.x + B.x * ry; }
                        { const f32x2 B = tb[2 * q2 + 1]; const float rw = sg * R2.w; tb[2 * q2 + 1].x = B.x * R2.z - B.y * rw; tb[2 * q2 + 1].y = B.y * R2.z + B.x * rw; } } }
                const int rl = 128 * ai + 64 * wr + 16 * m + fr, t = u.pm * 256 + rl; const float rs = aux[rl];
                float o1[8], o2[8];
#pragma unroll
                for (int q = 0; q < 8; ++q) {
                    const f32x2 A = ta[q], B = tb[q]; const float cs = A.x * B.x - A.y * B.y, sn = A.y * B.x + A.x * B.y;
                    const float v1 = rs * acc[ai][0][m][q >> 2][q & 3] + b[0][q], v2 = rs * acc[ai][1][m][q >> 2][q & 3] + b[1][q];
                    o1[q] = v1 * cs - v2 * sn; o2[q] = v1 * sn + v2 * cs; }
                store8bf(O + (size_t)t * 1024 + hcol + d0, o1); store8bf(O + (size_t)t * 1024 + hcol + 128 + d0, o2);
                if (pn >= 4) {
                    bf16_t* kd = KDT + (size_t)(hcol + d0) * T + t;
#pragma unroll
                    for (int q = 0; q < 8; ++q) { kd[(size_t)q * T] = (bf16_t)(pk2(o1[q] * dec[m], 0.f) & 0xffffu); kd[(size_t)(128 + q) * T] = (bf16_t)(pk2(o2[q] * dec[m], 0.f) & 0xffffu); } }
            }
        } else {
#pragma unroll
            for (int ai = 0; ai < 2; ++ai)
#pragma unroll
                for (int m = 0; m < 4; ++m) {
                    const int rl = 128 * ai + 64 * wr + 16 * m + fr, t = u.pm * 256 + rl; const float rs = aux[rl];
#pragma unroll
                    for (int bj = 0; bj < 2; ++bj) { float o[8];
#pragma unroll
                        for (int q = 0; q < 8; ++q) o[q] = silu_f(rs * acc[ai][bj][m][q >> 2][q & 3] + b[bj][q]);
                        store8bf(Gb + (size_t)t * 2048 + (pn - 8) * 256 + 128 * bj + d0, o); }
                }
        }
    }
};
struct EpiG1b {
    static constexpr bool PERM = true;
    const float* rowss; const float* bias; const f32x2* taba; const f32x2* tabb; const float* gp; bf16_t* KDT; bf16_t* VT;
    __device__ __forceinline__ void pre_load(const Unit& u, int tid, float (&r)[16]) const { if (tid < 256) bias_sum_ld(bias, 1024 + 256 * u.pm + tid, NIN, 2 * NIN, r); else r[0] = ldv_f(rowss + (size_t)(u.pn * 256 + tid - 256) * 16); }
    __device__ __forceinline__ void pre_store(const Unit&, LAS float* aux, int tid, const float (&r)[16]) const { aux[tid] = tid < 256 ? bias_sum_fin(r) : rstd_of(r[0]); }
    __device__ __forceinline__ void init(LAS float*, int) const {}
    __device__ __forceinline__ void operator()(const Acc& acc, const Unit& u, int wr, int wc, int fr, int fq, const LAS float* aux) const {
        asm volatile("" : "+v"(fr), "+v"(fq));
        const int pmf = u.pm, tl0 = 32 * wc + 8 * fq, tk0 = u.pn * 256 + tl0;
        float rs[2][8];
#pragma unroll
        for (int bj = 0; bj < 2; ++bj) { const f32x4 x = *(const LAS f32x4*)(aux + 256 + 128 * bj + tl0), y = *(const LAS f32x4*)(aux + 256 + 128 * bj + tl0 + 4);
            rs[bj][0] = x.x; rs[bj][1] = x.y; rs[bj][2] = x.z; rs[bj][3] = x.w; rs[bj][4] = y.x; rs[bj][5] = y.y; rs[bj][6] = y.z; rs[bj][7] = y.w; }
        if (pmf < 4) {
            const int h = pmf;
#pragma unroll
            for (int m = 0; m < 4; ++m) {
                const int d = 64 * wr + 16 * m + fr; const float b1 = aux[d], b2 = aux[128 + d];
#pragma unroll
                for (int bj = 0; bj < 2; ++bj) { float o1[8], o2[8]; const f32x2 A = taba[(2 * u.pn + bj) * 128 + d]; const float4 dq0 = *(const float4*)(gp + h * 132 + 120 - tl0), dq1 = *(const float4*)(gp + h * 132 + 124 - tl0);
                    const float decs[8] = {dq1.w, dq1.z, dq1.y, dq1.x, dq0.w, dq0.z, dq0.y, dq0.x};
#pragma unroll
                    for (int q = 0; q < 8; ++q) { const f32x2 B = tabb[(tl0 + q) * 128 + d]; const float cs = A.x * B.x - A.y * B.y, sn = A.y * B.x + A.x * B.y;
                        const float v1 = rs[bj][q] * acc[0][bj][m][q >> 2][q & 3] + b1, v2 = rs[bj][q] * acc[1][bj][m][q >> 2][q & 3] + b2;
                        o1[q] = (v1 * cs - v2 * sn) * decs[q]; o2[q] = (v1 * sn + v2 * cs) * decs[q]; }
                    store8bf(KDT + (size_t)(256 * h + d) * T + tk0 + 128 * bj, o1); store8bf(KDT + (size_t)(256 * h + 128 + d) * T + tk0 + 128 * bj, o2); }
            }
        } else {
#pragma unroll
            for (int ai = 0; ai < 2; ++ai)
#pragma unroll
                for (int m = 0; m < 4; ++m) {
                    const int rl = 128 * ai + 64 * wr + 16 * m + fr, f = 256 * (pmf - 4) + rl; const float bs = aux[rl];
#pragma unroll
                    for (int bj = 0; bj < 2; ++bj) { float o[8];
#pragma unroll
                        for (int q = 0; q < 8; ++q) o[q] = rs[bj][q] * acc[ai][bj][m][q >> 2][q & 3] + bs;
                        store8bf(VT + (size_t)f * T + tk0 + 128 * bj, o); }
                }
        }
    }
};
struct EpiKV {
    static constexpr bool PERM = true;
    bf16_t* SB;
    __device__ __forceinline__ void pre_load(const Unit&, int, float (&)[16]) const {}
    __device__ __forceinline__ void pre_store(const Unit&, LAS float*, int, const float (&)[16]) const {}
    __device__ __forceinline__ void init(LAS float*, int) const {}
    __device__ __forceinline__ void operator()(const Acc& acc, const Unit& u, int wr, int wc, int fr, int fq, const LAS float*) const {
        asm volatile("" : "+v"(fr), "+v"(fq));
        const int mt = u.aux & 1, nh = u.aux >> 1; bf16_t* base = SB + ((size_t)nh * 512 + 256 * mt) * 256; const int d0 = wc * 32 + 8 * fq;
#pragma unroll
        for (int ai = 0; ai < 2; ++ai)
#pragma unroll
            for (int m = 0; m < 4; ++m) { const int r = 128 * ai + 64 * wr + 16 * m + fr;
#pragma unroll
                for (int bj = 0; bj < 2; ++bj) { float o[8];
#pragma unroll
                    for (int q = 0; q < 8; ++q) o[q] = acc[ai][bj][m][q >> 2][q & 3];
                    store8bf(base + (size_t)r * 256 + 128 * bj + d0, o); } }
    }
};
struct EpiResid {
    static constexpr bool PERM = false;
    const float* base; float* out; bf16_t* xb; float* rowss; const float* g; const float* cb; const float* cs; float accscale;
    __device__ __forceinline__ void pre_load(const Unit& u, int tid, float (&r)[16]) const {
        if (tid < 256) { const int c = 256 * u.pn + tid; r[0] = ldv_f(g + c); r[1] = cs ? cs[c] : 1.0f; } else { const int c = 256 * u.pn + tid - 256; r[0] = cb ? cb[c] : 0.f; r[1] = 1.0f; } }
    __device__ __forceinline__ void pre_store(const Unit&, LAS float* aux, int tid, const float (&r)[16]) const { aux[256 + tid] = r[0] * r[1] * (tid < 256 ? accscale : 1.0f); }
    __device__ __forceinline__ void init(LAS float*, int) const {}
    __device__ __forceinline__ void operator()(const Acc& acc, const Unit& u, int wr, int wc, int fr, int fq, const LAS float* aux) const {
        asm volatile("" : "+v"(fr), "+v"(fq));
        const int cl0 = 32 * wc + 4 * fq, col0 = 256 * u.pn + cl0;
        f32x4 gv[2][2], cbv[2][2];
#pragma unroll
        for (int bj = 0; bj < 2; ++bj)
#pragma unroll
            for (int n = 0; n < 2; ++n) { gv[bj][n] = *(const LAS f32x4*)(aux + 256 + cl0 + 128 * bj + 16 * n); cbv[bj][n] = *(const LAS f32x4*)(aux + 512 + cl0 + 128 * bj + 16 * n); }
        f32x4 bsv[2][4];
        const size_t o0 = (size_t)(u.pm * 256 + 64 * wr + fr) * 1024 + col0;
#pragma unroll
        for (int j = 0; j < 4; ++j) bsv[0][j] = *(const f32x4*)(base + o0 + 128 * (j >> 1) + 16 * (j & 1));
#pragma unroll
        for (int it = 0; it < 8; ++it) { const int ai = it >> 2, m = it & 3; const int t = u.pm * 256 + 128 * ai + 64 * wr + 16 * m + fr; float s = 0.f;
            if (it < 7) { const int ai2 = (it + 1) >> 2, m2 = (it + 1) & 3; const size_t o2 = o0 + (size_t)(128 * ai2 + 16 * m2) * 1024;
#pragma unroll
                for (int j = 0; j < 4; ++j) bsv[(it + 1) & 1][j] = *(const f32x4*)(base + o2 + 128 * (j >> 1) + 16 * (j & 1)); }
#pragma unroll
            for (int bj = 0; bj < 2; ++bj)
#pragma unroll
                for (int n = 0; n < 2; ++n) { const size_t o = (size_t)t * 1024 + col0 + 128 * bj + 16 * n;
                    const f32x4 xo = bsv[it & 1][2 * bj + n] + (acc[ai][bj][m][n] + cbv[bj][n]) * gv[bj][n];
                    *(f32x4*)(out + o) = xo; s += (xo.x * xo.x + xo.y * xo.y) + (xo.z * xo.z + xo.w * xo.w);
                    if (xb) { u32x2 w; w.x = pk2(xo.x, xo.y); w.y = pk2(xo.z, xo.w); *(u32x2*)(xb + o) = w; } }
            s += __shfl_xor(s, 16); s += __shfl_xor(s, 32);
            if (fq == 0) rowss[(size_t)t * 16 + u.pn * 4 + wc] = s; }
    }
};
template <bool TILED, bool F8OUT = false> struct EpiSwiglu {
    static constexpr bool PERM = true;
    const float* rowss; const float* rowrs; const float* bias; bf16_t* Hout; int ldh, bs1, bs2;
    __device__ __forceinline__ void pre_load(const Unit& u, int tid, float (&r)[16]) const {
        if (tid < 256) { if (rowrs) r[0] = ldv_f(rowrs + u.rowbase + tid); else rstd_row_ld(rowss, u.rowbase + tid, r); } else bias_sum_ld(bias, u.aux + tid - 256, bs1, bs2, r); }
    __device__ __forceinline__ void pre_store(const Unit&, LAS float* aux, int tid, const float (&r)[16]) const { aux[tid] = tid < 256 ? (rowrs ? r[0] : rstd_row_fin(r)) : bias_sum_fin(r); }
    __device__ __forceinline__ void init(LAS float*, int) const {}
    __device__ __forceinline__ void operator()(const Acc& acc, const Unit& u, int wr, int wc, int fr, int fq, const LAS float* aux) const {
        asm volatile("" : "+v"(fr), "+v"(fq));
        const int d0 = wc * 32 + 8 * fq; float bg[8], bu[8];
        { const f32x4 x = *(const LAS f32x4*)(aux + 256 + d0), y = *(const LAS f32x4*)(aux + 256 + d0 + 4), z = *(const LAS f32x4*)(aux + 384 + d0), w = *(const LAS f32x4*)(aux + 384 + d0 + 4);
          bg[0] = x.x; bg[1] = x.y; bg[2] = x.z; bg[3] = x.w; bg[4] = y.x; bg[5] = y.y; bg[6] = y.z; bg[7] = y.w; bu[0] = z.x; bu[1] = z.y; bu[2] = z.z; bu[3] = z.w; bu[4] = w.x; bu[5] = w.y; bu[6] = w.z; bu[7] = w.w; }
        constexpr float KG = -1.4426950408889634f, KU = -0.6931471805599453f * (F8OUT ? F8_HSCALE : 1.0f);
#pragma unroll
        for (int q = 0; q < 8; ++q) { bg[q] *= KG; bu[q] *= KU; }
#pragma unroll
        for (int ai = 0; ai < 2; ++ai)
#pragma unroll
            for (int m = 0; m < 4; ++m) { const int rl = 128 * ai + 64 * wr + 16 * m + fr, row = u.rowbase + rl; const float rs = aux[rl], rsg = rs * KG, rsu = rs * KU; float o[8];
#pragma unroll
                for (int q = 0; q < 8; ++q) {
                    const float x = rsg * acc[ai][0][m][q >> 2][q & 3] + bg[q], y = rsu * acc[ai][1][m][q >> 2][q & 3] + bu[q];
                    o[q] = (x * __builtin_amdgcn_rcpf(1.0f + __builtin_amdgcn_exp2f(x))) * y; }
                if constexpr (F8OUT) {
#pragma unroll
                    for (int q = 0; q < 8; ++q) o[q] = __builtin_amdgcn_fmed3f(o[q], -448.0f, 448.0f);
                    u32x2 w8; w8.x = pk4f8(o[0], o[1], o[2], o[3]); w8.y = pk4f8(o[4], o[5], o[6], o[7]);
                    if (TILED) *(u32x2*)((unsigned char*)Hout + (((size_t)(row >> 8) * (ldh >> 7) + u.pn) * 256 + (row & 255)) * 128 + d0) = w8;
                    else *(u32x2*)((unsigned char*)Hout + (size_t)row * ldh + 128 * u.pn + d0) = w8; }
                else if (TILED) store8bf(Hout + (((size_t)(row >> 8) * (ldh >> 6) + 2 * u.pn + (d0 >> 6)) * 256 + (row & 255)) * 64 + (d0 & 63), o);
                else store8bf(Hout + (size_t)row * ldh + 128 * u.pn + d0, o); }
    }
};
struct EpiMoeDown {
    static constexpr bool PERM = true;
    const float* gate; bf16_t* YB; float* YBB;
    __device__ __forceinline__ void pre_load(const Unit& u, int tid, float (&r)[16]) const { if (tid < 256) r[0] = ldv_f(gate + u.rowbase + tid); }
    __device__ __forceinline__ void pre_store(const Unit&, LAS float* aux, int tid, const float (&r)[16]) const { if (tid < 256) aux[tid] = r[0] * (1.0f / (F8_DSCALE * F8_HSCALE)); }
    __device__ __forceinline__ void init(LAS float*, int) const {}
    __device__ __forceinline__ void operator()(const Acc& acc, const Unit& u, int wr, int wc, int fr, int fq, const LAS float* aux) const {
        asm volatile("" : "+v"(fr), "+v"(fq));
        const int col0 = 256 * u.pn + 32 * wc + 8 * fq;
#pragma unroll
        for (int ai = 0; ai < 2; ++ai)
#pragma unroll
            for (int m = 0; m < 4; ++m) { const int rl = 128 * ai + 64 * wr + 16 * m + fr, row = u.rowbase + rl; const float gt = aux[rl];
#pragma unroll
                for (int bj = 0; bj < 2; ++bj) {
                    if (u.aux == 0) { float o[8];
#pragma unroll
                        for (int q = 0; q < 8; ++q) o[q] = acc[ai][bj][m][q >> 2][q & 3] * gt;
                        store8bf(YB + (size_t)row * 1024 + col0 + 128 * bj, o); }
                    else { float* d = YBB + (size_t)(u.aux - 1) * 65536 + (size_t)rl * 256 + 32 * wc + 8 * fq + 128 * bj;
                        *(f32x4*)d = acc[ai][bj][m][0] * gt; *(f32x4*)(d + 4) = acc[ai][bj][m][1] * gt; } } }
    }
};

namespace pg8 {
constexpr int BM = 256, BK = 64, HALF = 128, HTB = HALF * BK * 2, STAGE_BYTES = 8 * HTB;
__device__ __forceinline__ int lds_byte(int r, int c) { const int st = (r >> 4) * 2 + (c >> 5), rr = r & 15, cc = c & 31, ob = rr * 64 + cc * 2; return st * 1024 + (ob ^ (((ob >> 9) & 1) << 5)); }
__device__ __forceinline__ void stage_rc(int b, int& R, int& C) { const int st = b / 1024, sb = b % 1024, swz = sb ^ (((sb >> 9) & 1) << 5); R = (st >> 1) * 16 + swz / 64; C = (st & 1) * 32 + (swz % 64) / 2; }
__device__ __forceinline__ int perm32(int rho) { const int n = rho >> 4, i = rho & 15; return 8 * (i >> 2) + 4 * n + (i & 3); }
}
typedef int i32x8 __attribute__((ext_vector_type(8)));
__device__ __forceinline__ void mfma_f8_inplace(f32x4& acc, const i32x8 a, const i32x8 b, int sc) {
    asm volatile("v_mfma_scale_f32_16x16x128_f8f6f4 %0, %1, %2, %0, %3, %3 op_sel_hi:[0,0,0]" : "+v"(acc) : "v"(a), "v"(b), "v"(sc)); }
template <class Desc, class Epi>
__device__ __forceinline__ void gemm_fast(LAS unsigned char* lds, const unsigned char* wsb, const Desc& Dc, const Epi& E, int c, int G, int wave_id) {
    using namespace pg8;
    constexpr bool GATHER = Desc::GATHER; constexpr bool FP8 = Desc::FP8;
    int lane_ = lane_id(); asm volatile("" : "+v"(lane_));
    const int wid = wave_id, lane = lane_, tid = wid * 64 + lane, wr = wid >> 2, wc = wid & 3, fr = lane & 15, fq = lane >> 4;
    unsigned vA[2][2], vAn[2][2], vB[2][2];
#pragma unroll
    for (int i = 0; i < 2; ++i) { int R, C; stage_rc(tid * 16 + i * 8192, R, C); const int Rb = Epi::PERM ? ((R & ~31) + perm32(R & 31)) : R;
#pragma unroll
        for (int h = 0; h < 2; ++h) { vA[h][i] = (unsigned)((h * HALF + R) * Dc.lda + C) * 2u; vB[h][i] = (unsigned)((h * HALF + Rb) * Dc.ldb + C) * 2u; vAn[h][i] = vA[h][i]; } }
    const unsigned ksA = (unsigned)Dc.ksa, ksB = (unsigned)Dc.ksb;
    const __amdgpu_buffer_rsrc_t rs = __builtin_amdgcn_make_buffer_rsrc((void*)wsb, (short)0, 0x7fffffff, 0x00020000);
    const unsigned ldsw = (unsigned)wid * 1024u;
    const int aoff = lds_byte(wr * 64 + fr, fq * 8), boff = lds_byte(wc * 32 + fr, fq * 8);
#define PG8_SA(b, h) (((b) * 2 + (h)) * HTB)
#define PG8_SB(b, h) ((4 + (b) * 2 + (h)) * HTB)
#define PG8_STAGE(bufoff, gbase, voff) do { _Pragma("unroll") for (int _i = 0; _i < 2; ++_i) \
        __builtin_amdgcn_raw_ptr_buffer_load_lds(rs, (LAS unsigned*)(lds + (bufoff) + ldsw + _i * 8192), 16, (int)(voff)[_i], (int)(gbase), 0, 0); } while (0)
#define PG8_LDA(dst, b, h) do { _Pragma("unroll") for (int m = 0; m < 4; ++m) _Pragma("unroll") for (int k = 0; k < 2; ++k) dst[m][k] = *(const LAS bf16x8*)(lds + PG8_SA(b, h) + aoff + m * 2048 + k * 1024); } while (0)
#define PG8_LDB(dst, b, h) do { _Pragma("unroll") for (int n = 0; n < 2; ++n) _Pragma("unroll") for (int k = 0; k < 2; ++k) dst[n][k] = *(const LAS bf16x8*)(lds + PG8_SB(b, h) + boff + n * 2048 + k * 1024); } while (0)
#define PG8_CAT(x) __builtin_shufflevector(__builtin_bit_cast(i32x4, x[0]), __builtin_bit_cast(i32x4, x[1]), 0, 1, 2, 3, 4, 5, 6, 7)
#define PG8_MMA(ai, bj, At, Bt) do { __builtin_amdgcn_s_setprio(1); if constexpr (FP8) { _Pragma("unroll") for (int m = 0; m < 4; ++m) _Pragma("unroll") for (int n = 0; n < 2; ++n) \
        mfma_f8_inplace(acc[ai][bj][m][n], PG8_CAT(Bt[n]), PG8_CAT(At[m]), f8sc); } else { \
        _Pragma("unroll") for (int m = 0; m < 4; ++m) _Pragma("unroll") for (int n = 0; n < 2; ++n) _Pragma("unroll") for (int k = 0; k < 2; ++k) \
        acc[ai][bj][m][n] = __builtin_amdgcn_mfma_f32_16x16x32_bf16(Bt[n][k], At[m][k], acc[ai][bj][m][n], 0, 0, 0); } __builtin_amdgcn_s_setprio(0); } while (0)
#define PG8_WAIT_V(n) asm volatile("s_waitcnt vmcnt(" #n ")" ::: "memory")
#define PG8_WAIT_L(n) asm volatile("s_waitcnt lgkmcnt(" #n ")" ::: "memory")
#define PG8_BAR __builtin_amdgcn_s_barrier()
#define PG8_SCHED __builtin_amdgcn_sched_barrier(0)
#define PG8_GATHER_OFFS(dst, un) do { const int _t = wid * 64 + lane_id(); _Pragma("unroll") for (int _i = 0; _i < 2; ++_i) { int _R, _C; stage_rc(_t * 16 + _i * 8192, _R, _C); \
        _Pragma("unroll") for (int _h = 0; _h < 2; ++_h) dst[_h][_i] = (unsigned)(ldv_i(Dc.tok + (un).rowbase + _h * HALF + _R) * Dc.lda + _C) * 2u; } } while (0)
    int f8sc = 0x7f7f7f7f; asm volatile("" : "+v"(f8sc));
    Unit cur, nxt; int ui = 0;
    if (!Dc.get(c, cur)) return;
    LAS float* const auxb = (LAS float*)(lds + 131072 + 1024);
    E.init(auxb, tid);
    { float r0[16]; E.pre_load(cur, tid, r0); E.pre_store(cur, auxb, tid, r0); }
    Acc acc;
#pragma unroll
    for (int a = 0; a < 2; ++a)
#pragma unroll
        for (int b = 0; b < 2; ++b)
#pragma unroll
            for (int m = 0; m < 4; ++m)
#pragma unroll
                for (int n = 0; n < 2; ++n) acc[a][b][m][n] = (f32x4){0.f, 0.f, 0.f, 0.f};
    bf16x8 At[4][2], B0[2][2], B1[2][2];
    unsigned cA = (unsigned)((const unsigned char*)cur.A - wsb), cB = (unsigned)((const unsigned char*)cur.B - wsb);
    if constexpr (GATHER) { PG8_GATHER_OFFS(vA, cur); }
    PG8_STAGE(PG8_SB(0, 0), cB, vB[0]); PG8_STAGE(PG8_SB(0, 1), cB, vB[1]); PG8_STAGE(PG8_SA(0, 0), cA, vA[0]); PG8_STAGE(PG8_SA(0, 1), cA, vA[1]);
    if (wr == 1) PG8_BAR;
    PG8_WAIT_V(2); PG8_BAR;
    PG8_STAGE(PG8_SB(1, 0), cB + ksB, vB[0]); PG8_STAGE(PG8_SA(1, 0), cA + ksA, vA[0]); PG8_STAGE(PG8_SB(1, 1), cB + ksB, vB[1]);
    PG8_WAIT_V(6); PG8_BAR;
    for (;;) {
        const bool has_next = Dc.get((ui + 1) * G + c, nxt);
        const unsigned nA = has_next ? (unsigned)((const unsigned char*)nxt.A - wsb) : cA, nB = has_next ? (unsigned)((const unsigned char*)nxt.B - wsb) : cB;
        if constexpr (GATHER) { if (has_next) { PG8_GATHER_OFFS(vAn, nxt); } else {
#pragma unroll
            for (int h = 0; h < 2; ++h)
#pragma unroll
                for (int i = 0; i < 2; ++i) vAn[h][i] = vA[h][i]; } }
        const int nt = cur.nt;
        for (int t = 0; t < nt; t += 2) {
            const bool last = (t == nt - 2);
            const unsigned a1 = cA + (unsigned)(t + 1) * ksA;
            const unsigned a2 = last ? nA : cA + (unsigned)(t + 2) * ksA, b2 = last ? nB : cB + (unsigned)(t + 2) * ksB;
            const unsigned a3 = a2 + ksA, b3 = b2 + ksB;
            unsigned x0[2], x1[2];
#pragma unroll
            for (int i = 0; i < 2; ++i) { x0[i] = (GATHER && last) ? vAn[0][i] : vA[0][i]; x1[i] = (GATHER && last) ? vAn[1][i] : vA[1][i]; }
            PG8_LDB(B0, 0, 0); PG8_LDB(B1, 0, 1); PG8_SCHED; PG8_LDA(At, 0, 0); PG8_STAGE(PG8_SA(1, 1), a1, vA[1]);
            PG8_WAIT_V(8); PG8_WAIT_L(0); PG8_BAR; PG8_MMA(0, 0, At, B0); PG8_MMA(0, 1, At, B1); PG8_BAR; PG8_SCHED;
            PG8_LDA(At, 0, 1); PG8_STAGE(PG8_SB(0, 0), b2, vB[0]); PG8_STAGE(PG8_SB(0, 1), b2, vB[1]); PG8_STAGE(PG8_SA(0, 0), a2, x0);
            PG8_WAIT_V(8); PG8_WAIT_L(0); PG8_BAR; PG8_MMA(1, 0, At, B0); PG8_MMA(1, 1, At, B1); PG8_BAR; PG8_SCHED;
            PG8_LDB(B0, 1, 0); PG8_LDB(B1, 1, 1); PG8_SCHED; PG8_LDA(At, 1, 0); PG8_STAGE(PG8_SA(0, 1), a2, x1);
            PG8_WAIT_V(8); PG8_WAIT_L(0); PG8_BAR; PG8_MMA(0, 0, At, B0); PG8_MMA(0, 1, At, B1); PG8_BAR; PG8_SCHED;
            PG8_LDA(At, 1, 1); PG8_STAGE(PG8_SB(1, 0), b3, vB[0]); PG8_STAGE(PG8_SB(1, 1), b3, vB[1]); PG8_STAGE(PG8_SA(1, 0), a3, x0);
            PG8_WAIT_V(8); PG8_WAIT_L(0); PG8_BAR; PG8_MMA(1, 0, At, B0); PG8_MMA(1, 1, At, B1); PG8_BAR; PG8_SCHED;
        }
        if constexpr (FP8) asm volatile("s_nop 15\n\ts_nop 15\n\ts_nop 15\n\ts_nop 15\n\ts_nop 15" ::: "memory");
        if (wr == 0) PG8_BAR;
        { const int l2 = lane_id(); float rn[16];
          if (has_next) E.pre_load(nxt, wid * 64 + l2, rn);
          E(acc, cur, wr, wc, l2 & 15, l2 >> 4, auxb + (ui & 1) * 768);
          if (has_next) E.pre_store(nxt, auxb + ((ui + 1) & 1) * 768, wid * 64 + l2, rn); }
        if (!has_next) break;
#pragma unroll
        for (int a = 0; a < 2; ++a)
#pragma unroll
            for (int b = 0; b < 2; ++b)
#pragma unroll
                for (int m = 0; m < 4; ++m)
#pragma unroll
                    for (int n = 0; n < 2; ++n) acc[a][b][m][n] = (f32x4){0.f, 0.f, 0.f, 0.f};
        cur = nxt; cA = nA; cB = nB; ++ui;
        if constexpr (GATHER) {
#pragma unroll
            for (int h = 0; h < 2; ++h)
#pragma unroll
                for (int i = 0; i < 2; ++i) vA[h][i] = vAn[h][i]; }
        if (wr == 1) PG8_BAR;
    }
    PG8_WAIT_V(0);
    PG8_BAR;
#undef PG8_SA
#undef PG8_SB
#undef PG8_STAGE
#undef PG8_LDA
#undef PG8_LDB
#undef PG8_MMA
#undef PG8_CAT
#undef PG8_WAIT_V
#undef PG8_WAIT_L
#undef PG8_BAR
#undef PG8_SCHED
#undef PG8_GATHER_OFFS
}

struct Frame {
    Params p; unsigned char* ws; LAS unsigned char* lds; int tid, lane, wave, c, G;
    __device__ __forceinline__ float* MOD() const { return (float*)(ws + CT_MOD); }
    __device__ __forceinline__ float* BIAS_IN() const { return (float*)(ws + CT_BIAS_IN); }
    __device__ __forceinline__ float* BIAS_GU() const { return (float*)(ws + CT_BIAS_GU); }
    __device__ __forceinline__ float* BIAS_R() const { return (float*)(ws + CT_BIAS_R); }
    __device__ __forceinline__ float* BIAS_MGU() const { return (float*)(ws + CT_BIAS_MGU); }
    __device__ __forceinline__ float* ROWSS() const { return (float*)(ws + WS_ROWSSP); }
    __device__ __forceinline__ float* MODP() const { return (float*)(ws + WS_MODP); }
    __device__ __forceinline__ f32x2* TABA() const { return (f32x2*)(ws + WS_TABA); }
    __device__ __forceinline__ f32x2* TABB() const { return (f32x2*)(ws + WS_TABB); }
    __device__ __forceinline__ float* GP() const { return (float*)(ws + WS_GP); }
    __device__ __forceinline__ float* WR() const { return (float*)(ws + WS_WR); }
    __device__ __forceinline__ int* TOPE() const { return (int*)(ws + WS_TOPE); }
    __device__ __forceinline__ float* TOPG() const { return (float*)(ws + WS_TOPG); }
    __device__ __forceinline__ int* CNT() const { return (int*)(ws + WS_CNT); }
    __device__ __forceinline__ int* BUFTOK() const { return (int*)(ws + WS_BUFTOK); }
    __device__ __forceinline__ float* BUFGATE() const { return (float*)(ws + WS_BUFGATE); }
    __device__ __forceinline__ int* POS() const { return (int*)(ws + WS_POS); }
    __device__ __forceinline__ int* BLKE() const { return (int*)(ws + WS_BLKE); }
    __device__ __forceinline__ float* RSTD3() const { return (float*)(ws + WS_RSTD3); }
    __device__ __forceinline__ float* BUFRS() const { return (float*)(ws + WS_BUFRS); }
    __device__ __forceinline__ bf16_t* WIN() const { return (bf16_t*)(ws + WS_WIN); }
    __device__ __forceinline__ bf16_t* WOUT() const { return (bf16_t*)(ws + WS_WOUT); }
    __device__ __forceinline__ bf16_t* WGU() const { return (bf16_t*)(ws + WS_WGU); }
    __device__ __forceinline__ bf16_t* WD() const { return (bf16_t*)(ws + WS_WD); }
    __device__ __forceinline__ bf16_t* WP() const { return (bf16_t*)(ws + WS_WP); }
    __device__ __forceinline__ bf16_t* XB() const { return (bf16_t*)(ws + WS_XB); }
    __device__ __forceinline__ bf16_t* Q() const { return (bf16_t*)(ws + WS_Q); }
    __device__ __forceinline__ bf16_t* KN() const { return (bf16_t*)(ws + WS_KN); }
    __device__ __forceinline__ bf16_t* KDT() const { return (bf16_t*)(ws + WS_KDT); }
    __device__ __forceinline__ bf16_t* VT() const { return (bf16_t*)(ws + WS_VT); }
    __device__ __forceinline__ bf16_t* Gb() const { return (bf16_t*)(ws + WS_G); }
    __device__ __forceinline__ bf16_t* SB() const { return (bf16_t*)(ws + WS_SB); }
    __device__ __forceinline__ bf16_t* Y() const { return (bf16_t*)(ws + WS_Y); }
    __device__ __forceinline__ bf16_t* H1() const { return (bf16_t*)(ws + WS_H1); }
    __device__ __forceinline__ bf16_t* PB() const { return (bf16_t*)(ws + WS_PB); }
    __device__ __forceinline__ bf16_t* H1M() const { return (bf16_t*)(ws + WS_H1M); }
    __device__ __forceinline__ bf16_t* WMGU() const { return (bf16_t*)(ws + WS_WMGU); }
    __device__ __forceinline__ bf16_t* WMD() const { return (bf16_t*)(ws + WS_WMD); }
    __device__ __forceinline__ bf16_t* YB() const { return (bf16_t*)(ws + WS_YB); }
    __device__ __forceinline__ float* YBB() const { return (float*)(ws + WS_YBB); }
    __device__ __forceinline__ float* X2() const { return (float*)(ws + WS_X2); }
};
__device__ __forceinline__ void frame_fresh(Frame& F) { int l = lane_id(); asm volatile("" : "+v"(l)); F.lane = l; F.tid = F.wave * 64 + l; }
__device__ __forceinline__ void frame_init(Frame& F, const Params& p, LAS unsigned char* lds, int c, int G) {
    F.p = p; F.ws = p.ws; F.lds = lds; F.tid = threadIdx.x; F.lane = F.tid & 63; F.wave = __builtin_amdgcn_readfirstlane(F.tid >> 6); F.c = c; F.G = G;
}

__device__ __forceinline__ void dsincos(double x, double& s, double& c) {
    const double k = rint(x * 0.6366197723675814); double y = fma(-k, 1.5707963267948966, x); y = fma(-k, 6.123233995736766e-17, y);
    const double z = y * y;
    double sp = -7.6471637318198164759e-13; sp = fma(sp, z, 1.6059043836821614599e-10); sp = fma(sp, z, -2.5052108385441718775e-8); sp = fma(sp, z, 2.7557319223985890653e-6);
    sp = fma(sp, z, -1.9841269841269841270e-4); sp = fma(sp, z, 8.3333333333333333333e-3); sp = fma(sp, z, -1.6666666666666666667e-1); const double sy = fma(sp * z, y, y);
    double cp = 4.7794773323873852974e-14; cp = fma(cp, z, -1.1470745597729724714e-11); cp = fma(cp, z, 2.0876756987868098979e-9); cp = fma(cp, z, -2.7557319223985890653e-7);
    cp = fma(cp, z, 2.4801587301587301587e-5); cp = fma(cp, z, -1.3888888888888888889e-3); cp = fma(cp, z, 4.1666666666666666667e-2); cp = fma(cp, z, -0.5); const double cy = fma(cp, z, 1.0);
    const int q = ((int)k) & 3;
    s = (q == 0) ? sy : (q == 1) ? cy : (q == 2) ? -sy : -cy;
    c = (q == 0) ? cy : (q == 1) ? -sy : (q == 2) ? -cy : sy;
}
__device__ __forceinline__ void phase_p0(Frame& F) {
    const Params& p = F.p; const int gw = F.c * NWAVE + F.wave, NGW = F.G * NWAVE, lane = F.lane;
    LAS float* cact = (LAS float*)F.lds;
    __syncthreads();
    for (int k = F.tid; k < 1024; k += NTHR) cact[k] = silu_f(p.c[k]);
    __syncthreads();
    for (int task = gw; task < 1536; task += NGW) {
        const int i = task / 768, rem = task % 768, cb = rem >> 3, ks = rem & 7, n = cb * 64 + lane;
        const float* w = p.ada_w + (size_t)i * 1024 * NIN + (size_t)(ks * 128) * NIN + n; float a = 0.f;
#pragma unroll
        for (int k0 = 0; k0 < 128; k0 += 32) { float wv[32];
#pragma unroll
            for (int k = 0; k < 32; ++k) wv[k] = w[(size_t)(k0 + k) * NIN];
#pragma unroll
            for (int k = 0; k < 32; ++k) a = fmaf(cact[ks * 128 + k0 + k], wv[k], a); }
        if (ks == 0) a += p.ada_b[i * NIN + n];
        F.MODP()[ks * 12288 + i * NIN + n] = a;
    }
    const int gt = F.c * NTHR + F.tid, NGT = F.G * NTHR;
    for (int e = gt; e < 32768 + 4; e += NGT) {
        if (e < 32768) {
            const int which = e >> 14, ab = (e >> 7) & 127, i = e & 127; double inv = 1.0;
            for (int q = 0; q < i; ++q) inv *= 0.93057204092969897929;
            const double ang = (double)(which == 0 ? 128 * ab : ab) * inv; double s, c2; dsincos(ang, s, c2);
            (which == 0 ? F.TABA() : F.TABB())[ab * 128 + i] = (f32x2){(float)c2, (float)s};
        } else {
            const int h = e - 32768; const double g = 1.0 - 1.0 / (double)(32 << h); double v = 1.0;
            for (int j = 0; j <= 128; ++j) { F.GP()[h * 132 + j] = (float)v; v *= g; }
        }
    }
    for (int row = 2 * gw; row < T; row += 2 * NGW) {
        f32x4 v[2][4];
#pragma unroll
        for (int r = 0; r < 2; ++r) { const f32x4* xr = (const f32x4*)(p.x + (size_t)(row + r) * D) + lane;
#pragma unroll
            for (int j = 0; j < 4; ++j) v[r][j] = xr[64 * j]; }
#pragma unroll
        for (int r = 0; r < 2; ++r) { float s = 0.f;
#pragma unroll
            for (int j = 0; j < 4; ++j) s += (v[r][j].x * v[r][j].x + v[r][j].y * v[r][j].y) + (v[r][j].z * v[r][j].z + v[r][j].w * v[r][j].w);
            s = wave_sum(s); if (lane < 16) F.ROWSS()[(size_t)(row + r) * 16 + lane] = (lane == 0) ? s : 0.f;
            u32x2* o = (u32x2*)(F.XB() + (size_t)(row + r) * D) + lane;
#pragma unroll
            for (int j = 0; j < 4; ++j) { u32x2 w; w.x = pk2(v[r][j].x, v[r][j].y); w.y = pk2(v[r][j].z, v[r][j].w); o[64 * j] = w; } }
    }
}

template <bool F8 = false>
__device__ __forceinline__ void conv_strip(const float* W, int ldw, int kb0, int nkb, int n0, bf16_t* WT, int ldt, int drow0, const LAS float* gsl, const LAS float* shl,
                                           float* bias, float cscale, LAS float* scr, int lane, int tiled_nkt = 0, float wmul = 1.0f) {
    f32x4 bacc = (f32x4){0.f, 0.f, 0.f, 0.f}; f32x4 w[8];
    const int lr = lane >> 3, lc = 4 * (lane & 7);
    const float* wp = W + (size_t)(kb0 * 64 + lr) * ldw + n0 + lc;
#pragma unroll
    for (int i = 0; i < 8; ++i) w[i] = *(const f32x4*)(wp + (size_t)(8 * i) * ldw);
    for (int kb = kb0; kb < kb0 + nkb; ++kb) {
        const int k0 = kb * 64; f32x4 wn[8];
        if (kb + 1 < kb0 + nkb) {
#pragma unroll
            for (int i = 0; i < 8; ++i) wn[i] = *(const f32x4*)(wp + (size_t)(64 * (kb + 1 - kb0) + 8 * i) * ldw);
        } else {
#pragma unroll
            for (int i = 0; i < 8; ++i) wn[i] = (f32x4){0.f, 0.f, 0.f, 0.f};
        }
#pragma unroll
        for (int i = 0; i < 8; ++i) { const int kk = lr + 8 * i;
            float gsv = cscale * wmul; if (gsl) { gsv *= gsl[k0 + kk]; const float sv = shl[k0 + kk]; bacc = bacc + w[i] * sv; }
            *(LAS f32x4*)(scr + kk * 36 + 4 * ((lane & 7) ^ i)) = w[i] * gsv; }
        asm volatile("s_waitcnt lgkmcnt(0)" ::: "memory");
        const int cc = lane & 7;
#pragma unroll
        for (int j = 0; j < 4; ++j) { const int n = (lane >> 3) + 8 * j; const LAS float* s = scr + (8 * cc) * 36 + 4 * ((n >> 2) ^ cc) + (n & 3);
            const int nr = drow0 + n;
            if constexpr (F8) { u32x2 o8; o8.x = pk4f8(s[0 * 36], s[1 * 36], s[2 * 36], s[3 * 36]); o8.y = pk4f8(s[4 * 36], s[5 * 36], s[6 * 36], s[7 * 36]);
                if (tiled_nkt) *(u32x2*)((unsigned char*)WT + (((size_t)(nr >> 8) * tiled_nkt + (kb >> 1)) * 256 + (nr & 255)) * 128 + (kb & 1) * 64 + 8 * cc) = o8;
                else *(u32x2*)((unsigned char*)WT + (size_t)nr * ldt + k0 + 8 * cc) = o8;
                continue; }
            u32x4 o; o.x = pk2(s[0 * 36], s[1 * 36]); o.y = pk2(s[2 * 36], s[3 * 36]); o.z = pk2(s[4 * 36], s[5 * 36]); o.w = pk2(s[6 * 36], s[7 * 36]);
            if (tiled_nkt) *(u32x4*)(WT + (((size_t)(nr >> 8) * tiled_nkt + kb) * 256 + (nr & 255)) * 64 + 8 * cc) = o;
            else *(u32x4*)(WT + (size_t)nr * ldt + k0 + 8 * cc) = o; }
        asm volatile("s_waitcnt lgkmcnt(0)" ::: "memory");
#pragma unroll
        for (int i = 0; i < 8; ++i) w[i] = wn[i];
    }
    if (bias) {
#pragma unroll
        for (int o = 8; o < 64; o <<= 1) { bacc.x += __shfl_xor(bacc.x, o); bacc.y += __shfl_xor(bacc.y, o); bacc.z += __shfl_xor(bacc.z, o); bacc.w += __shfl_xor(bacc.w, o); }
        if (lane < 8) *(f32x4*)(bias + drow0 + lc) = bacc * cscale; }
}
__device__ __forceinline__ void phase_p1(Frame& F) {
    const Params& p = F.p; const int gw = F.c * NWAVE + F.wave, NGW = F.G * NWAVE, lane = F.lane;
    LAS float* modl = (LAS float*)F.lds;
    LAS float* scr = (LAS float*)(F.lds + 49152 + F.wave * 9216);
    __syncthreads();
    for (int idx = F.tid; idx < 12288; idx += NTHR) { float v = 0.f;
#pragma unroll
        for (int ks = 0; ks < 8; ++ks) v += F.MODP()[ks * 12288 + idx];
        modl[idx] = v; if ((idx % F.G) == F.c) F.MOD()[idx] = v; }
    __syncthreads();
    const LAS float* MOD0 = modl; const LAS float* MOD1 = modl + NIN; const LAS float* nul = nullptr;
    LAS float* gs_in = modl + 2048; LAS float* gs_ffn = modl + 5120; LAS float* gs_pool = modl + NIN + 2048;
    for (int k = F.tid; k < 1024; k += NTHR) { gs_in[k] = p.norm_gain[k] * (1.0f + MOD0[1024 + k]); gs_ffn[k] = p.norm_gain[1024 + k] * (1.0f + MOD0[4 * 1024 + k]); gs_pool[k] = p.norm_gain[2048 + k] * (1.0f + MOD1[1024 + k]); }
    __syncthreads();
    constexpr int S_IN = 192 * 4, S_G = 88 * 4, I_OUT = 32 * 32, I_D = 44 * 32, I_P = 4 * 4 * 8;
    constexpr int NIT = S_IN + 2 * S_G + I_OUT + I_D + I_P + 1;
    for (int it = gw; it < NIT; it += NGW) {
        int r = it;
        if (r < S_IN) { const int part = r / 192, n0 = (r % 192) * 32; const float cs = (n0 >= 1024 && n0 < 2048) ? 0.0625f : 1.0f;
            conv_strip(p.ret_w_in, NIN, 4 * part, 4, n0, F.WIN(), 1024, n0, gs_in, MOD0, F.BIAS_IN() + part * NIN, cs, scr, lane); continue; } r -= S_IN;
        if (r < 2 * S_G) { const int up = r >= S_G; if (up) r -= S_G; const int part = r / 88, n0 = (r % 88) * 32, drow = (n0 >> 7) * 256 + (up ? 128 : 0) + (n0 & 127);
            conv_strip(up ? p.ffn_w_up : p.ffn_w_gate, DFF, 4 * part, 4, n0, F.WGU(), 1024, drow, gs_ffn, MOD0 + 3 * 1024, F.BIAS_GU() + part * 5632, 1.0f, scr, lane); continue; } r -= 2 * S_G;
        if (r < I_OUT) { const int kb = r / 32, nb = r % 32; conv_strip(p.ret_w_out, 1024, kb, 1, nb * 32, F.WOUT(), 2048, nb * 32, nul, nul, nullptr, 1.0f, scr, lane); continue; } r -= I_OUT;
        if (r < I_D) { const int kb = r / 32, nb = r % 32; conv_strip<true>(p.ffn_w_down, 1024, kb, 1, nb * 32, F.WD(), DFF, nb * 32, nul, nul, nullptr, 1.0f, scr, lane, 22, F8_DSCALE); continue; } r -= I_D;
        if (r < I_P) { const int g = r / 32, q = r % 32, kb = q / 8, nb = q % 8;
            conv_strip(p.pool_w + (size_t)g * 65536, 256, kb, 1, nb * 32, F.WP() + (size_t)g * 65536, 256, nb * 32, gs_pool + g * 256, MOD1 + g * 256, nullptr, 1.0f, scr, lane); continue; }
        { float ba = 0.f; const int e = lane & 7;
            for (int k0 = lane >> 3; k0 < 1024; k0 += 128) { float w[16], gn[16];
#pragma unroll
                for (int j = 0; j < 16; ++j) { const int k = k0 + 8 * j; w[j] = p.moe_router[k * 8 + e]; gn[j] = p.norm_gain[3 * 1024 + k]; }
#pragma unroll
                for (int j = 0; j < 16; ++j) { const int k = k0 + 8 * j; F.WR()[k * 8 + e] = w[j] * (gn[j] * (1.0f + MOD1[4 * 1024 + k])); ba = fmaf(MOD1[3 * 1024 + k], w[j], ba); } }
            ba += __shfl_xor(ba, 8); ba += __shfl_xor(ba, 16); ba += __shfl_xor(ba, 32);
            if (lane < 8) F.BIAS_R()[lane] = ba; }
    }
}
constexpr int PX_SG = 112 * 4, PX_EARLY = 1024;
__device__ __forceinline__ void px_tables(Frame& F) {
    const Params& p = F.p;
    LAS float* gsl = (LAS float*)(F.lds + 8 * 9216 + 1024);
    LAS float* shl = gsl + 1024;
    const float* MOD1 = F.MOD() + NIN;
    for (int k = F.tid; k < 1024; k += NTHR) { gsl[k] = p.norm_gain[3 * 1024 + k] * (1.0f + ldv_f(MOD1 + 4 * 1024 + k)); shl[k] = ldv_f(MOD1 + 3 * 1024 + k); }
    __syncthreads();
}
__device__ __forceinline__ void px_gu_item(Frame& F, int it, int lane) {
    const Params& p = F.p;
    LAS float* scr = (LAS float*)(F.lds + F.wave * 9216);
    LAS float* gsl = (LAS float*)(F.lds + 8 * 9216 + 1024); LAS float* shl = gsl + 1024;
    const int e = it / (2 * PX_SG); int r = it % (2 * PX_SG); const int up = r >= PX_SG; if (up) r -= PX_SG;
    const int part = r / 112, n0 = (r % 112) * 32, drow = e * 7168 + (n0 >> 7) * 256 + (up ? 128 : 0) + (n0 & 127);
    conv_strip<true>((up ? p.moe_w_up : p.moe_w_gate) + (size_t)e * 1024 * DFE, DFE, 4 * part, 4, n0, F.WMGU(), 1024, drow, gsl, shl,
                     F.BIAS_MGU() + (part >> 1) * 262144 + (part & 1) * 57344, 1.0f, scr, lane, 0, F8_WSCALE);
}
__device__ __forceinline__ void phase_px(Frame& F) {
    const Params& p = F.p; const int gw = F.c * NWAVE + F.wave, NGW = F.G * NWAVE, lane = F.lane;
    LAS float* scr = (LAS float*)(F.lds + F.wave * 9216);
    const LAS float* nul = nullptr;
    px_tables(F);
    constexpr int I_D = 14 * 32;
    for (int it = (F.G == 256 ? PX_EARLY : 0) + gw; it < NE * 2 * PX_SG; it += NGW) px_gu_item(F, it, lane);
    const int lane2 = lane_id();
    for (int it = gw; it < NE * I_D; it += NGW) {
        const int e = it / I_D, r = it % I_D, kg = r / 32, nb = r % 32;
        conv_strip<true>(p.moe_w_down + (size_t)e * DFE * 1024, 1024, 4 * kg, 4, nb * 32, (bf16_t*)((unsigned char*)F.WMD() + (size_t)e * 1024 * DFE), DFE, nb * 32, nul, nul, nullptr, 1.0f, scr, lane2, 28, F8_DSCALE);
    }
}

__device__ __forceinline__ void phase_scan(Frame& F) {
    const int gt = F.c * NTHR + F.tid, NGT = F.G * NTHR;
    for (int v = gt; v < 131072; v += NGT) {
        const int h = v >> 15; const float dec = F.GP()[h * 132 + 128]; float s0 = 0.f, s1 = 0.f, s2 = 0.f, s3 = 0.f;
        u32x2* ptr = (u32x2*)(F.SB() + (size_t)v * 4);
        for (int n0 = 0; n0 < 128; n0 += 16) {
            u32x2 kv[16];
#pragma unroll
            for (int j = 0; j < 16; ++j) { kv[j] = (u32x2){0u, 0u}; if (n0 + j < 127) kv[j] = ptr[(size_t)(n0 + j) * 131072]; }
#pragma unroll
            for (int j = 0; j < 16; ++j) {
                u32x2 o; o.x = pk2(s0, s1); o.y = pk2(s2, s3); ptr[(size_t)(n0 + j) * 131072] = o;
                s0 = s0 * dec + bflo(kv[j].x); s1 = s1 * dec + bfhi(kv[j].x); s2 = s2 * dec + bflo(kv[j].y); s3 = s3 * dec + bfhi(kv[j].y); }
        }
    }
}

namespace ret {
constexpr int BUFB = 40960, OFF_B = 8192, OFF_P = 81920, OFF_RED = 114688, OFF_GP = 118784;
__device__ __forceinline__ int swz(int o) { return o ^ (((o >> 9) & 1) << 5); }
}
#define RET_WAITV(n) asm volatile("s_waitcnt vmcnt(" #n ")" ::: "memory")
#define RET_WAITL0() asm volatile("s_waitcnt lgkmcnt(0)" ::: "memory")
#define RET_BAR() do { asm volatile("" ::: "memory"); __builtin_amdgcn_s_barrier(); asm volatile("" ::: "memory"); } while (0)
__device__ __forceinline__ void phase_ret_fast(Frame& F) {
    using namespace ret;
    const Params& p = F.p; LAS unsigned char* lds = F.lds;
    const int tid = F.tid, lane = tid & 63, wid = F.wave, wr = wid >> 2, wc = wid & 3, fr = lane & 15, fq = lane >> 4;
    const int foff = swz(fr * 64 + fq * 16);
    const int srow = lane >> 2, scol = ((lane & 3) * 8) ^ (((lane >> 5) & 1) * 16);
    LAS float* gps = (LAS float*)(lds + OFF_GP); LAS f32x2* red = (LAS f32x2*)(lds + OFF_RED);
    __syncthreads();
    for (int i = tid; i < 4 * 132; i += NTHR) gps[i] = F.GP()[i];
    __syncthreads();
    const __amdgpu_buffer_rsrc_t rs = __builtin_amdgcn_make_buffer_rsrc((void*)F.ws, (short)0, 0x7fffffff, 0x00020000);
    const unsigned qoff = (unsigned)((16 * wid + srow) * 1024 + scol) * 2u;
    unsigned soff[4], voff[4];
#pragma unroll
    for (int i = 0; i < 4; ++i) { soff[i] = (unsigned)((16 * (wid + 8 * i) + srow) * 256 + scol) * 2u; voff[i] = (unsigned)((16 * (wid + 8 * i) + srow) * T + scol) * 2u; }
#define RET_GLDS(uoff, loff, dst) __builtin_amdgcn_raw_ptr_buffer_load_lds(rs, (LAS unsigned*)(lds + (dst)), 16, (int)(loff), (int)(uoff), 0, 0)
#define RET_LOADS(kind, ks, b, hh, nn) do { const unsigned _qk = (unsigned)((nn) * 128 * 1024 + (hh) * 256 + 32 * (ks)) * 2u; \
        if ((kind) != 2) RET_GLDS((unsigned)WS_Q + _qk, qoff, (b) * BUFB + wid * 1024); \
        if ((kind) == 0) RET_GLDS((unsigned)WS_KN + _qk, qoff, (b) * BUFB + OFF_B + wid * 1024); \
        if ((kind) == 1) { const unsigned _sb = (unsigned)WS_SB + (unsigned)(((nn) * 4 + (hh)) * 512 * 256 + 32 * (ks)) * 2u; _Pragma("unroll") for (int _i = 0; _i < 4; ++_i) \
            RET_GLDS(_sb, soff[_i], (b) * BUFB + OFF_B + (wid + 8 * _i) * 1024); } \
        if ((kind) == 2) { const unsigned _vb = (unsigned)WS_VT + (unsigned)((hh) * 512 * T + (nn) * 128 + 32 * (ks)) * 2u; _Pragma("unroll") for (int _i = 0; _i < 4; ++_i) \
            RET_GLDS(_vb, voff[_i], (b) * BUFB + OFF_B + (wid + 8 * _i) * 1024); } } while (0)
    int u = F.c;
    if (u >= 512) return;
    { const int h = u & 3, n = u >> 2; RET_LOADS(0, 0, 0, h, n); }
    for (; u < 512; u += F.G) {
        const int h = u & 3, n = u >> 2, t0 = n * 128; const int un = u + F.G; const bool has_next = un < 512; const int hn = un & 3, nn = un >> 2;
        f32x4 pacc[4][2];
#pragma unroll
        for (int m = 0; m < 4; ++m)
#pragma unroll
            for (int q = 0; q < 2; ++q) pacc[m][q] = (f32x4){0.f, 0.f, 0.f, 0.f};
#pragma unroll
        for (int ks = 0; ks < 8; ++ks) {
            const int b = ks & 1;
            if (ks < 7) { RET_LOADS(0, ks + 1, b ^ 1, h, n); RET_WAITV(2); } else { RET_LOADS(1, 0, b ^ 1, h, n); RET_WAITV(5); }
            RET_BAR();
            bf16x8 af[4], bf[2];
#pragma unroll
            for (int m = 0; m < 4; ++m) af[m] = *(const LAS bf16x8*)(lds + b * BUFB + (4 * wr + m) * 1024 + foff);
#pragma unroll
            for (int q = 0; q < 2; ++q) bf[q] = *(const LAS bf16x8*)(lds + b * BUFB + OFF_B + (2 * wc + q) * 1024 + foff);
            RET_WAITL0(); RET_BAR();
#pragma unroll
            for (int m = 0; m < 4; ++m)
#pragma unroll
                for (int q = 0; q < 2; ++q) pacc[m][q] = __builtin_amdgcn_mfma_f32_16x16x32_bf16(bf[q], af[m], pacc[m][q], 0, 0, 0);
            __builtin_amdgcn_sched_barrier(0);
        }
        { int l2 = lane; asm volatile("" : "+v"(l2)); const int fr = l2 & 15, fq = l2 >> 4;
#pragma unroll
        for (int m = 0; m < 4; ++m)
#pragma unroll
            for (int q = 0; q < 2; ++q) { const int r = 64 * wr + 16 * m + fr, cc = 32 * wc + 16 * q + 4 * fq; float v[4];
#pragma unroll
                for (int j = 0; j < 4; ++j) { const int dd = r - (cc + j); v[j] = dd >= 0 ? pacc[m][q][j] * gps[h * 132 + dd] : 0.f; }
                u32x2 w; w.x = pk2(v[0], v[1]); w.y = pk2(v[2], v[3]);
                *(LAS u32x2*)(lds + OFF_P + wc * 8192 + (4 * wr + m) * 1024 + swz(fr * 64 + 32 * q + 8 * fq)) = w; } }
        f32x4 acc[4][8];
#pragma unroll
        for (int m = 0; m < 4; ++m)
#pragma unroll
            for (int q = 0; q < 8; ++q) acc[m][q] = (f32x4){0.f, 0.f, 0.f, 0.f};
#pragma unroll
        for (int ks = 0; ks < 8; ++ks) {
            const int b = ks & 1;
            if (ks < 7) { RET_LOADS(1, ks + 1, b ^ 1, h, n); RET_WAITV(5); } else { RET_LOADS(2, 0, b ^ 1, h, n); RET_WAITV(4); }
            RET_BAR();
            bf16x8 af[4], bf[8];
#pragma unroll
            for (int m = 0; m < 4; ++m) af[m] = *(const LAS bf16x8*)(lds + b * BUFB + (4 * wr + m) * 1024 + foff);
#pragma unroll
            for (int q = 0; q < 8; ++q) bf[q] = *(const LAS bf16x8*)(lds + b * BUFB + OFF_B + (8 * wc + q) * 1024 + foff);
            RET_WAITL0(); RET_BAR();
#pragma unroll
            for (int m = 0; m < 4; ++m)
#pragma unroll
                for (int q = 0; q < 8; ++q) acc[m][q] = __builtin_amdgcn_mfma_f32_16x16x32_bf16(bf[q], af[m], acc[m][q], 0, 0, 0);
            __builtin_amdgcn_sched_barrier(0);
        }
        { int l3 = lane; asm volatile("" : "+v"(l3)); const int fr = l3 & 15;
#pragma unroll
        for (int m = 0; m < 4; ++m) { const float qd = gps[h * 132 + 64 * wr + 16 * m + fr + 1];
#pragma unroll
            for (int q = 0; q < 8; ++q) acc[m][q] = acc[m][q] * qd; } }
#pragma unroll
        for (int ks = 0; ks < 4; ++ks) {
            const int b = ks & 1;
            if (ks < 3) { RET_LOADS(2, ks + 1, b ^ 1, h, n); RET_WAITV(4); }
            else if (has_next) { RET_LOADS(0, 0, b ^ 1, hn, nn); RET_WAITV(2); }
            else { RET_WAITV(0); }
            RET_BAR();
            bf16x8 af[4], bf[8];
#pragma unroll
            for (int m = 0; m < 4; ++m) af[m] = *(const LAS bf16x8*)(lds + OFF_P + ks * 8192 + (4 * wr + m) * 1024 + foff);
#pragma unroll
            for (int q = 0; q < 8; ++q) bf[q] = *(const LAS bf16x8*)(lds + b * BUFB + OFF_B + (8 * wc + q) * 1024 + foff);
            RET_WAITL0(); RET_BAR();
#pragma unroll
            for (int m = 0; m < 4; ++m)
#pragma unroll
                for (int q = 0; q < 8; ++q) acc[m][q] = __builtin_amdgcn_mfma_f32_16x16x32_bf16(bf[q], af[m], acc[m][q], 0, 0, 0);
            __builtin_amdgcn_sched_barrier(0);
        }
        { int l4 = lane; asm volatile("" : "+v"(l4)); const int fr = l4 & 15, fq = l4 >> 4;
#pragma unroll
        for (int m = 0; m < 4; ++m) { float s1 = 0.f, s2 = 0.f;
#pragma unroll
            for (int q = 0; q < 8; ++q) { const f32x4 v = acc[m][q]; s1 += (v.x + v.y) + (v.z + v.w); s2 += (v.x * v.x + v.y * v.y) + (v.z * v.z + v.w * v.w); }
            s1 += __shfl_xor(s1, 16); s1 += __shfl_xor(s1, 32); s2 += __shfl_xor(s2, 16); s2 += __shfl_xor(s2, 32);
            if (fq == 0) red[(64 * wr + 16 * m + fr) * 4 + wc] = (f32x2){s1, s2}; }
        RET_WAITL0(); RET_BAR();
#pragma unroll
        for (int m = 0; m < 4; ++m) { const int r = 64 * wr + 16 * m + fr; const f32x2 a = red[r * 4 + 0], b2 = red[r * 4 + 1], c2 = red[r * 4 + 2], d2 = red[r * 4 + 3];
            const float mu = ((a.x + b2.x) + (c2.x + d2.x)) * (1.0f / 512.0f), ex2 = ((a.y + b2.y) + (c2.y + d2.y)) * (1.0f / 512.0f);
            const float rs = 1.0f / sqrtf(ex2 - mu * mu + EPS); const size_t rowoff = (size_t)(t0 + r) * 2048 + h * 512 + 128 * wc + 4 * fq;
#pragma unroll
            for (int q = 0; q < 8; ++q) { const u32x2 gw = *(const u32x2*)(F.Gb() + rowoff + 16 * q); const f32x4 gn = *(const f32x4*)(p.ret_gn_gain + h * 512 + 128 * wc + 16 * q + 4 * fq);
                const f32x4 v = acc[m][q]; u32x2 w;
                w.x = pk2((v.x - mu) * rs * gn.x * bflo(gw.x), (v.y - mu) * rs * gn.y * bfhi(gw.x)); w.y = pk2((v.z - mu) * rs * gn.z * bflo(gw.y), (v.w - mu) * rs * gn.w * bfhi(gw.y));
                *(u32x2*)(F.Y() + rowoff + 16 * q) = w; }
             } }
        RET_BAR();
    }
    RET_WAITV(0); RET_BAR();
#undef RET_GLDS
#undef RET_LOADS
}

namespace pf { constexpr int XTP = 132, OFF_RS = 42496, OFF_PT = 43008, OFF_WB = 59392, OFF_END = 124928; }
template <int W>
__device__ __forceinline__ void pf_pool(LAS unsigned char* lds, int t0, int tid) {
    using namespace pf; const LAS float* XT = (const LAS float*)lds; const LAS float* RS = (const LAS float*)(lds + OFF_RS);
    const int cp = tid & 63, tb = tid >> 6, r0 = 8 * tb, ch = 2 * cp; float s0 = 0.f, s1 = 0.f;
#pragma unroll
    for (int i = 1; i < W; ++i) { const int rr = 16 + r0 - i; const f32x2 xv = *(const LAS f32x2*)(XT + rr * XTP + ch); const float rs = RS[rr]; s0 += xv.x * rs; s1 += xv.y * rs; }
#pragma unroll
    for (int j = 0; j < 8; ++j) { const int r = r0 + j, rr = 16 + r; const f32x2 xv = *(const LAS f32x2*)(XT + rr * XTP + ch); const float rs = RS[rr]; const float a0 = xv.x * rs, a1 = xv.y * rs;
        s0 += a0; s1 += a1; const int t = t0 + r; const float ic = 1.0f / (float)((t + 1) < W ? (t + 1) : W);
        *(LAS unsigned*)(lds + OFF_PT + (ch >> 5) * 4096 + (r >> 4) * 1024 + ret::swz((r & 15) * 64 + (ch & 31) * 2)) = pk2(s0 * ic - a0, s1 * ic - a1);
        const int ro = rr - W + 1; const f32x2 xo = *(const LAS f32x2*)(XT + ro * XTP + ch); const float rso = RS[ro]; s0 -= xo.x * rso; s1 -= xo.y * rso; }
}
__device__ __forceinline__ void phase_pool_fused(Frame& F) {
    using namespace pf;
    const Params& p = F.p; LAS unsigned char* lds = F.lds; const int tid = F.tid, lane = F.lane, wid = F.wave;
    const float* X2 = F.X2(); const float* rss = F.ROWSS(); const float* g1 = F.MOD() + NIN + 2 * 1024; const float* WRg = F.WR();
    LAS float* XT = (LAS float*)lds; LAS float* RS = (LAS float*)(lds + OFF_RS);
    const int foff = ret::swz((lane & 15) * 64 + (lane >> 4) * 16);
    const int srow = lane >> 2, scol = ((lane & 3) * 8) ^ (((lane >> 5) & 1) * 16);
    const __amdgpu_buffer_rsrc_t rs_ws = __builtin_amdgcn_make_buffer_rsrc((void*)F.ws, (short)0, 0x7fffffff, 0x00020000);
    unsigned loff[2];
#pragma unroll
    for (int i = 0; i < 2; ++i) loff[i] = (unsigned)((16 * (wid + 8 * i) + srow) * 256 + scol) * 2u;
    for (int seg = F.c; seg < 256; seg += F.G) {
        const int t0 = seg * 64;
        float ss[4], lg[4][8];
#pragma unroll
        for (int m = 0; m < 4; ++m) { ss[m] = 0.f;
#pragma unroll
            for (int e = 0; e < 8; ++e) lg[m][e] = 0.f; }
        __syncthreads();
        if (tid < 80) { const int tt = t0 - 16 + tid; RS[tid] = tt >= 0 ? rstd_row(rss, tt) : 0.f; }
        f32x4 acc[4][2]; f32x4 xv[5];
#define PF_LOADX(gg, kk) do { int _tl = tid; asm volatile("" : "+v"(_tl)); _Pragma("unroll") for (int _i = 0; _i < 5; ++_i) { const int _idx = _tl + 512 * _i, _rr = _idx >> 5, _c4 = (_idx & 31) * 4; const int _tt = t0 - 16 + _rr; \
            xv[_i] = *(const f32x4*)(X2 + (size_t)(_tt < 0 ? 0 : _tt) * 1024 + 256 * (gg) + 128 * (kk) + _c4); } } while (0)
        PF_LOADX(0, 0);
#pragma unroll 1
        for (int it = 0; it < 8; ++it) {
            const int g = it >> 1, kh = it & 1;
            if (kh == 0) {
#pragma unroll
                for (int m = 0; m < 4; ++m) { acc[m][0] = (f32x4){0.f, 0.f, 0.f, 0.f}; acc[m][1] = (f32x4){0.f, 0.f, 0.f, 0.f}; } }
            {
                __syncthreads();
                int tl = tid; asm volatile("" : "+v"(tl));
#pragma unroll
                for (int i = 0; i < 5; ++i) { const int idx = tl + 512 * i, rr = idx >> 5, c4 = (idx & 31) * 4; *(LAS f32x4*)(XT + rr * XTP + c4) = xv[i]; }
#pragma unroll
                for (int kc = 0; kc < 4; ++kc)
#pragma unroll
                    for (int i = 0; i < 2; ++i)
                        __builtin_amdgcn_raw_ptr_buffer_load_lds(rs_ws, (LAS unsigned*)(lds + OFF_WB + kc * 16384 + (wid + 8 * i) * 1024), 16, (int)loff[i], (int)((unsigned)WS_WP + (unsigned)(g * 65536 + kh * 128 + 32 * kc) * 2u), 0, 0);
                { const int itn = it < 7 ? it + 1 : 7; PF_LOADX(itn >> 1, itn & 1); }
                __syncthreads();
                if (g == 0) pf_pool<2>(lds, t0, tl); else if (g == 1) pf_pool<4>(lds, t0, tl); else if (g == 2) pf_pool<8>(lds, t0, tl); else pf_pool<16>(lds, t0, tl);
                asm volatile("s_waitcnt vmcnt(5)" ::: "memory");
                __syncthreads();
#pragma unroll
                for (int kc = 0; kc < 4; ++kc) { bf16x8 af[4], bf[2];
#pragma unroll
                    for (int m = 0; m < 4; ++m) af[m] = *(const LAS bf16x8*)(lds + OFF_PT + kc * 4096 + m * 1024 + foff);
#pragma unroll
                    for (int n = 0; n < 2; ++n) bf[n] = *(const LAS bf16x8*)(lds + OFF_WB + kc * 16384 + (2 * wid + n) * 1024 + foff);
#pragma unroll
                    for (int m = 0; m < 4; ++m)
#pragma unroll
                        for (int n = 0; n < 2; ++n) acc[m][n] = __builtin_amdgcn_mfma_f32_16x16x32_bf16(bf[n], af[m], acc[m][n], 0, 0, 0); }
            }
            if (kh == 0) continue;
            { int l5 = lane; asm volatile("" : "+v"(l5)); const int fr = l5 & 15, fq = l5 >> 4;
              f32x4 x2a[2][4];
#pragma unroll
              for (int n = 0; n < 2; ++n)
#pragma unroll
                for (int m = 0; m < 4; ++m) x2a[n][m] = *(const f32x4*)(X2 + (size_t)(t0 + 16 * m + fr) * 1024 + 256 * g + 32 * wid + 16 * n + 4 * fq);
              f32x4 bva[2], sva[2], gva[2], wra[2][4], wrb[2][4];
#pragma unroll
              for (int n = 0; n < 2; ++n) { const int cg = 256 * g + 32 * wid + 16 * n + 4 * fq;
                bva[n] = *(const f32x4*)(p.pool_b + cg); sva[n] = *(const f32x4*)(p.pool_scale + cg); gva[n].x = ldv_f(g1 + cg); gva[n].y = ldv_f(g1 + cg + 1); gva[n].z = ldv_f(g1 + cg + 2); gva[n].w = ldv_f(g1 + cg + 3);
#pragma unroll
                for (int j = 0; j < 4; ++j) { wra[n][j] = *(const f32x4*)(WRg + (cg + j) * 8); wrb[n][j] = *(const f32x4*)(WRg + (cg + j) * 8 + 4); } }
#pragma unroll
              for (int n = 0; n < 2; ++n) { const int cg = 256 * g + 32 * wid + 16 * n + 4 * fq;
                const f32x4 bv = bva[n], sv = sva[n], gv = gva[n];
                f32x4 wr0[4], wr1[4];
#pragma unroll
                for (int j = 0; j < 4; ++j) { wr0[j] = wra[n][j]; wr1[j] = wrb[n][j]; }
#pragma unroll
                for (int m = 0; m < 4; ++m) { const size_t o = (size_t)(t0 + 16 * m + fr) * 1024 + cg;
                    const f32x4 xo = x2a[n][m] + gv * ((acc[m][n] + bv) * sv);
                    *(f32x4*)(p.out + o) = xo; *(unsigned*)((unsigned char*)F.XB() + o) = pk4f8(xo.x, xo.y, xo.z, xo.w);
                    ss[m] += (xo.x * xo.x + xo.y * xo.y) + (xo.z * xo.z + xo.w * xo.w);
                    lg[m][0] += xo.x * wr0[0].x + xo.y * wr0[1].x + xo.z * wr0[2].x + xo.w * wr0[3].x; lg[m][1] += xo.x * wr0[0].y + xo.y * wr0[1].y + xo.z * wr0[2].y + xo.w * wr0[3].y;
                    lg[m][2] += xo.x * wr0[0].z + xo.y * wr0[1].z + xo.z * wr0[2].z + xo.w * wr0[3].z; lg[m][3] += xo.x * wr0[0].w + xo.y * wr0[1].w + xo.z * wr0[2].w + xo.w * wr0[3].w;
                    lg[m][4] += xo.x * wr1[0].x + xo.y * wr1[1].x + xo.z * wr1[2].x + xo.w * wr1[3].x; lg[m][5] += xo.x * wr1[0].y + xo.y * wr1[1].y + xo.z * wr1[2].y + xo.w * wr1[3].y;
                    lg[m][6] += xo.x * wr1[0].z + xo.y * wr1[1].z + xo.z * wr1[2].z + xo.w * wr1[3].z; lg[m][7] += xo.x * wr1[0].w + xo.y * wr1[1].w + xo.z * wr1[2].w + xo.w * wr1[3].w; } } }
        }
#undef PF_LOADX
#pragma unroll
        for (int m = 0; m < 4; ++m) { ss[m] += __shfl_xor(ss[m], 16); ss[m] += __shfl_xor(ss[m], 32);
#pragma unroll
            for (int e = 0; e < 8; ++e) { lg[m][e] += __shfl_xor(lg[m][e], 16); lg[m][e] += __shfl_xor(lg[m][e], 32); } }
        __syncthreads();
        { LAS float* red = (LAS float*)lds; int l6 = lane; asm volatile("" : "+v"(l6)); const int fr = l6 & 15;
          if ((l6 >> 4) == 0) {
#pragma unroll
            for (int m = 0; m < 4; ++m) { LAS float* q = red + ((16 * m + fr) * 8 + wid) * 12; q[0] = ss[m];
#pragma unroll
                for (int e = 0; e < 8; ++e) q[1 + e] = lg[m][e]; } }
          LAS int* cnt = (LAS int*)(lds + OFF_RS);
          if (tid < 8) cnt[tid] = 0;
          __syncthreads();
          if (tid < 64) { float sq = 0.f, a[8];
#pragma unroll
            for (int e = 0; e < 8; ++e) a[e] = 0.f;
#pragma unroll
            for (int w = 0; w < 8; ++w) { const LAS float* q = red + (tid * 8 + w) * 12; sq += q[0];
#pragma unroll
                for (int e = 0; e < 8; ++e) a[e] += q[1 + e]; }
            const int t = t0 + tid; const float rs = rstd_of(sq); float lgt[8]; F.RSTD3()[t] = rs;
#pragma unroll
            for (int e = 0; e < 8; ++e) lgt[e] = rs * a[e] + ldv_f(F.BIAS_R() + e);
            int e0 = 0; float l0 = lgt[0];
#pragma unroll
            for (int e = 1; e < 8; ++e) if (lgt[e] > l0) { l0 = lgt[e]; e0 = e; }
            int e1 = -1; float l1 = -3.0e38f;
#pragma unroll
            for (int e = 0; e < 8; ++e) if (e != e0 && lgt[e] > l1) { l1 = lgt[e]; e1 = e; }
            const float g0 = 1.0f / (1.0f + __expf(l1 - l0));
            F.TOPE()[t * 2] = e0; F.TOPE()[t * 2 + 1] = e1; F.TOPG()[t * 2] = g0; F.TOPG()[t * 2 + 1] = 1.0f - g0;
            atomicAdd((int*)(cnt + e0), 1); atomicAdd((int*)(cnt + e1), 1); }
          __syncthreads();
          if (tid < 8) F.CNT()[seg * 8 + tid] = cnt[tid]; }
    }
    __syncthreads();
}

__device__ __forceinline__ void phase_route2(Frame& F) {
    const int tid = F.tid;
    LAS int* cn = (LAS int*)F.lds;
    LAS int* part = cn + 2048;
    LAS int* tot = part + 512;
    LAS int* te = tot + 32;
    __syncthreads();
    for (int i = tid; i < 2048; i += NTHR) cn[i] = ldv_i(F.CNT() + i);
    __syncthreads();
    { const int e = tid & 7, pq = tid >> 3; part[pq * 8 + e] = cn[(4 * pq) * 8 + e] + cn[(4 * pq + 1) * 8 + e] + cn[(4 * pq + 2) * 8 + e] + cn[(4 * pq + 3) * 8 + e]; }
    __syncthreads();
    if (tid < 8) { int run = 0; for (int q = 0; q < 64; ++q) { const int v = part[q * 8 + tid]; part[q * 8 + tid] = run; run += v; } tot[tid] = run; }
    __syncthreads();
    { const int e = tid & 7, pq = tid >> 3; int run = part[pq * 8 + e];
#pragma unroll
        for (int j = 0; j < 4; ++j) { const int v = cn[(4 * pq + j) * 8 + e]; cn[(4 * pq + j) * 8 + e] = run; run += v; } }
    if (tid == 0) { int sp = 0; for (int e = 0; e < 8; ++e) { const int pd = (tot[e] + 255) / 256 * 256; tot[8 + e] = sp; tot[16 + e] = pd; sp += pd; } tot[24] = sp / 256; }
    __syncthreads();
    for (int seg = F.c; seg < 256; seg += F.G) {
        int e = -1; if (tid < 128) e = ldv_i(F.TOPE() + seg * 128 + tid);
        int rank = 0;
#pragma unroll
        for (int ee = 0; ee < 8; ++ee) { const unsigned long long m = __ballot(e == ee); if (e == ee) rank = __popcll(m & ((1ull << F.lane) - 1ull)); if (tid == 0) te[ee] = __popcll(m); }
        __syncthreads();
        if (tid < 128) { if (tid >= 64) rank += te[e];
            const int pos = tot[8 + e] + cn[seg * 8 + e] + rank, idx = seg * 128 + tid;
            const float gt = ldv_f(F.TOPG() + idx), rsd = ldv_f(F.RSTD3() + (idx >> 1));
            F.BUFTOK()[pos] = idx >> 1; F.BUFGATE()[pos] = gt; F.BUFRS()[pos] = rsd * (1.0f / F8_WSCALE); F.POS()[idx] = pos; }
        __syncthreads();
    }
    if (F.c < 8) { const int e = F.c; const int b0 = tot[8 + e] + tot[e], b1 = tot[8 + e] + tot[16 + e]; for (int r = b0 + tid; r < b1; r += NTHR) { F.BUFTOK()[r] = 0; F.BUFGATE()[r] = 0.f; F.BUFRS()[r] = 0.f; } }
    if (F.c == (8 % F.G)) { if (tid < NBLK) { int e = 0; for (int q = 0; q < 8; ++q) if (tid * 256 >= tot[8 + q] + tot[16 + q]) ++e; F.BLKE()[tid] = e < 7 ? e : 7; } if (tid == NBLK) F.BLKE()[NBLK] = tot[24]; }
}

__device__ __forceinline__ void phase_final(Frame& F) {
    const Params& p = F.p; const int gw = F.c * NWAVE + F.wave, NGW = F.G * NWAVE, lane = F.lane; const float* g2 = F.MOD() + NIN + 5 * 1024;
    const int nused = ldv_i(F.BLKE() + NBLK); const int ntail = (F.G == 256) ? (nused - 128) * 4 : 0; const int spu = ntail > 0 ? moe_tail_spu(ntail) : 1;
    f32x4 gv[4], fg[4];
#pragma unroll
    for (int j = 0; j < 4; ++j) { gv[j] = *((const f32x4*)g2 + lane + 64 * j); fg[j] = *((const f32x4*)p.final_norm_gain + lane + 64 * j); }
    for (int row = 2 * gw; row < T; row += 2 * NGW) {
        f32x4 xv[2][4]; f32x4 fa[2][4];
#pragma unroll
        for (int r = 0; r < 2; ++r) {
            const f32x4* xr = (const f32x4*)(p.out + (size_t)(row + r) * D) + lane;
#pragma unroll
            for (int j = 0; j < 4; ++j) { xv[r][j] = xr[64 * j]; fa[r][j] = (f32x4){0.f, 0.f, 0.f, 0.f}; }
#pragma unroll
            for (int a = 0; a < 2; ++a) { const int pos = ldv_i(F.POS() + (row + r) * 2 + a); const int blk = pos >> 8;
                if (ntail > 0 && blk >= 128) {
#pragma unroll
                    for (int j = 0; j < 4; ++j) { const float* sl = F.YBB() + (size_t)(((blk - 128) * 4 + j) * spu) * 65536 + (size_t)(pos & 255) * 256 + 4 * lane;
                        for (int q = 0; q < spu; ++q) fa[r][j] = fa[r][j] + *(const f32x4*)(sl + (size_t)q * 65536); }
                } else { const u32x2* y = (const u32x2*)(F.YB() + (size_t)pos * D) + lane;
#pragma unroll
                    for (int j = 0; j < 4; ++j) { const u32x2 w = y[64 * j]; fa[r][j] = fa[r][j] + (f32x4){bflo(w.x), bfhi(w.x), bflo(w.y), bfhi(w.y)}; } } } }
#pragma unroll
        for (int r = 0; r < 2; ++r) { f32x4 v[4]; float s = 0.f;
#pragma unroll
            for (int j = 0; j < 4; ++j) { v[j] = xv[r][j] + gv[j] * fa[r][j]; s += (v[j].x * v[j].x + v[j].y * v[j].y) + (v[j].z * v[j].z + v[j].w * v[j].w); }
            s = wave_sum(s); const float rs = rstd_of(s);
            f32x4* o = (f32x4*)(p.out + (size_t)(row + r) * D) + lane;
#pragma unroll
            for (int j = 0; j < 4; ++j) o[64 * j] = v[j] * rs * fg[j]; }
    }
}

template <class Desc, class Epi> __device__ __forceinline__ void run_gemm(Frame& F, const Desc& Dc, const Epi& E) {
    gemm_fast(F.lds, F.ws, Dc, E, F.c, F.G, F.wave);
}

__device__ __forceinline__ void phase_g1(Frame& F) {
    { DescG1a<false> d{F.XB(), F.WIN(), nullptr, 1024, 1024, 16, 128, 128}; EpiG1a<false> e{F.ROWSS(), F.BIAS_IN(), F.TABA(), F.TABB(), F.Q(), F.KN(), F.Gb(), F.GP(), F.KDT()}; run_gemm(F, d, e); }
    { DescG1a<true> d{F.XB(), F.WIN(), nullptr, 1024, 1024, 16, 128, 128}; EpiG1a<true> e{F.ROWSS(), F.BIAS_IN(), F.TABA(), F.TABB(), F.Q(), F.KN(), F.Gb(), F.GP(), F.KDT()}; run_gemm(F, d, e); }
    { DescG1b d{F.XB(), F.WIN(), nullptr, 1024, 1024, 16, 128, 128}; EpiG1b e{F.ROWSS(), F.BIAS_IN(), F.TABA(), F.TABB(), F.GP(), F.KDT(), F.VT()}; run_gemm(F, d, e); }
}
__device__ __forceinline__ void phase_kv(Frame& F) { DescKV d{F.VT(), F.KDT(), nullptr, T, T, 2, 128, 128}; EpiKV e{F.SB()}; run_gemm(F, d, e); }
__device__ __forceinline__ void phase_outproj(Frame& F) {
    DescOut d{F.Y(), F.WOUT(), nullptr, 2048, 2048, 32, 128, 128}; EpiResid e{F.p.x, F.p.out, F.XB(), F.ROWSS(), F.MOD() + 2 * 1024, nullptr, nullptr, 1.0f}; run_gemm(F, d, e); }
__device__ __forceinline__ void phase_ffn_up(Frame& F) {
    DescFfnUp d{F.XB(), F.WGU(), nullptr, 1024, 1024, 16, 128, 128}; EpiSwiglu<true, true> e{F.ROWSS(), nullptr, F.BIAS_GU(), F.H1(), DFF, 5632, 2 * 5632}; run_gemm(F, d, e);
    if (F.G == 256 && F.c >= 128) {
        frame_fresh(F); px_tables(F); px_gu_item(F, (F.c - 128) * NWAVE + F.wave, F.lane); __syncthreads(); } }
__device__ __forceinline__ void phase_ffn_down(Frame& F) {
    DescFfnDown d{F.H1(), F.WD(), nullptr, 64, 64, 22, 32768, 32768};     EpiResid e{F.p.out, F.X2(), nullptr, F.ROWSS(), F.MOD() + 5 * 1024, nullptr, nullptr, 1.0f / (F8_DSCALE * F8_HSCALE)}; run_gemm(F, d, e); }
__device__ __forceinline__ void phase_moe_up(Frame& F) {
    DescMoeUp d{F.XB(), F.WMGU(), F.BUFTOK(), 512, 512, 8, 128, 128, F.BLKE()}; EpiSwiglu<true, true> e{F.ROWSS(), F.BUFRS(), F.BIAS_MGU(), F.H1M(), DFE, 57344, 262144}; run_gemm(F, d, e); }
__device__ __forceinline__ void phase_moe_down(Frame& F) {
    DescMoeDown d{F.H1M(), F.WMD(), nullptr, 64, 64, 28, 32768, 32768, F.BLKE(), F.G}; EpiMoeDown e{F.BUFGATE(), F.YB(), F.YBB()}; run_gemm(F, d, e); }

#define XB_TMO      128
#define XB_XCNT(j)  (256  + 64 * (j))
#define XB_XSUB(j)  (1280 + 64 * (j))
#define XB_XGEN(j)  (2304 + 64 * (j))
#define XB_TOP      3328
#define XB_TOPGEN   3392
#define XCD_BAR_WORDS 3456
#define XB_SPIN_CAP (1u << 18)
__device__ __forceinline__ unsigned xb_ld(unsigned* p)              { return __hip_atomic_load(p, __ATOMIC_RELAXED, __HIP_MEMORY_SCOPE_AGENT); }
__device__ __forceinline__ unsigned xb_add(unsigned* p, unsigned v) { return __hip_atomic_fetch_add(p, v, __ATOMIC_RELAXED, __HIP_MEMORY_SCOPE_AGENT); }
__device__ __forceinline__ unsigned xb_xcc_id() { return (unsigned)__builtin_amdgcn_s_getreg((3 << 11) | 20) & 0xFu; }
#define XB_SPIN(cond, bar) do { unsigned _sp = 0; while (cond) { __builtin_amdgcn_s_sleep(1); \
    if ((++_sp & 255u) == 0u) { if (xb_ld(&(bar)[XB_TMO])) break; if (_sp > XB_SPIN_CAP) { atomicAdd(&(bar)[XB_TMO], 1u); break; } } } } while (0)
struct XcdBarrier { unsigned* bar; unsigned x; volatile LAS unsigned* st; int wave; };
__device__ __forceinline__ XcdBarrier xcd_barrier_post(unsigned* bar, volatile LAS unsigned* st, int wave) {
    XcdBarrier b; b.bar = bar; b.x = xb_xcc_id(); b.st = st; b.wave = wave;
    if (wave == 0 && lane_id() == 0) (void)xb_add(&bar[XB_XCNT(b.x)], 1u);
    return b;
}
__device__ __forceinline__ void xcd_barrier_complete(unsigned* bar, unsigned x, unsigned& nloc, unsigned& nx) {
    const unsigned G = gridDim.x * gridDim.y * gridDim.z;
    unsigned sum, cnt, mine, sp = 0u;
    for (;;) {
        sum = 0u; cnt = 0u; mine = 0u;
#pragma unroll
        for (unsigned j = 0; j < 16; ++j) { const unsigned c = xb_ld(&bar[XB_XCNT(j)]); sum += c; cnt += (c > 0u) ? 1u : 0u; mine = (j == x) ? c : mine; }
        if (sum == G) break;
        __builtin_amdgcn_s_sleep(1);
        if ((++sp & 255u) == 0u) { if (xb_ld(&bar[XB_TMO])) break; if (sp > XB_SPIN_CAP) { atomicAdd(&bar[XB_TMO], 1u); break; } }
    }
    nloc = mine > 0u ? mine : 1u; nx = cnt > 0u ? cnt : 1u;
}
__device__ __forceinline__ void xcd_barrier(const XcdBarrier& b) {
    asm volatile("s_waitcnt vmcnt(0)" ::: "memory");
    __syncthreads();
    if (b.wave == 0 && lane_id() == 0) {
        unsigned* bar = b.bar;
        __builtin_amdgcn_s_waitcnt(0);
        unsigned nloc = b.st[0], nx = b.st[1];
        if (nloc == 0u) { xcd_barrier_complete(bar, b.x, nloc, nx); b.st[0] = nloc; b.st[1] = nx; }
        const unsigned old = xb_add(&bar[XB_XSUB(b.x)], 1u);
        const unsigned gen = old / nloc;
        if (old + 1u == (gen + 1u) * nloc) {
            __builtin_amdgcn_fence(__ATOMIC_RELEASE, "agent");
            asm volatile("s_waitcnt vmcnt(0)" ::: "memory");
            const unsigned og = xb_add(&bar[XB_TOP], 1u);
            const unsigned tg = og / nx;
            if (og + 1u == (tg + 1u) * nx) xb_add(&bar[XB_TOPGEN], 1u);
            else XB_SPIN(xb_ld(&bar[XB_TOPGEN]) == tg, bar);
            __builtin_amdgcn_fence(__ATOMIC_ACQUIRE, "agent");
            xb_add(&bar[XB_XGEN(b.x)], 1u);
            asm volatile("s_waitcnt vmcnt(0)" ::: "memory");
        } else {
            XB_SPIN(xb_ld(&bar[XB_XGEN(b.x)]) == gen, bar);
            __builtin_amdgcn_fence(__ATOMIC_ACQUIRE, "agent");
            asm volatile("s_waitcnt vmcnt(0)" ::: "memory");
        }
    }
    __syncthreads();
}

constexpr int LDSCTL_OFF = 131072;
__global__ void __launch_bounds__(NTHR, 2) k_mega(Params p) {
    extern __shared__ __attribute__((aligned(16))) unsigned char lds_raw[];
    Frame F; frame_init(F, p, (LAS unsigned char*)lds_raw, (int)blockIdx.x, (int)gridDim.x);
    for (int u = F.tid; u < (LDS_BYTES - LDSCTL_OFF) / 4; u += NTHR) ((LAS unsigned*)(F.lds + LDSCTL_OFF))[u] = 0u;
    __syncthreads();
    const XcdBarrier bar = xcd_barrier_post((unsigned*)(p.ws + CT_BAR), (volatile LAS unsigned*)(F.lds + LDSCTL_OFF + 32), F.wave);
#define GRID_BAR() xcd_barrier(bar)

    frame_fresh(F); phase_p0(F); GRID_BAR();
    frame_fresh(F); phase_p1(F); GRID_BAR();
    frame_fresh(F); phase_g1(F); GRID_BAR();
    frame_fresh(F); phase_kv(F); GRID_BAR();
    frame_fresh(F); phase_scan(F); GRID_BAR();
    frame_fresh(F); phase_ret_fast(F); GRID_BAR();
    frame_fresh(F); phase_outproj(F); GRID_BAR();
    frame_fresh(F); phase_ffn_up(F); GRID_BAR();
    frame_fresh(F); phase_ffn_down(F); GRID_BAR();
    if ((F.c >> 3) & 1) { frame_fresh(F); phase_px(F); __syncthreads(); frame_fresh(F); phase_pool_fused(F); } else { frame_fresh(F); phase_pool_fused(F); frame_fresh(F); phase_px(F); }
    GRID_BAR();
    frame_fresh(F); phase_route2(F); GRID_BAR();
    frame_fresh(F); phase_moe_up(F); GRID_BAR();
    frame_fresh(F); phase_moe_down(F); GRID_BAR();
    frame_fresh(F); phase_final(F);
#undef GRID_BAR
}

extern "C" void kernel_launch(void* const* d_in, const int* in_sizes, int n_in, void* d_out, int out_size, void* d_ws, size_t ws_size, hipStream_t stream) {
    static int grid = 0;
    if (grid == 0) {
        if (n_in != 19 || out_size != T * D || ws_size < WS_END) { fprintf(stderr, "kernel_launch: unexpected shapes (n_in %d out %d ws %zu)\n", n_in, out_size, ws_size); grid = -1; return; }
        int dev = 0, cus = 0, per_cu = 0;
        if (hipGetDevice(&dev) != hipSuccess || hipDeviceGetAttribute(&cus, hipDeviceAttributeMultiprocessorCount, dev) != hipSuccess) { grid = -1; return; }
        if (hipFuncSetAttribute((const void*)k_mega, hipFuncAttributeMaxDynamicSharedMemorySize, LDS_BYTES) != hipSuccess) { fprintf(stderr, "kernel_launch: hipFuncSetAttribute failed\n"); grid = -1; return; }
        if (hipOccupancyMaxActiveBlocksPerMultiprocessor(&per_cu, (const void*)k_mega, NTHR, LDS_BYTES) != hipSuccess || per_cu < 1) { fprintf(stderr, "kernel_launch: occupancy query says %d blocks per CU\n", per_cu); (void)hipGetLastError(); grid = -1; return; }
        grid = cus * (per_cu < 1 ? 1 : 1);
    }
    if (grid < 0) return;
    Params p{};
    const float** pp = (const float**)&p;
    for (int i = 0; i < 19; ++i) pp[i] = (const float*)d_in[i];
    p.out = (float*)d_out; p.ws = (unsigned char*)d_ws;
    (void)hipMemsetAsync((char*)d_ws + WS_CTL, 0, 64 * KiB, stream);
    void* args[] = {&p};
    hipError_t e = hipLaunchCooperativeKernel((const void*)k_mega, dim3(grid), dim3(NTHR), args, LDS_BYTES, stream);
    if (e != hipSuccess) fprintf(stderr, "kernel_launch: cooperative launch failed: %s (grid %d)\n", hipGetErrorString(e), grid);
}
```

```cpp
#include <hip/hip_runtime.h>
#include <cstdio>

#define GAS __attribute__((address_space(1)))
#define LAS __attribute__((address_space(3)))
typedef unsigned short bf16_t;
typedef short bf16x8 __attribute__((ext_vector_type(8)));
typedef float f32x4 __attribute__((ext_vector_type(4)));
typedef float f32x2 __attribute__((ext_vector_type(2)));
typedef unsigned u32x4 __attribute__((ext_vector_type(4)));
typedef int i32x4 __attribute__((ext_vector_type(4)));
typedef unsigned u32x2 __attribute__((ext_vector_type(2)));

#ifndef FAST_GEMM
#define FAST_GEMM 1
#endif

constexpr int T = 16384, D = 1024, NH = 4, DK = 256, DV = 512, CH = 128, NCH = 128;
constexpr int NIN = 6144, DFF = 2816, NE = 8, DFE = 3584, CAP = 34816, NBLK = 136;
constexpr float EPS = 1e-6f;
constexpr int GPS = 260, RC = 256, NRC = 64;
constexpr int NTHR = 512, NWAVE = 8;

constexpr size_t KiB = 1024, MiB = 1u << 20;
constexpr size_t WS_CTL = 0, CTL_BYTES = 1 * MiB;
constexpr size_t CT_BAR = 16 * KiB;
constexpr size_t CT_MOD = 64 * KiB;
constexpr size_t CT_BIAS_R = 158 * KiB;
constexpr size_t WS_ROWSSP = 2 * MiB;
constexpr size_t WS_MODP = 3 * MiB;
constexpr size_t CT_BIAS_IN = 3584 * KiB;
constexpr size_t CT_BIAS_GU = 3584 * KiB + 96 * KiB;
constexpr size_t CT_BIAS_MGU = 36 * MiB + 512 * KiB;
constexpr size_t WS_TABA = 1 * MiB;
constexpr size_t WS_TABB = WS_TABA + 128 * KiB;
constexpr size_t WS_GP = WS_TABB + 128 * KiB;
constexpr size_t WS_WR = WS_GP + 8 * KiB;
constexpr size_t WS_TOPE = WS_WR + 32 * KiB;
constexpr size_t WS_TOPG = WS_TOPE + 128 * KiB;
constexpr size_t WS_CNT = WS_TOPG + 128 * KiB;
constexpr size_t WS_BUFTOK = WS_CNT + 8 * KiB;
constexpr size_t WS_BUFGATE = WS_BUFTOK + 136 * KiB;
constexpr size_t WS_POS = WS_BUFGATE + 136 * KiB;
constexpr size_t WS_BLKE = WS_POS + 128 * KiB;
constexpr size_t WS_RSTD3 = 256 * KiB;
constexpr size_t WS_BUFRS = 320 * KiB;
constexpr size_t WS_WIN = 4 * MiB;
constexpr size_t WS_WOUT = 16 * MiB;
constexpr size_t WS_WGU = 20 * MiB;
constexpr size_t WS_WD = 31 * MiB;
constexpr size_t WS_WP = 37 * MiB;
constexpr size_t WS_XB = 38 * MiB;
constexpr size_t WS_Q = 70 * MiB;
constexpr size_t WS_KN = 102 * MiB;
constexpr size_t WS_KDT = 134 * MiB;
constexpr size_t WS_VT = 166 * MiB;
constexpr size_t WS_G = 230 * MiB;
constexpr size_t WS_SB = 294 * MiB;
constexpr size_t WS_Y = 422 * MiB;
constexpr size_t WS_H1 = 70 * MiB;
constexpr size_t WS_PB = 158 * MiB;
constexpr size_t WS_X2 = 158 * MiB;
constexpr size_t WS_H1M = 70 * MiB;
constexpr size_t WS_WMGU = 308 * MiB;
constexpr size_t WS_WMD = 456 * MiB;
constexpr size_t WS_YB = 308 * MiB;
constexpr size_t WS_YBB = 4 * MiB;
constexpr size_t WS_END = 512 * MiB;
static_assert(WS_BUFRS + 136 * KiB <= WS_TABA && WS_BLKE + 4 * KiB <= WS_ROWSSP && WS_MODP + 8 * 12288 * 4 <= CT_BIAS_IN && CT_BIAS_GU + 4 * 5632 * 4 <= WS_WIN, "small region");
static_assert(WS_YBB + (size_t)224 * 65536 * 4 <= WS_H1M && WS_H1M + (size_t)CAP * DFE * 2 <= WS_WMGU && WS_YB + (size_t)CAP * D * 4 <= WS_WMD && WS_WMD + (size_t)NE * D * DFE * 2 <= WS_END, "moe map");
static_assert(WS_Y + (size_t)T * 2048 * 2 <= WS_END && WS_SB + (size_t)128 * 4 * 512 * 256 * 2 <= WS_Y, "ret map");

constexpr int LDS_BYTES = 147456;

struct Params {
    const float *x, *c, *ada_w, *ada_b, *norm_gain, *ret_w_in, *ret_gn_gain, *ret_w_out, *ffn_w_gate, *ffn_w_up, *ffn_w_down,
        *pool_w, *pool_b, *pool_scale, *moe_router, *moe_w_gate, *moe_w_up, *moe_w_down, *final_norm_gain;
    float* out; unsigned char* ws;
};

__device__ __forceinline__ unsigned f2bf(float f) { unsigned u = __builtin_bit_cast(unsigned, f); return (u + 0x7fffu + ((u >> 16) & 1u)) >> 16; }
typedef __bf16 bf16x2_t __attribute__((ext_vector_type(2)));
__device__ __forceinline__ unsigned pk2(float lo, float hi) { const f32x2 v = {lo, hi}; return __builtin_bit_cast(unsigned, __builtin_convertvector(v, bf16x2_t)); }
constexpr float F8_WSCALE = 32.0f, F8_DSCALE = 64.0f, F8_HSCALE = 4.0f;
__device__ __forceinline__ unsigned pk4f8(float a, float b, float c, float d) { int w = __builtin_amdgcn_cvt_pk_fp8_f32(a, b, 0, false); w = __builtin_amdgcn_cvt_pk_fp8_f32(c, d, w, true); return (unsigned)w; }
__device__ __forceinline__ float bf2f(unsigned b) { return __builtin_bit_cast(float, b << 16); }
__device__ __forceinline__ float bflo(unsigned w) { return __builtin_bit_cast(float, w << 16); }
__device__ __forceinline__ float bfhi(unsigned w) { return __builtin_bit_cast(float, w & 0xffff0000u); }
__device__ __forceinline__ float silu_f(float v) { return v * __builtin_amdgcn_rcpf(1.0f + __expf(-v)); }
__device__ __forceinline__ float rstd_of(float ss) { return __builtin_amdgcn_rsqf(ss * (1.0f / 1024.0f) + EPS); }
__device__ __forceinline__ float rstd_row(const float* rssp, int t) {
    const f32x4* q = (const f32x4*)(rssp + (size_t)t * 16); const f32x4 a = q[0], b = q[1], c = q[2], d = q[3];
    const float s = (((a.x + a.y) + (a.z + a.w)) + ((b.x + b.y) + (b.z + b.w))) + (((c.x + c.y) + (c.z + c.w)) + ((d.x + d.y) + (d.z + d.w)));
    return __builtin_amdgcn_rsqf(s * (1.0f / 1024.0f) + EPS);
}
__device__ __forceinline__ float wave_sum(float v) {
#pragma unroll
    for (int o = 1; o < 64; o <<= 1) v += __shfl_xor(v, o);
    return v;
}
__device__ __forceinline__ float ldv_f(const float* p) { return __builtin_bit_cast(float, __hip_atomic_load((const unsigned*)p, __ATOMIC_RELAXED, __HIP_MEMORY_SCOPE_AGENT)); }
__device__ __forceinline__ int ldv_i(const int* p) { return __hip_atomic_load(p, __ATOMIC_RELAXED, __HIP_MEMORY_SCOPE_AGENT); }
__device__ __forceinline__ float bias_sum(const float* b, int idx, int s1, int s2) { return (ldv_f(b + idx) + ldv_f(b + s1 + idx)) + (ldv_f(b + s2 + idx) + ldv_f(b + s2 + s1 + idx)); }
__device__ __forceinline__ void rstd_row_ld(const float* rssp, int t, float (&r)[16]) { const f32x4* q = (const f32x4*)(rssp + (size_t)t * 16);
#pragma unroll
    for (int i = 0; i < 4; ++i) { const f32x4 v = q[i]; r[4 * i] = v.x; r[4 * i + 1] = v.y; r[4 * i + 2] = v.z; r[4 * i + 3] = v.w; } }
__device__ __forceinline__ float rstd_row_fin(const float (&r)[16]) {
    const float s = (((r[0] + r[1]) + (r[2] + r[3])) + ((r[4] + r[5]) + (r[6] + r[7]))) + (((r[8] + r[9]) + (r[10] + r[11])) + ((r[12] + r[13]) + (r[14] + r[15])));
    return __builtin_amdgcn_rsqf(s * (1.0f / 1024.0f) + EPS); }
__device__ __forceinline__ void bias_sum_ld(const float* b, int idx, int s1, int s2, float (&r)[16]) { r[0] = ldv_f(b + idx); r[1] = ldv_f(b + s1 + idx); r[2] = ldv_f(b + s2 + idx); r[3] = ldv_f(b + s2 + s1 + idx); }
__device__ __forceinline__ float bias_sum_fin(const float (&r)[16]) { return (r[0] + r[1]) + (r[2] + r[3]); }

__device__ __forceinline__ int lane_id() { int l; asm volatile("v_mbcnt_lo_u32_b32 %0, -1, 0\n\tv_mbcnt_hi_u32_b32 %0, -1, %0" : "=v"(l)); return l; }

struct Unit { const bf16_t* A; const bf16_t* B; int pm, pn, aux, rowbase, nt; };

__device__ __forceinline__ void tile_order(int L, int nM, int nN, int& pm, int& pn) {
    const int nwg = nM * nN; int wgid = L;
    { const int q = nwg / 8, r = nwg % 8, xcd = wgid % 8, off = wgid / 8; wgid = (xcd < r ? xcd * (q + 1) : r * (q + 1) + (xcd - r) * q) + off; }
    const int nig = 8 * nN, gid = wgid / nig, fm = gid * 8, gsz = (nM - fm) < 8 ? (nM - fm) : 8;
    pm = fm + ((wgid % nig) % gsz); pn = (wgid % nig) / gsz;
}

template <bool GATE> struct DescG1a {
    static constexpr bool GATHER = false; static constexpr bool FP8 = false;
    const bf16_t* xb; const bf16_t* win; const int* tok; int lda, ldb, nt, ksa, ksb;
    __device__ __forceinline__ bool get(int L, Unit& u) const {
        if (L >= 64 * 8) return false; tile_order(L, 64, 8, u.pm, u.pn); if (GATE) u.pn += 8;
        const int wrow = u.pn < 8 ? u.pn * 256 : (u.pn + 8) * 256;
        u.A = xb + (size_t)u.pm * 256 * 1024; u.B = win + (size_t)wrow * 1024; u.aux = wrow; u.rowbase = u.pm * 256; u.nt = nt; return true; }
};
struct DescG1b {
    static constexpr bool GATHER = false; static constexpr bool FP8 = false;
    const bf16_t* xb; const bf16_t* win; const int* tok; int lda, ldb, nt, ksa, ksb;
    __device__ __forceinline__ bool get(int L, Unit& u) const {
        if (L >= 8 * 64) return false; tile_order(L, 8, 64, u.pm, u.pn); u.pm += 4;
        u.A = win + (size_t)(1024 + 256 * u.pm) * 1024; u.B = xb + (size_t)u.pn * 256 * 1024; u.aux = 0; u.rowbase = 0; u.nt = nt; return true; }
};
struct DescKV {
    static constexpr bool GATHER = false; static constexpr bool FP8 = false;
    const bf16_t* vt; const bf16_t* kdt; const int* tok; int lda, ldb, nt, ksa, ksb;
    __device__ __forceinline__ bool get(int L, Unit& u) const {
        if (L >= (NRC - 1) * 8) return false; const int mt = L & 1, h = (L >> 1) & 3, n = L >> 3;
        u.A = vt + (size_t)(h * 512 + 256 * mt) * T + n * RC; u.B = kdt + (size_t)(h * 256) * T + n * RC;
        u.pm = mt; u.pn = 0; u.aux = (n * 4 + h) * 2 + mt; u.rowbase = 0; u.nt = nt; return true; }
};
struct DescOut {
    static constexpr bool GATHER = false; static constexpr bool FP8 = false;
    const bf16_t* y; const bf16_t* w; const int* tok; int lda, ldb, nt, ksa, ksb;
    __device__ __forceinline__ bool get(int L, Unit& u) const {
        if (L >= 256) return false; tile_order(L, 64, 4, u.pm, u.pn);
        u.A = y + (size_t)u.pm * 256 * 2048; u.B = w + (size_t)u.pn * 256 * 2048; u.aux = 0; u.rowbase = u.pm * 256; u.nt = nt; return true; }
};
struct DescFfnUp {
    static constexpr bool GATHER = false; static constexpr bool FP8 = false;
    const bf16_t* xb; const bf16_t* w; const int* tok; int lda, ldb, nt, ksa, ksb;
    __device__ __forceinline__ bool get(int L, Unit& u) const {
        if (L >= 64 * 22) return false; tile_order(L, 64, 22, u.pm, u.pn);
        u.A = xb + (size_t)u.pm * 256 * 1024; u.B = w + (size_t)u.pn * 256 * 1024; u.aux = 256 * u.pn; u.rowbase = u.pm * 256; u.nt = nt; return true; }
};
struct DescFfnDown {
    static constexpr bool GATHER = false; static constexpr bool FP8 = true;
    const bf16_t* h1; const bf16_t* w; const int* tok; int lda, ldb, nt, ksa, ksb;
    __device__ __forceinline__ bool get(int L, Unit& u) const {
        if (L >= 256) return false; tile_order(L, 64, 4, u.pm, u.pn);
        u.A = h1 + (size_t)u.pm * 128 * DFF; u.B = w + (size_t)u.pn * 128 * DFF; u.aux = 0; u.rowbase = u.pm * 256; u.nt = nt; return true; }
};
struct DescMoeUp {
    static constexpr bool GATHER = true; static constexpr bool FP8 = true;
    const bf16_t* xb; const bf16_t* w; const int* tok; int lda, ldb, nt, ksa, ksb; const int* blke;
    __device__ __forceinline__ bool get(int L, Unit& u) const {
        const int nused = ldv_i(blke + NBLK); if (L >= nused * 28) return false; tile_order(L, nused, 28, u.pm, u.pn);
        const int e = ldv_i(blke + u.pm);
        u.A = xb; u.B = w + (size_t)(e * 7168 + 256 * u.pn) * 512; u.aux = e * 7168 + 256 * u.pn; u.rowbase = u.pm * 256; u.nt = nt; return true; }
};
__device__ __forceinline__ int moe_tail_spu(int ntail) { const int q = 256 / ntail; return q >= 14 ? 14 : 7; }
struct DescMoeDown {
    static constexpr bool GATHER = false; static constexpr bool FP8 = true;
    const bf16_t* h1; const bf16_t* w; const int* tok; int lda, ldb, nt, ksa, ksb; const int* blke; int G;
    __device__ __forceinline__ bool get(int L, Unit& u) const {
        const int nused = ldv_i(blke + NBLK); int k0 = 0, npair = 14; u.aux = 0;
        if (G != 256) { if (L >= nused * 4) return false; tile_order(L, nused, 4, u.pm, u.pn); }
        else { const int i = L >> 8, c = L & 255;
            if (i < 2) { const int x = c & 7, j = c >> 3; u.pm = (i * 8 + x) * 8 + (j & 7); u.pn = j >> 3; }
            else { const int ntail = (nused - 128) * 4; if (i > 2 || ntail <= 0) return false; const int spu = moe_tail_spu(ntail); if (c >= ntail * spu) return false;
                const int ut = c / spu, sl = c - ut * spu; u.pm = 128 + (ut >> 2); u.pn = ut & 3; npair = 14 / spu; k0 = sl * npair; u.aux = 1 + c; } }
        const int e = ldv_i(blke + u.pm);
        u.A = h1 + (size_t)u.pm * 128 * DFE + (size_t)k0 * 2 * 16384; u.B = w + (size_t)(e * 4 + u.pn) * 128 * DFE + (size_t)k0 * 2 * 16384;
        u.rowbase = u.pm * 256; u.nt = 2 * npair; return true; }
};

typedef f32x4 Acc[2][2][4][2];

__device__ __forceinline__ void store8bf(bf16_t* p, const float* v) {
    u32x4 w; w.x = pk2(v[0], v[1]); w.y = pk2(v[2], v[3]); w.z = pk2(v[4], v[5]); w.w = pk2(v[6], v[7]); *(u32x4*)p = w; }

template <bool GATE> struct EpiG1a {
    static constexpr bool PERM = true;
    const float* rowss; const float* bias; const f32x2* taba; const f32x2* tabb; bf16_t* Q; bf16_t* KN; bf16_t* Gb; const float* gp; bf16_t* KDT;
    __device__ __forceinline__ void pre_load(const Unit& u, int tid, float (&r)[16]) const { if (tid < 256) r[0] = ldv_f(rowss + (size_t)(u.pm * 256 + tid) * 16); else bias_sum_ld(bias, u.aux + tid - 256, NIN, 2 * NIN, r); }
    __device__ __forceinline__ void pre_store(const Unit&, LAS float* aux, int tid, const float (&r)[16]) const { aux[tid] = tid < 256 ? rstd_of(r[0]) : bias_sum_fin(r); }
    __device__ __forceinline__ void init(LAS float* auxb, int tid) const {
        if (!GATE && tid < 256) { const float v = ((const float*)tabb)[16 * 256 + tid]; auxb[512 + tid] = v; auxb[768 + 512 + tid] = v; } }
    __device__ __forceinline__ void operator()(const Acc& acc, const Unit& u, int wr, int wc, int fr, int fq, const LAS float* aux) const {
        asm volatile("" : "+v"(fr), "+v"(fq));
        const int pn = u.pn, d0 = wc * 32 + 8 * fq;
        float b[2][8];
#pragma unroll
        for (int bj = 0; bj < 2; ++bj) { const f32x4 x = *(const LAS f32x4*)(aux + 256 + 128 * bj + d0), y = *(const LAS f32x4*)(aux + 256 + 128 * bj + d0 + 4);
            b[bj][0] = x.x; b[bj][1] = x.y; b[bj][2] = x.z; b[bj][3] = x.w; b[bj][4] = y.x; b[bj][5] = y.y; b[bj][6] = y.z; b[bj][7] = y.w; }
        if constexpr (!GATE) {
            bf16_t* O = pn < 4 ? Q : KN; const int hcol = (pn & 3) * 256;
            f32x2 ta[8], tn[8], tb[8]; float dec[4];
            { const f32x2* tp0 = taba + (2 * u.pm) * 128 + d0; const f32x2* tpb = tabb + (64 * wr + fr) * 128 + d0;
#pragma unroll
              for (int q = 0; q < 8; ++q) { ta[q] = tp0[q]; tb[q] = tpb[q]; }
#pragma unroll
              for (int m = 0; m < 4; ++m) dec[m] = pn >= 4 ? gp[(pn - 4) * GPS + 127 - (64 * wr + 16 * m + fr)] : 0.f; }
            const float c128 = pn >= 4 ? gp[(pn - 4) * GPS + 128] : 0.f;
#pragma unroll
            for (int it = 0; it < 8; ++it) {
                const int ai = it >> 2, m = ai ? 3 - (it & 3) : (it & 3);
                if (it == 2) { const f32x2* tp1 = taba + (2 * u.pm + 1) * 128 + d0;
#pragma unroll
                    for (int q = 0; q < 8; ++q) tn[q] = tp1[q]; }
                if (it == 4) {
#pragma unroll
                    for (int q = 0; q < 8; ++q) ta[q] = tn[q]; }
                if ((it & 3) != 0) {
                    const float sg = ai ? -1.0f : 1.0f; int dl = 2 * d0; asm volatile("" : "+v"(dl));
#pragma unroll
                    for (int q2 = 0; q2 < 4; ++q2) { const f32x4 R2 = *(const LAS f32x4*)(aux + 512 + dl + 4 * q2);
                        { const f32x2 B = tb[2 * q2]; const float ry = sg * R2.y; tb[2 * q2].x = B.x * R2.x - B.y * ry; tb[2 * q2].y = B.y * R2.x + B.x * ry; }
                        { const f32x2 B = tb[2 * q2 + 1]; const float rw = sg * R2.w; tb[2 * q2 + 1].x = B.x * R2.z - B.y * rw; tb[2 * q2 + 1].y = B.y * R2.z + B.x * rw; } } }
                const int rl = 128 * ai + 64 * wr + 16 * m + fr, t = u.pm * 256 + rl; const float rs = aux[rl];
                float o1[8], o2[8];
#pragma unroll
                for (int q = 0; q < 8; ++q) {
                    const f32x2 A = ta[q], B = tb[q]; const float cs = A.x * B.x - A.y * B.y, sn = A.y * B.x + A.x * B.y;
                    const float v1 = rs * acc[ai][0][m][q >> 2][q & 3] + b[0][q], v2 = rs * acc[ai][1][m][q >> 2][q & 3] + b[1][q];
                    o1[q] = v1 * cs - v2 * sn; o2[q] = v1 * sn + v2 * cs; }
                store8bf(O + (size_t)t * 1024 + hcol + d0, o1); store8bf(O + (size_t)t * 1024 + hcol + 128 + d0, o2);
                if (pn >= 4) {
                    bf16_t* kd = KDT + (size_t)(hcol + d0) * T + t;
                    const float dk = ai ? dec[m] : dec[m] * c128;
#pragma unroll
                    for (int q = 0; q < 8; ++q) { kd[(size_t)q * T] = (bf16_t)(pk2(o1[q] * dk, 0.f) & 0xffffu); kd[(size_t)(128 + q) * T] = (bf16_t)(pk2(o2[q] * dk, 0.f) & 0xffffu); } }
            }
        } else {
#pragma unroll
            for (int ai = 0; ai < 2; ++ai)
#pragma unroll
                for (int m = 0; m < 4; ++m) {
                    const int rl = 128 * ai + 64 * wr + 16 * m + fr, t = u.pm * 256 + rl; const float rs = aux[rl];
#pragma unroll
                    for (int bj = 0; bj < 2; ++bj) { float o[8];
#pragma unroll
                        for (int q = 0; q < 8; ++q) o[q] = silu_f(rs * acc[ai][bj][m][q >> 2][q & 3] + b[bj][q]);
                        store8bf(Gb + (size_t)t * 2048 + (pn - 8) * 256 + 128 * bj + d0, o); }
                }
        }
    }
};
struct EpiG1b {
    static constexpr bool PERM = true;
    const float* rowss; const float* bias; const f32x2* taba; const f32x2* tabb; const float* gp; bf16_t* KDT; bf16_t* VT;
    __device__ __forceinline__ void pre_load(const Unit& u, int tid, float (&r)[16]) const { if (tid < 256) bias_sum_ld(bias, 1024 + 256 * u.pm + tid, NIN, 2 * NIN, r); else r[0] = ldv_f(rowss + (size_t)(u.pn * 256 + tid - 256) * 16); }
    __device__ __forceinline__ void pre_store(const Unit&, LAS float* aux, int tid, const float (&r)[16]) const { aux[tid] = tid < 256 ? bias_sum_fin(r) : rstd_of(r[0]); }
    __device__ __forceinline__ void init(LAS float*, int) const {}
    __device__ __forceinline__ void operator()(const Acc& acc, const Unit& u, int wr, int wc, int fr, int fq, const LAS float* aux) const {
        asm volatile("" : "+v"(fr), "+v"(fq));
        const int pmf = u.pm, tl0 = 32 * wc + 8 * fq, tk0 = u.pn * 256 + tl0;
        float rs[2][8];
#pragma unroll
        for (int bj = 0; bj < 2; ++bj) { const f32x4 x = *(const LAS f32x4*)(aux + 256 + 128 * bj + tl0), y = *(const LAS f32x4*)(aux + 256 + 128 * bj + tl0 + 4);
            rs[bj][0] = x.x; rs[bj][1] = x.y; rs[bj][2] = x.z; rs[bj][3] = x.w; rs[bj][4] = y.x; rs[bj][5] = y.y; rs[bj][6] = y.z; rs[bj][7] = y.w; }
        if (pmf < 4) {
            const int h = pmf;
#pragma unroll
            for (int m = 0; m < 4; ++m) {
                const int d = 64 * wr + 16 * m + fr; const float b1 = aux[d], b2 = aux[128 + d];
#pragma unroll
                for (int bj = 0; bj < 2; ++bj) { float o1[8], o2[8]; const f32x2 A = taba[(2 * u.pn + bj) * 128 + d]; const float4 dq0 = *(const float4*)(gp + h * GPS + 120 - tl0), dq1 = *(const float4*)(gp + h * GPS + 124 - tl0);
                    const float decs[8] = {dq1.w, dq1.z, dq1.y, dq1.x, dq0.w, dq0.z, dq0.y, dq0.x};
#pragma unroll
                    for (int q = 0; q < 8; ++q) { const f32x2 B = tabb[(tl0 + q) * 128 + d]; const float cs = A.x * B.x - A.y * B.y, sn = A.y * B.x + A.x * B.y;
                        const float v1 = rs[bj][q] * acc[0][bj][m][q >> 2][q & 3] + b1, v2 = rs[bj][q] * acc[1][bj][m][q >> 2][q & 3] + b2;
                        o1[q] = (v1 * cs - v2 * sn) * decs[q]; o2[q] = (v1 * sn + v2 * cs) * decs[q]; }
                    store8bf(KDT + (size_t)(256 * h + d) * T + tk0 + 128 * bj, o1); store8bf(KDT + (size_t)(256 * h + 128 + d) * T + tk0 + 128 * bj, o2); }
            }
        } else {
#pragma unroll
            for (int ai = 0; ai < 2; ++ai)
#pragma unroll
                for (int m = 0; m < 4; ++m) {
                    const int rl = 128 * ai + 64 * wr + 16 * m + fr, f = 256 * (pmf - 4) + rl; const float bs = aux[rl];
#pragma unroll
                    for (int bj = 0; bj < 2; ++bj) { float o[8];
#pragma unroll
                        for (int q = 0; q < 8; ++q) o[q] = rs[bj][q] * acc[ai][bj][m][q >> 2][q & 3] + bs;
                        store8bf(VT + (size_t)f * T + tk0 + 128 * bj, o); }
                }
        }
    }
};
struct EpiKV {
    static constexpr bool PERM = true;
    bf16_t* SB;
    __device__ __forceinline__ void pre_load(const Unit&, int, float (&)[16]) const {}
    __device__ __forceinline__ void pre_store(const Unit&, LAS float*, int, const float (&)[16]) const {}
    __device__ __forceinline__ void init(LAS float*, int) const {}
    __device__ __forceinline__ void operator()(const Acc& acc, const Unit& u, int wr, int wc, int fr, int fq, const LAS float*) const {
        asm volatile("" : "+v"(fr), "+v"(fq));
        const int mt = u.aux & 1, nh = u.aux >> 1; bf16_t* base = SB + ((size_t)nh * 512 + 256 * mt) * 256; const int d0 = wc * 32 + 8 * fq;
#pragma unroll
        for (int ai = 0; ai < 2; ++ai)
#pragma unroll
            for (int m = 0; m < 4; ++m) { const int r = 128 * ai + 64 * wr + 16 * m + fr;
#pragma unroll
                for (int bj = 0; bj < 2; ++bj) { float o[8];
#pragma unroll
                    for (int q = 0; q < 8; ++q) o[q] = acc[ai][bj][m][q >> 2][q & 3];
                    store8bf(base + (size_t)r * 256 + 128 * bj + d0, o); } }
    }
};
struct EpiResid {
    static constexpr bool PERM = false;
    const float* base; float* out; bf16_t* xb; float* rowss; const float* g; const float* cb; const float* cs; float accscale;
    __device__ __forceinline__ void pre_load(const Unit& u, int tid, float (&r)[16]) const {
        if (tid < 256) { const int c = 256 * u.pn + tid; r[0] = ldv_f(g + c); r[1] = cs ? cs[c] : 1.0f; } else { const int c = 256 * u.pn + tid - 256; r[0] = cb ? cb[c] : 0.f; r[1] = 1.0f; } }
    __device__ __forceinline__ void pre_store(const Unit&, LAS float* aux, int tid, const float (&r)[16]) const { aux[256 + tid] = r[0] * r[1] * (tid < 256 ? accscale : 1.0f); }
    __device__ __forceinline__ void init(LAS float*, int) const {}
    __device__ __forceinline__ void operator()(const Acc& acc, const Unit& u, int wr, int wc, int fr, int fq, const LAS float* aux) const {
        asm volatile("" : "+v"(fr), "+v"(fq));
        const int cl0 = 32 * wc + 4 * fq, col0 = 256 * u.pn + cl0;
        f32x4 gv[2][2], cbv[2][2];
#pragma unroll
        for (int bj = 0; bj < 2; ++bj)
#pragma unroll
            for (int n = 0; n < 2; ++n) { gv[bj][n] = *(const LAS f32x4*)(aux + 256 + cl0 + 128 * bj + 16 * n); cbv[bj][n] = *(const LAS f32x4*)(aux + 512 + cl0 + 128 * bj + 16 * n); }
        f32x4 bsv[2][4];
        const size_t o0 = (size_t)(u.pm * 256 + 64 * wr + fr) * 1024 + col0;
#pragma unroll
        for (int j = 0; j < 4; ++j) bsv[0][j] = *(const f32x4*)(base + o0 + 128 * (j >> 1) + 16 * (j & 1));
#pragma unroll
        for (int it = 0; it < 8; ++it) { const int ai = it >> 2, m = it & 3; const int t = u.pm * 256 + 128 * ai + 64 * wr + 16 * m + fr; float s = 0.f;
            if (it < 7) { const int ai2 = (it + 1) >> 2, m2 = (it + 1) & 3; const size_t o2 = o0 + (size_t)(128 * ai2 + 16 * m2) * 1024;
#pragma unroll
                for (int j = 0; j < 4; ++j) bsv[(it + 1) & 1][j] = *(const f32x4*)(base + o2 + 128 * (j >> 1) + 16 * (j & 1)); }
#pragma unroll
            for (int bj = 0; bj < 2; ++bj)
#pragma unroll
                for (int n = 0; n < 2; ++n) { const size_t o = (size_t)t * 1024 + col0 + 128 * bj + 16 * n;
                    const f32x4 xo = bsv[it & 1][2 * bj + n] + (acc[ai][bj][m][n] + cbv[bj][n]) * gv[bj][n];
                    *(f32x4*)(out + o) = xo; s += (xo.x * xo.x + xo.y * xo.y) + (xo.z * xo.z + xo.w * xo.w);
                    if (xb) { u32x2 w; w.x = pk2(xo.x, xo.y); w.y = pk2(xo.z, xo.w); *(u32x2*)(xb + o) = w; } }
            s += __shfl_xor(s, 16); s += __shfl_xor(s, 32);
            if (fq == 0) rowss[(size_t)t * 16 + u.pn * 4 + wc] = s; }
    }
};
template <bool TILED, bool F8OUT = false> struct EpiSwiglu {
    static constexpr bool PERM = true;
    const float* rowss; const float* rowrs; const float* bias; bf16_t* Hout; int ldh, bs1, bs2;
    __device__ __forceinline__ void pre_load(const Unit& u, int tid, float (&r)[16]) const {
        if (tid < 256) { if (rowrs) r[0] = ldv_f(rowrs + u.rowbase + tid); else rstd_row_ld(rowss, u.rowbase + tid, r); } else bias_sum_ld(bias, u.aux + tid - 256, bs1, bs2, r); }
    __device__ __forceinline__ void pre_store(const Unit&, LAS float* aux, int tid, const float (&r)[16]) const { aux[tid] = tid < 256 ? (rowrs ? r[0] : rstd_row_fin(r)) : bias_sum_fin(r); }
    __device__ __forceinline__ void init(LAS float*, int) const {}
    __device__ __forceinline__ void operator()(const Acc& acc, const Unit& u, int wr, int wc, int fr, int fq, const LAS float* aux) const {
        asm volatile("" : "+v"(fr), "+v"(fq));
        const int d0 = wc * 32 + 8 * fq; float bg[8], bu[8];
        { const f32x4 x = *(const LAS f32x4*)(aux + 256 + d0), y = *(const LAS f32x4*)(aux + 256 + d0 + 4), z = *(const LAS f32x4*)(aux + 384 + d0), w = *(const LAS f32x4*)(aux + 384 + d0 + 4);
          bg[0] = x.x; bg[1] = x.y; bg[2] = x.z; bg[3] = x.w; bg[4] = y.x; bg[5] = y.y; bg[6] = y.z; bg[7] = y.w; bu[0] = z.x; bu[1] = z.y; bu[2] = z.z; bu[3] = z.w; bu[4] = w.x; bu[5] = w.y; bu[6] = w.z; bu[7] = w.w; }
        constexpr float KG = -1.4426950408889634f, KU = -0.6931471805599453f * (F8OUT ? F8_HSCALE : 1.0f);
#pragma unroll
        for (int q = 0; q < 8; ++q) { bg[q] *= KG; bu[q] *= KU; }
#pragma unroll
        for (int ai = 0; ai < 2; ++ai)
#pragma unroll
            for (int m = 0; m < 4; ++m) { const int rl = 128 * ai + 64 * wr + 16 * m + fr, row = u.rowbase + rl; const float rs = aux[rl], rsg = rs * KG, rsu = rs * KU; float o[8];
#pragma unroll
                for (int q = 0; q < 8; ++q) {
                    const float x = rsg * acc[ai][0][m][q >> 2][q & 3] + bg[q], y = rsu * acc[ai][1][m][q >> 2][q & 3] + bu[q];
                    o[q] = (x * __builtin_amdgcn_rcpf(1.0f + __builtin_amdgcn_exp2f(x))) * y; }
                if constexpr (F8OUT) {
#pragma unroll
                    for (int q = 0; q < 8; ++q) o[q] = __builtin_amdgcn_fmed3f(o[q], -448.0f, 448.0f);
                    u32x2 w8; w8.x = pk4f8(o[0], o[1], o[2], o[3]); w8.y = pk4f8(o[4], o[5], o[6], o[7]);
                    if (TILED) *(u32x2*)((unsigned char*)Hout + (((size_t)(row >> 8) * (ldh >> 7) + u.pn) * 256 + (row & 255)) * 128 + d0) = w8;
                    else *(u32x2*)((unsigned char*)Hout + (size_t)row * ldh + 128 * u.pn + d0) = w8; }
                else if (TILED) store8bf(Hout + (((size_t)(row >> 8) * (ldh >> 6) + 2 * u.pn + (d0 >> 6)) * 256 + (row & 255)) * 64 + (d0 & 63), o);
                else store8bf(Hout + (size_t)row * ldh + 128 * u.pn + d0, o); }
    }
};
struct EpiMoeDown {
    static constexpr bool PERM = true;
    const float* gate; bf16_t* YB; float* YBB;
    __device__ __forceinline__ void pre_load(const Unit& u, int tid, float (&r)[16]) const { if (tid < 256) r[0] = ldv_f(gate + u.rowbase + tid); }
    __device__ __forceinline__ void pre_store(const Unit&, LAS float* aux, int tid, const float (&r)[16]) const { if (tid < 256) aux[tid] = r[0] * (1.0f / (F8_DSCALE * F8_HSCALE)); }
    __device__ __forceinline__ void init(LAS float*, int) const {}
    __device__ __forceinline__ void operator()(const Acc& acc, const Unit& u, int wr, int wc, int fr, int fq, const LAS float* aux) const {
        asm volatile("" : "+v"(fr), "+v"(fq));
        const int col0 = 256 * u.pn + 32 * wc + 8 * fq;
#pragma unroll
        for (int ai = 0; ai < 2; ++ai)
#pragma unroll
            for (int m = 0; m < 4; ++m) { const int rl = 128 * ai + 64 * wr + 16 * m + fr, row = u.rowbase + rl; const float gt = aux[rl];
#pragma unroll
                for (int bj = 0; bj < 2; ++bj) {
                    if (u.aux == 0) { float o[8];
#pragma unroll
                        for (int q = 0; q < 8; ++q) o[q] = acc[ai][bj][m][q >> 2][q & 3] * gt;
                        store8bf(YB + (size_t)row * 1024 + col0 + 128 * bj, o); }
                    else { float* d = YBB + (size_t)(u.aux - 1) * 65536 + (size_t)rl * 256 + 32 * wc + 8 * fq + 128 * bj;
                        *(f32x4*)d = acc[ai][bj][m][0] * gt; *(f32x4*)(d + 4) = acc[ai][bj][m][1] * gt; } } }
    }
};

namespace pg8 {
constexpr int BM = 256, BK = 64, HALF = 128, HTB = HALF * BK * 2, STAGE_BYTES = 8 * HTB;
__device__ __forceinline__ int lds_byte(int r, int c) { const int st = (r >> 4) * 2 + (c >> 5), rr = r & 15, cc = c & 31, ob = rr * 64 + cc * 2; return st * 1024 + (ob ^ (((ob >> 9) & 1) << 5)); }
__device__ __forceinline__ void stage_rc(int b, int& R, int& C) { const int st = b / 1024, sb = b % 1024, swz = sb ^ (((sb >> 9) & 1) << 5); R = (st >> 1) * 16 + swz / 64; C = (st & 1) * 32 + (swz % 64) / 2; }
__device__ __forceinline__ int perm32(int rho) { const int n = rho >> 4, i = rho & 15; return 8 * (i >> 2) + 4 * n + (i & 3); }
}
typedef int i32x8 __attribute__((ext_vector_type(8)));
__device__ __forceinline__ void mfma_f8_inplace(f32x4& acc, const i32x8 a, const i32x8 b, int sc) {
    asm volatile("v_mfma_scale_f32_16x16x128_f8f6f4 %0, %1, %2, %0, %3, %3 op_sel_hi:[0,0,0]" : "+v"(acc) : "v"(a), "v"(b), "v"(sc)); }
template <class Desc, class Epi>
__device__ __forceinline__ void gemm_fast(LAS unsigned char* lds, const unsigned char* wsb, const Desc& Dc, const Epi& E, int c, int G, int wave_id) {
    using namespace pg8;
    constexpr bool GATHER = Desc::GATHER; constexpr bool FP8 = Desc::FP8;
    int lane_ = lane_id(); asm volatile("" : "+v"(lane_));
    const int wid = wave_id, lane = lane_, tid = wid * 64 + lane, wr = wid >> 2, wc = wid & 3, fr = lane & 15, fq = lane >> 4;
    unsigned vA[2][2], vAn[2][2], vB[2][2];
#pragma unroll
    for (int i = 0; i < 2; ++i) { int R, C; stage_rc(tid * 16 + i * 8192, R, C); const int Rb = Epi::PERM ? ((R & ~31) + perm32(R & 31)) : R;
#pragma unroll
        for (int h = 0; h < 2; ++h) { vA[h][i] = (unsigned)((h * HALF + R) * Dc.lda + C) * 2u; vB[h][i] = (unsigned)((h * HALF + Rb) * Dc.ldb + C) * 2u; vAn[h][i] = vA[h][i]; } }
    const unsigned ksA = (unsigned)Dc.ksa, ksB = (unsigned)Dc.ksb;
    const __amdgpu_buffer_rsrc_t rs = __builtin_amdgcn_make_buffer_rsrc((void*)wsb, (short)0, 0x7fffffff, 0x00020000);
    const unsigned ldsw = (unsigned)wid * 1024u;
    const int aoff = lds_byte(wr * 64 + fr, fq * 8), boff = lds_byte(wc * 32 + fr, fq * 8);
#define PG8_SA(b, h) (((b) * 2 + (h)) * HTB)
#define PG8_SB(b, h) ((4 + (b) * 2 + (h)) * HTB)
#define PG8_STAGE(bufoff, gbase, voff) do { _Pragma("unroll") for (int _i = 0; _i < 2; ++_i) \
        __builtin_amdgcn_raw_ptr_buffer_load_lds(rs, (LAS unsigned*)(lds + (bufoff) + ldsw + _i * 8192), 16, (int)(voff)[_i], (int)(gbase), 0, 0); } while (0)
#define PG8_LDA(dst, b, h) do { _Pragma("unroll") for (int m = 0; m < 4; ++m) _Pragma("unroll") for (int k = 0; k < 2; ++k) dst[m][k] = *(const LAS bf16x8*)(lds + PG8_SA(b, h) + aoff + m * 2048 + k * 1024); } while (0)
#define PG8_LDB(dst, b, h) do { _Pragma("unroll") for (int n = 0; n < 2; ++n) _Pragma("unroll") for (int k = 0; k < 2; ++k) dst[n][k] = *(const LAS bf16x8*)(lds + PG8_SB(b, h) + boff + n * 2048 + k * 1024); } while (0)
#define PG8_CAT(x) __builtin_shufflevector(__builtin_bit_cast(i32x4, x[0]), __builtin_bit_cast(i32x4, x[1]), 0, 1, 2, 3, 4, 5, 6, 7)
#define PG8_MMA(ai, bj, At, Bt) do { __builtin_amdgcn_s_setprio(1); if constexpr (FP8) { _Pragma("unroll") for (int m = 0; m < 4; ++m) _Pragma("unroll") for (int n = 0; n < 2; ++n) \
        mfma_f8_inplace(acc[ai][bj][m][n], PG8_CAT(Bt[n]), PG8_CAT(At[m]), f8sc); } else { \
        _Pragma("unroll") for (int m = 0; m < 4; ++m) _Pragma("unroll") for (int n = 0; n < 2; ++n) _Pragma("unroll") for (int k = 0; k < 2; ++k) \
        acc[ai][bj][m][n] = __builtin_amdgcn_mfma_f32_16x16x32_bf16(Bt[n][k], At[m][k], acc[ai][bj][m][n], 0, 0, 0); } __builtin_amdgcn_s_setprio(0); } while (0)
#define PG8_WAIT_V(n) asm volatile("s_waitcnt vmcnt(" #n ")" ::: "memory")
#define PG8_WAIT_L(n) asm volatile("s_waitcnt lgkmcnt(" #n ")" ::: "memory")
#define PG8_BAR __builtin_amdgcn_s_barrier()
#define PG8_SCHED __builtin_amdgcn_sched_barrier(0)
#define PG8_GATHER_OFFS(dst, un) do { const int _t = wid * 64 + lane_id(); _Pragma("unroll") for (int _i = 0; _i < 2; ++_i) { int _R, _C; stage_rc(_t * 16 + _i * 8192, _R, _C); \
        _Pragma("unroll") for (int _h = 0; _h < 2; ++_h) dst[_h][_i] = (unsigned)(ldv_i(Dc.tok + (un).rowbase + _h * HALF + _R) * Dc.lda + _C) * 2u; } } while (0)
    int f8sc = 0x7f7f7f7f; asm volatile("" : "+v"(f8sc));
    Unit cur, nxt; int ui = 0;
    if (!Dc.get(c, cur)) return;
    LAS float* const auxb = (LAS float*)(lds + 131072 + 1024);
    E.init(auxb, tid);
    { float r0[16]; E.pre_load(cur, tid, r0); E.pre_store(cur, auxb, tid, r0); }
    Acc acc;
#pragma unroll
    for (int a = 0; a < 2; ++a)
#pragma unroll
        for (int b = 0; b < 2; ++b)
#pragma unroll
            for (int m = 0; m < 4; ++m)
#pragma unroll
                for (int n = 0; n < 2; ++n) acc[a][b][m][n] = (f32x4){0.f, 0.f, 0.f, 0.f};
    bf16x8 At[4][2], B0[2][2], B1[2][2];
    unsigned cA = (unsigned)((const unsigned char*)cur.A - wsb), cB = (unsigned)((const unsigned char*)cur.B - wsb);
    if constexpr (GATHER) { PG8_GATHER_OFFS(vA, cur); }
    PG8_STAGE(PG8_SB(0, 0), cB, vB[0]); PG8_STAGE(PG8_SB(0, 1), cB, vB[1]); PG8_STAGE(PG8_SA(0, 0), cA, vA[0]); PG8_STAGE(PG8_SA(0, 1), cA, vA[1]);
    if (wr == 1) PG8_BAR;
    PG8_WAIT_V(2); PG8_BAR;
    PG8_STAGE(PG8_SB(1, 0), cB + ksB, vB[0]); PG8_STAGE(PG8_SA(1, 0), cA + ksA, vA[0]); PG8_STAGE(PG8_SB(1, 1), cB + ksB, vB[1]);
    PG8_WAIT_V(6); PG8_BAR;
    for (;;) {
        const bool has_next = Dc.get((ui + 1) * G + c, nxt);
        const unsigned nA = has_next ? (unsigned)((const unsigned char*)nxt.A - wsb) : cA, nB = has_next ? (unsigned)((const unsigned char*)nxt.B - wsb) : cB;
        if constexpr (GATHER) { if (has_next) { PG8_GATHER_OFFS(vAn, nxt); } else {
#pragma unroll
            for (int h = 0; h < 2; ++h)
#pragma unroll
                for (int i = 0; i < 2; ++i) vAn[h][i] = vA[h][i]; } }
        const int nt = cur.nt;
        for (int t = 0; t < nt; t += 2) {
            const bool last = (t == nt - 2);
            const unsigned a1 = cA + (unsigned)(t + 1) * ksA;
            const unsigned a2 = last ? nA : cA + (unsigned)(t + 2) * ksA, b2 = last ? nB : cB + (unsigned)(t + 2) * ksB;
            const unsigned a3 = a2 + ksA, b3 = b2 + ksB;
            unsigned x0[2], x1[2];
#pragma unroll
            for (int i = 0; i < 2; ++i) { x0[i] = (GATHER && last) ? vAn[0][i] : vA[0][i]; x1[i] = (GATHER && last) ? vAn[1][i] : vA[1][i]; }
            PG8_LDB(B0, 0, 0); PG8_LDB(B1, 0, 1); PG8_SCHED; PG8_LDA(At, 0, 0); PG8_STAGE(PG8_SA(1, 1), a1, vA[1]);
            PG8_WAIT_V(8); PG8_WAIT_L(0); PG8_BAR; PG8_MMA(0, 0, At, B0); PG8_MMA(0, 1, At, B1); PG8_BAR; PG8_SCHED;
            PG8_LDA(At, 0, 1); PG8_STAGE(PG8_SB(0, 0), b2, vB[0]); PG8_STAGE(PG8_SB(0, 1), b2, vB[1]); PG8_STAGE(PG8_SA(0, 0), a2, x0);
            PG8_WAIT_V(8); PG8_WAIT_L(0); PG8_BAR; PG8_MMA(1, 0, At, B0); PG8_MMA(1, 1, At, B1); PG8_BAR; PG8_SCHED;
            PG8_LDB(B0, 1, 0); PG8_LDB(B1, 1, 1); PG8_SCHED; PG8_LDA(At, 1, 0); PG8_STAGE(PG8_SA(0, 1), a2, x1);
            PG8_WAIT_V(8); PG8_WAIT_L(0); PG8_BAR; PG8_MMA(0, 0, At, B0); PG8_MMA(0, 1, At, B1); PG8_BAR; PG8_SCHED;
            PG8_LDA(At, 1, 1); PG8_STAGE(PG8_SB(1, 0), b3, vB[0]); PG8_STAGE(PG8_SB(1, 1), b3, vB[1]); PG8_STAGE(PG8_SA(1, 0), a3, x0);
            PG8_WAIT_V(8); PG8_WAIT_L(0); PG8_BAR; PG8_MMA(1, 0, At, B0); PG8_MMA(1, 1, At, B1); PG8_BAR; PG8_SCHED;
        }
        if constexpr (FP8) asm volatile("s_nop 15\n\ts_nop 15\n\ts_nop 15\n\ts_nop 15\n\ts_nop 15" ::: "memory");
        if (wr == 0) PG8_BAR;
        { const int l2 = lane_id(); float rn[16];
          if (has_next) E.pre_load(nxt, wid * 64 + l2, rn);
          E(acc, cur, wr, wc, l2 & 15, l2 >> 4, auxb + (ui & 1) * 768);
          if (has_next) E.pre_store(nxt, auxb + ((ui + 1) & 1) * 768, wid * 64 + l2, rn); }
        if (!has_next) break;
#pragma unroll
        for (int a = 0; a < 2; ++a)
#pragma unroll
            for (int b = 0; b < 2; ++b)
#pragma unroll
                for (int m = 0; m < 4; ++m)
#pragma unroll
                    for (int n = 0; n < 2; ++n) acc[a][b][m][n] = (f32x4){0.f, 0.f, 0.f, 0.f};
        cur = nxt; cA = nA; cB = nB; ++ui;
        if constexpr (GATHER) {
#pragma unroll
            for (int h = 0; h < 2; ++h)
#pragma unroll
                for (int i = 0; i < 2; ++i) vA[h][i] = vAn[h][i]; }
        if (wr == 1) PG8_BAR;
    }
    PG8_WAIT_V(0);
    PG8_BAR;
#undef PG8_SA
#undef PG8_SB
#undef PG8_STAGE
#undef PG8_LDA
#undef PG8_LDB
#undef PG8_MMA
#undef PG8_CAT
#undef PG8_WAIT_V
#undef PG8_WAIT_L
#undef PG8_BAR
#undef PG8_SCHED
#undef PG8_GATHER_OFFS
}

struct Frame {
    Params p; unsigned char* ws; LAS unsigned char* lds; int tid, lane, wave, c, G;
    __device__ __forceinline__ float* MOD() const { return (float*)(ws + CT_MOD); }
    __device__ __forceinline__ float* BIAS_IN() const { return (float*)(ws + CT_BIAS_IN); }
    __device__ __forceinline__ float* BIAS_GU() const { return (float*)(ws + CT_BIAS_GU); }
    __device__ __forceinline__ float* BIAS_R() const { return (float*)(ws + CT_BIAS_R); }
    __device__ __forceinline__ float* BIAS_MGU() const { return (float*)(ws + CT_BIAS_MGU); }
    __device__ __forceinline__ float* ROWSS() const { return (float*)(ws + WS_ROWSSP); }
    __device__ __forceinline__ float* MODP() const { return (float*)(ws + WS_MODP); }
    __device__ __forceinline__ f32x2* TABA() const { return (f32x2*)(ws + WS_TABA); }
    __device__ __forceinline__ f32x2* TABB() const { return (f32x2*)(ws + WS_TABB); }
    __device__ __forceinline__ float* GP() const { return (float*)(ws + WS_GP); }
    __device__ __forceinline__ float* WR() const { return (float*)(ws + WS_WR); }
    __device__ __forceinline__ int* TOPE() const { return (int*)(ws + WS_TOPE); }
    __device__ __forceinline__ float* TOPG() const { return (float*)(ws + WS_TOPG); }
    __device__ __forceinline__ int* CNT() const { return (int*)(ws + WS_CNT); }
    __device__ __forceinline__ int* BUFTOK() const { return (int*)(ws + WS_BUFTOK); }
    __device__ __forceinline__ float* BUFGATE() const { return (float*)(ws + WS_BUFGATE); }
    __device__ __forceinline__ int* POS() const { return (int*)(ws + WS_POS); }
    __device__ __forceinline__ int* BLKE() const { return (int*)(ws + WS_BLKE); }
    __device__ __forceinline__ float* RSTD3() const { return (float*)(ws + WS_RSTD3); }
    __device__ __forceinline__ float* BUFRS() const { return (float*)(ws + WS_BUFRS); }
    __device__ __forceinline__ bf16_t* WIN() const { return (bf16_t*)(ws + WS_WIN); }
    __device__ __forceinline__ bf16_t* WOUT() const { return (bf16_t*)(ws + WS_WOUT); }
    __device__ __forceinline__ bf16_t* WGU() const { return (bf16_t*)(ws + WS_WGU); }
    __device__ __forceinline__ bf16_t* WD() const { return (bf16_t*)(ws + WS_WD); }
    __device__ __forceinline__ bf16_t* WP() const { return (bf16_t*)(ws + WS_WP); }
    __device__ __forceinline__ bf16_t* XB() const { return (bf16_t*)(ws + WS_XB); }
    __device__ __forceinline__ bf16_t* Q() const { return (bf16_t*)(ws + WS_Q); }
    __device__ __forceinline__ bf16_t* KN() const { return (bf16_t*)(ws + WS_KN); }
    __device__ __forceinline__ bf16_t* KDT() const { return (bf16_t*)(ws + WS_KDT); }
    __device__ __forceinline__ bf16_t* VT() const { return (bf16_t*)(ws + WS_VT); }
    __device__ __forceinline__ bf16_t* Gb() const { return (bf16_t*)(ws + WS_G); }
    __device__ __forceinline__ bf16_t* SB() const { return (bf16_t*)(ws + WS_SB); }
    __device__ __forceinline__ bf16_t* Y() const { return (bf16_t*)(ws + WS_Y); }
    __device__ __forceinline__ bf16_t* H1() const { return (bf16_t*)(ws + WS_H1); }
    __device__ __forceinline__ bf16_t* PB() const { return (bf16_t*)(ws + WS_PB); }
    __device__ __forceinline__ bf16_t* H1M() const { return (bf16_t*)(ws + WS_H1M); }
    __device__ __forceinline__ bf16_t* WMGU() const { return (bf16_t*)(ws + WS_WMGU); }
    __device__ __forceinline__ bf16_t* WMD() const { return (bf16_t*)(ws + WS_WMD); }
    __device__ __forceinline__ bf16_t* YB() const { return (bf16_t*)(ws + WS_YB); }
    __device__ __forceinline__ float* YBB() const { return (float*)(ws + WS_YBB); }
    __device__ __forceinline__ float* X2() const { return (float*)(ws + WS_X2); }
};
__device__ __forceinline__ void frame_fresh(Frame& F) { int l = lane_id(); asm volatile("" : "+v"(l)); F.lane = l; F.tid = F.wave * 64 + l; }
__device__ __forceinline__ void frame_init(Frame& F, const Params& p, LAS unsigned char* lds, int c, int G) {
    F.p = p; F.ws = p.ws; F.lds = lds; F.tid = threadIdx.x; F.lane = F.tid & 63; F.wave = __builtin_amdgcn_readfirstlane(F.tid >> 6); F.c = c; F.G = G;
}

__device__ __forceinline__ void dsincos(double x, double& s, double& c) {
    const double k = rint(x * 0.6366197723675814); double y = fma(-k, 1.5707963267948966, x); y = fma(-k, 6.123233995736766e-17, y);
    const double z = y * y;
    double sp = -7.6471637318198164759e-13; sp = fma(sp, z, 1.6059043836821614599e-10); sp = fma(sp, z, -2.5052108385441718775e-8); sp = fma(sp, z, 2.7557319223985890653e-6);
    sp = fma(sp, z, -1.9841269841269841270e-4); sp = fma(sp, z, 8.3333333333333333333e-3); sp = fma(sp, z, -1.6666666666666666667e-1); const double sy = fma(sp * z, y, y);
    double cp = 4.7794773323873852974e-14; cp = fma(cp, z, -1.1470745597729724714e-11); cp = fma(cp, z, 2.0876756987868098979e-9); cp = fma(cp, z, -2.7557319223985890653e-7);
    cp = fma(cp, z, 2.4801587301587301587e-5); cp = fma(cp, z, -1.3888888888888888889e-3); cp = fma(cp, z, 4.1666666666666666667e-2); cp = fma(cp, z, -0.5); const double cy = fma(cp, z, 1.0);
    const int q = ((int)k) & 3;
    s = (q == 0) ? sy : (q == 1) ? cy : (q == 2) ? -sy : -cy;
    c = (q == 0) ? cy : (q == 1) ? -sy : (q == 2) ? -cy : sy;
}
__device__ __forceinline__ void phase_p0(Frame& F) {
    const Params& p = F.p; const int gw = F.c * NWAVE + F.wave, NGW = F.G * NWAVE, lane = F.lane;
    LAS float* cact = (LAS float*)F.lds;
    __syncthreads();
    for (int k = F.tid; k < 1024; k += NTHR) cact[k] = silu_f(p.c[k]);
    __syncthreads();
    for (int task = gw; task < 1536; task += NGW) {
        const int i = task / 768, rem = task % 768, cb = rem >> 3, ks = rem & 7, n = cb * 64 + lane;
        const float* w = p.ada_w + (size_t)i * 1024 * NIN + (size_t)(ks * 128) * NIN + n; float a = 0.f;
#pragma unroll
        for (int k0 = 0; k0 < 128; k0 += 32) { float wv[32];
#pragma unroll
            for (int k = 0; k < 32; ++k) wv[k] = w[(size_t)(k0 + k) * NIN];
#pragma unroll
            for (int k = 0; k < 32; ++k) a = fmaf(cact[ks * 128 + k0 + k], wv[k], a); }
        if (ks == 0) a += p.ada_b[i * NIN + n];
        F.MODP()[ks * 12288 + i * NIN + n] = a;
    }
    const int gt = F.c * NTHR + F.tid, NGT = F.G * NTHR;
    for (int e = gt; e < 32768 + 4; e += NGT) {
        if (e < 32768) {
            const int which = e >> 14, ab = (e >> 7) & 127, i = e & 127; double inv = 1.0;
            for (int q = 0; q < i; ++q) inv *= 0.93057204092969897929;
            const double ang = (double)(which == 0 ? 128 * ab : ab) * inv; double s, c2; dsincos(ang, s, c2);
            (which == 0 ? F.TABA() : F.TABB())[ab * 128 + i] = (f32x2){(float)c2, (float)s};
        } else {
            const int h = e - 32768; const double g = 1.0 - 1.0 / (double)(32 << h); double v = 1.0;
            for (int j = 0; j <= 256; ++j) { F.GP()[h * GPS + j] = (float)v; v *= g; }
        }
    }
    for (int row = 2 * gw; row < T; row += 2 * NGW) {
        f32x4 v[2][4];
#pragma unroll
        for (int r = 0; r < 2; ++r) { const f32x4* xr = (const f32x4*)(p.x + (size_t)(row + r) * D) + lane;
#pragma unroll
            for (int j = 0; j < 4; ++j) v[r][j] = xr[64 * j]; }
#pragma unroll
        for (int r = 0; r < 2; ++r) { float s = 0.f;
#pragma unroll
            for (int j = 0; j < 4; ++j) s += (v[r][j].x * v[r][j].x + v[r][j].y * v[r][j].y) + (v[r][j].z * v[r][j].z + v[r][j].w * v[r][j].w);
            s = wave_sum(s); if (lane < 16) F.ROWSS()[(size_t)(row + r) * 16 + lane] = (lane == 0) ? s : 0.f;
            u32x2* o = (u32x2*)(F.XB() + (size_t)(row + r) * D) + lane;
#pragma unroll
            for (int j = 0; j < 4; ++j) { u32x2 w; w.x = pk2(v[r][j].x, v[r][j].y); w.y = pk2(v[r][j].z, v[r][j].w); o[64 * j] = w; } }
    }
}

template <bool F8 = false>
__device__ __forceinline__ void conv_strip(const float* W, int ldw, int kb0, int nkb, int n0, bf16_t* WT, int ldt, int drow0, const LAS float* gsl, const LAS float* shl,
                                           float* bias, float cscale, LAS float* scr, int lane, int tiled_nkt = 0, float wmul = 1.0f) {
    f32x4 bacc = (f32x4){0.f, 0.f, 0.f, 0.f}; f32x4 w[8];
    const int lr = lane >> 3, lc = 4 * (lane & 7);
    const float* wp = W + (size_t)(kb0 * 64 + lr) * ldw + n0 + lc;
#pragma unroll
    for (int i = 0; i < 8; ++i) w[i] = *(const f32x4*)(wp + (size_t)(8 * i) * ldw);
    for (int kb = kb0; kb < kb0 + nkb; ++kb) {
        const int k0 = kb * 64; f32x4 wn[8];
        if (kb + 1 < kb0 + nkb) {
#pragma unroll
            for (int i = 0; i < 8; ++i) wn[i] = *(const f32x4*)(wp + (size_t)(64 * (kb + 1 - kb0) + 8 * i) * ldw);
        } else {
#pragma unroll
            for (int i = 0; i < 8; ++i) wn[i] = (f32x4){0.f, 0.f, 0.f, 0.f};
        }
#pragma unroll
        for (int i = 0; i < 8; ++i) { const int kk = lr + 8 * i;
            float gsv = cscale * wmul; if (gsl) { gsv *= gsl[k0 + kk]; const float sv = shl[k0 + kk]; bacc = bacc + w[i] * sv; }
            *(LAS f32x4*)(scr + kk * 36 + 4 * ((lane & 7) ^ i)) = w[i] * gsv; }
        asm volatile("s_waitcnt lgkmcnt(0)" ::: "memory");
        const int cc = lane & 7;
#pragma unroll
        for (int j = 0; j < 4; ++j) { const int n = (lane >> 3) + 8 * j; const LAS float* s = scr + (8 * cc) * 36 + 4 * ((n >> 2) ^ cc) + (n & 3);
            const int nr = drow0 + n;
            if constexpr (F8) { u32x2 o8; o8.x = pk4f8(s[0 * 36], s[1 * 36], s[2 * 36], s[3 * 36]); o8.y = pk4f8(s[4 * 36], s[5 * 36], s[6 * 36], s[7 * 36]);
                if (tiled_nkt) *(u32x2*)((unsigned char*)WT + (((size_t)(nr >> 8) * tiled_nkt + (kb >> 1)) * 256 + (nr & 255)) * 128 + (kb & 1) * 64 + 8 * cc) = o8;
                else *(u32x2*)((unsigned char*)WT + (size_t)nr * ldt + k0 + 8 * cc) = o8;
                continue; }
            u32x4 o; o.x = pk2(s[0 * 36], s[1 * 36]); o.y = pk2(s[2 * 36], s[3 * 36]); o.z = pk2(s[4 * 36], s[5 * 36]); o.w = pk2(s[6 * 36], s[7 * 36]);
            if (tiled_nkt) *(u32x4*)(WT + (((size_t)(nr >> 8) * tiled_nkt + kb) * 256 + (nr & 255)) * 64 + 8 * cc) = o;
            else *(u32x4*)(WT + (size_t)nr * ldt + k0 + 8 * cc) = o; }
        asm volatile("s_waitcnt lgkmcnt(0)" ::: "memory");
#pragma unroll
        for (int i = 0; i < 8; ++i) w[i] = wn[i];
    }
    if (bias) {
#pragma unroll
        for (int o = 8; o < 64; o <<= 1) { bacc.x += __shfl_xor(bacc.x, o); bacc.y += __shfl_xor(bacc.y, o); bacc.z += __shfl_xor(bacc.z, o); bacc.w += __shfl_xor(bacc.w, o); }
        if (lane < 8) *(f32x4*)(bias + drow0 + lc) = bacc * cscale; }
}
__device__ __forceinline__ void phase_p1(Frame& F) {
    const Params& p = F.p; const int gw = F.c * NWAVE + F.wave, NGW = F.G * NWAVE, lane = F.lane;
    LAS float* modl = (LAS float*)F.lds;
    LAS float* scr = (LAS float*)(F.lds + 49152 + F.wave * 9216);
    __syncthreads();
    for (int idx = F.tid; idx < 12288; idx += NTHR) { float v = 0.f;
#pragma unroll
        for (int ks = 0; ks < 8; ++ks) v += F.MODP()[ks * 12288 + idx];
        modl[idx] = v; if ((idx % F.G) == F.c) F.MOD()[idx] = v; }
    __syncthreads();
    const LAS float* MOD0 = modl; const LAS float* MOD1 = modl + NIN; const LAS float* nul = nullptr;
    LAS float* gs_in = modl + 2048; LAS float* gs_ffn = modl + 5120; LAS float* gs_pool = modl + NIN + 2048;
    for (int k = F.tid; k < 1024; k += NTHR) { gs_in[k] = p.norm_gain[k] * (1.0f + MOD0[1024 + k]); gs_ffn[k] = p.norm_gain[1024 + k] * (1.0f + MOD0[4 * 1024 + k]); gs_pool[k] = p.norm_gain[2048 + k] * (1.0f + MOD1[1024 + k]); }
    __syncthreads();
    constexpr int S_IN = 192 * 4, S_G = 88 * 4, I_OUT = 32 * 32, I_D = 44 * 32, I_P = 4 * 4 * 8;
    constexpr int NIT = S_IN + 2 * S_G + I_OUT + I_D + I_P + 1;
    for (int it = gw; it < NIT; it += NGW) {
        int r = it;
        if (r < S_IN) { const int part = r / 192, n0 = (r % 192) * 32; const float cs = (n0 >= 1024 && n0 < 2048) ? 0.0625f : 1.0f;
            conv_strip(p.ret_w_in, NIN, 4 * part, 4, n0, F.WIN(), 1024, n0, gs_in, MOD0, F.BIAS_IN() + part * NIN, cs, scr, lane); continue; } r -= S_IN;
        if (r < 2 * S_G) { const int up = r >= S_G; if (up) r -= S_G; const int part = r / 88, n0 = (r % 88) * 32, drow = (n0 >> 7) * 256 + (up ? 128 : 0) + (n0 & 127);
            conv_strip(up ? p.ffn_w_up : p.ffn_w_gate, DFF, 4 * part, 4, n0, F.WGU(), 1024, drow, gs_ffn, MOD0 + 3 * 1024, F.BIAS_GU() + part * 5632, 1.0f, scr, lane); continue; } r -= 2 * S_G;
        if (r < I_OUT) { const int kb = r / 32, nb = r % 32; conv_strip(p.ret_w_out, 1024, kb, 1, nb * 32, F.WOUT(), 2048, nb * 32, nul, nul, nullptr, 1.0f, scr, lane); continue; } r -= I_OUT;
        if (r < I_D) { const int kb = r / 32, nb = r % 32; conv_strip<true>(p.ffn_w_down, 1024, kb, 1, nb * 32, F.WD(), DFF, nb * 32, nul, nul, nullptr, 1.0f, scr, lane, 22, F8_DSCALE); continue; } r -= I_D;
        if (r < I_P) { const int g = r / 32, q = r % 32, kb = q / 8, nb = q % 8;
            conv_strip(p.pool_w + (size_t)g * 65536, 256, kb, 1, nb * 32, F.WP() + (size_t)g * 65536, 256, nb * 32, gs_pool + g * 256, MOD1 + g * 256, nullptr, 1.0f, scr, lane); continue; }
        { float ba = 0.f; const int e = lane & 7;
            for (int k0 = lane >> 3; k0 < 1024; k0 += 128) { float w[16], gn[16];
#pragma unroll
                for (int j = 0; j < 16; ++j) { const int k = k0 + 8 * j; w[j] = p.moe_router[k * 8 + e]; gn[j] = p.norm_gain[3 * 1024 + k]; }
#pragma unroll
                for (int j = 0; j < 16; ++j) { const int k = k0 + 8 * j; F.WR()[k * 8 + e] = w[j] * (gn[j] * (1.0f + MOD1[4 * 1024 + k])); ba = fmaf(MOD1[3 * 1024 + k], w[j], ba); } }
            ba += __shfl_xor(ba, 8); ba += __shfl_xor(ba, 16); ba += __shfl_xor(ba, 32);
            if (lane < 8) F.BIAS_R()[lane] = ba; }
    }
}
constexpr int PX_SG = 112 * 4, PX_EARLY = 1024;
__device__ __forceinline__ void px_tables(Frame& F) {
    const Params& p = F.p;
    LAS float* gsl = (LAS float*)(F.lds + 8 * 9216 + 1024);
    LAS float* shl = gsl + 1024;
    const float* MOD1 = F.MOD() + NIN;
    for (int k = F.tid; k < 1024; k += NTHR) { gsl[k] = p.norm_gain[3 * 1024 + k] * (1.0f + ldv_f(MOD1 + 4 * 1024 + k)); shl[k] = ldv_f(MOD1 + 3 * 1024 + k); }
    __syncthreads();
}
__device__ __forceinline__ void px_gu_item(Frame& F, int it, int lane) {
    const Params& p = F.p;
    LAS float* scr = (LAS float*)(F.lds + F.wave * 9216);
    LAS float* gsl = (LAS float*)(F.lds + 8 * 9216 + 1024); LAS float* shl = gsl + 1024;
    const int e = it / (2 * PX_SG); int r = it % (2 * PX_SG); const int up = r >= PX_SG; if (up) r -= PX_SG;
    const int part = r / 112, n0 = (r % 112) * 32, drow = e * 7168 + (n0 >> 7) * 256 + (up ? 128 : 0) + (n0 & 127);
    conv_strip<true>((up ? p.moe_w_up : p.moe_w_gate) + (size_t)e * 1024 * DFE, DFE, 4 * part, 4, n0, F.WMGU(), 1024, drow, gsl, shl,
                     F.BIAS_MGU() + (part >> 1) * 262144 + (part & 1) * 57344, 1.0f, scr, lane, 0, F8_WSCALE);
}
__device__ __forceinline__ void phase_px(Frame& F) {
    const Params& p = F.p; const int gw = F.c * NWAVE + F.wave, NGW = F.G * NWAVE, lane = F.lane;
    LAS float* scr = (LAS float*)(F.lds + F.wave * 9216);
    const LAS float* nul = nullptr;
    px_tables(F);
    constexpr int I_D = 14 * 32;
    for (int it = (F.G == 256 ? PX_EARLY : 0) + gw; it < NE * 2 * PX_SG; it += NGW) px_gu_item(F, it, lane);
    const int lane2 = lane_id();
    for (int it = gw; it < NE * I_D; it += NGW) {
        const int e = it / I_D, r = it % I_D, kg = r / 32, nb = r % 32;
        conv_strip<true>(p.moe_w_down + (size_t)e * DFE * 1024, 1024, 4 * kg, 4, nb * 32, (bf16_t*)((unsigned char*)F.WMD() + (size_t)e * 1024 * DFE), DFE, nb * 32, nul, nul, nullptr, 1.0f, scr, lane2, 28, F8_DSCALE);
    }
}

__device__ __forceinline__ void phase_scan(Frame& F) {
    const int gt = F.c * NTHR + F.tid, NGT = F.G * NTHR;
    for (int v = gt; v < 131072; v += NGT) {
        const int h = v >> 15; const float dec = F.GP()[h * GPS + RC]; float s0 = 0.f, s1 = 0.f, s2 = 0.f, s3 = 0.f;
        u32x2* ptr = (u32x2*)(F.SB() + (size_t)v * 4);
        for (int n0 = 0; n0 < NRC; n0 += 16) {
            u32x2 kv[16];
#pragma unroll
            for (int j = 0; j < 16; ++j) { kv[j] = (u32x2){0u, 0u}; if (n0 + j < NRC - 1) kv[j] = ptr[(size_t)(n0 + j) * 131072]; }
#pragma unroll
            for (int j = 0; j < 16; ++j) {
                u32x2 o; o.x = pk2(s0, s1); o.y = pk2(s2, s3); ptr[(size_t)(n0 + j) * 131072] = o;
                s0 = s0 * dec + bflo(kv[j].x); s1 = s1 * dec + bfhi(kv[j].x); s2 = s2 * dec + bflo(kv[j].y); s3 = s3 * dec + bfhi(kv[j].y); }
        }
    }
}

namespace ret {
constexpr int BUFB = 40960, OFF_B = 8192, OFF_P = 81920, OFF_RED = 114688, OFF_GP = 118784;
__device__ __forceinline__ int swz(int o) { return o ^ (((o >> 9) & 1) << 5); }
}
#define RET_WAITV(n) asm volatile("s_waitcnt vmcnt(" #n ")" ::: "memory")
#define RET_WAITL0() asm volatile("s_waitcnt lgkmcnt(0)" ::: "memory")
#define RET_BAR() do { asm volatile("" ::: "memory"); __builtin_amdgcn_s_barrier(); asm volatile("" ::: "memory"); } while (0)
__device__ __forceinline__ void phase_ret_fast(Frame& F) {
    using namespace ret;
    const Params& p = F.p; LAS unsigned char* lds = F.lds;
    const int tid = F.tid, lane = tid & 63, wid = F.wave, wr = wid >> 2, wc = wid & 3, fr = lane & 15, fq = lane >> 4;
    const int foff = swz(fr * 64 + fq * 16);
    const int srow = lane >> 2, scol = ((lane & 3) * 8) ^ (((lane >> 5) & 1) * 16);
    LAS float* gps = (LAS float*)(lds + OFF_GP); LAS f32x2* red = (LAS f32x2*)(lds + OFF_RED);
    __syncthreads();
    for (int i = tid; i < 4 * GPS; i += NTHR) gps[i] = F.GP()[i];
    __syncthreads();
    const __amdgpu_buffer_rsrc_t rs = __builtin_amdgcn_make_buffer_rsrc((void*)F.ws, (short)0, 0x7fffffff, 0x00020000);
    const unsigned qoff = (unsigned)((16 * wid + srow) * 1024 + scol) * 2u;
    unsigned soff[4], voff[4];
#pragma unroll
    for (int i = 0; i < 4; ++i) { soff[i] = (unsigned)((16 * (wid + 8 * i) + srow) * 256 + scol) * 2u; voff[i] = (unsigned)((16 * (wid + 8 * i) + srow) * T + scol) * 2u; }
#define RET_GLDS(uoff, loff, dst) __builtin_amdgcn_raw_ptr_buffer_load_lds(rs, (LAS unsigned*)(lds + (dst)), 16, (int)(loff), (int)(uoff), 0, 0)
#define RET_LOADS(kind, ks, b, hh, nn, nk) do { const unsigned _qk = (unsigned)((nn) * 128 * 1024 + (hh) * 256 + 32 * (ks)) * 2u, _kk = (unsigned)((nk) * 128 * 1024 + (hh) * 256 + 32 * (ks)) * 2u; \
        if ((kind) != 2) RET_GLDS((unsigned)WS_Q + _qk, qoff, (b) * BUFB + wid * 1024); \
        if ((kind) == 0) RET_GLDS((unsigned)WS_KN + _kk, qoff, (b) * BUFB + OFF_B + wid * 1024); \
        if ((kind) == 1) { const unsigned _sb = (unsigned)WS_SB + (unsigned)((((nn) >> 1) * 4 + (hh)) * 512 * 256 + 32 * (ks)) * 2u; _Pragma("unroll") for (int _i = 0; _i < 4; ++_i) \
            RET_GLDS(_sb, soff[_i], (b) * BUFB + OFF_B + (wid + 8 * _i) * 1024); } \
        if ((kind) == 2) { const unsigned _vb = (unsigned)WS_VT + (unsigned)((hh) * 512 * T + (nk) * 128 + 32 * (ks)) * 2u; _Pragma("unroll") for (int _i = 0; _i < 4; ++_i) \
            RET_GLDS(_vb, voff[_i], (b) * BUFB + OFF_B + (wid + 8 * _i) * 1024); } } while (0)
    int u = F.c;
    if (u >= 512) return;
    { const int h = u & 3, n = (u >> 2) ^ ((u >> 8) & 1); RET_LOADS(0, 0, 0, h, n, n); }
    for (; u < 512; u += F.G) {
        const int h = u & 3, n = (u >> 2) ^ ((u >> 8) & 1), t0 = n * 128; const int un = u + F.G; const bool has_next = un < 512; const int hn = un & 3, nn = (un >> 2) ^ ((un >> 8) & 1);
        const bool half = (n & 1) != 0;
        f32x4 pacc[4][2];
#pragma unroll
        for (int m = 0; m < 4; ++m)
#pragma unroll
            for (int q = 0; q < 2; ++q) pacc[m][q] = (f32x4){0.f, 0.f, 0.f, 0.f};
#pragma unroll
        for (int ks = 0; ks < 8; ++ks) {
            const int b = ks & 1;
            if (ks < 7) { RET_LOADS(0, ks + 1, b ^ 1, h, n, n); RET_WAITV(2); } else { RET_LOADS(1, 0, b ^ 1, h, n, n); RET_WAITV(5); }
            RET_BAR();
            bf16x8 af[4], bf[2];
#pragma unroll
            for (int m = 0; m < 4; ++m) af[m] = *(const LAS bf16x8*)(lds + b * BUFB + (4 * wr + m) * 1024 + foff);
#pragma unroll
            for (int q = 0; q < 2; ++q) bf[q] = *(const LAS bf16x8*)(lds + b * BUFB + OFF_B + (2 * wc + q) * 1024 + foff);
            RET_WAITL0(); RET_BAR();
#pragma unroll
            for (int m = 0; m < 4; ++m)
#pragma unroll
                for (int q = 0; q < 2; ++q) pacc[m][q] = __builtin_amdgcn_mfma_f32_16x16x32_bf16(bf[q], af[m], pacc[m][q], 0, 0, 0);
            __builtin_amdgcn_sched_barrier(0);
        }
        { int l2 = lane; asm volatile("" : "+v"(l2)); const int fr = l2 & 15, fq = l2 >> 4;
#pragma unroll
        for (int m = 0; m < 4; ++m)
#pragma unroll
            for (int q = 0; q < 2; ++q) { const int r = 64 * wr + 16 * m + fr, cc = 32 * wc + 16 * q + 4 * fq; float v[4];
#pragma unroll
                for (int j = 0; j < 4; ++j) { const int dd = r - (cc + j); v[j] = dd >= 0 ? pacc[m][q][j] * gps[h * GPS + dd] : 0.f; }
                u32x2 w; w.x = pk2(v[0], v[1]); w.y = pk2(v[2], v[3]);
                *(LAS u32x2*)(lds + OFF_P + wc * 8192 + (4 * wr + m) * 1024 + swz(fr * 64 + 32 * q + 8 * fq)) = w; } }
        f32x4 acc[4][8];
#pragma unroll
        for (int m = 0; m < 4; ++m)
#pragma unroll
            for (int q = 0; q < 8; ++q) acc[m][q] = (f32x4){0.f, 0.f, 0.f, 0.f};
#pragma unroll
        for (int ks = 0; ks < 8; ++ks) {
            const int b = ks & 1;
            if (ks < 7) { RET_LOADS(1, ks + 1, b ^ 1, h, n, n); RET_WAITV(5); } else { RET_LOADS(2, 0, b ^ 1, h, n, n); RET_WAITV(4); }
            RET_BAR();
            bf16x8 af[4], bf[8];
#pragma unroll
            for (int m = 0; m < 4; ++m) af[m] = *(const LAS bf16x8*)(lds + b * BUFB + (4 * wr + m) * 1024 + foff);
#pragma unroll
            for (int q = 0; q < 8; ++q) bf[q] = *(const LAS bf16x8*)(lds + b * BUFB + OFF_B + (8 * wc + q) * 1024 + foff);
            RET_WAITL0(); RET_BAR();
#pragma unroll
            for (int m = 0; m < 4; ++m)
#pragma unroll
                for (int q = 0; q < 8; ++q) acc[m][q] = __builtin_amdgcn_mfma_f32_16x16x32_bf16(bf[q], af[m], acc[m][q], 0, 0, 0);
            __builtin_amdgcn_sched_barrier(0);
        }
        { int l3 = lane; asm volatile("" : "+v"(l3)); const int fr = l3 & 15;
#pragma unroll
        for (int m = 0; m < 4; ++m) { const float qd = gps[h * GPS + 64 * wr + 16 * m + fr + 1] * (half ? gps[h * GPS + 128] : 1.0f);
#pragma unroll
            for (int q = 0; q < 8; ++q) acc[m][q] = acc[m][q] * qd; } }
#pragma unroll
        for (int ks = 0; ks < 4; ++ks) {
            const int b = ks & 1;
            if (ks < 3) { RET_LOADS(2, ks + 1, b ^ 1, h, n, n); RET_WAITV(4); }
            else if (half) { RET_LOADS(0, 0, b ^ 1, h, n, n - 1); RET_WAITV(2); }
            else if (has_next) { RET_LOADS(0, 0, b ^ 1, hn, nn, nn); RET_WAITV(2); }
            else { RET_WAITV(0); }
            RET_BAR();
            bf16x8 af[4], bf[8];
#pragma unroll
            for (int m = 0; m < 4; ++m) af[m] = *(const LAS bf16x8*)(lds + OFF_P + ks * 8192 + (4 * wr + m) * 1024 + foff);
#pragma unroll
            for (int q = 0; q < 8; ++q) bf[q] = *(const LAS bf16x8*)(lds + b * BUFB + OFF_B + (8 * wc + q) * 1024 + foff);
            RET_WAITL0(); RET_BAR();
#pragma unroll
            for (int m = 0; m < 4; ++m)
#pragma unroll
                for (int q = 0; q < 8; ++q) acc[m][q] = __builtin_amdgcn_mfma_f32_16x16x32_bf16(bf[q], af[m], acc[m][q], 0, 0, 0);
            __builtin_amdgcn_sched_barrier(0);
        }
        if (half) {
#pragma unroll
            for (int m = 0; m < 4; ++m)
#pragma unroll
                for (int q = 0; q < 2; ++q) pacc[m][q] = (f32x4){0.f, 0.f, 0.f, 0.f};
#pragma unroll
            for (int ks = 0; ks < 8; ++ks) {
                const int b = ks & 1;
                if (ks < 7) { RET_LOADS(0, ks + 1, b ^ 1, h, n, n - 1); RET_WAITV(2); } else { RET_LOADS(2, 0, b ^ 1, h, n, n - 1); RET_WAITV(4); }
                RET_BAR();
                bf16x8 af[4], bf[2];
#pragma unroll
                for (int m = 0; m < 4; ++m) af[m] = *(const LAS bf16x8*)(lds + b * BUFB + (4 * wr + m) * 1024 + foff);
#pragma unroll
                for (int q = 0; q < 2; ++q) bf[q] = *(const LAS bf16x8*)(lds + b * BUFB + OFF_B + (2 * wc + q) * 1024 + foff);
                RET_WAITL0(); RET_BAR();
#pragma unroll
                for (int m = 0; m < 4; ++m)
#pragma unroll
                    for (int q = 0; q < 2; ++q) pacc[m][q] = __builtin_amdgcn_mfma_f32_16x16x32_bf16(bf[q], af[m], pacc[m][q], 0, 0, 0);
                __builtin_amdgcn_sched_barrier(0);
            }
            { int l6 = lane; asm volatile("" : "+v"(l6)); const int fr = l6 & 15, fq = l6 >> 4;
#pragma unroll
            for (int m = 0; m < 4; ++m)
#pragma unroll
                for (int q = 0; q < 2; ++q) { const int r = 64 * wr + 16 * m + fr, cc = 32 * wc + 16 * q + 4 * fq; float v[4];
#pragma unroll
                    for (int j = 0; j < 4; ++j) v[j] = pacc[m][q][j] * gps[h * GPS + 128 + r - (cc + j)];
                    u32x2 w; w.x = pk2(v[0], v[1]); w.y = pk2(v[2], v[3]);
                    *(LAS u32x2*)(lds + OFF_P + wc * 8192 + (4 * wr + m) * 1024 + swz(fr * 64 + 32 * q + 8 * fq)) = w; } }
            RET_WAITL0();
#pragma unroll
            for (int ks = 0; ks < 4; ++ks) {
                const int b = ks & 1;
                if (ks < 3) { RET_LOADS(2, ks + 1, b ^ 1, h, n, n - 1); RET_WAITV(4); }
                else if (has_next) { RET_LOADS(0, 0, b ^ 1, hn, nn, nn); RET_WAITV(2); }
                else { RET_WAITV(0); }
                RET_BAR();
                bf16x8 af[4], bf[8];
    #pragma unroll
                for (int m = 0; m < 4; ++m) af[m] = *(const LAS bf16x8*)(lds + OFF_P + ks * 8192 + (4 * wr + m) * 1024 + foff);
    #pragma unroll
                for (int q = 0; q < 8; ++q) bf[q] = *(const LAS bf16x8*)(lds + b * BUFB + OFF_B + (8 * wc + q) * 1024 + foff);
                RET_WAITL0(); RET_BAR();
    #pragma unroll
                for (int m = 0; m < 4; ++m)
    #pragma unroll
                    for (int q = 0; q < 8; ++q) acc[m][q] = __builtin_amdgcn_mfma_f32_16x16x32_bf16(bf[q], af[m], acc[m][q], 0, 0, 0);
                __builtin_amdgcn_sched_barrier(0);
            }
        }
        { int l4 = lane; asm volatile("" : "+v"(l4)); const int fr = l4 & 15, fq = l4 >> 4;
#pragma unroll
        for (int m = 0; m < 4; ++m) { float s1 = 0.f, s2 = 0.f;
#pragma unroll
            for (int q = 0; q < 8; ++q) { const f32x4 v = acc[m][q]; s1 += (v.x + v.y) + (v.z + v.w); s2 += (v.x * v.x + v.y * v.y) + (v.z * v.z + v.w * v.w); }
            s1 += __shfl_xor(s1, 16); s1 += __shfl_xor(s1, 32); s2 += __shfl_xor(s2, 16); s2 += __shfl_xor(s2, 32);
            if (fq == 0) red[(64 * wr + 16 * m + fr) * 4 + wc] = (f32x2){s1, s2}; }
        RET_WAITL0(); RET_BAR();
#pragma unroll
        for (int m = 0; m < 4; ++m) { const int r = 64 * wr + 16 * m + fr; const f32x2 a = red[r * 4 + 0], b2 = red[r * 4 + 1], c2 = red[r * 4 + 2], d2 = red[r * 4 + 3];
            const float mu = ((a.x + b2.x) + (c2.x + d2.x)) * (1.0f / 512.0f), ex2 = ((a.y + b2.y) + (c2.y + d2.y)) * (1.0f / 512.0f);
            const float rs = 1.0f / sqrtf(ex2 - mu * mu + EPS); const size_t rowoff = (size_t)(t0 + r) * 2048 + h * 512 + 128 * wc + 4 * fq;
#pragma unroll
            for (int q = 0; q < 8; ++q) { const u32x2 gw = *(const u32x2*)(F.Gb() + rowoff + 16 * q); const f32x4 gn = *(const f32x4*)(p.ret_gn_gain + h * 512 + 128 * wc + 16 * q + 4 * fq);
                const f32x4 v = acc[m][q]; u32x2 w;
                w.x = pk2((v.x - mu) * rs * gn.x * bflo(gw.x), (v.y - mu) * rs * gn.y * bfhi(gw.x)); w.y = pk2((v.z - mu) * rs * gn.z * bflo(gw.y), (v.w - mu) * rs * gn.w * bfhi(gw.y));
                *(u32x2*)(F.Y() + rowoff + 16 * q) = w; }
             } }
        RET_BAR();
    }
    RET_WAITV(0); RET_BAR();
#undef RET_GLDS
#undef RET_LOADS
}

namespace pf { constexpr int XTP = 132, OFF_RS = 42496, OFF_PT = 43008, OFF_WB = 59392, OFF_END = 124928; }
template <int W>
__device__ __forceinline__ void pf_pool(LAS unsigned char* lds, int t0, int tid) {
    using namespace pf; const LAS float* XT = (const LAS float*)lds; const LAS float* RS = (const LAS float*)(lds + OFF_RS);
    const int cp = tid & 63, tb = tid >> 6, r0 = 8 * tb, ch = 2 * cp; float s0 = 0.f, s1 = 0.f;
#pragma unroll
    for (int i = 1; i < W; ++i) { const int rr = 16 + r0 - i; const f32x2 xv = *(const LAS f32x2*)(XT + rr * XTP + ch); const float rs = RS[rr]; s0 += xv.x * rs; s1 += xv.y * rs; }
#pragma unroll
    for (int j = 0; j < 8; ++j) { const int r = r0 + j, rr = 16 + r; const f32x2 xv = *(const LAS f32x2*)(XT + rr * XTP + ch); const float rs = RS[rr]; const float a0 = xv.x * rs, a1 = xv.y * rs;
        s0 += a0; s1 += a1; const int t = t0 + r; const float ic = 1.0f / (float)((t + 1) < W ? (t + 1) : W);
        *(LAS unsigned*)(lds + OFF_PT + (ch >> 5) * 4096 + (r >> 4) * 1024 + ret::swz((r & 15) * 64 + (ch & 31) * 2)) = pk2(s0 * ic - a0, s1 * ic - a1);
        const int ro = rr - W + 1; const f32x2 xo = *(const LAS f32x2*)(XT + ro * XTP + ch); const float rso = RS[ro]; s0 -= xo.x * rso; s1 -= xo.y * rso; }
}
__device__ __forceinline__ void phase_pool_fused(Frame& F) {
    using namespace pf;
    const Params& p = F.p; LAS unsigned char* lds = F.lds; const int tid = F.tid, lane = F.lane, wid = F.wave;
    const float* X2 = F.X2(); const float* rss = F.ROWSS(); const float* g1 = F.MOD() + NIN + 2 * 1024; const float* WRg = F.WR();
    LAS float* XT = (LAS float*)lds; LAS float* RS = (LAS float*)(lds + OFF_RS);
    const int foff = ret::swz((lane & 15) * 64 + (lane >> 4) * 16);
    const int srow = lane >> 2, scol = ((lane & 3) * 8) ^ (((lane >> 5) & 1) * 16);
    const __amdgpu_buffer_rsrc_t rs_ws = __builtin_amdgcn_make_buffer_rsrc((void*)F.ws, (short)0, 0x7fffffff, 0x00020000);
    unsigned loff[2];
#pragma unroll
    for (int i = 0; i < 2; ++i) loff[i] = (unsigned)((16 * (wid + 8 * i) + srow) * 256 + scol) * 2u;
    for (int seg = F.c; seg < 256; seg += F.G) {
        const int t0 = seg * 64;
        float ss[4], lg[4][8];
#pragma unroll
        for (int m = 0; m < 4; ++m) { ss[m] = 0.f;
#pragma unroll
            for (int e = 0; e < 8; ++e) lg[m][e] = 0.f; }
        __syncthreads();
        if (tid < 80) { const int tt = t0 - 16 + tid; RS[tid] = tt >= 0 ? rstd_row(rss, tt) : 0.f; }
        f32x4 acc[4][2]; f32x4 xv[5];
#define PF_LOADX(gg, kk) do { int _tl = tid; asm volatile("" : "+v"(_tl)); _Pragma("unroll") for (int _i = 0; _i < 5; ++_i) { const int _idx = _tl + 512 * _i, _rr = _idx >> 5, _c4 = (_idx & 31) * 4; const int _tt = t0 - 16 + _rr; \
            xv[_i] = *(const f32x4*)(X2 + (size_t)(_tt < 0 ? 0 : _tt) * 1024 + 256 * (gg) + 128 * (kk) + _c4); } } while (0)
        PF_LOADX(0, 0);
#pragma unroll 1
        for (int it = 0; it < 8; ++it) {
            const int g = it >> 1, kh = it & 1;
            if (kh == 0) {
#pragma unroll
                for (int m = 0; m < 4; ++m) { acc[m][0] = (f32x4){0.f, 0.f, 0.f, 0.f}; acc[m][1] = (f32x4){0.f, 0.f, 0.f, 0.f}; } }
            {
                __syncthreads();
                int tl = tid; asm volatile("" : "+v"(tl));
#pragma unroll
                for (int i = 0; i < 5; ++i) { const int idx = tl + 512 * i, rr = idx >> 5, c4 = (idx & 31) * 4; *(LAS f32x4*)(XT + rr * XTP + c4) = xv[i]; }
#pragma unroll
                for (int kc = 0; kc < 4; ++kc)
#pragma unroll
                    for (int i = 0; i < 2; ++i)
                        __builtin_amdgcn_raw_ptr_buffer_load_lds(rs_ws, (LAS unsigned*)(lds + OFF_WB + kc * 16384 + (wid + 8 * i) * 1024), 16, (int)loff[i], (int)((unsigned)WS_WP + (unsigned)(g * 65536 + kh * 128 + 32 * kc) * 2u), 0, 0);
                { const int itn = it < 7 ? it + 1 : 7; PF_LOADX(itn >> 1, itn & 1); }
                __syncthreads();
                if (g == 0) pf_pool<2>(lds, t0, tl); else if (g == 1) pf_pool<4>(lds, t0, tl); else if (g == 2) pf_pool<8>(lds, t0, tl); else pf_pool<16>(lds, t0, tl);
                asm volatile("s_waitcnt vmcnt(5)" ::: "memory");
                __syncthreads();
#pragma unroll
                for (int kc = 0; kc < 4; ++kc) { bf16x8 af[4], bf[2];
#pragma unroll
                    for (int m = 0; m < 4; ++m) af[m] = *(const LAS bf16x8*)(lds + OFF_PT + kc * 4096 + m * 1024 + foff);
#pragma unroll
                    for (int n = 0; n < 2; ++n) bf[n] = *(const LAS bf16x8*)(lds + OFF_WB + kc * 16384 + (2 * wid + n) * 1024 + foff);
#pragma unroll
                    for (int m = 0; m < 4; ++m)
#pragma unroll
                        for (int n = 0; n < 2; ++n) acc[m][n] = __builtin_amdgcn_mfma_f32_16x16x32_bf16(bf[n], af[m], acc[m][n], 0, 0, 0); }
            }
            if (kh == 0) continue;
            { int l5 = lane; asm volatile("" : "+v"(l5)); const int fr = l5 & 15, fq = l5 >> 4;
              f32x4 x2a[2][4];
#pragma unroll
              for (int n = 0; n < 2; ++n)
#pragma unroll
                for (int m = 0; m < 4; ++m) x2a[n][m] = *(const f32x4*)(X2 + (size_t)(t0 + 16 * m + fr) * 1024 + 256 * g + 32 * wid + 16 * n + 4 * fq);
              f32x4 bva[2], sva[2], gva[2], wra[2][4], wrb[2][4];
#pragma unroll
              for (int n = 0; n < 2; ++n) { const int cg = 256 * g + 32 * wid + 16 * n + 4 * fq;
                bva[n] = *(const f32x4*)(p.pool_b + cg); sva[n] = *(const f32x4*)(p.pool_scale + cg); gva[n].x = ldv_f(g1 + cg); gva[n].y = ldv_f(g1 + cg + 1); gva[n].z = ldv_f(g1 + cg + 2); gva[n].w = ldv_f(g1 + cg + 3);
#pragma unroll
                for (int j = 0; j < 4; ++j) { wra[n][j] = *(const f32x4*)(WRg + (cg + j) * 8); wrb[n][j] = *(const f32x4*)(WRg + (cg + j) * 8 + 4); } }
#pragma unroll
              for (int n = 0; n < 2; ++n) { const int cg = 256 * g + 32 * wid + 16 * n + 4 * fq;
                const f32x4 bv = bva[n], sv = sva[n], gv = gva[n];
                f32x4 wr0[4], wr1[4];
#pragma unroll
                for (int j = 0; j < 4; ++j) { wr0[j] = wra[n][j]; wr1[j] = wrb[n][j]; }
#pragma unroll
                for (int m = 0; m < 4; ++m) { const size_t o = (size_t)(t0 + 16 * m + fr) * 1024 + cg;
                    const f32x4 xo = x2a[n][m] + gv * ((acc[m][n] + bv) * sv);
                    *(f32x4*)(p.out + o) = xo; *(unsigned*)((unsigned char*)F.XB() + o) = pk4f8(xo.x, xo.y, xo.z, xo.w);
                    ss[m] += (xo.x * xo.x + xo.y * xo.y) + (xo.z * xo.z + xo.w * xo.w);
                    lg[m][0] += xo.x * wr0[0].x + xo.y * wr0[1].x + xo.z * wr0[2].x + xo.w * wr0[3].x; lg[m][1] += xo.x * wr0[0].y + xo.y * wr0[1].y + xo.z * wr0[2].y + xo.w * wr0[3].y;
                    lg[m][2] += xo.x * wr0[0].z + xo.y * wr0[1].z + xo.z * wr0[2].z + xo.w * wr0[3].z; lg[m][3] += xo.x * wr0[0].w + xo.y * wr0[1].w + xo.z * wr0[2].w + xo.w * wr0[3].w;
                    lg[m][4] += xo.x * wr1[0].x + xo.y * wr1[1].x + xo.z * wr1[2].x + xo.w * wr1[3].x; lg[m][5] += xo.x * wr1[0].y + xo.y * wr1[1].y + xo.z * wr1[2].y + xo.w * wr1[3].y;
                    lg[m][6] += xo.x * wr1[0].z + xo.y * wr1[1].z + xo.z * wr1[2].z + xo.w * wr1[3].z; lg[m][7] += xo.x * wr1[0].w + xo.y * wr1[1].w + xo.z * wr1[2].w + xo.w * wr1[3].w; } } }
        }
#undef PF_LOADX
#pragma unroll
        for (int m = 0; m < 4; ++m) { ss[m] += __shfl_xor(ss[m], 16); ss[m] += __shfl_xor(ss[m], 32);
#pragma unroll
            for (int e = 0; e < 8; ++e) { lg[m][e] += __shfl_xor(lg[m][e], 16); lg[m][e] += __shfl_xor(lg[m][e], 32); } }
        __syncthreads();
        { LAS float* red = (LAS float*)lds; int l6 = lane; asm volatile("" : "+v"(l6)); const int fr = l6 & 15;
          if ((l6 >> 4) == 0) {
#pragma unroll
            for (int m = 0; m < 4; ++m) { LAS float* q = red + ((16 * m + fr) * 8 + wid) * 12; q[0] = ss[m];
#pragma unroll
                for (int e = 0; e < 8; ++e) q[1 + e] = lg[m][e]; } }
          LAS int* cnt = (LAS int*)(lds + OFF_RS);
          if (tid < 8) cnt[tid] = 0;
          __syncthreads();
          if (tid < 64) { float sq = 0.f, a[8];
#pragma unroll
            for (int e = 0; e < 8; ++e) a[e] = 0.f;
#pragma unroll
            for (int w = 0; w < 8; ++w) { const LAS float* q = red + (tid * 8 + w) * 12; sq += q[0];
#pragma unroll
                for (int e = 0; e < 8; ++e) a[e] += q[1 + e]; }
            const int t = t0 + tid; const float rs = rstd_of(sq); float lgt[8]; F.RSTD3()[t] = rs;
#pragma unroll
            for (int e = 0; e < 8; ++e) lgt[e] = rs * a[e] + ldv_f(F.BIAS_R() + e);
            int e0 = 0; float l0 = lgt[0];
#pragma unroll
            for (int e = 1; e < 8; ++e) if (lgt[e] > l0) { l0 = lgt[e]; e0 = e; }
            int e1 = -1; float l1 = -3.0e38f;
#pragma unroll
            for (int e = 0; e < 8; ++e) if (e != e0 && lgt[e] > l1) { l1 = lgt[e]; e1 = e; }
            const float g0 = 1.0f / (1.0f + __expf(l1 - l0));
            F.TOPE()[t * 2] = e0; F.TOPE()[t * 2 + 1] = e1; F.TOPG()[t * 2] = g0; F.TOPG()[t * 2 + 1] = 1.0f - g0;
            atomicAdd((int*)(cnt + e0), 1); atomicAdd((int*)(cnt + e1), 1); }
          __syncthreads();
          if (tid < 8) F.CNT()[seg * 8 + tid] = cnt[tid]; }
    }
    __syncthreads();
}

__device__ __forceinline__ void phase_route2(Frame& F) {
    const int tid = F.tid;
    LAS int* cn = (LAS int*)F.lds;
    LAS int* part = cn + 2048;
    LAS int* tot = part + 512;
    LAS int* te = tot + 32;
    __syncthreads();
    for (int i = tid; i < 2048; i += NTHR) cn[i] = ldv_i(F.CNT() + i);
    __syncthreads();
    { const int e = tid & 7, pq = tid >> 3; part[pq * 8 + e] = cn[(4 * pq) * 8 + e] + cn[(4 * pq + 1) * 8 + e] + cn[(4 * pq + 2) * 8 + e] + cn[(4 * pq + 3) * 8 + e]; }
    __syncthreads();
    if (tid < 8) { int run = 0; for (int q = 0; q < 64; ++q) { const int v = part[q * 8 + tid]; part[q * 8 + tid] = run; run += v; } tot[tid] = run; }
    __syncthreads();
    { const int e = tid & 7, pq = tid >> 3; int run = part[pq * 8 + e];
#pragma unroll
        for (int j = 0; j < 4; ++j) { const int v = cn[(4 * pq + j) * 8 + e]; cn[(4 * pq + j) * 8 + e] = run; run += v; } }
    if (tid == 0) { int sp = 0; for (int e = 0; e < 8; ++e) { const int pd = (tot[e] + 255) / 256 * 256; tot[8 + e] = sp; tot[16 + e] = pd; sp += pd; } tot[24] = sp / 256; }
    __syncthreads();
    for (int seg = F.c; seg < 256; seg += F.G) {
        int e = -1; if (tid < 128) e = ldv_i(F.TOPE() + seg * 128 + tid);
        int rank = 0;
#pragma unroll
        for (int ee = 0; ee < 8; ++ee) { const unsigned long long m = __ballot(e == ee); if (e == ee) rank = __popcll(m & ((1ull << F.lane) - 1ull)); if (tid == 0) te[ee] = __popcll(m); }
        __syncthreads();
        if (tid < 128) { if (tid >= 64) rank += te[e];
            const int pos = tot[8 + e] + cn[seg * 8 + e] + rank, idx = seg * 128 + tid;
            const float gt = ldv_f(F.TOPG() + idx), rsd = ldv_f(F.RSTD3() + (idx >> 1));
            F.BUFTOK()[pos] = idx >> 1; F.BUFGATE()[pos] = gt; F.BUFRS()[pos] = rsd * (1.0f / F8_WSCALE); F.POS()[idx] = pos; }
        __syncthreads();
    }
    if (F.c < 8) { const int e = F.c; const int b0 = tot[8 + e] + tot[e], b1 = tot[8 + e] + tot[16 + e]; for (int r = b0 + tid; r < b1; r += NTHR) { F.BUFTOK()[r] = 0; F.BUFGATE()[r] = 0.f; F.BUFRS()[r] = 0.f; } }
    if (F.c == (8 % F.G)) { if (tid < NBLK) { int e = 0; for (int q = 0; q < 8; ++q) if (tid * 256 >= tot[8 + q] + tot[16 + q]) ++e; F.BLKE()[tid] = e < 7 ? e : 7; } if (tid == NBLK) F.BLKE()[NBLK] = tot[24]; }
}

__device__ __forceinline__ void phase_final(Frame& F) {
    const Params& p = F.p; const int gw = F.c * NWAVE + F.wave, NGW = F.G * NWAVE, lane = F.lane; const float* g2 = F.MOD() + NIN + 5 * 1024;
    const int nused = ldv_i(F.BLKE() + NBLK); const int ntail = (F.G == 256) ? (nused - 128) * 4 : 0; const int spu = ntail > 0 ? moe_tail_spu(ntail) : 1;
    f32x4 gv[4], fg[4];
#pragma unroll
    for (int j = 0; j < 4; ++j) { gv[j] = *((const f32x4*)g2 + lane + 64 * j); fg[j] = *((const f32x4*)p.final_norm_gain + lane + 64 * j); }
    for (int row = 2 * gw; row < T; row += 2 * NGW) {
        f32x4 xv[2][4]; f32x4 fa[2][4];
#pragma unroll
        for (int r = 0; r < 2; ++r) {
            const f32x4* xr = (const f32x4*)(p.out + (size_t)(row + r) * D) + lane;
#pragma unroll
            for (int j = 0; j < 4; ++j) { xv[r][j] = xr[64 * j]; fa[r][j] = (f32x4){0.f, 0.f, 0.f, 0.f}; }
#pragma unroll
            for (int a = 0; a < 2; ++a) { const int pos = ldv_i(F.POS() + (row + r) * 2 + a); const int blk = pos >> 8;
                if (ntail > 0 && blk >= 128) {
#pragma unroll
                    for (int j = 0; j < 4; ++j) { const float* sl = F.YBB() + (size_t)(((blk - 128) * 4 + j) * spu) * 65536 + (size_t)(pos & 255) * 256 + 4 * lane;
                        for (int q = 0; q < spu; ++q) fa[r][j] = fa[r][j] + *(const f32x4*)(sl + (size_t)q * 65536); }
                } else { const u32x2* y = (const u32x2*)(F.YB() + (size_t)pos * D) + lane;
#pragma unroll
                    for (int j = 0; j < 4; ++j) { const u32x2 w = y[64 * j]; fa[r][j] = fa[r][j] + (f32x4){bflo(w.x), bfhi(w.x), bflo(w.y), bfhi(w.y)}; } } } }
#pragma unroll
        for (int r = 0; r < 2; ++r) { f32x4 v[4]; float s = 0.f;
#pragma unroll
            for (int j = 0; j < 4; ++j) { v[j] = xv[r][j] + gv[j] * fa[r][j]; s += (v[j].x * v[j].x + v[j].y * v[j].y) + (v[j].z * v[j].z + v[j].w * v[j].w); }
            s = wave_sum(s); const float rs = rstd_of(s);
            f32x4* o = (f32x4*)(p.out + (size_t)(row + r) * D) + lane;
#pragma unroll
            for (int j = 0; j < 4; ++j) o[64 * j] = v[j] * rs * fg[j]; }
    }
}

template <class Desc, class Epi> __device__ __forceinline__ void run_gemm(Frame& F, const Desc& Dc, const Epi& E) {
    gemm_fast(F.lds, F.ws, Dc, E, F.c, F.G, F.wave);
}

__device__ __forceinline__ void phase_g1(Frame& F) {
    { DescG1a<false> d{F.XB(), F.WIN(), nullptr, 1024, 1024, 16, 128, 128}; EpiG1a<false> e{F.ROWSS(), F.BIAS_IN(), F.TABA(), F.TABB(), F.Q(), F.KN(), F.Gb(), F.GP(), F.KDT()}; run_gemm(F, d, e); }
    { DescG1a<true> d{F.XB(), F.WIN(), nullptr, 1024, 1024, 16, 128, 128}; EpiG1a<true> e{F.ROWSS(), F.BIAS_IN(), F.TABA(), F.TABB(), F.Q(), F.KN(), F.Gb(), F.GP(), F.KDT()}; run_gemm(F, d, e); }
    { DescG1b d{F.XB(), F.WIN(), nullptr, 1024, 1024, 16, 128, 128}; EpiG1b e{F.ROWSS(), F.BIAS_IN(), F.TABA(), F.TABB(), F.GP(), F.KDT(), F.VT()}; run_gemm(F, d, e); }
}
__device__ __forceinline__ void phase_kv(Frame& F) { DescKV d{F.VT(), F.KDT(), nullptr, T, T, 4, 128, 128}; EpiKV e{F.SB()}; run_gemm(F, d, e); }
__device__ __forceinline__ void phase_outproj(Frame& F) {
    DescOut d{F.Y(), F.WOUT(), nullptr, 2048, 2048, 32, 128, 128}; EpiResid e{F.p.x, F.p.out, F.XB(), F.ROWSS(), F.MOD() + 2 * 1024, nullptr, nullptr, 1.0f}; run_gemm(F, d, e); }
__device__ __forceinline__ void phase_ffn_up(Frame& F) {
    DescFfnUp d{F.XB(), F.WGU(), nullptr, 1024, 1024, 16, 128, 128}; EpiSwiglu<true, true> e{F.ROWSS(), nullptr, F.BIAS_GU(), F.H1(), DFF, 5632, 2 * 5632}; run_gemm(F, d, e);
    if (F.G == 256 && F.c >= 128) {
        frame_fresh(F); px_tables(F); px_gu_item(F, (F.c - 128) * NWAVE + F.wave, F.lane); __syncthreads(); } }
__device__ __forceinline__ void phase_ffn_down(Frame& F) {
    DescFfnDown d{F.H1(), F.WD(), nullptr, 64, 64, 22, 32768, 32768};     EpiResid e{F.p.out, F.X2(), nullptr, F.ROWSS(), F.MOD() + 5 * 1024, nullptr, nullptr, 1.0f / (F8_DSCALE * F8_HSCALE)}; run_gemm(F, d, e); }
__device__ __forceinline__ void phase_moe_up(Frame& F) {
    DescMoeUp d{F.XB(), F.WMGU(), F.BUFTOK(), 512, 512, 8, 128, 128, F.BLKE()}; EpiSwiglu<true, true> e{F.ROWSS(), F.BUFRS(), F.BIAS_MGU(), F.H1M(), DFE, 57344, 262144}; run_gemm(F, d, e); }
__device__ __forceinline__ void phase_moe_down(Frame& F) {
    DescMoeDown d{F.H1M(), F.WMD(), nullptr, 64, 64, 28, 32768, 32768, F.BLKE(), F.G}; EpiMoeDown e{F.BUFGATE(), F.YB(), F.YBB()}; run_gemm(F, d, e); }

#define XB_TMO      128
#define XB_XCNT(j)  (256  + 64 * (j))
#define XB_XSUB(j)  (1280 + 64 * (j))
#define XB_XGEN(j)  (2304 + 64 * (j))
#define XB_TOP      3328
#define XB_TOPGEN   3392
#define XCD_BAR_WORDS 3456
#define XB_SPIN_CAP (1u << 18)
__device__ __forceinline__ unsigned xb_ld(unsigned* p)              { return __hip_atomic_load(p, __ATOMIC_RELAXED, __HIP_MEMORY_SCOPE_AGENT); }
__device__ __forceinline__ unsigned xb_add(unsigned* p, unsigned v) { return __hip_atomic_fetch_add(p, v, __ATOMIC_RELAXED, __HIP_MEMORY_SCOPE_AGENT); }
__device__ __forceinline__ unsigned xb_xcc_id() { return (unsigned)__builtin_amdgcn_s_getreg((3 << 11) | 20) & 0xFu; }
#define XB_SPIN(cond, bar) do { unsigned _sp = 0; while (cond) { __builtin_amdgcn_s_sleep(1); \
    if ((++_sp & 255u) == 0u) { if (xb_ld(&(bar)[XB_TMO])) break; if (_sp > XB_SPIN_CAP) { atomicAdd(&(bar)[XB_TMO], 1u); break; } } } } while (0)
struct XcdBarrier { unsigned* bar; unsigned x; volatile LAS unsigned* st; int wave; };
__device__ __forceinline__ XcdBarrier xcd_barrier_post(unsigned* bar, volatile LAS unsigned* st, int wave) {
    XcdBarrier b; b.bar = bar; b.x = xb_xcc_id(); b.st = st; b.wave = wave;
    if (wave == 0 && lane_id() == 0) (void)xb_add(&bar[XB_XCNT(b.x)], 1u);
    return b;
}
__device__ __forceinline__ void xcd_barrier_complete(unsigned* bar, unsigned x, unsigned& nloc, unsigned& nx) {
    const unsigned G = gridDim.x * gridDim.y * gridDim.z;
    unsigned sum, cnt, mine, sp = 0u;
    for (;;) {
        sum = 0u; cnt = 0u; mine = 0u;
#pragma unroll
        for (unsigned j = 0; j < 16; ++j) { const unsigned c = xb_ld(&bar[XB_XCNT(j)]); sum += c; cnt += (c > 0u) ? 1u : 0u; mine = (j == x) ? c : mine; }
        if (sum == G) break;
        __builtin_amdgcn_s_sleep(1);
        if ((++sp & 255u) == 0u) { if (xb_ld(&bar[XB_TMO])) break; if (sp > XB_SPIN_CAP) { atomicAdd(&bar[XB_TMO], 1u); break; } }
    }
    nloc = mine > 0u ? mine : 1u; nx = cnt > 0u ? cnt : 1u;
}
__device__ __forceinline__ void xcd_barrier(const XcdBarrier& b) {
    asm volatile("s_waitcnt vmcnt(0)" ::: "memory");
    __syncthreads();
    if (b.wave == 0 && lane_id() == 0) {
        unsigned* bar = b.bar;
        __builtin_amdgcn_s_waitcnt(0);
        unsigned nloc = b.st[0], nx = b.st[1];
        if (nloc == 0u) { xcd_barrier_complete(bar, b.x, nloc, nx); b.st[0] = nloc; b.st[1] = nx; }
        const unsigned old = xb_add(&bar[XB_XSUB(b.x)], 1u);
        const unsigned gen = old / nloc;
        if (old + 1u == (gen + 1u) * nloc) {
            __builtin_amdgcn_fence(__ATOMIC_RELEASE, "agent");
            asm volatile("s_waitcnt vmcnt(0)" ::: "memory");
            const unsigned og = xb_add(&bar[XB_TOP], 1u);
            const unsigned tg = og / nx;
            if (og + 1u == (tg + 1u) * nx) xb_add(&bar[XB_TOPGEN], 1u);
            else XB_SPIN(xb_ld(&bar[XB_TOPGEN]) == tg, bar);
            __builtin_amdgcn_fence(__ATOMIC_ACQUIRE, "agent");
            xb_add(&bar[XB_XGEN(b.x)], 1u);
            asm volatile("s_waitcnt vmcnt(0)" ::: "memory");
        } else {
            XB_SPIN(xb_ld(&bar[XB_XGEN(b.x)]) == gen, bar);
            __builtin_amdgcn_fence(__ATOMIC_ACQUIRE, "agent");
            asm volatile("s_waitcnt vmcnt(0)" ::: "memory");
        }
    }
    __syncthreads();
}

constexpr int LDSCTL_OFF = 131072;
__global__ void __launch_bounds__(NTHR, 2) k_mega(Params p) {
    extern __shared__ __attribute__((aligned(16))) unsigned char lds_raw[];
    Frame F; frame_init(F, p, (LAS unsigned char*)lds_raw, (int)blockIdx.x, (int)gridDim.x);
    for (int u = F.tid; u < (LDS_BYTES - LDSCTL_OFF) / 4; u += NTHR) ((LAS unsigned*)(F.lds + LDSCTL_OFF))[u] = 0u;
    __syncthreads();
    const XcdBarrier bar = xcd_barrier_post((unsigned*)(p.ws + CT_BAR), (volatile LAS unsigned*)(F.lds + LDSCTL_OFF + 32), F.wave);
#define GRID_BAR() xcd_barrier(bar)

    frame_fresh(F); phase_p0(F); GRID_BAR();
    frame_fresh(F); phase_p1(F); GRID_BAR();
    frame_fresh(F); phase_g1(F); GRID_BAR();
    frame_fresh(F); phase_kv(F); GRID_BAR();
    frame_fresh(F); phase_scan(F); GRID_BAR();
    frame_fresh(F); phase_ret_fast(F); GRID_BAR();
    frame_fresh(F); phase_outproj(F); GRID_BAR();
    frame_fresh(F); phase_ffn_up(F); GRID_BAR();
    frame_fresh(F); phase_ffn_down(F); GRID_BAR();
    if ((F.c >> 3) & 1) { frame_fresh(F); phase_px(F); __syncthreads(); frame_fresh(F); phase_pool_fused(F); } else { frame_fresh(F); phase_pool_fused(F); frame_fresh(F); phase_px(F); }
    GRID_BAR();
    frame_fresh(F); phase_route2(F); GRID_BAR();
    frame_fresh(F); phase_moe_up(F); GRID_BAR();
    frame_fresh(F); phase_moe_down(F); GRID_BAR();
    frame_fresh(F); phase_final(F);
#undef GRID_BAR
}

extern "C" void kernel_launch(void* const* d_in, const int* in_sizes, int n_in, void* d_out, int out_size, void* d_ws, size_t ws_size, hipStream_t stream) {
    static int grid = 0;
    if (grid == 0) {
        if (n_in != 19 || out_size != T * D || ws_size < WS_END) { fprintf(stderr, "kernel_launch: unexpected shapes (n_in %d out %d ws %zu)\n", n_in, out_size, ws_size); grid = -1; return; }
        int dev = 0, cus = 0, per_cu = 0;
        if (hipGetDevice(&dev) != hipSuccess || hipDeviceGetAttribute(&cus, hipDeviceAttributeMultiprocessorCount, dev) != hipSuccess) { grid = -1; return; }
        if (hipFuncSetAttribute((const void*)k_mega, hipFuncAttributeMaxDynamicSharedMemorySize, LDS_BYTES) != hipSuccess) { fprintf(stderr, "kernel_launch: hipFuncSetAttribute failed\n"); grid = -1; return; }
        if (hipOccupancyMaxActiveBlocksPerMultiprocessor(&per_cu, (const void*)k_mega, NTHR, LDS_BYTES) != hipSuccess || per_cu < 1) { fprintf(stderr, "kernel_launch: occupancy query says %d blocks per CU\n", per_cu); (void)hipGetLastError(); grid = -1; return; }
        grid = cus * (per_cu < 1 ? 1 : 1);
    }
    if (grid < 0) return;
    Params p{};
    const float** pp = (const float**)&p;
    for (int i = 0; i < 19; ++i) pp[i] = (const float*)d_in[i];
    p.out = (float*)d_out; p.ws = (unsigned char*)d_ws;
    (void)hipMemsetAsync((char*)d_ws + WS_CTL, 0, 64 * KiB, stream);
    void* args[] = {&p};
    hipError_t e = hipLaunchCooperativeKernel((const void*)k_mega, dim3(grid), dim3(NTHR), args, LDS_BYTES, stream);
    if (e != hipSuccess) fprintf(stderr, "kernel_launch: cooperative launch failed: %s (grid %d)\n", hipGetErrorString(e), grid);
}
```

```cpp
#include <hip/hip_runtime.h>
#include <cstdio>

#define GAS __attribute__((address_space(1)))
#define LAS __attribute__((address_space(3)))
typedef unsigned short bf16_t;
typedef short bf16x8 __attribute__((ext_vector_type(8)));
typedef float f32x4 __attribute__((ext_vector_type(4)));
typedef float f32x2 __attribute__((ext_vector_type(2)));
typedef unsigned u32x4 __attribute__((ext_vector_type(4)));
typedef int i32x4 __attribute__((ext_vector_type(4)));
typedef unsigned u32x2 __attribute__((ext_vector_type(2)));

#ifndef FAST_GEMM
#define FAST_GEMM 1
#endif

constexpr int T = 16384, D = 1024, NH = 4, DK = 256, DV = 512, CH = 128, NCH = 128;
constexpr int NIN = 6144, DFF = 2816, NE = 8, DFE = 3584, CAP = 34816, NBLK = 136;
constexpr float EPS = 1e-6f;
constexpr int GPS = 260, RC = 256, NRC = 64;
constexpr int NTHR = 512, NWAVE = 8;

constexpr size_t KiB = 1024, MiB = 1u << 20;
constexpr size_t WS_CTL = 0, CTL_BYTES = 1 * MiB;
constexpr size_t CT_BAR = 16 * KiB;
constexpr size_t CT_MOD = 64 * KiB;
constexpr size_t CT_BIAS_R = 158 * KiB;
constexpr size_t WS_ROWSSP = 2 * MiB;
constexpr size_t WS_MODP = 3 * MiB;
constexpr size_t CT_BIAS_IN = 3584 * KiB;
constexpr size_t CT_BIAS_GU = 3584 * KiB + 96 * KiB;
constexpr size_t CT_BIAS_MGU = 36 * MiB + 512 * KiB;
constexpr size_t WS_TABA = 1 * MiB;
constexpr size_t WS_TABB = WS_TABA + 128 * KiB;
constexpr size_t WS_GP = WS_TABB + 128 * KiB;
constexpr size_t WS_WR = WS_GP + 8 * KiB;
constexpr size_t WS_TOPE = WS_WR + 32 * KiB;
constexpr size_t WS_TOPG = WS_TOPE + 128 * KiB;
constexpr size_t WS_CNT = WS_TOPG + 128 * KiB;
constexpr size_t WS_BUFTOK = WS_CNT + 8 * KiB;
constexpr size_t WS_BUFGATE = WS_BUFTOK + 136 * KiB;
constexpr size_t WS_POS = WS_BUFGATE + 136 * KiB;
constexpr size_t WS_BLKE = WS_POS + 128 * KiB;
constexpr size_t WS_RSTD3 = 256 * KiB;
constexpr size_t WS_BUFRS = 320 * KiB;
constexpr size_t WS_WIN = 4 * MiB;
constexpr size_t WS_WOUT = 16 * MiB;
constexpr size_t WS_WGU = 20 * MiB;
constexpr size_t WS_WD = 31 * MiB;
constexpr size_t WS_WP = 37 * MiB;
constexpr size_t WS_XB = 38 * MiB;
constexpr size_t WS_Q = 70 * MiB;
constexpr size_t WS_KN = 102 * MiB;
constexpr size_t WS_KDT = 134 * MiB;
constexpr size_t WS_VT = 166 * MiB;
constexpr size_t WS_G = 230 * MiB;
constexpr size_t WS_SB = 294 * MiB;
constexpr size_t WS_Y = 422 * MiB;
constexpr size_t WS_H1 = 70 * MiB;
constexpr size_t WS_PB = 158 * MiB;
constexpr size_t WS_X2 = 158 * MiB;
constexpr size_t WS_H1M = 70 * MiB;
constexpr size_t WS_WMGU = 308 * MiB;
constexpr size_t WS_WMD = 456 * MiB;
constexpr size_t WS_YB = 308 * MiB;
constexpr size_t WS_YBB = 4 * MiB;
constexpr size_t WS_END = 512 * MiB;
static_assert(WS_BUFRS + 136 * KiB <= WS_TABA && WS_BLKE + 4 * KiB <= WS_ROWSSP && WS_MODP + 8 * 12288 * 4 <= CT_BIAS_IN && CT_BIAS_GU + 4 * 5632 * 4 <= WS_WIN, "small region");
static_assert(WS_YBB + (size_t)224 * 65536 * 4 <= WS_H1M && WS_H1M + (size_t)CAP * DFE * 2 <= WS_WMGU && WS_YB + (size_t)CAP * D * 4 <= WS_WMD && WS_WMD + (size_t)NE * D * DFE * 2 <= WS_END, "moe map");
static_assert(WS_Y + (size_t)T * 2048 * 2 <= WS_END && WS_SB + (size_t)128 * 4 * 512 * 256 * 2 <= WS_Y, "ret map");

constexpr int LDS_BYTES = 147456;

struct Params {
    const float *x, *c, *ada_w, *ada_b, *norm_gain, *ret_w_in, *ret_gn_gain, *ret_w_out, *ffn_w_gate, *ffn_w_up, *ffn_w_down,
        *pool_w, *pool_b, *pool_scale, *moe_router, *moe_w_gate, *moe_w_up, *moe_w_down, *final_norm_gain;
    float* out; unsigned char* ws;
};

__device__ __forceinline__ unsigned f2bf(float f) { unsigned u = __builtin_bit_cast(unsigned, f); return (u + 0x7fffu + ((u >> 16) & 1u)) >> 16; }
typedef __bf16 bf16x2_t __attribute__((ext_vector_type(2)));
__device__ __forceinline__ unsigned pk2(float lo, float hi) { const f32x2 v = {lo, hi}; return __builtin_bit_cast(unsigned, __builtin_convertvector(v, bf16x2_t)); }
constexpr float F8_WSCALE = 32.0f, F8_DSCALE = 64.0f, F8_HSCALE = 4.0f;
__device__ __forceinline__ unsigned pk4f8(float a, float b, float c, float d) { int w = __builtin_amdgcn_cvt_pk_fp8_f32(a, b, 0, false); w = __builtin_amdgcn_cvt_pk_fp8_f32(c, d, w, true); return (unsigned)w; }
__device__ __forceinline__ float bf2f(unsigned b) { return __builtin_bit_cast(float, b << 16); }
__device__ __forceinline__ float bflo(unsigned w) { return __builtin_bit_cast(float, w << 16); }
__device__ __forceinline__ float bfhi(unsigned w) { return __builtin_bit_cast(float, w & 0xffff0000u); }
__device__ __forceinline__ float silu_f(float v) { return v * __builtin_amdgcn_rcpf(1.0f + __expf(-v)); }
__device__ __forceinline__ float rstd_of(float ss) { return __builtin_amdgcn_rsqf(ss * (1.0f / 1024.0f) + EPS); }
__device__ __forceinline__ float rstd_row(const float* rssp, int t) {
    const f32x4* q = (const f32x4*)(rssp + (size_t)t * 16); const f32x4 a = q[0], b = q[1], c = q[2], d = q[3];
    const float s = (((a.x + a.y) + (a.z + a.w)) + ((b.x + b.y) + (b.z + b.w))) + (((c.x + c.y) + (c.z + c.w)) + ((d.x + d.y) + (d.z + d.w)));
    return __builtin_amdgcn_rsqf(s * (1.0f / 1024.0f) + EPS);
}
__device__ __forceinline__ float wave_sum(float v) {
#pragma unroll
    for (int o = 1; o < 64; o <<= 1) v += __shfl_xor(v, o);
    return v;
}
__device__ __forceinline__ float ldv_f(const float* p) { return __builtin_bit_cast(float, __hip_atomic_load((const unsigned*)p, __ATOMIC_RELAXED, __HIP_MEMORY_SCOPE_AGENT)); }
__device__ __forceinline__ int ldv_i(const int* p) { return __hip_atomic_load(p, __ATOMIC_RELAXED, __HIP_MEMORY_SCOPE_AGENT); }
__device__ __forceinline__ float bias_sum(const float* b, int idx, int s1, int s2) { return (ldv_f(b + idx) + ldv_f(b + s1 + idx)) + (ldv_f(b + s2 + idx) + ldv_f(b + s2 + s1 + idx)); }
__device__ __forceinline__ void rstd_row_ld(const float* rssp, int t, float (&r)[16]) { const f32x4* q = (const f32x4*)(rssp + (size_t)t * 16);
#pragma unroll
    for (int i = 0; i < 4; ++i) { const f32x4 v = q[i]; r[4 * i] = v.x; r[4 * i + 1] = v.y; r[4 * i + 2] = v.z; r[4 * i + 3] = v.w; } }
__device__ __forceinline__ float rstd_row_fin(const float (&r)[16]) {
    const float s = (((r[0] + r[1]) + (r[2] + r[3])) + ((r[4] + r[5]) + (r[6] + r[7]))) + (((r[8] + r[9]) + (r[10] + r[11])) + ((r[12] + r[13]) + (r[14] + r[15])));
    return __builtin_amdgcn_rsqf(s * (1.0f / 1024.0f) + EPS); }
__device__ __forceinline__ void bias_sum_ld(const float* b, int idx, int s1, int s2, float (&r)[16]) { r[0] = ldv_f(b + idx); r[1] = ldv_f(b + s1 + idx); r[2] = ldv_f(b + s2 + idx); r[3] = ldv_f(b + s2 + s1 + idx); }
__device__ __forceinline__ float bias_sum_fin(const float (&r)[16]) { return (r[0] + r[1]) + (r[2] + r[3]); }

__device__ __forceinline__ int lane_id() { int l; asm volatile("v_mbcnt_lo_u32_b32 %0, -1, 0\n\tv_mbcnt_hi_u32_b32 %0, -1, %0" : "=v"(l)); return l; }

struct Unit { const bf16_t* A; const bf16_t* B; int pm, pn, aux, rowbase, nt; };

__device__ __forceinline__ void tile_order(int L, int nM, int nN, int& pm, int& pn) {
    const int nwg = nM * nN; int wgid = L;
    { const int q = nwg / 8, r = nwg % 8, xcd = wgid % 8, off = wgid / 8; wgid = (xcd < r ? xcd * (q + 1) : r * (q + 1) + (xcd - r) * q) + off; }
    const int nig = 8 * nN, gid = wgid / nig, fm = gid * 8, gsz = (nM - fm) < 8 ? (nM - fm) : 8;
    pm = fm + ((wgid % nig) % gsz); pn = (wgid % nig) / gsz;
}

template <bool GATE> struct DescG1a {
    static constexpr bool GATHER = false; static constexpr bool FP8 = false;
    const bf16_t* xb; const bf16_t* win; const int* tok; int lda, ldb, nt, ksa, ksb;
    __device__ __forceinline__ bool get(int L, Unit& u) const {
        if (L >= 64 * 8) return false; tile_order(L, 64, 8, u.pm, u.pn); if (GATE) u.pn += 8;
        const int wrow = u.pn < 8 ? u.pn * 256 : (u.pn + 8) * 256;
        u.A = xb + (size_t)u.pm * 256 * 1024; u.B = win + (size_t)wrow * 1024; u.aux = wrow; u.rowbase = u.pm * 256; u.nt = nt; return true; }
};
struct DescG1b {
    static constexpr bool GATHER = false; static constexpr bool FP8 = false;
    const bf16_t* xb; const bf16_t* win; const int* tok; int lda, ldb, nt, ksa, ksb;
    __device__ __forceinline__ bool get(int L, Unit& u) const {
        if (L >= 8 * 64) return false; tile_order(L, 8, 64, u.pm, u.pn); u.pm += 4;
        u.A = win + (size_t)(1024 + 256 * u.pm) * 1024; u.B = xb + (size_t)u.pn * 256 * 1024; u.aux = 0; u.rowbase = 0; u.nt = nt; return true; }
};
struct DescKV {
    static constexpr bool GATHER = false; static constexpr bool FP8 = false;
    const bf16_t* vt; const bf16_t* kdt; const int* tok; int lda, ldb, nt, ksa, ksb;
    __device__ __forceinline__ bool get(int L, Unit& u) const {
        if (L >= (NRC - 1) * 8) return false; const int mt = L & 1, h = (L >> 1) & 3, n = L >> 3;
        u.A = vt + (size_t)(h * 512 + 256 * mt) * T + n * RC; u.B = kdt + (size_t)(h * 256) * T + n * RC;
        u.pm = mt; u.pn = 0; u.aux = (n * 4 + h) * 2 + mt; u.rowbase = 0; u.nt = nt; return true; }
};
struct DescOut {
    static constexpr bool GATHER = false; static constexpr bool FP8 = false;
    const bf16_t* y; const bf16_t* w; const int* tok; int lda, ldb, nt, ksa, ksb;
    __device__ __forceinline__ bool get(int L, Unit& u) const {
        if (L >= 256) return false; tile_order(L, 64, 4, u.pm, u.pn);
        u.A = y + (size_t)u.pm * 256 * 2048; u.B = w + (size_t)u.pn * 256 * 2048; u.aux = 0; u.rowbase = u.pm * 256; u.nt = nt; return true; }
};
struct DescFfnUp {
    static constexpr bool GATHER = false; static constexpr bool FP8 = false;
    const bf16_t* xb; const bf16_t* w; const int* tok; int lda, ldb, nt, ksa, ksb;
    __device__ __forceinline__ bool get(int L, Unit& u) const {
        if (L >= 64 * 22) return false; tile_order(L, 64, 22, u.pm, u.pn);
        u.A = xb + (size_t)u.pm * 256 * 1024; u.B = w + (size_t)u.pn * 256 * 1024; u.aux = 256 * u.pn; u.rowbase = u.pm * 256; u.nt = nt; return true; }
};
struct DescFfnDown {
    static constexpr bool GATHER = false; static constexpr bool FP8 = true;
    const bf16_t* h1; const bf16_t* w; const int* tok; int lda, ldb, nt, ksa, ksb;
    __device__ __forceinline__ bool get(int L, Unit& u) const {
        if (L >= 256) return false; tile_order(L, 64, 4, u.pm, u.pn);
        u.A = h1 + (size_t)u.pm * 128 * DFF; u.B = w + (size_t)u.pn * 128 * DFF; u.aux = 0; u.rowbase = u.pm * 256; u.nt = nt; return true; }
};
struct DescMoeUp {
    static constexpr bool GATHER = true; static constexpr bool FP8 = true;
    const bf16_t* xb; const bf16_t* w; const int* tok; int lda, ldb, nt, ksa, ksb; const int* blke;
    __device__ __forceinline__ bool get(int L, Unit& u) const {
        const int nused = ldv_i(blke + NBLK); if (L >= nused * 28) return false; tile_order(L, nused, 28, u.pm, u.pn);
        const int e = ldv_i(blke + u.pm);
        u.A = xb; u.B = w + (size_t)(e * 7168 + 256 * u.pn) * 512; u.aux = e * 7168 + 256 * u.pn; u.rowbase = u.pm * 256; u.nt = nt; return true; }
};
__device__ __forceinline__ int moe_tail_spu(int ntail) { const int q = 256 / ntail; return q >= 14 ? 14 : 7; }
struct DescMoeDown {
    static constexpr bool GATHER = false; static constexpr bool FP8 = true;
    const bf16_t* h1; const bf16_t* w; const int* tok; int lda, ldb, nt, ksa, ksb; const int* blke; int G;
    __device__ __forceinline__ bool get(int L, Unit& u) const {
        const int nused = ldv_i(blke + NBLK); int k0 = 0, npair = 14; u.aux = 0;
        if (G != 256) { if (L >= nused * 4) return false; tile_order(L, nused, 4, u.pm, u.pn); }
        else { const int i = L >> 8, c = L & 255;
            if (i < 2) { const int x = c & 7, j = c >> 3; u.pm = (i * 8 + x) * 8 + (j & 7); u.pn = j >> 3; }
            else { const int ntail = (nused - 128) * 4; if (i > 2 || ntail <= 0) return false; const int spu = moe_tail_spu(ntail); if (c >= ntail * spu) return false;
                const int ut = c / spu, sl = c - ut * spu; u.pm = 128 + (ut >> 2); u.pn = ut & 3; npair = 14 / spu; k0 = sl * npair; u.aux = 1 + c; } }
        const int e = ldv_i(blke + u.pm);
        u.A = h1 + (size_t)u.pm * 128 * DFE + (size_t)k0 * 2 * 16384; u.B = w + (size_t)(e * 4 + u.pn) * 128 * DFE + (size_t)k0 * 2 * 16384;
        u.rowbase = u.pm * 256; u.nt = 2 * npair; return true; }
};

typedef f32x4 Acc[2][2][4][2];

__device__ __forceinline__ void store8bf(bf16_t* p, const float* v) {
    u32x4 w; w.x = pk2(v[0], v[1]); w.y = pk2(v[2], v[3]); w.z = pk2(v[4], v[5]); w.w = pk2(v[6], v[7]); *(u32x4*)p = w; }

template <bool GATE> struct EpiG1a {
    static constexpr bool PERM = true;
    const float* rowss; const float* bias; const f32x2* taba; const f32x2* tabb; bf16_t* Q; bf16_t* KN; bf16_t* Gb; const float* gp; bf16_t* KDT;
    __device__ __forceinline__ void pre_load(const Unit& u, int tid, float (&r)[16]) const { if (tid < 256) r[0] = ldv_f(rowss + (size_t)(u.pm * 256 + tid) * 16); else bias_sum_ld(bias, u.aux + tid - 256, NIN, 2 * NIN, r); }
    __device__ __forceinline__ void pre_store(const Unit&, LAS float* aux, int tid, const float (&r)[16]) const { aux[tid] = tid < 256 ? rstd_of(r[0]) : bias_sum_fin(r); }
    __device__ __forceinline__ void init(LAS float* auxb, int tid) const {
        if (!GATE && tid < 256) { const float v = ((const float*)tabb)[16 * 256 + tid]; auxb[512 + tid] = v; auxb[768 + 512 + tid] = v; } }
    __device__ __forceinline__ void operator()(const Acc& acc, const Unit& u, int wr, int wc, int fr, int fq, const LAS float* aux) const {
        asm volatile("" : "+v"(fr), "+v"(fq));
        const int pn = u.pn, d0 = wc * 32 + 8 * fq;
        float b[2][8];
#pragma unroll
        for (int bj = 0; bj < 2; ++bj) { const f32x4 x = *(const LAS f32x4*)(aux + 256 + 128 * bj + d0), y = *(const LAS f32x4*)(aux + 256 + 128 * bj + d0 + 4);
            b[bj][0] = x.x; b[bj][1] = x.y; b[bj][2] = x.z; b[bj][3] = x.w; b[bj][4] = y.x; b[bj][5] = y.y; b[bj][6] = y.z; b[bj][7] = y.w; }
        if constexpr (!GATE) {
            bf16_t* O = pn < 4 ? Q : KN; const int hcol = (pn & 3) * 256;
            f32x2 ta[8], tn[8], tb[8]; float dec[4];
            { const f32x2* tp0 = taba + (2 * u.pm) * 128 + d0; const f32x2* tpb = tabb + (64 * wr + fr) * 128 + d0;
#pragma unroll
              for (int q = 0; q < 8; ++q) { ta[q] = tp0[q]; tb[q] = tpb[q]; }
#pragma unroll
              for (int m = 0; m < 4; ++m) dec[m] = pn >= 4 ? gp[(pn - 4) * GPS + 127 - (64 * wr + 16 * m + fr)] : 0.f; }
            const float c128 = pn >= 4 ? gp[(pn - 4) * GPS + 128] : 0.f;
#pragma unroll
            for (int it = 0; it < 8; ++it) {
                const int ai = it >> 2, m = ai ? 3 - (it & 3) : (it & 3);
                if (it == 2) { const f32x2* tp1 = taba + (2 * u.pm + 1) * 128 + d0;
#pragma unroll
                    for (int q = 0; q < 8; ++q) tn[q] = tp1[q]; }
                if (it == 4) {
#pragma unroll
                    for (int q = 0; q < 8; ++q) ta[q] = tn[q]; }
                if ((it & 3) != 0) {
                    const float sg = ai ? -1.0f : 1.0f; int dl = 2 * d0; asm volatile("" : "+v"(dl));
#pragma unroll
                    for (int q2 = 0; q2 < 4; ++q2) { const f32x4 R2 = *(const LAS f32x4*)(aux + 512 + dl + 4 * q2);
                        { const f32x2 B = tb[2 * q2]; const float ry = sg * R2.y; tb[2 * q2].x = B.x * R2.x - B.y * ry; tb[2 * q2].y = B.y * R2.x + B.x * ry; }
                        { const f32x2 B = tb[2 * q2 + 1]; const float rw = sg * R2.w; tb[2 * q2 + 1].x = B.x * R2.z - B.y * rw; tb[2 * q2 + 1].y = B.y * R2.z + B.x * rw; } } }
                const int rl = 128 * ai + 64 * wr + 16 * m + fr, t = u.pm * 256 + rl; const float rs = aux[rl];
                float o1[8], o2[8];
#pragma unroll
                for (int q = 0; q < 8; ++q) {
                    const f32x2 A = ta[q], B = tb[q]; const float cs = A.x * B.x - A.y * B.y, sn = A.y * B.x + A.x * B.y;
                    const float v1 = rs * acc[ai][0][m][q >> 2][q & 3] + b[0][q], v2 = rs * acc[ai][1][m][q >> 2][q & 3] + b[1][q];
                    o1[q] = v1 * cs - v2 * sn; o2[q] = v1 * sn + v2 * cs; }
                store8bf(O + (size_t)t * 1024 + hcol + d0, o1); store8bf(O + (size_t)t * 1024 + hcol + 128 + d0, o2);
                if (pn >= 4) {
                    bf16_t* kd = KDT + (size_t)(hcol + d0) * T + t;
                    const float dk = ai ? dec[m] : dec[m] * c128;
#pragma unroll
                    for (int q = 0; q < 8; ++q) { kd[(size_t)q * T] = (bf16_t)(pk2(o1[q] * dk, 0.f) & 0xffffu); kd[(size_t)(128 + q) * T] = (bf16_t)(pk2(o2[q] * dk, 0.f) & 0xffffu); } }
            }
        } else {
#pragma unroll
            for (int ai = 0; ai < 2; ++ai)
#pragma unroll
                for (int m = 0; m < 4; ++m) {
                    const int rl = 128 * ai + 64 * wr + 16 * m + fr, t = u.pm * 256 + rl; const float rs = aux[rl];
#pragma unroll
                    for (int bj = 0; bj < 2; ++bj) { float o[8];
#pragma unroll
                        for (int q = 0; q < 8; ++q) o[q] = silu_f(rs * acc[ai][bj][m][q >> 2][q & 3] + b[bj][q]);
                        store8bf(Gb + (size_t)t * 2048 + (pn - 8) * 256 + 128 * bj + d0, o); }
                }
        }
    }
};
struct EpiG1b {
    static constexpr bool PERM = true;
    const float* rowss; const float* bias; const f32x2* taba; const f32x2* tabb; const float* gp; bf16_t* KDT; bf16_t* VT;
    __device__ __forceinline__ void pre_load(const Unit& u, int tid, float (&r)[16]) const { if (tid < 256) bias_sum_ld(bias, 1024 + 256 * u.pm + tid, NIN, 2 * NIN, r); else r[0] = ldv_f(rowss + (size_t)(u.pn * 256 + tid - 256) * 16); }
    __device__ __forceinline__ void pre_store(const Unit&, LAS float* aux, int tid, const float (&r)[16]) const { aux[tid] = tid < 256 ? bias_sum_fin(r) : rstd_of(r[0]); }
    __device__ __forceinline__ void init(LAS float*, int) const {}
    __device__ __forceinline__ void operator()(const Acc& acc, const Unit& u, int wr, int wc, int fr, int fq, const LAS float* aux) const {
        asm volatile("" : "+v"(fr), "+v"(fq));
        const int pmf = u.pm, tl0 = 32 * wc + 8 * fq, tk0 = u.pn * 256 + tl0;
        float rs[2][8];
#pragma unroll
        for (int bj = 0; bj < 2; ++bj) { const f32x4 x = *(const LAS f32x4*)(aux + 256 + 128 * bj + tl0), y = *(const LAS f32x4*)(aux + 256 + 128 * bj + tl0 + 4);
            rs[bj][0] = x.x; rs[bj][1] = x.y; rs[bj][2] = x.z; rs[bj][3] = x.w; rs[bj][4] = y.x; rs[bj][5] = y.y; rs[bj][6] = y.z; rs[bj][7] = y.w; }
        if (pmf < 4) {
            const int h = pmf;
#pragma unroll
            for (int m = 0; m < 4; ++m) {
                const int d = 64 * wr + 16 * m + fr; const float b1 = aux[d], b2 = aux[128 + d];
#pragma unroll
                for (int bj = 0; bj < 2; ++bj) { float o1[8], o2[8]; const f32x2 A = taba[(2 * u.pn + bj) * 128 + d]; const float4 dq0 = *(const float4*)(gp + h * GPS + 120 - tl0), dq1 = *(const float4*)(gp + h * GPS + 124 - tl0);
                    const float decs[8] = {dq1.w, dq1.z, dq1.y, dq1.x, dq0.w, dq0.z, dq0.y, dq0.x};
#pragma unroll
                    for (int q = 0; q < 8; ++q) { const f32x2 B = tabb[(tl0 + q) * 128 + d]; const float cs = A.x * B.x - A.y * B.y, sn = A.y * B.x + A.x * B.y;
                        const float v1 = rs[bj][q] * acc[0][bj][m][q >> 2][q & 3] + b1, v2 = rs[bj][q] * acc[1][bj][m][q >> 2][q & 3] + b2;
                        o1[q] = (v1 * cs - v2 * sn) * decs[q]; o2[q] = (v1 * sn + v2 * cs) * decs[q]; }
                    store8bf(KDT + (size_t)(256 * h + d) * T + tk0 + 128 * bj, o1); store8bf(KDT + (size_t)(256 * h + 128 + d) * T + tk0 + 128 * bj, o2); }
            }
        } else {
#pragma unroll
            for (int ai = 0; ai < 2; ++ai)
#pragma unroll
                for (int m = 0; m < 4; ++m) {
                    const int rl = 128 * ai + 64 * wr + 16 * m + fr, f = 256 * (pmf - 4) + rl; const float bs = aux[rl];
#pragma unroll
                    for (int bj = 0; bj < 2; ++bj) { float o[8];
#pragma unroll
                        for (int q = 0; q < 8; ++q) o[q] = rs[bj][q] * acc[ai][bj][m][q >> 2][q & 3] + bs;
                        store8bf(VT + (size_t)f * T + tk0 + 128 * bj, o); }
                }
        }
    }
};
struct EpiKV {
    static constexpr bool PERM = true;
    bf16_t* SB;
    __device__ __forceinline__ void pre_load(const Unit&, int, float (&)[16]) const {}
    __device__ __forceinline__ void pre_store(const Unit&, LAS float*, int, const float (&)[16]) const {}
    __device__ __forceinline__ void init(LAS float*, int) const {}
    __device__ __forceinline__ void operator()(const Acc& acc, const Unit& u, int wr, int wc, int fr, int fq, const LAS float*) const {
        asm volatile("" : "+v"(fr), "+v"(fq));
        const int mt = u.aux & 1, nh = u.aux >> 1; bf16_t* base = SB + ((size_t)nh * 512 + 256 * mt) * 256; const int d0 = wc * 32 + 8 * fq;
#pragma unroll
        for (int ai = 0; ai < 2; ++ai)
#pragma unroll
            for (int m = 0; m < 4; ++m) { const int r = 128 * ai + 64 * wr + 16 * m + fr;
#pragma unroll
                for (int bj = 0; bj < 2; ++bj) { float o[8];
#pragma unroll
                    for (int q = 0; q < 8; ++q) o[q] = acc[ai][bj][m][q >> 2][q & 3];
                    store8bf(base + (size_t)r * 256 + 128 * bj + d0, o); } }
    }
};
struct EpiResid {
    static constexpr bool PERM = false;
    const float* base; float* out; bf16_t* xb; float* rowss; const float* g; const float* cb; const float* cs; float accscale;
    __device__ __forceinline__ void pre_load(const Unit& u, int tid, float (&r)[16]) const {
        if (tid < 256) { const int c = 256 * u.pn + tid; r[0] = ldv_f(g + c); r[1] = cs ? cs[c] : 1.0f; } else { const int c = 256 * u.pn + tid - 256; r[0] = cb ? cb[c] : 0.f; r[1] = 1.0f; } }
    __device__ __forceinline__ void pre_store(const Unit&, LAS float* aux, int tid, const float (&r)[16]) const { aux[256 + tid] = r[0] * r[1] * (tid < 256 ? accscale : 1.0f); }
    __device__ __forceinline__ void init(LAS float*, int) const {}
    __device__ __forceinline__ void operator()(const Acc& acc, const Unit& u, int wr, int wc, int fr, int fq, const LAS float* aux) const {
        asm volatile("" : "+v"(fr), "+v"(fq));
        const int cl0 = 32 * wc + 4 * fq, col0 = 256 * u.pn + cl0;
        f32x4 gv[2][2], cbv[2][2];
#pragma unroll
        for (int bj = 0; bj < 2; ++bj)
#pragma unroll
            for (int n = 0; n < 2; ++n) { gv[bj][n] = *(const LAS f32x4*)(aux + 256 + cl0 + 128 * bj + 16 * n); cbv[bj][n] = *(const LAS f32x4*)(aux + 512 + cl0 + 128 * bj + 16 * n); }
        f32x4 bsv[2][4];
        const size_t o0 = (size_t)(u.pm * 256 + 64 * wr + fr) * 1024 + col0;
#pragma unroll
        for (int j = 0; j < 4; ++j) bsv[0][j] = *(const f32x4*)(base + o0 + 128 * (j >> 1) + 16 * (j & 1));
#pragma unroll
        for (int it = 0; it < 8; ++it) { const int ai = it >> 2, m = it & 3; const int t = u.pm * 256 + 128 * ai + 64 * wr + 16 * m + fr; float s = 0.f;
            if (it < 7) { const int ai2 = (it + 1) >> 2, m2 = (it + 1) & 3; const size_t o2 = o0 + (size_t)(128 * ai2 + 16 * m2) * 1024;
#pragma unroll
                for (int j = 0; j < 4; ++j) bsv[(it + 1) & 1][j] = *(const f32x4*)(base + o2 + 128 * (j >> 1) + 16 * (j & 1)); }
#pragma unroll
            for (int bj = 0; bj < 2; ++bj)
#pragma unroll
                for (int n = 0; n < 2; ++n) { const size_t o = (size_t)t * 1024 + col0 + 128 * bj + 16 * n;
                    const f32x4 xo = bsv[it & 1][2 * bj + n] + (acc[ai][bj][m][n] + cbv[bj][n]) * gv[bj][n];
                    *(f32x4*)(out + o) = xo; s += (xo.x * xo.x + xo.y * xo.y) + (xo.z * xo.z + xo.w * xo.w);
                    if (xb) { u32x2 w; w.x = pk2(xo.x, xo.y); w.y = pk2(xo.z, xo.w); *(u32x2*)(xb + o) = w; } }
            s += __shfl_xor(s, 16); s += __shfl_xor(s, 32);
            if (fq == 0) rowss[(size_t)t * 16 + u.pn * 4 + wc] = s; }
    }
};
template <bool TILED, bool F8OUT = false> struct EpiSwiglu {
    static constexpr bool PERM = true;
    const float* rowss; const float* rowrs; const float* bias; bf16_t* Hout; int ldh, bs1, bs2;
    __device__ __forceinline__ void pre_load(const Unit& u, int tid, float (&r)[16]) const {
        if (tid < 256) { if (rowrs) r[0] = ldv_f(rowrs + u.rowbase + tid); else rstd_row_ld(rowss, u.rowbase + tid, r); } else bias_sum_ld(bias, u.aux + tid - 256, bs1, bs2, r); }
    __device__ __forceinline__ void pre_store(const Unit&, LAS float* aux, int tid, const float (&r)[16]) const { aux[tid] = tid < 256 ? (rowrs ? r[0] : rstd_row_fin(r)) : bias_sum_fin(r); }
    __device__ __forceinline__ void init(LAS float*, int) const {}
    __device__ __forceinline__ void operator()(const Acc& acc, const Unit& u, int wr, int wc, int fr, int fq, const LAS float* aux) const {
        asm volatile("" : "+v"(fr), "+v"(fq));
        const int d0 = wc * 32 + 8 * fq; float bg[8], bu[8];
        { const f32x4 x = *(const LAS f32x4*)(aux + 256 + d0), y = *(const LAS f32x4*)(aux + 256 + d0 + 4), z = *(const LAS f32x4*)(aux + 384 + d0), w = *(const LAS f32x4*)(aux + 384 + d0 + 4);
          bg[0] = x.x; bg[1] = x.y; bg[2] = x.z; bg[3] = x.w; bg[4] = y.x; bg[5] = y.y; bg[6] = y.z; bg[7] = y.w; bu[0] = z.x; bu[1] = z.y; bu[2] = z.z; bu[3] = z.w; bu[4] = w.x; bu[5] = w.y; bu[6] = w.z; bu[7] = w.w; }
        constexpr float KG = -1.4426950408889634f, KU = -0.6931471805599453f * (F8OUT ? F8_HSCALE : 1.0f);
#pragma unroll
        for (int q = 0; q < 8; ++q) { bg[q] *= KG; bu[q] *= KU; }
#pragma unroll
        for (int ai = 0; ai < 2; ++ai)
#pragma unroll
            for (int m = 0; m < 4; ++m) { const int rl = 128 * ai + 64 * wr + 16 * m + fr, row = u.rowbase + rl; const float rs = aux[rl], rsg = rs * KG, rsu = rs * KU; float o[8];
#pragma unroll
                for (int q = 0; q < 8; ++q) {
                    const float x = rsg * acc[ai][0][m][q >> 2][q & 3] + bg[q], y = rsu * acc[ai][1][m][q >> 2][q & 3] + bu[q];
                    o[q] = (x * __builtin_amdgcn_rcpf(1.0f + __builtin_amdgcn_exp2f(x))) * y; }
                if constexpr (F8OUT) {
#pragma unroll
                    for (int q = 0; q < 8; ++q) o[q] = __builtin_amdgcn_fmed3f(o[q], -448.0f, 448.0f);
                    u32x2 w8; w8.x = pk4f8(o[0], o[1], o[2], o[3]); w8.y = pk4f8(o[4], o[5], o[6], o[7]);
                    if (TILED) *(u32x2*)((unsigned char*)Hout + (((size_t)(row >> 8) * (ldh >> 7) + u.pn) * 256 + (row & 255)) * 128 + d0) = w8;
                    else *(u32x2*)((unsigned char*)Hout + (size_t)row * ldh + 128 * u.pn + d0) = w8; }
                else if (TILED) store8bf(Hout + (((size_t)(row >> 8) * (ldh >> 6) + 2 * u.pn + (d0 >> 6)) * 256 + (row & 255)) * 64 + (d0 & 63), o);
                else store8bf(Hout + (size_t)row * ldh + 128 * u.pn + d0, o); }
    }
};
struct EpiMoeDown {
    static constexpr bool PERM = true;
    const float* gate; bf16_t* YB; float* YBB;
    __device__ __forceinline__ void pre_load(const Unit& u, int tid, float (&r)[16]) const { if (tid < 256) r[0] = ldv_f(gate + u.rowbase + tid); }
    __device__ __forceinline__ void pre_store(const Unit&, LAS float* aux, int tid, const float (&r)[16]) const { if (tid < 256) aux[tid] = r[0] * (1.0f / (F8_DSCALE * F8_HSCALE)); }
    __device__ __forceinline__ void init(LAS float*, int) const {}
    __device__ __forceinline__ void operator()(const Acc& acc, const Unit& u, int wr, int wc, int fr, int fq, const LAS float* aux) const {
        asm volatile("" : "+v"(fr), "+v"(fq));
        const int col0 = 256 * u.pn + 32 * wc + 8 * fq;
#pragma unroll
        for (int ai = 0; ai < 2; ++ai)
#pragma unroll
            for (int m = 0; m < 4; ++m) { const int rl = 128 * ai + 64 * wr + 16 * m + fr, row = u.rowbase + rl; const float gt = aux[rl];
#pragma unroll
                for (int bj = 0; bj < 2; ++bj) {
                    if (u.aux == 0) { float o[8];
#pragma unroll
                        for (int q = 0; q < 8; ++q) o[q] = acc[ai][bj][m][q >> 2][q & 3] * gt;
                        store8bf(YB + (size_t)row * 1024 + col0 + 128 * bj, o); }
                    else { float* d = YBB + (size_t)(u.aux - 1) * 65536 + (size_t)rl * 256 + 32 * wc + 8 * fq + 128 * bj;
                        *(f32x4*)d = acc[ai][bj][m][0] * gt; *(f32x4*)(d + 4) = acc[ai][bj][m][1] * gt; } } }
    }
};

namespace pg8 {
constexpr int BM = 256, BK = 64, HALF = 128, HTB = HALF * BK * 2, STAGE_BYTES = 8 * HTB;
__device__ __forceinline__ int lds_byte(int r, int c) { const int st = (r >> 4) * 2 + (c >> 5), rr = r & 15, cc = c & 31, ob = rr * 64 + cc * 2; return st * 1024 + (ob ^ (((ob >> 9) & 1) << 5)); }
__device__ __forceinline__ void stage_rc(int b, int& R, int& C) { const int st = b / 1024, sb = b % 1024, swz = sb ^ (((sb >> 9) & 1) << 5); R = (st >> 1) * 16 + swz / 64; C = (st & 1) * 32 + (swz % 64) / 2; }
__device__ __forceinline__ int perm32(int rho) { const int n = rho >> 4, i = rho & 15; return 8 * (i >> 2) + 4 * n + (i & 3); }
}
typedef int i32x8 __attribute__((ext_vector_type(8)));
__device__ __forceinline__ void mfma_f8_inplace(f32x4& acc, const i32x8 a, const i32x8 b, int sc) {
    asm volatile("v_mfma_scale_f32_16x16x128_f8f6f4 %0, %1, %2, %0, %3, %3 op_sel_hi:[0,0,0]" : "+v"(acc) : "v"(a), "v"(b), "v"(sc)); }
template <class Desc, class Epi>
__device__ __forceinline__ void gemm_fast(LAS unsigned char* lds, const unsigned char* wsb, const Desc& Dc, const Epi& E, int c, int G, int wave_id) {
    using namespace pg8;
    constexpr bool GATHER = Desc::GATHER; constexpr bool FP8 = Desc::FP8;
    int lane_ = lane_id(); asm volatile("" : "+v"(lane_));
    const int wid = wave_id, lane = lane_, tid = wid * 64 + lane, wr = wid >> 2, wc = wid & 3, fr = lane & 15, fq = lane >> 4;
    unsigned vA[2][2], vAn[2][2], vB[2][2];
#pragma unroll
    for (int i = 0; i < 2; ++i) { int R, C; stage_rc(tid * 16 + i * 8192, R, C); const int Rb = Epi::PERM ? ((R & ~31) + perm32(R & 31)) : R;
#pragma unroll
        for (int h = 0; h < 2; ++h) { vA[h][i] = (unsigned)((h * HALF + R) * Dc.lda + C) * 2u; vB[h][i] = (unsigned)((h * HALF + Rb) * Dc.ldb + C) * 2u; vAn[h][i] = vA[h][i]; } }
    const unsigned ksA = (unsigned)Dc.ksa, ksB = (unsigned)Dc.ksb;
    const __amdgpu_buffer_rsrc_t rs = __builtin_amdgcn_make_buffer_rsrc((void*)wsb, (short)0, 0x7fffffff, 0x00020000);
    const unsigned ldsw = (unsigned)wid * 1024u;
    const int aoff = lds_byte(wr * 64 + fr, fq * 8), boff = lds_byte(wc * 32 + fr, fq * 8);
#define PG8_SA(b, h) (((b) * 2 + (h)) * HTB)
#define PG8_SB(b, h) ((4 + (b) * 2 + (h)) * HTB)
#define PG8_STAGE(bufoff, gbase, voff) do { _Pragma("unroll") for (int _i = 0; _i < 2; ++_i) \
        __builtin_amdgcn_raw_ptr_buffer_load_lds(rs, (LAS unsigned*)(lds + (bufoff) + ldsw + _i * 8192), 16, (int)(voff)[_i], (int)(gbase), 0, 0); } while (0)
#define PG8_LDA(dst, b, h) do { _Pragma("unroll") for (int m = 0; m < 4; ++m) _Pragma("unroll") for (int k = 0; k < 2; ++k) dst[m][k] = *(const LAS bf16x8*)(lds + PG8_SA(b, h) + aoff + m * 2048 + k * 1024); } while (0)
#define PG8_LDB(dst, b, h) do { _Pragma("unroll") for (int n = 0; n < 2; ++n) _Pragma("unroll") for (int k = 0; k < 2; ++k) dst[n][k] = *(const LAS bf16x8*)(lds + PG8_SB(b, h) + boff + n * 2048 + k * 1024); } while (0)
#define PG8_CAT(x) __builtin_shufflevector(__builtin_bit_cast(i32x4, x[0]), __builtin_bit_cast(i32x4, x[1]), 0, 1, 2, 3, 4, 5, 6, 7)
#define PG8_MMA(ai, bj, At, Bt) do { __builtin_amdgcn_s_setprio(1); if constexpr (FP8) { _Pragma("unroll") for (int m = 0; m < 4; ++m) _Pragma("unroll") for (int n = 0; n < 2; ++n) \
        mfma_f8_inplace(acc[ai][bj][m][n], PG8_CAT(Bt[n]), PG8_CAT(At[m]), f8sc); } else { \
        _Pragma("unroll") for (int m = 0; m < 4; ++m) _Pragma("unroll") for (int n = 0; n < 2; ++n) _Pragma("unroll") for (int k = 0; k < 2; ++k) \
        acc[ai][bj][m][n] = __builtin_amdgcn_mfma_f32_16x16x32_bf16(Bt[n][k], At[m][k], acc[ai][bj][m][n], 0, 0, 0); } __builtin_amdgcn_s_setprio(0); } while (0)
#define PG8_WAIT_V(n) asm volatile("s_waitcnt vmcnt(" #n ")" ::: "memory")
#define PG8_WAIT_L(n) asm volatile("s_waitcnt lgkmcnt(" #n ")" ::: "memory")
#define PG8_BAR __builtin_amdgcn_s_barrier()
#define PG8_SCHED __builtin_amdgcn_sched_barrier(0)
#define PG8_GATHER_OFFS(dst, un) do { const int _t = wid * 64 + lane_id(); _Pragma("unroll") for (int _i = 0; _i < 2; ++_i) { int _R, _C; stage_rc(_t * 16 + _i * 8192, _R, _C); \
        _Pragma("unroll") for (int _h = 0; _h < 2; ++_h) dst[_h][_i] = (unsigned)(ldv_i(Dc.tok + (un).rowbase + _h * HALF + _R) * Dc.lda + _C) * 2u; } } while (0)
    int f8sc = 0x7f7f7f7f; asm volatile("" : "+v"(f8sc));
    Unit cur, nxt; int ui = 0;
    if (!Dc.get(c, cur)) return;
    LAS float* const auxb = (LAS float*)(lds + 131072 + 1024);
    E.init(auxb, tid);
    { float r0[16]; E.pre_load(cur, tid, r0); E.pre_store(cur, auxb, tid, r0); }
    Acc acc;
#pragma unroll
    for (int a = 0; a < 2; ++a)
#pragma unroll
        for (int b = 0; b < 2; ++b)
#pragma unroll
            for (int m = 0; m < 4; ++m)
#pragma unroll
                for (int n = 0; n < 2; ++n) acc[a][b][m][n] = (f32x4){0.f, 0.f, 0.f, 0.f};
    bf16x8 At[4][2], B0[2][2], B1[2][2];
    unsigned cA = (unsigned)((const unsigned char*)cur.A - wsb), cB = (unsigned)((const unsigned char*)cur.B - wsb);
    if constexpr (GATHER) { PG8_GATHER_OFFS(vA, cur); }
    PG8_STAGE(PG8_SB(0, 0), cB, vB[0]); PG8_STAGE(PG8_SB(0, 1), cB, vB[1]); PG8_STAGE(PG8_SA(0, 0), cA, vA[0]); PG8_STAGE(PG8_SA(0, 1), cA, vA[1]);
    if (wr == 1) PG8_BAR;
    PG8_WAIT_V(2); PG8_BAR;
    PG8_STAGE(PG8_SB(1, 0), cB + ksB, vB[0]); PG8_STAGE(PG8_SA(1, 0), cA + ksA, vA[0]); PG8_STAGE(PG8_SB(1, 1), cB + ksB, vB[1]);
    PG8_WAIT_V(6); PG8_BAR;
    for (;;) {
        const bool has_next = Dc.get((ui + 1) * G + c, nxt);
        const unsigned nA = has_next ? (unsigned)((const unsigned char*)nxt.A - wsb) : cA, nB = has_next ? (unsigned)((const unsigned char*)nxt.B - wsb) : cB;
        if constexpr (GATHER) { if (has_next) { PG8_GATHER_OFFS(vAn, nxt); } else {
#pragma unroll
            for (int h = 0; h < 2; ++h)
#pragma unroll
                for (int i = 0; i < 2; ++i) vAn[h][i] = vA[h][i]; } }
        const int nt = cur.nt;
        for (int t = 0; t < nt; t += 2) {
            const bool last = (t == nt - 2);
            const unsigned a1 = cA + (unsigned)(t + 1) * ksA;
            const unsigned a2 = last ? nA : cA + (unsigned)(t + 2) * ksA, b2 = last ? nB : cB + (unsigned)(t + 2) * ksB;
            const unsigned a3 = a2 + ksA, b3 = b2 + ksB;
            unsigned x0[2], x1[2];
#pragma unroll
            for (int i = 0; i < 2; ++i) { x0[i] = (GATHER && last) ? vAn[0][i] : vA[0][i]; x1[i] = (GATHER && last) ? vAn[1][i] : vA[1][i]; }
            PG8_LDB(B0, 0, 0); PG8_LDB(B1, 0, 1); PG8_SCHED; PG8_LDA(At, 0, 0); PG8_STAGE(PG8_SA(1, 1), a1, vA[1]);
            PG8_WAIT_V(8); PG8_WAIT_L(0); PG8_BAR; PG8_MMA(0, 0, At, B0); PG8_MMA(0, 1, At, B1); PG8_BAR; PG8_SCHED;
            PG8_LDA(At, 0, 1); PG8_STAGE(PG8_SB(0, 0), b2, vB[0]); PG8_STAGE(PG8_SB(0, 1), b2, vB[1]); PG8_STAGE(PG8_SA(0, 0), a2, x0);
            PG8_WAIT_V(8); PG8_WAIT_L(0); PG8_BAR; PG8_MMA(1, 0, At, B0); PG8_MMA(1, 1, At, B1); PG8_BAR; PG8_SCHED;
            PG8_LDB(B0, 1, 0); PG8_LDB(B1, 1, 1); PG8_SCHED; PG8_LDA(At, 1, 0); PG8_STAGE(PG8_SA(0, 1), a2, x1);
            PG8_WAIT_V(8); PG8_WAIT_L(0); PG8_BAR; PG8_MMA(0, 0, At, B0); PG8_MMA(0, 1, At, B1); PG8_BAR; PG8_SCHED;
            PG8_LDA(At, 1, 1); PG8_STAGE(PG8_SB(1, 0), b3, vB[0]); PG8_STAGE(PG8_SB(1, 1), b3, vB[1]); PG8_STAGE(PG8_SA(1, 0), a3, x0);
            PG8_WAIT_V(8); PG8_WAIT_L(0); PG8_BAR; PG8_MMA(1, 0, At, B0); PG8_MMA(1, 1, At, B1); PG8_BAR; PG8_SCHED;
        }
        if constexpr (FP8) asm volatile("s_nop 15\n\ts_nop 15\n\ts_nop 15\n\ts_nop 15\n\ts_nop 15" ::: "memory");
        if (wr == 0) PG8_BAR;
        { const int l2 = lane_id(); float rn[16];
          if (has_next) E.pre_load(nxt, wid * 64 + l2, rn);
          E(acc, cur, wr, wc, l2 & 15, l2 >> 4, auxb + (ui & 1) * 768);
          if (has_next) E.pre_store(nxt, auxb + ((ui + 1) & 1) * 768, wid * 64 + l2, rn); }
        if (!has_next) break;
#pragma unroll
        for (int a = 0; a < 2; ++a)
#pragma unroll
            for (int b = 0; b < 2; ++b)
#pragma unroll
                for (int m = 0; m < 4; ++m)
#pragma unroll
                    for (int n = 0; n < 2; ++n) acc[a][b][m][n] = (f32x4){0.f, 0.f, 0.f, 0.f};
        cur = nxt; cA = nA; cB = nB; ++ui;
        if constexpr (GATHER) {
#pragma unroll
            for (int h = 0; h < 2; ++h)
#pragma unroll
                for (int i = 0; i < 2; ++i) vA[h][i] = vAn[h][i]; }
        if (wr == 1) PG8_BAR;
    }
    PG8_WAIT_V(0);
    PG8_BAR;
#undef PG8_SA
#undef PG8_SB
#undef PG8_STAGE
#undef PG8_LDA
#undef PG8_LDB
#undef PG8_MMA
#undef PG8_CAT
#undef PG8_WAIT_V
#undef PG8_WAIT_L
#undef PG8_BAR
#undef PG8_SCHED
#undef PG8_GATHER_OFFS
}

struct Frame {
    Params p; unsigned char* ws; LAS unsigned char* lds; int tid, lane, wave, c, G;
    __device__ __forceinline__ float* MOD() const { return (float*)(ws + CT_MOD); }
    __device__ __forceinline__ float* BIAS_IN() const { return (float*)(ws + CT_BIAS_IN); }
    __device__ __forceinline__ float* BIAS_GU() const { return (float*)(ws + CT_BIAS_GU); }
    __device__ __forceinline__ float* BIAS_R() const { return (float*)(ws + CT_BIAS_R); }
    __device__ __forceinline__ float* BIAS_MGU() const { return (float*)(ws + CT_BIAS_MGU); }
    __device__ __forceinline__ float* ROWSS() const { return (float*)(ws + WS_ROWSSP); }
    __device__ __forceinline__ float* MODP() const { return (float*)(ws + WS_MODP); }
    __device__ __forceinline__ f32x2* TABA() const { return (f32x2*)(ws + WS_TABA); }
    __device__ __forceinline__ f32x2* TABB() const { return (f32x2*)(ws + WS_TABB); }
    __device__ __forceinline__ float* GP() const { return (float*)(ws + WS_GP); }
    __device__ __forceinline__ float* WR() const { return (float*)(ws + WS_WR); }
    __device__ __forceinline__ int* TOPE() const { return (int*)(ws + WS_TOPE); }
    __device__ __forceinline__ float* TOPG() const { return (float*)(ws + WS_TOPG); }
    __device__ __forceinline__ int* CNT() const { return (int*)(ws + WS_CNT); }
    __device__ __forceinline__ int* BUFTOK() const { return (int*)(ws + WS_BUFTOK); }
    __device__ __forceinline__ float* BUFGATE() const { return (float*)(ws + WS_BUFGATE); }
    __device__ __forceinline__ int* POS() const { return (int*)(ws + WS_POS); }
    __device__ __forceinline__ int* BLKE() const { return (int*)(ws + WS_BLKE); }
    __device__ __forceinline__ float* RSTD3() const { return (float*)(ws + WS_RSTD3); }
    __device__ __forceinline__ float* BUFRS() const { return (float*)(ws + WS_BUFRS); }
    __device__ __forceinline__ bf16_t* WIN() const { return (bf16_t*)(ws + WS_WIN); }
    __device__ __forceinline__ bf16_t* WOUT() const { return (bf16_t*)(ws + WS_WOUT); }
    __device__ __forceinline__ bf16_t* WGU() const { return (bf16_t*)(ws + WS_WGU); }
    __device__ __forceinline__ bf16_t* WD() const { return (bf16_t*)(ws + WS_WD); }
    __device__ __forceinline__ bf16_t* WP() const { return (bf16_t*)(ws + WS_WP); }
    __device__ __forceinline__ bf16_t* XB() const { return (bf16_t*)(ws + WS_XB); }
    __device__ __forceinline__ bf16_t* Q() const { return (bf16_t*)(ws + WS_Q); }
    __device__ __forceinline__ bf16_t* KN() const { return (bf16_t*)(ws + WS_KN); }
    __device__ __forceinline__ bf16_t* KDT() const { return (bf16_t*)(ws + WS_KDT); }
    __device__ __forceinline__ bf16_t* VT() const { return (bf16_t*)(ws + WS_VT); }
    __device__ __forceinline__ bf16_t* Gb() const { return (bf16_t*)(ws + WS_G); }
    __device__ __forceinline__ bf16_t* SB() const { return (bf16_t*)(ws + WS_SB); }
    __device__ __forceinline__ bf16_t* Y() const { return (bf16_t*)(ws + WS_Y); }
    __device__ __forceinline__ bf16_t* H1() const { return (bf16_t*)(ws + WS_H1); }
    __device__ __forceinline__ bf16_t* PB() const { return (bf16_t*)(ws + WS_PB); }
    __device__ __forceinline__ bf16_t* H1M() const { return (bf16_t*)(ws + WS_H1M); }
    __device__ __forceinline__ bf16_t* WMGU() const { return (bf16_t*)(ws + WS_WMGU); }
    __device__ __forceinline__ bf16_t* WMD() const { return (bf16_t*)(ws + WS_WMD); }
    __device__ __forceinline__ bf16_t* YB() const { return (bf16_t*)(ws + WS_YB); }
    __device__ __forceinline__ float* YBB() const { return (float*)(ws + WS_YBB); }
    __device__ __forceinline__ float* X2() const { return (float*)(ws + WS_X2); }
};
__device__ __forceinline__ void frame_fresh(Frame& F) { int l = lane_id(); asm volatile("" : "+v"(l)); F.lane = l; F.tid = F.wave * 64 + l; }
__device__ __forceinline__ void frame_init(Frame& F, const Params& p, LAS unsigned char* lds, int c, int G) {
    F.p = p; F.ws = p.ws; F.lds = lds; F.tid = threadIdx.x; F.lane = F.tid & 63; F.wave = __builtin_amdgcn_readfirstlane(F.tid >> 6); F.c = c; F.G = G;
}

__device__ __forceinline__ void dsincos(double x, double& s, double& c) {
    const double k = rint(x * 0.6366197723675814); double y = fma(-k, 1.5707963267948966, x); y = fma(-k, 6.123233995736766e-17, y);
    const double z = y * y;
    double sp = -7.6471637318198164759e-13; sp = fma(sp, z, 1.6059043836821614599e-10); sp = fma(sp, z, -2.5052108385441718775e-8); sp = fma(sp, z, 2.7557319223985890653e-6);
    sp = fma(sp, z, -1.9841269841269841270e-4); sp = fma(sp, z, 8.3333333333333333333e-3); sp = fma(sp, z, -1.6666666666666666667e-1); const double sy = fma(sp * z, y, y);
    double cp = 4.7794773323873852974e-14; cp = fma(cp, z, -1.1470745597729724714e-11); cp = fma(cp, z, 2.0876756987868098979e-9); cp = fma(cp, z, -2.7557319223985890653e-7);
    cp = fma(cp, z, 2.4801587301587301587e-5); cp = fma(cp, z, -1.3888888888888888889e-3); cp = fma(cp, z, 4.1666666666666666667e-2); cp = fma(cp, z, -0.5); const double cy = fma(cp, z, 1.0);
    const int q = ((int)k) & 3;
    s = (q == 0) ? sy : (q == 1) ? cy : (q == 2) ? -sy : -cy;
    c = (q == 0) ? cy : (q == 1) ? -sy : (q == 2) ? -cy : sy;
}
__device__ __forceinline__ void phase_p0(Frame& F) {
    const Params& p = F.p; const int gw = F.c * NWAVE + F.wave, NGW = F.G * NWAVE, lane = F.lane;
    LAS float* cact = (LAS float*)F.lds;
    __syncthreads();
    for (int k = F.tid; k < 1024; k += NTHR) cact[k] = silu_f(p.c[k]);
    __syncthreads();
    for (int task = gw; task < 1536; task += NGW) {
        const int i = task / 768, rem = task % 768, cb = rem >> 3, ks = rem & 7, n = cb * 64 + lane;
        const float* w = p.ada_w + (size_t)i * 1024 * NIN + (size_t)(ks * 128) * NIN + n; float a = 0.f;
#pragma unroll
        for (int k0 = 0; k0 < 128; k0 += 32) { float wv[32];
#pragma unroll
            for (int k = 0; k < 32; ++k) wv[k] = w[(size_t)(k0 + k) * NIN];
#pragma unroll
            for (int k = 0; k < 32; ++k) a = fmaf(cact[ks * 128 + k0 + k], wv[k], a); }
        if (ks == 0) a += p.ada_b[i * NIN + n];
        F.MODP()[ks * 12288 + i * NIN + n] = a;
    }
    const int gt = F.c * NTHR + F.tid, NGT = F.G * NTHR;
    for (int e = gt; e < 32768 + 4; e += NGT) {
        if (e < 32768) {
            const int which = e >> 14, ab = (e >> 7) & 127, i = e & 127; double inv = 1.0;
            for (int q = 0; q < i; ++q) inv *= 0.93057204092969897929;
            const double ang = (double)(which == 0 ? 128 * ab : ab) * inv; double s, c2; dsincos(ang, s, c2);
            (which == 0 ? F.TABA() : F.TABB())[ab * 128 + i] = (f32x2){(float)c2, (float)s};
        } else {
            const int h = e - 32768; const double g = 1.0 - 1.0 / (double)(32 << h); double v = 1.0;
            for (int j = 0; j <= 256; ++j) { F.GP()[h * GPS + j] = (float)v; v *= g; }
        }
    }
    for (int row = 2 * gw; row < T; row += 2 * NGW) {
        f32x4 v[2][4];
#pragma unroll
        for (int r = 0; r < 2; ++r) { const f32x4* xr = (const f32x4*)(p.x + (size_t)(row + r) * D) + lane;
#pragma unroll
            for (int j = 0; j < 4; ++j) v[r][j] = xr[64 * j]; }
#pragma unroll
        for (int r = 0; r < 2; ++r) { float s = 0.f;
#pragma unroll
            for (int j = 0; j < 4; ++j) s += (v[r][j].x * v[r][j].x + v[r][j].y * v[r][j].y) + (v[r][j].z * v[r][j].z + v[r][j].w * v[r][j].w);
            s = wave_sum(s); if (lane < 16) F.ROWSS()[(size_t)(row + r) * 16 + lane] = (lane == 0) ? s : 0.f;
            u32x2* o = (u32x2*)(F.XB() + (size_t)(row + r) * D) + lane;
#pragma unroll
            for (int j = 0; j < 4; ++j) { u32x2 w; w.x = pk2(v[r][j].x, v[r][j].y); w.y = pk2(v[r][j].z, v[r][j].w); o[64 * j] = w; } }
    }
}

template <bool F8 = false>
__device__ __forceinline__ void conv_strip(const float* W, int ldw, int kb0, int nkb, int n0, bf16_t* WT, int ldt, int drow0, const LAS float* gsl, const LAS float* shl,
                                           float* bias, float cscale, LAS float* scr, int lane, int tiled_nkt = 0, float wmul = 1.0f) {
    f32x4 bacc = (f32x4){0.f, 0.f, 0.f, 0.f}; f32x4 w[8];
    const int lr = lane >> 3, lc = 4 * (lane & 7);
    const float* wp = W + (size_t)(kb0 * 64 + lr) * ldw + n0 + lc;
#pragma unroll
    for (int i = 0; i < 8; ++i) w[i] = *(const f32x4*)(wp + (size_t)(8 * i) * ldw);
    for (int kb = kb0; kb < kb0 + nkb; ++kb) {
        const int k0 = kb * 64; f32x4 wn[8];
        if (kb + 1 < kb0 + nkb) {
#pragma unroll
            for (int i = 0; i < 8; ++i) wn[i] = *(const f32x4*)(wp + (size_t)(64 * (kb + 1 - kb0) + 8 * i) * ldw);
        } else {
#pragma unroll
            for (int i = 0; i < 8; ++i) wn[i] = (f32x4){0.f, 0.f, 0.f, 0.f};
        }
#pragma unroll
        for (int i = 0; i < 8; ++i) { const int kk = lr + 8 * i;
            float gsv = cscale * wmul; if (gsl) { gsv *= gsl[k0 + kk]; const float sv = shl[k0 + kk]; bacc = bacc + w[i] * sv; }
            *(LAS f32x4*)(scr + kk * 36 + 4 * ((lane & 7) ^ i)) = w[i] * gsv; }
        asm volatile("s_waitcnt lgkmcnt(0)" ::: "memory");
        const int cc = lane & 7;
#pragma unroll
        for (int j = 0; j < 4; ++j) { const int n = (lane >> 3) + 8 * j; const LAS float* s = scr + (8 * cc) * 36 + 4 * ((n >> 2) ^ cc) + (n & 3);
            const int nr = drow0 + n;
            if constexpr (F8) { u32x2 o8; o8.x = pk4f8(s[0 * 36], s[1 * 36], s[2 * 36], s[3 * 36]); o8.y = pk4f8(s[4 * 36], s[5 * 36], s[6 * 36], s[7 * 36]);
                if (tiled_nkt) *(u32x2*)((unsigned char*)WT + (((size_t)(nr >> 8) * tiled_nkt + (kb >> 1)) * 256 + (nr & 255)) * 128 + (kb & 1) * 64 + 8 * cc) = o8;
                else *(u32x2*)((unsigned char*)WT + (size_t)nr * ldt + k0 + 8 * cc) = o8;
                continue; }
            u32x4 o; o.x = pk2(s[0 * 36], s[1 * 36]); o.y = pk2(s[2 * 36], s[3 * 36]); o.z = pk2(s[4 * 36], s[5 * 36]); o.w = pk2(s[6 * 36], s[7 * 36]);
            if (tiled_nkt) *(u32x4*)(WT + (((size_t)(nr >> 8) * tiled_nkt + kb) * 256 + (nr & 255)) * 64 + 8 * cc) = o;
            else *(u32x4*)(WT + (size_t)nr * ldt + k0 + 8 * cc) = o; }
        asm volatile("s_waitcnt lgkmcnt(0)" ::: "memory");
#pragma unroll
        for (int i = 0; i < 8; ++i) w[i] = wn[i];
    }
    if (bias) {
#pragma unroll
        for (int o = 8; o < 64; o <<= 1) { bacc.x += __shfl_xor(bacc.x, o); bacc.y += __shfl_xor(bacc.y, o); bacc.z += __shfl_xor(bacc.z, o); bacc.w += __shfl_xor(bacc.w, o); }
        if (lane < 8) *(f32x4*)(bias + drow0 + lc) = bacc * cscale; }
}
__device__ __forceinline__ void phase_p1(Frame& F) {
    const Params& p = F.p; const int gw = F.c * NWAVE + F.wave, NGW = F.G * NWAVE, lane = F.lane;
    LAS float* modl = (LAS float*)F.lds;
    LAS float* scr = (LAS float*)(F.lds + 49152 + F.wave * 9216);
    __syncthreads();
    for (int idx = F.tid; idx < 12288; idx += NTHR) { float v = 0.f;
#pragma unroll
        for (int ks = 0; ks < 8; ++ks) v += F.MODP()[ks * 12288 + idx];
        modl[idx] = v; if ((idx % F.G) == F.c) F.MOD()[idx] = v; }
    __syncthreads();
    const LAS float* MOD0 = modl; const LAS float* MOD1 = modl + NIN; const LAS float* nul = nullptr;
    LAS float* gs_in = modl + 2048; LAS float* gs_ffn = modl + 5120; LAS float* gs_pool = modl + NIN + 2048;
    for (int k = F.tid; k < 1024; k += NTHR) { gs_in[k] = p.norm_gain[k] * (1.0f + MOD0[1024 + k]); gs_ffn[k] = p.norm_gain[1024 + k] * (1.0f + MOD0[4 * 1024 + k]); gs_pool[k] = p.norm_gain[2048 + k] * (1.0f + MOD1[1024 + k]); }
    __syncthreads();
    constexpr int S_IN = 192 * 4, S_G = 88 * 4, I_OUT = 32 * 32, I_D = 44 * 32, I_P = 4 * 4 * 8;
    constexpr int NIT = S_IN + 2 * S_G + I_OUT + I_D + I_P + 1;
    for (int it = gw; it < NIT; it += NGW) {
        int r = it;
        if (r < S_IN) { const int part = r / 192, n0 = (r % 192) * 32; const float cs = (n0 >= 1024 && n0 < 2048) ? 0.0625f : 1.0f;
            conv_strip(p.ret_w_in, NIN, 4 * part, 4, n0, F.WIN(), 1024, n0, gs_in, MOD0, F.BIAS_IN() + part * NIN, cs, scr, lane); continue; } r -= S_IN;
        if (r < 2 * S_G) { const int up = r >= S_G; if (up) r -= S_G; const int part = r / 88, n0 = (r % 88) * 32, drow = (n0 >> 7) * 256 + (up ? 128 : 0) + (n0 & 127);
            conv_strip(up ? p.ffn_w_up : p.ffn_w_gate, DFF, 4 * part, 4, n0, F.WGU(), 1024, drow, gs_ffn, MOD0 + 3 * 1024, F.BIAS_GU() + part * 5632, 1.0f, scr, lane); continue; } r -= 2 * S_G;
        if (r < I_OUT) { const int kb = r / 32, nb = r % 32; conv_strip(p.ret_w_out, 1024, kb, 1, nb * 32, F.WOUT(), 2048, nb * 32, nul, nul, nullptr, 1.0f, scr, lane); continue; } r -= I_OUT;
        if (r < I_D) { const int kb = r / 32, nb = r % 32; conv_strip<true>(p.ffn_w_down, 1024, kb, 1, nb * 32, F.WD(), DFF, nb * 32, nul, nul, nullptr, 1.0f, scr, lane, 22, F8_DSCALE); continue; } r -= I_D;
        if (r < I_P) { const int g = r / 32, q = r % 32, kb = q / 8, nb = q % 8;
            conv_strip(p.pool_w + (size_t)g * 65536, 256, kb, 1, nb * 32, F.WP() + (size_t)g * 65536, 256, nb * 32, gs_pool + g * 256, MOD1 + g * 256, nullptr, 1.0f, scr, lane); continue; }
        { float ba = 0.f; const int e = lane & 7;
            for (int k0 = lane >> 3; k0 < 1024; k0 += 128) { float w[16], gn[16];
#pragma unroll
                for (int j = 0; j < 16; ++j) { const int k = k0 + 8 * j; w[j] = p.moe_router[k * 8 + e]; gn[j] = p.norm_gain[3 * 1024 + k]; }
#pragma unroll
                for (int j = 0; j < 16; ++j) { const int k = k0 + 8 * j; F.WR()[k * 8 + e] = w[j] * (gn[j] * (1.0f + MOD1[4 * 1024 + k])); ba = fmaf(MOD1[3 * 1024 + k], w[j], ba); } }
            ba += __shfl_xor(ba, 8); ba += __shfl_xor(ba, 16); ba += __shfl_xor(ba, 32);
            if (lane < 8) F.BIAS_R()[lane] = ba; }
    }
}
constexpr int PX_SG = 112 * 4, PX_EARLY = 1024;
__device__ __forceinline__ void px_tables(Frame& F) {
    const Params& p = F.p;
    LAS float* gsl = (LAS float*)(F.lds + 8 * 9216 + 1024);
    LAS float* shl = gsl + 1024;
    const float* MOD1 = F.MOD() + NIN;
    for (int k = F.tid; k < 1024; k += NTHR) { gsl[k] = p.norm_gain[3 * 1024 + k] * (1.0f + ldv_f(MOD1 + 4 * 1024 + k)); shl[k] = ldv_f(MOD1 + 3 * 1024 + k); }
    __syncthreads();
}
__device__ __forceinline__ void px_gu_item(Frame& F, int it, int lane) {
    const Params& p = F.p;
    LAS float* scr = (LAS float*)(F.lds + F.wave * 9216);
    LAS float* gsl = (LAS float*)(F.lds + 8 * 9216 + 1024); LAS float* shl = gsl + 1024;
    const int e = it / (2 * PX_SG); int r = it % (2 * PX_SG); const int up = r >= PX_SG; if (up) r -= PX_SG;
    const int part = r / 112, n0 = (r % 112) * 32, drow = e * 7168 + (n0 >> 7) * 256 + (up ? 128 : 0) + (n0 & 127);
    conv_strip<true>((up ? p.moe_w_up : p.moe_w_gate) + (size_t)e * 1024 * DFE, DFE, 4 * part, 4, n0, F.WMGU(), 1024, drow, gsl, shl,
                     F.BIAS_MGU() + (part >> 1) * 262144 + (part & 1) * 57344, 1.0f, scr, lane, 0, F8_WSCALE);
}
__device__ __forceinline__ void phase_px(Frame& F) {
    const Params& p = F.p; const int gw = F.c * NWAVE + F.wave, NGW = F.G * NWAVE, lane = F.lane;
    LAS float* scr = (LAS float*)(F.lds + F.wave * 9216);
    const LAS float* nul = nullptr;
    px_tables(F);
    constexpr int I_D = 14 * 32;
    for (int it = (F.G == 256 ? PX_EARLY : 0) + gw; it < NE * 2 * PX_SG; it += NGW) px_gu_item(F, it, lane);
    const int lane2 = lane_id();
    for (int it = gw; it < NE * I_D; it += NGW) {
        const int e = it / I_D, r = it % I_D, kg = r / 32, nb = r % 32;
        conv_strip<true>(p.moe_w_down + (size_t)e * DFE * 1024, 1024, 4 * kg, 4, nb * 32, (bf16_t*)((unsigned char*)F.WMD() + (size_t)e * 1024 * DFE), DFE, nb * 32, nul, nul, nullptr, 1.0f, scr, lane2, 28, F8_DSCALE);
    }
}

__device__ __forceinline__ void phase_scan(Frame& F) {
    const int gt = F.c * NTHR + F.tid, NGT = F.G * NTHR;
    for (int v = gt; v < 131072; v += NGT) {
        const int h = v >> 15; const float dec = F.GP()[h * GPS + RC]; float s0 = 0.f, s1 = 0.f, s2 = 0.f, s3 = 0.f;
        u32x2* ptr = (u32x2*)(F.SB() + (size_t)v * 4);
        for (int n0 = 0; n0 < NRC; n0 += 16) {
            u32x2 kv[16];
#pragma unroll
            for (int j = 0; j < 16; ++j) { kv[j] = (u32x2){0u, 0u}; if (n0 + j < NRC - 1) kv[j] = ptr[(size_t)(n0 + j) * 131072]; }
#pragma unroll
            for (int j = 0; j < 16; ++j) {
                u32x2 o; o.x = pk2(s0, s1); o.y = pk2(s2, s3); ptr[(size_t)(n0 + j) * 131072] = o;
                s0 = s0 * dec + bflo(kv[j].x); s1 = s1 * dec + bfhi(kv[j].x); s2 = s2 * dec + bflo(kv[j].y); s3 = s3 * dec + bfhi(kv[j].y); }
        }
    }
}

namespace ret {
constexpr int BUFB = 40960, OFF_B = 8192, OFF_P = 81920, OFF_RED = 114688, OFF_GP = 118784;
__device__ __forceinline__ int swz(int o) { return o ^ (((o >> 9) & 1) << 5); }
}
#define RET_WAITV(n) asm volatile("s_waitcnt vmcnt(" #n ")" ::: "memory")
#define RET_WAITL0() asm volatile("s_waitcnt lgkmcnt(0)" ::: "memory")
#define RET_BAR() do { asm volatile("" ::: "memory"); __builtin_amdgcn_s_barrier(); asm volatile("" ::: "memory"); } while (0)
__device__ __forceinline__ void phase_ret_fast(Frame& F) {
    using namespace ret;
    const Params& p = F.p; LAS unsigned char* lds = F.lds;
    const int tid = F.tid, lane = tid & 63, wid = F.wave, wr = wid >> 2, wc = wid & 3, fr = lane & 15, fq = lane >> 4;
    const int foff = swz(fr * 64 + fq * 16);
    const int srow = lane >> 2, scol = ((lane & 3) * 8) ^ (((lane >> 5) & 1) * 16);
    LAS float* gps = (LAS float*)(lds + OFF_GP); LAS f32x2* red = (LAS f32x2*)(lds + OFF_RED);
    __syncthreads();
    for (int i = tid; i < 4 * GPS; i += NTHR) gps[i] = F.GP()[i];
    __syncthreads();
    const __amdgpu_buffer_rsrc_t rs = __builtin_amdgcn_make_buffer_rsrc((void*)F.ws, (short)0, 0x7fffffff, 0x00020000);
    const unsigned qoff = (unsigned)((16 * wid + srow) * 1024 + scol) * 2u;
    unsigned soff[4], voff[4];
#pragma unroll
    for (int i = 0; i < 4; ++i) { soff[i] = (unsigned)((16 * (wid + 8 * i) + srow) * 256 + scol) * 2u; voff[i] = (unsigned)((16 * (wid + 8 * i) + srow) * T + scol) * 2u; }
#define RET_GLDS(uoff, loff, dst) __builtin_amdgcn_raw_ptr_buffer_load_lds(rs, (LAS unsigned*)(lds + (dst)), 16, (int)(loff), (int)(uoff), 0, 0)
#define RET_LOADS(kind, ks, b, hh, nn, nk) do { const unsigned _qk = (unsigned)((nn) * 128 * 1024 + (hh) * 256 + 32 * (ks)) * 2u, _kk = (unsigned)((nk) * 128 * 1024 + (hh) * 256 + 32 * (ks)) * 2u; \
        if ((kind) != 2) RET_GLDS((unsigned)WS_Q + _qk, qoff, (b) * BUFB + wid * 1024); \
        if ((kind) == 0) RET_GLDS((unsigned)WS_KN + _kk, qoff, (b) * BUFB + OFF_B + wid * 1024); \
        if ((kind) == 1) { const unsigned _sb = (unsigned)WS_SB + (unsigned)((((nn) >> 1) * 4 + (hh)) * 512 * 256 + 32 * (ks)) * 2u; _Pragma("unroll") for (int _i = 0; _i < 4; ++_i) \
            RET_GLDS(_sb, soff[_i], (b) * BUFB + OFF_B + (wid + 8 * _i) * 1024); } \
        if ((kind) == 2) { const unsigned _vb = (unsigned)WS_VT + (unsigned)((hh) * 512 * T + (nk) * 128 + 32 * (ks)) * 2u; _Pragma("unroll") for (int _i = 0; _i < 4; ++_i) \
            RET_GLDS(_vb, voff[_i], (b) * BUFB + OFF_B + (wid + 8 * _i) * 1024); } } while (0)
    int u = F.c;
    if (u >= 512) return;
#define RET_NOF(uu) ((((uu) >> 4) << 2) | ((((uu) >> 2) & 1) << 1) | ((((uu) >> 3) ^ ((uu) >> 8)) & 1))
    { const int h = u & 3, n = RET_NOF(u); RET_LOADS(0, 0, 0, h, n, n); }
    for (; u < 512; u += F.G) {
        const int h = u & 3, n = RET_NOF(u), t0 = n * 128; const int un = u + F.G; const bool has_next = un < 512; const int hn = un & 3, nn = RET_NOF(un);
        const bool half = (n & 1) != 0;
        f32x4 pacc[4][2];
#pragma unroll
        for (int m = 0; m < 4; ++m)
#pragma unroll
            for (int q = 0; q < 2; ++q) pacc[m][q] = (f32x4){0.f, 0.f, 0.f, 0.f};
#pragma unroll
        for (int ks = 0; ks < 8; ++ks) {
            const int b = ks & 1;
            if (ks < 7) { RET_LOADS(0, ks + 1, b ^ 1, h, n, n); RET_WAITV(2); } else { RET_LOADS(1, 0, b ^ 1, h, n, n); RET_WAITV(5); }
            RET_BAR();
            bf16x8 af[4], bf[2];
#pragma unroll
            for (int m = 0; m < 4; ++m) af[m] = *(const LAS bf16x8*)(lds + b * BUFB + (4 * wr + m) * 1024 + foff);
#pragma unroll
            for (int q = 0; q < 2; ++q) bf[q] = *(const LAS bf16x8*)(lds + b * BUFB + OFF_B + (2 * wc + q) * 1024 + foff);
            RET_WAITL0(); RET_BAR();
#pragma unroll
            for (int m = 0; m < 4; ++m)
#pragma unroll
                for (int q = 0; q < 2; ++q) pacc[m][q] = __builtin_amdgcn_mfma_f32_16x16x32_bf16(bf[q], af[m], pacc[m][q], 0, 0, 0);
            __builtin_amdgcn_sched_barrier(0);
        }
        { int l2 = lane; asm volatile("" : "+v"(l2)); const int fr = l2 & 15, fq = l2 >> 4;
#pragma unroll
        for (int m = 0; m < 4; ++m)
#pragma unroll
            for (int q = 0; q < 2; ++q) { const int r = 64 * wr + 16 * m + fr, cc = 32 * wc + 16 * q + 4 * fq; float v[4];
#pragma unroll
                for (int j = 0; j < 4; ++j) { const int dd = r - (cc + j); v[j] = dd >= 0 ? pacc[m][q][j] * gps[h * GPS + dd] : 0.f; }
                u32x2 w; w.x = pk2(v[0], v[1]); w.y = pk2(v[2], v[3]);
                *(LAS u32x2*)(lds + OFF_P + wc * 8192 + (4 * wr + m) * 1024 + swz(fr * 64 + 32 * q + 8 * fq)) = w; } }
        f32x4 acc[4][8];
#pragma unroll
        for (int m = 0; m < 4; ++m)
#pragma unroll
            for (int q = 0; q < 8; ++q) acc[m][q] = (f32x4){0.f, 0.f, 0.f, 0.f};
#pragma unroll
        for (int ks = 0; ks < 8; ++ks) {
            const int b = ks & 1;
            if (ks < 7) { RET_LOADS(1, ks + 1, b ^ 1, h, n, n); RET_WAITV(5); } else { RET_LOADS(2, 0, b ^ 1, h, n, n); RET_WAITV(4); }
            RET_BAR();
            bf16x8 af[4], bf[8];
#pragma unroll
            for (int m = 0; m < 4; ++m) af[m] = *(const LAS bf16x8*)(lds + b * BUFB + (4 * wr + m) * 1024 + foff);
#pragma unroll
            for (int q = 0; q < 8; ++q) bf[q] = *(const LAS bf16x8*)(lds + b * BUFB + OFF_B + (8 * wc + q) * 1024 + foff);
            RET_WAITL0(); RET_BAR();
#pragma unroll
            for (int m = 0; m < 4; ++m)
#pragma unroll
                for (int q = 0; q < 8; ++q) acc[m][q] = __builtin_amdgcn_mfma_f32_16x16x32_bf16(bf[q], af[m], acc[m][q], 0, 0, 0);
            __builtin_amdgcn_sched_barrier(0);
        }
        { int l3 = lane; asm volatile("" : "+v"(l3)); const int fr = l3 & 15;
#pragma unroll
        for (int m = 0; m < 4; ++m) { const float qd = gps[h * GPS + 64 * wr + 16 * m + fr + 1] * (half ? gps[h * GPS + 128] : 1.0f);
#pragma unroll
            for (int q = 0; q < 8; ++q) acc[m][q] = acc[m][q] * qd; } }
#pragma unroll
        for (int ks = 0; ks < 4; ++ks) {
            const int b = ks & 1;
            if (ks < 3) { RET_LOADS(2, ks + 1, b ^ 1, h, n, n); RET_WAITV(4); }
            else if (half) { RET_LOADS(0, 0, b ^ 1, h, n, n - 1); RET_WAITV(2); }
            else if (has_next) { RET_LOADS(0, 0, b ^ 1, hn, nn, nn); RET_WAITV(2); }
            else { RET_WAITV(0); }
            RET_BAR();
            bf16x8 af[4], bf[8];
#pragma unroll
            for (int m = 0; m < 4; ++m) af[m] = *(const LAS bf16x8*)(lds + OFF_P + ks * 8192 + (4 * wr + m) * 1024 + foff);
#pragma unroll
            for (int q = 0; q < 8; ++q) bf[q] = *(const LAS bf16x8*)(lds + b * BUFB + OFF_B + (8 * wc + q) * 1024 + foff);
            RET_WAITL0(); RET_BAR();
#pragma unroll
            for (int m = 0; m < 4; ++m)
#pragma unroll
                for (int q = 0; q < 8; ++q) acc[m][q] = __builtin_amdgcn_mfma_f32_16x16x32_bf16(bf[q], af[m], acc[m][q], 0, 0, 0);
            __builtin_amdgcn_sched_barrier(0);
        }
        if (half) {
#pragma unroll
            for (int m = 0; m < 4; ++m)
#pragma unroll
                for (int q = 0; q < 2; ++q) pacc[m][q] = (f32x4){0.f, 0.f, 0.f, 0.f};
#pragma unroll
            for (int ks = 0; ks < 8; ++ks) {
                const int b = ks & 1;
                if (ks < 7) { RET_LOADS(0, ks + 1, b ^ 1, h, n, n - 1); RET_WAITV(2); } else { RET_LOADS(2, 0, b ^ 1, h, n, n - 1); RET_WAITV(4); }
                RET_BAR();
                bf16x8 af[4], bf[2];
#pragma unroll
                for (int m = 0; m < 4; ++m) af[m] = *(const LAS bf16x8*)(lds + b * BUFB + (4 * wr + m) * 1024 + foff);
#pragma unroll
                for (int q = 0; q < 2; ++q) bf[q] = *(const LAS bf16x8*)(lds + b * BUFB + OFF_B + (2 * wc + q) * 1024 + foff);
                RET_WAITL0(); RET_BAR();
#pragma unroll
                for (int m = 0; m < 4; ++m)
#pragma unroll
                    for (int q = 0; q < 2; ++q) pacc[m][q] = __builtin_amdgcn_mfma_f32_16x16x32_bf16(bf[q], af[m], pacc[m][q], 0, 0, 0);
                __builtin_amdgcn_sched_barrier(0);
            }
            { int l6 = lane; asm volatile("" : "+v"(l6)); const int fr = l6 & 15, fq = l6 >> 4;
#pragma unroll
            for (int m = 0; m < 4; ++m)
#pragma unroll
                for (int q = 0; q < 2; ++q) { const int r = 64 * wr + 16 * m + fr, cc = 32 * wc + 16 * q + 4 * fq; float v[4];
#pragma unroll
                    for (int j = 0; j < 4; ++j) v[j] = pacc[m][q][j] * gps[h * GPS + 128 + r - (cc + j)];
                    u32x2 w; w.x = pk2(v[0], v[1]); w.y = pk2(v[2], v[3]);
                    *(LAS u32x2*)(lds + OFF_P + wc * 8192 + (4 * wr + m) * 1024 + swz(fr * 64 + 32 * q + 8 * fq)) = w; } }
            RET_WAITL0();
#pragma unroll
            for (int ks = 0; ks < 4; ++ks) {
                const int b = ks & 1;
                if (ks < 3) { RET_LOADS(2, ks + 1, b ^ 1, h, n, n - 1); RET_WAITV(4); }
                else if (has_next) { RET_LOADS(0, 0, b ^ 1, hn, nn, nn); RET_WAITV(2); }
                else { RET_WAITV(0); }
                RET_BAR();
                bf16x8 af[4], bf[8];
    #pragma unroll
                for (int m = 0; m < 4; ++m) af[m] = *(const LAS bf16x8*)(lds + OFF_P + ks * 8192 + (4 * wr + m) * 1024 + foff);
    #pragma unroll
                for (int q = 0; q < 8; ++q) bf[q] = *(const LAS bf16x8*)(lds + b * BUFB + OFF_B + (8 * wc + q) * 1024 + foff);
                RET_WAITL0(); RET_BAR();
    #pragma unroll
                for (int m = 0; m < 4; ++m)
    #pragma unroll
                    for (int q = 0; q < 8; ++q) acc[m][q] = __builtin_amdgcn_mfma_f32_16x16x32_bf16(bf[q], af[m], acc[m][q], 0, 0, 0);
                __builtin_amdgcn_sched_barrier(0);
            }
        }
        { int l4 = lane; asm volatile("" : "+v"(l4)); const int fr = l4 & 15, fq = l4 >> 4;
#pragma unroll
        for (int m = 0; m < 4; ++m) { float s1 = 0.f, s2 = 0.f;
#pragma unroll
            for (int q = 0; q < 8; ++q) { const f32x4 v = acc[m][q]; s1 += (v.x + v.y) + (v.z + v.w); s2 += (v.x * v.x + v.y * v.y) + (v.z * v.z + v.w * v.w); }
            s1 += __shfl_xor(s1, 16); s1 += __shfl_xor(s1, 32); s2 += __shfl_xor(s2, 16); s2 += __shfl_xor(s2, 32);
            if (fq == 0) red[(64 * wr + 16 * m + fr) * 4 + wc] = (f32x2){s1, s2}; }
        RET_WAITL0(); RET_BAR();
#pragma unroll
        for (int m = 0; m < 4; ++m) { const int r = 64 * wr + 16 * m + fr; const f32x2 a = red[r * 4 + 0], b2 = red[r * 4 + 1], c2 = red[r * 4 + 2], d2 = red[r * 4 + 3];
            const float mu = ((a.x + b2.x) + (c2.x + d2.x)) * (1.0f / 512.0f), ex2 = ((a.y + b2.y) + (c2.y + d2.y)) * (1.0f / 512.0f);
            const float rs = 1.0f / sqrtf(ex2 - mu * mu + EPS); const size_t rowoff = (size_t)(t0 + r) * 2048 + h * 512 + 128 * wc + 4 * fq;
#pragma unroll
            for (int q = 0; q < 8; ++q) { const u32x2 gw = *(const u32x2*)(F.Gb() + rowoff + 16 * q); const f32x4 gn = *(const f32x4*)(p.ret_gn_gain + h * 512 + 128 * wc + 16 * q + 4 * fq);
                const f32x4 v = acc[m][q]; u32x2 w;
                w.x = pk2((v.x - mu) * rs * gn.x * bflo(gw.x), (v.y - mu) * rs * gn.y * bfhi(gw.x)); w.y = pk2((v.z - mu) * rs * gn.z * bflo(gw.y), (v.w - mu) * rs * gn.w * bfhi(gw.y));
                *(u32x2*)(F.Y() + rowoff + 16 * q) = w; }
             } }
        RET_BAR();
    }
    RET_WAITV(0); RET_BAR();
#undef RET_GLDS
#undef RET_NOF
#undef RET_LOADS
}

namespace pf { constexpr int XTP = 132, OFF_RS = 42496, OFF_PT = 43008, OFF_WB = 59392, OFF_END = 124928; }
template <int W>
__device__ __forceinline__ void pf_pool(LAS unsigned char* lds, int t0, int tid) {
    using namespace pf; const LAS float* XT = (const LAS float*)lds; const LAS float* RS = (const LAS float*)(lds + OFF_RS);
    const int cp = tid & 63, tb = tid >> 6, r0 = 8 * tb, ch = 2 * cp; float s0 = 0.f, s1 = 0.f;
#pragma unroll
    for (int i = 1; i < W; ++i) { const int rr = 16 + r0 - i; const f32x2 xv = *(const LAS f32x2*)(XT + rr * XTP + ch); const float rs = RS[rr]; s0 += xv.x * rs; s1 += xv.y * rs; }
#pragma unroll
    for (int j = 0; j < 8; ++j) { const int r = r0 + j, rr = 16 + r; const f32x2 xv = *(const LAS f32x2*)(XT + rr * XTP + ch); const float rs = RS[rr]; const float a0 = xv.x * rs, a1 = xv.y * rs;
        s0 += a0; s1 += a1; const int t = t0 + r; const float ic = 1.0f / (float)((t + 1) < W ? (t + 1) : W);
        *(LAS unsigned*)(lds + OFF_PT + (ch >> 5) * 4096 + (r >> 4) * 1024 + ret::swz((r & 15) * 64 + (ch & 31) * 2)) = pk2(s0 * ic - a0, s1 * ic - a1);
        const int ro = rr - W + 1; const f32x2 xo = *(const LAS f32x2*)(XT + ro * XTP + ch); const float rso = RS[ro]; s0 -= xo.x * rso; s1 -= xo.y * rso; }
}
__device__ __forceinline__ void phase_pool_fused(Frame& F) {
    using namespace pf;
    const Params& p = F.p; LAS unsigned char* lds = F.lds; const int tid = F.tid, lane = F.lane, wid = F.wave;
    const float* X2 = F.X2(); const float* rss = F.ROWSS(); const float* g1 = F.MOD() + NIN + 2 * 1024; const float* WRg = F.WR();
    LAS float* XT = (LAS float*)lds; LAS float* RS = (LAS float*)(lds + OFF_RS);
    const int foff = ret::swz((lane & 15) * 64 + (lane >> 4) * 16);
    const int srow = lane >> 2, scol = ((lane & 3) * 8) ^ (((lane >> 5) & 1) * 16);
    const __amdgpu_buffer_rsrc_t rs_ws = __builtin_amdgcn_make_buffer_rsrc((void*)F.ws, (short)0, 0x7fffffff, 0x00020000);
    unsigned loff[2];
#pragma unroll
    for (int i = 0; i < 2; ++i) loff[i] = (unsigned)((16 * (wid + 8 * i) + srow) * 256 + scol) * 2u;
    for (int seg = F.c; seg < 256; seg += F.G) {
        const int t0 = seg * 64;
        float ss[4], lg[4][8];
#pragma unroll
        for (int m = 0; m < 4; ++m) { ss[m] = 0.f;
#pragma unroll
            for (int e = 0; e < 8; ++e) lg[m][e] = 0.f; }
        __syncthreads();
        if (tid < 80) { const int tt = t0 - 16 + tid; RS[tid] = tt >= 0 ? rstd_row(rss, tt) : 0.f; }
        f32x4 acc[4][2]; f32x4 xv[5];
#define PF_LOADX(gg, kk) do { int _tl = tid; asm volatile("" : "+v"(_tl)); _Pragma("unroll") for (int _i = 0; _i < 5; ++_i) { const int _idx = _tl + 512 * _i, _rr = _idx >> 5, _c4 = (_idx & 31) * 4; const int _tt = t0 - 16 + _rr; \
            xv[_i] = *(const f32x4*)(X2 + (size_t)(_tt < 0 ? 0 : _tt) * 1024 + 256 * (gg) + 128 * (kk) + _c4); } } while (0)
        PF_LOADX(0, 0);
#pragma unroll 1
        for (int it = 0; it < 8; ++it) {
            const int g = it >> 1, kh = it & 1;
            if (kh == 0) {
#pragma unroll
                for (int m = 0; m < 4; ++m) { acc[m][0] = (f32x4){0.f, 0.f, 0.f, 0.f}; acc[m][1] = (f32x4){0.f, 0.f, 0.f, 0.f}; } }
            {
                __syncthreads();
                int tl = tid; asm volatile("" : "+v"(tl));
#pragma unroll
                for (int i = 0; i < 5; ++i) { const int idx = tl + 512 * i, rr = idx >> 5, c4 = (idx & 31) * 4; *(LAS f32x4*)(XT + rr * XTP + c4) = xv[i]; }
#pragma unroll
                for (int kc = 0; kc < 4; ++kc)
#pragma unroll
                    for (int i = 0; i < 2; ++i)
                        __builtin_amdgcn_raw_ptr_buffer_load_lds(rs_ws, (LAS unsigned*)(lds + OFF_WB + kc * 16384 + (wid + 8 * i) * 1024), 16, (int)loff[i], (int)((unsigned)WS_WP + (unsigned)(g * 65536 + kh * 128 + 32 * kc) * 2u), 0, 0);
                { const int itn = it < 7 ? it + 1 : 7; PF_LOADX(itn >> 1, itn & 1); }
                __syncthreads();
                if (g == 0) pf_pool<2>(lds, t0, tl); else if (g == 1) pf_pool<4>(lds, t0, tl); else if (g == 2) pf_pool<8>(lds, t0, tl); else pf_pool<16>(lds, t0, tl);
                asm volatile("s_waitcnt vmcnt(5)" ::: "memory");
                __syncthreads();
#pragma unroll
                for (int kc = 0; kc < 4; ++kc) { bf16x8 af[4], bf[2];
#pragma unroll
                    for (int m = 0; m < 4; ++m) af[m] = *(const LAS bf16x8*)(lds + OFF_PT + kc * 4096 + m * 1024 + foff);
#pragma unroll
                    for (int n = 0; n < 2; ++n) bf[n] = *(const LAS bf16x8*)(lds + OFF_WB + kc * 16384 + (2 * wid + n) * 1024 + foff);
#pragma unroll
                    for (int m = 0; m < 4; ++m)
#pragma unroll
                        for (int n = 0; n < 2; ++n) acc[m][n] = __builtin_amdgcn_mfma_f32_16x16x32_bf16(bf[n], af[m], acc[m][n], 0, 0, 0); }
            }
            if (kh == 0) continue;
            { int l5 = lane; asm volatile("" : "+v"(l5)); const int fr = l5 & 15, fq = l5 >> 4;
              f32x4 x2a[2][4];
#pragma unroll
              for (int n = 0; n < 2; ++n)
#pragma unroll
                for (int m = 0; m < 4; ++m) x2a[n][m] = *(const f32x4*)(X2 + (size_t)(t0 + 16 * m + fr) * 1024 + 256 * g + 32 * wid + 16 * n + 4 * fq);
              f32x4 bva[2], sva[2], gva[2], wra[2][4], wrb[2][4];
#pragma unroll
              for (int n = 0; n < 2; ++n) { const int cg = 256 * g + 32 * wid + 16 * n + 4 * fq;
                bva[n] = *(const f32x4*)(p.pool_b + cg); sva[n] = *(const f32x4*)(p.pool_scale + cg); gva[n].x = ldv_f(g1 + cg); gva[n].y = ldv_f(g1 + cg + 1); gva[n].z = ldv_f(g1 + cg + 2); gva[n].w = ldv_f(g1 + cg + 3);
#pragma unroll
                for (int j = 0; j < 4; ++j) { wra[n][j] = *(const f32x4*)(WRg + (cg + j) * 8); wrb[n][j] = *(const f32x4*)(WRg + (cg + j) * 8 + 4); } }
#pragma unroll
              for (int n = 0; n < 2; ++n) { const int cg = 256 * g + 32 * wid + 16 * n + 4 * fq;
                const f32x4 bv = bva[n], sv = sva[n], gv = gva[n];
                f32x4 wr0[4], wr1[4];
#pragma unroll
                for (int j = 0; j < 4; ++j) { wr0[j] = wra[n][j]; wr1[j] = wrb[n][j]; }
#pragma unroll
                for (int m = 0; m < 4; ++m) { const size_t o = (size_t)(t0 + 16 * m + fr) * 1024 + cg;
                    const f32x4 xo = x2a[n][m] + gv * ((acc[m][n] + bv) * sv);
                    *(f32x4*)(p.out + o) = xo; *(unsigned*)((unsigned char*)F.XB() + o) = pk4f8(xo.x, xo.y, xo.z, xo.w);
                    ss[m] += (xo.x * xo.x + xo.y * xo.y) + (xo.z * xo.z + xo.w * xo.w);
                    lg[m][0] += xo.x * wr0[0].x + xo.y * wr0[1].x + xo.z * wr0[2].x + xo.w * wr0[3].x; lg[m][1] += xo.x * wr0[0].y + xo.y * wr0[1].y + xo.z * wr0[2].y + xo.w * wr0[3].y;
                    lg[m][2] += xo.x * wr0[0].z + xo.y * wr0[1].z + xo.z * wr0[2].z + xo.w * wr0[3].z; lg[m][3] += xo.x * wr0[0].w + xo.y * wr0[1].w + xo.z * wr0[2].w + xo.w * wr0[3].w;
                    lg[m][4] += xo.x * wr1[0].x + xo.y * wr1[1].x + xo.z * wr1[2].x + xo.w * wr1[3].x; lg[m][5] += xo.x * wr1[0].y + xo.y * wr1[1].y + xo.z * wr1[2].y + xo.w * wr1[3].y;
                    lg[m][6] += xo.x * wr1[0].z + xo.y * wr1[1].z + xo.z * wr1[2].z + xo.w * wr1[3].z; lg[m][7] += xo.x * wr1[0].w + xo.y * wr1[1].w + xo.z * wr1[2].w + xo.w * wr1[3].w; } } }
        }
#undef PF_LOADX
#pragma unroll
        for (int m = 0; m < 4; ++m) { ss[m] += __shfl_xor(ss[m], 16); ss[m] += __shfl_xor(ss[m], 32);
#pragma unroll
            for (int e = 0; e < 8; ++e) { lg[m][e] += __shfl_xor(lg[m][e], 16); lg[m][e] += __shfl_xor(lg[m][e], 32); } }
        __syncthreads();
        { LAS float* red = (LAS float*)lds; int l6 = lane; asm volatile("" : "+v"(l6)); const int fr = l6 & 15;
          if ((l6 >> 4) == 0) {
#pragma unroll
            for (int m = 0; m < 4; ++m) { LAS float* q = red + ((16 * m + fr) * 8 + wid) * 12; q[0] = ss[m];
#pragma unroll
                for (int e = 0; e < 8; ++e) q[1 + e] = lg[m][e]; } }
          LAS int* cnt = (LAS int*)(lds + OFF_RS);
          if (tid < 8) cnt[tid] = 0;
          __syncthreads();
          if (tid < 64) { float sq = 0.f, a[8];
#pragma unroll
            for (int e = 0; e < 8; ++e) a[e] = 0.f;
#pragma unroll
            for (int w = 0; w < 8; ++w) { const LAS float* q = red + (tid * 8 + w) * 12; sq += q[0];
#pragma unroll
                for (int e = 0; e < 8; ++e) a[e] += q[1 + e]; }
            const int t = t0 + tid; const float rs = rstd_of(sq); float lgt[8]; F.RSTD3()[t] = rs;
#pragma unroll
            for (int e = 0; e < 8; ++e) lgt[e] = rs * a[e] + ldv_f(F.BIAS_R() + e);
            int e0 = 0; float l0 = lgt[0];
#pragma unroll
            for (int e = 1; e < 8; ++e) if (lgt[e] > l0) { l0 = lgt[e]; e0 = e; }
            int e1 = -1; float l1 = -3.0e38f;
#pragma unroll
            for (int e = 0; e < 8; ++e) if (e != e0 && lgt[e] > l1) { l1 = lgt[e]; e1 = e; }
            const float g0 = 1.0f / (1.0f + __expf(l1 - l0));
            F.TOPE()[t * 2] = e0; F.TOPE()[t * 2 + 1] = e1; F.TOPG()[t * 2] = g0; F.TOPG()[t * 2 + 1] = 1.0f - g0;
            atomicAdd((int*)(cnt + e0), 1); atomicAdd((int*)(cnt + e1), 1); }
          __syncthreads();
          if (tid < 8) F.CNT()[seg * 8 + tid] = cnt[tid]; }
    }
    __syncthreads();
}

__device__ __forceinline__ void phase_route2(Frame& F) {
    const int tid = F.tid;
    LAS int* cn = (LAS int*)F.lds;
    LAS int* part = cn + 2048;
    LAS int* tot = part + 512;
    LAS int* te = tot + 32;
    __syncthreads();
    for (int i = tid; i < 2048; i += NTHR) cn[i] = ldv_i(F.CNT() + i);
    __syncthreads();
    { const int e = tid & 7, pq = tid >> 3; part[pq * 8 + e] = cn[(4 * pq) * 8 + e] + cn[(4 * pq + 1) * 8 + e] + cn[(4 * pq + 2) * 8 + e] + cn[(4 * pq + 3) * 8 + e]; }
    __syncthreads();
    if (tid < 8) { int run = 0; for (int q = 0; q < 64; ++q) { const int v = part[q * 8 + tid]; part[q * 8 + tid] = run; run += v; } tot[tid] = run; }
    __syncthreads();
    { const int e = tid & 7, pq = tid >> 3; int run = part[pq * 8 + e];
#pragma unroll
        for (int j = 0; j < 4; ++j) { const int v = cn[(4 * pq + j) * 8 + e]; cn[(4 * pq + j) * 8 + e] = run; run += v; } }
    if (tid == 0) { int sp = 0; for (int e = 0; e < 8; ++e) { const int pd = (tot[e] + 255) / 256 * 256; tot[8 + e] = sp; tot[16 + e] = pd; sp += pd; } tot[24] = sp / 256; }
    __syncthreads();
    for (int seg = F.c; seg < 256; seg += F.G) {
        int e = -1; if (tid < 128) e = ldv_i(F.TOPE() + seg * 128 + tid);
        int rank = 0;
#pragma unroll
        for (int ee = 0; ee < 8; ++ee) { const unsigned long long m = __ballot(e == ee); if (e == ee) rank = __popcll(m & ((1ull << F.lane) - 1ull)); if (tid == 0) te[ee] = __popcll(m); }
        __syncthreads();
        if (tid < 128) { if (tid >= 64) rank += te[e];
            const int pos = tot[8 + e] + cn[seg * 8 + e] + rank, idx = seg * 128 + tid;
            const float gt = ldv_f(F.TOPG() + idx), rsd = ldv_f(F.RSTD3() + (idx >> 1));
            F.BUFTOK()[pos] = idx >> 1; F.BUFGATE()[pos] = gt; F.BUFRS()[pos] = rsd * (1.0f / F8_WSCALE); F.POS()[idx] = pos; }
        __syncthreads();
    }
    if (F.c < 8) { const int e = F.c; const int b0 = tot[8 + e] + tot[e], b1 = tot[8 + e] + tot[16 + e]; for (int r = b0 + tid; r < b1; r += NTHR) { F.BUFTOK()[r] = 0; F.BUFGATE()[r] = 0.f; F.BUFRS()[r] = 0.f; } }
    if (F.c == (8 % F.G)) { if (tid < NBLK) { int e = 0; for (int q = 0; q < 8; ++q) if (tid * 256 >= tot[8 + q] + tot[16 + q]) ++e; F.BLKE()[tid] = e < 7 ? e : 7; } if (tid == NBLK) F.BLKE()[NBLK] = tot[24]; }
}

__device__ __forceinline__ void phase_final(Frame& F) {
    const Params& p = F.p; const int gw = F.c * NWAVE + F.wave, NGW = F.G * NWAVE, lane = F.lane; const float* g2 = F.MOD() + NIN + 5 * 1024;
    const int nused = ldv_i(F.BLKE() + NBLK); const int ntail = (F.G == 256) ? (nused - 128) * 4 : 0; const int spu = ntail > 0 ? moe_tail_spu(ntail) : 1;
    f32x4 gv[4], fg[4];
#pragma unroll
    for (int j = 0; j < 4; ++j) { gv[j] = *((const f32x4*)g2 + lane + 64 * j); fg[j] = *((const f32x4*)p.final_norm_gain + lane + 64 * j); }
    for (int row = 2 * gw; row < T; row += 2 * NGW) {
        f32x4 xv[2][4]; f32x4 fa[2][4];
#pragma unroll
        for (int r = 0; r < 2; ++r) {
            const f32x4* xr = (const f32x4*)(p.out + (size_t)(row + r) * D) + lane;
#pragma unroll
            for (int j = 0; j < 4; ++j) { xv[r][j] = xr[64 * j]; fa[r][j] = (f32x4){0.f, 0.f, 0.f, 0.f}; }
#pragma unroll
            for (int a = 0; a < 2; ++a) { const int pos = ldv_i(F.POS() + (row + r) * 2 + a); const int blk = pos >> 8;
                if (ntail > 0 && blk >= 128) {
#pragma unroll
                    for (int j = 0; j < 4; ++j) { const float* sl = F.YBB() + (size_t)(((blk - 128) * 4 + j) * spu) * 65536 + (size_t)(pos & 255) * 256 + 4 * lane;
                        for (int q = 0; q < spu; ++q) fa[r][j] = fa[r][j] + *(const f32x4*)(sl + (size_t)q * 65536); }
                } else { const u32x2* y = (const u32x2*)(F.YB() + (size_t)pos * D) + lane;
#pragma unroll
                    for (int j = 0; j < 4; ++j) { const u32x2 w = y[64 * j]; fa[r][j] = fa[r][j] + (f32x4){bflo(w.x), bfhi(w.x), bflo(w.y), bfhi(w.y)}; } } } }
#pragma unroll
        for (int r = 0; r < 2; ++r) { f32x4 v[4]; float s = 0.f;
#pragma unroll
            for (int j = 0; j < 4; ++j) { v[j] = xv[r][j] + gv[j] * fa[r][j]; s += (v[j].x * v[j].x + v[j].y * v[j].y) + (v[j].z * v[j].z + v[j].w * v[j].w); }
            s = wave_sum(s); const float rs = rstd_of(s);
            f32x4* o = (f32x4*)(p.out + (size_t)(row + r) * D) + lane;
#pragma unroll
            for (int j = 0; j < 4; ++j) o[64 * j] = v[j] * rs * fg[j]; }
    }
}

template <class Desc, class Epi> __device__ __forceinline__ void run_gemm(Frame& F, const Desc& Dc, const Epi& E) {
    gemm_fast(F.lds, F.ws, Dc, E, F.c, F.G, F.wave);
}

__device__ __forceinline__ void phase_g1(Frame& F) {
    { DescG1a<false> d{F.XB(), F.WIN(), nullptr, 1024, 1024, 16, 128, 128}; EpiG1a<false> e{F.ROWSS(), F.BIAS_IN(), F.TABA(), F.TABB(), F.Q(), F.KN(), F.Gb(), F.GP(), F.KDT()}; run_gemm(F, d, e); }
    { DescG1a<true> d{F.XB(), F.WIN(), nullptr, 1024, 1024, 16, 128, 128}; EpiG1a<true> e{F.ROWSS(), F.BIAS_IN(), F.TABA(), F.TABB(), F.Q(), F.KN(), F.Gb(), F.GP(), F.KDT()}; run_gemm(F, d, e); }
    { DescG1b d{F.XB(), F.WIN(), nullptr, 1024, 1024, 16, 128, 128}; EpiG1b e{F.ROWSS(), F.BIAS_IN(), F.TABA(), F.TABB(), F.GP(), F.KDT(), F.VT()}; run_gemm(F, d, e); }
}
__device__ __forceinline__ void phase_kv(Frame& F) { DescKV d{F.VT(), F.KDT(), nullptr, T, T, 4, 128, 128}; EpiKV e{F.SB()}; run_gemm(F, d, e); }
__device__ __forceinline__ void phase_outproj(Frame& F) {
    DescOut d{F.Y(), F.WOUT(), nullptr, 2048, 2048, 32, 128, 128}; EpiResid e{F.p.x, F.p.out, F.XB(), F.ROWSS(), F.MOD() + 2 * 1024, nullptr, nullptr, 1.0f}; run_gemm(F, d, e); }
__device__ __forceinline__ void phase_ffn_up(Frame& F) {
    DescFfnUp d{F.XB(), F.WGU(), nullptr, 1024, 1024, 16, 128, 128}; EpiSwiglu<true, true> e{F.ROWSS(), nullptr, F.BIAS_GU(), F.H1(), DFF, 5632, 2 * 5632}; run_gemm(F, d, e);
    if (F.G == 256 && F.c >= 128) {
        frame_fresh(F); px_tables(F); px_gu_item(F, (F.c - 128) * NWAVE + F.wave, F.lane); __syncthreads(); } }
__device__ __forceinline__ void phase_ffn_down(Frame& F) {
    DescFfnDown d{F.H1(), F.WD(), nullptr, 64, 64, 22, 32768, 32768};     EpiResid e{F.p.out, F.X2(), nullptr, F.ROWSS(), F.MOD() + 5 * 1024, nullptr, nullptr, 1.0f / (F8_DSCALE * F8_HSCALE)}; run_gemm(F, d, e); }
__device__ __forceinline__ void phase_moe_up(Frame& F) {
    DescMoeUp d{F.XB(), F.WMGU(), F.BUFTOK(), 512, 512, 8, 128, 128, F.BLKE()}; EpiSwiglu<true, true> e{F.ROWSS(), F.BUFRS(), F.BIAS_MGU(), F.H1M(), DFE, 57344, 262144}; run_gemm(F, d, e); }
__device__ __forceinline__ void phase_moe_down(Frame& F) {
    DescMoeDown d{F.H1M(), F.WMD(), nullptr, 64, 64, 28, 32768, 32768, F.BLKE(), F.G}; EpiMoeDown e{F.BUFGATE(), F.YB(), F.YBB()}; run_gemm(F, d, e); }

#define XB_TMO      128
#define XB_XCNT(j)  (256  + 64 * (j))
#define XB_XSUB(j)  (1280 + 64 * (j))
#define XB_XGEN(j)  (2304 + 64 * (j))
#define XB_TOP      3328
#define XB_TOPGEN   3392
#define XCD_BAR_WORDS 3456
#define XB_SPIN_CAP (1u << 18)
__device__ __forceinline__ unsigned xb_ld(unsigned* p)              { return __hip_atomic_load(p, __ATOMIC_RELAXED, __HIP_MEMORY_SCOPE_AGENT); }
__device__ __forceinline__ unsigned xb_add(unsigned* p, unsigned v) { return __hip_atomic_fetch_add(p, v, __ATOMIC_RELAXED, __HIP_MEMORY_SCOPE_AGENT); }
__device__ __forceinline__ unsigned xb_xcc_id() { return (unsigned)__builtin_amdgcn_s_getreg((3 << 11) | 20) & 0xFu; }
#define XB_SPIN(cond, bar) do { unsigned _sp = 0; while (cond) { __builtin_amdgcn_s_sleep(1); \
    if ((++_sp & 255u) == 0u) { if (xb_ld(&(bar)[XB_TMO])) break; if (_sp > XB_SPIN_CAP) { atomicAdd(&(bar)[XB_TMO], 1u); break; } } } } while (0)
struct XcdBarrier { unsigned* bar; unsigned x; volatile LAS unsigned* st; int wave; };
__device__ __forceinline__ XcdBarrier xcd_barrier_post(unsigned* bar, volatile LAS unsigned* st, int wave) {
    XcdBarrier b; b.bar = bar; b.x = xb_xcc_id(); b.st = st; b.wave = wave;
    if (wave == 0 && lane_id() == 0) (void)xb_add(&bar[XB_XCNT(b.x)], 1u);
    return b;
}
__device__ __forceinline__ void xcd_barrier_complete(unsigned* bar, unsigned x, unsigned& nloc, unsigned& nx) {
    const unsigned G = gridDim.x * gridDim.y * gridDim.z;
    unsigned sum, cnt, mine, sp = 0u;
    for (;;) {
        sum = 0u; cnt = 0u; mine = 0u;
#pragma unroll
        for (unsigned j = 0; j < 16; ++j) { const unsigned c = xb_ld(&bar[XB_XCNT(j)]); sum += c; cnt += (c > 0u) ? 1u : 0u; mine = (j == x) ? c : mine; }
        if (sum == G) break;
        __builtin_amdgcn_s_sleep(1);
        if ((++sp & 255u) == 0u) { if (xb_ld(&bar[XB_TMO])) break; if (sp > XB_SPIN_CAP) { atomicAdd(&bar[XB_TMO], 1u); break; } }
    }
    nloc = mine > 0u ? mine : 1u; nx = cnt > 0u ? cnt : 1u;
}
__device__ __forceinline__ void xcd_barrier(const XcdBarrier& b) {
    asm volatile("s_waitcnt vmcnt(0)" ::: "memory");
    __syncthreads();
    if (b.wave == 0 && lane_id() == 0) {
        unsigned* bar = b.bar;
        __builtin_amdgcn_s_waitcnt(0);
        unsigned nloc = b.st[0], nx = b.st[1];
        if (nloc == 0u) { xcd_barrier_complete(bar, b.x, nloc, nx); b.st[0] = nloc; b.st[1] = nx; }
        const unsigned old = xb_add(&bar[XB_XSUB(b.x)], 1u);
        const unsigned gen = old / nloc;
        if (old + 1u == (gen + 1u) * nloc) {
            __builtin_amdgcn_fence(__ATOMIC_RELEASE, "agent");
            asm volatile("s_waitcnt vmcnt(0)" ::: "memory");
            const unsigned og = xb_add(&bar[XB_TOP], 1u);
            const unsigned tg = og / nx;
            if (og + 1u == (tg + 1u) * nx) xb_add(&bar[XB_TOPGEN], 1u);
            else XB_SPIN(xb_ld(&bar[XB_TOPGEN]) == tg, bar);
            __builtin_amdgcn_fence(__ATOMIC_ACQUIRE, "agent");
            xb_add(&bar[XB_XGEN(b.x)], 1u);
            asm volatile("s_waitcnt vmcnt(0)" ::: "memory");
        } else {
            XB_SPIN(xb_ld(&bar[XB_XGEN(b.x)]) == gen, bar);
            __builtin_amdgcn_fence(__ATOMIC_ACQUIRE, "agent");
            asm volatile("s_waitcnt vmcnt(0)" ::: "memory");
        }
    }
    __syncthreads();
}

constexpr int LDSCTL_OFF = 131072;
__global__ void __launch_bounds__(NTHR, 2) k_mega(Params p) {
    extern __shared__ __attribute__((aligned(16))) unsigned char lds_raw[];
    Frame F; frame_init(F, p, (LAS unsigned char*)lds_raw, (int)blockIdx.x, (int)gridDim.x);
    for (int u = F.tid; u < (LDS_BYTES - LDSCTL_OFF) / 4; u += NTHR) ((LAS unsigned*)(F.lds + LDSCTL_OFF))[u] = 0u;
    __syncthreads();
    const XcdBarrier bar = xcd_barrier_post((unsigned*)(p.ws + CT_BAR), (volatile LAS unsigned*)(F.lds + LDSCTL_OFF + 32), F.wave);
#define GRID_BAR() xcd_barrier(bar)

    frame_fresh(F); phase_p0(F); GRID_BAR();
    frame_fresh(F); phase_p1(F); GRID_BAR();
    frame_fresh(F); phase_g1(F); GRID_BAR();
    frame_fresh(F); phase_kv(F); GRID_BAR();
    frame_fresh(F); phase_scan(F); GRID_BAR();
    frame_fresh(F); phase_ret_fast(F); GRID_BAR();
    frame_fresh(F); phase_outproj(F); GRID_BAR();
    frame_fresh(F); phase_ffn_up(F); GRID_BAR();
    frame_fresh(F); phase_ffn_down(F); GRID_BAR();
    if ((F.c >> 3) & 1) { frame_fresh(F); phase_px(F); __syncthreads(); frame_fresh(F); phase_pool_fused(F); } else { frame_fresh(F); phase_pool_fused(F); frame_fresh(F); phase_px(F); }
    GRID_BAR();
    frame_fresh(F); phase_route2(F); GRID_BAR();
    frame_fresh(F); phase_moe_up(F); GRID_BAR();
    frame_fresh(F); phase_moe_down(F); GRID_BAR();
    frame_fresh(F); phase_final(F);
#undef GRID_BAR
}

extern "C" void kernel_launch(void* const* d_in, const int* in_sizes, int n_in, void* d_out, int out_size, void* d_ws, size_t ws_size, hipStream_t stream) {
    static int grid = 0;
    if (grid == 0) {
        if (n_in != 19 || out_size != T * D || ws_size < WS_END) { fprintf(stderr, "kernel_launch: unexpected shapes (n_in %d out %d ws %zu)\n", n_in, out_size, ws_size); grid = -1; return; }
        int dev = 0, cus = 0, per_cu = 0;
        if (hipGetDevice(&dev) != hipSuccess || hipDeviceGetAttribute(&cus, hipDeviceAttributeMultiprocessorCount, dev) != hipSuccess) { grid = -1; return; }
        if (hipFuncSetAttribute((const void*)k_mega, hipFuncAttributeMaxDynamicSharedMemorySize, LDS_BYTES) != hipSuccess) { fprintf(stderr, "kernel_launch: hipFuncSetAttribute failed\n"); grid = -1; return; }
        if (hipOccupancyMaxActiveBlocksPerMultiprocessor(&per_cu, (const void*)k_mega, NTHR, LDS_BYTES) != hipSuccess || per_cu < 1) { fprintf(stderr, "kernel_launch: occupancy query says %d blocks per CU\n", per_cu); (void)hipGetLastError(); grid = -1; return; }
        grid = cus * (per_cu < 1 ? 1 : 1);
    }
    if (grid < 0) return;
    Params p{};
    const float** pp = (const float**)&p;
    for (int i = 0; i < 19; ++i) pp[i] = (const float*)d_in[i];
    p.out = (float*)d_out; p.ws = (unsigned char*)d_ws;
    (void)hipMemsetAsync((char*)d_ws + WS_CTL, 0, 64 * KiB, stream);
    void* args[] = {&p};
    hipError_t e = hipLaunchCooperativeKernel((const void*)k_mega, dim3(grid), dim3(NTHR), args, LDS_BYTES, stream);
    if (e != hipSuccess) fprintf(stderr, "kernel_launch: cooperative launch failed: %s (grid %d)\n", hipGetErrorString(e), grid);
}
```

```cpp
#include <hip/hip_runtime.h>
#include <cstdio>

#define GAS __attribute__((address_space(1)))
#define LAS __attribute__((address_space(3)))
typedef unsigned short bf16_t;
typedef short bf16x8 __attribute__((ext_vector_type(8)));
typedef float f32x4 __attribute__((ext_vector_type(4)));
typedef float f32x2 __attribute__((ext_vector_type(2)));
typedef unsigned u32x4 __attribute__((ext_vector_type(4)));
typedef int i32x4 __attribute__((ext_vector_type(4)));
typedef unsigned u32x2 __attribute__((ext_vector_type(2)));

#ifndef FAST_GEMM
#define FAST_GEMM 1
#endif

constexpr int T = 16384, D = 1024, NH = 4, DK = 256, DV = 512, CH = 128, NCH = 128;
constexpr int NIN = 6144, DFF = 2816, NE = 8, DFE = 3584, CAP = 34816, NBLK = 136;
constexpr float EPS = 1e-6f;
constexpr int GPS = 260, RC = 256, NRC = 64;
constexpr int NTHR = 512, NWAVE = 8;

constexpr size_t KiB = 1024, MiB = 1u << 20;
constexpr size_t WS_CTL = 0, CTL_BYTES = 1 * MiB;
constexpr size_t CT_BAR = 16 * KiB;
constexpr size_t CT_MOD = 64 * KiB;
constexpr size_t CT_BIAS_R = 158 * KiB;
constexpr size_t WS_ROWSSP = 2 * MiB;
constexpr size_t WS_MODP = 3 * MiB;
constexpr size_t CT_BIAS_IN = 3584 * KiB;
constexpr size_t CT_BIAS_GU = 3584 * KiB + 96 * KiB;
constexpr size_t CT_BIAS_MGU = 36 * MiB + 512 * KiB;
constexpr size_t WS_TABA = 1 * MiB;
constexpr size_t WS_TABB = WS_TABA + 128 * KiB;
constexpr size_t WS_GP = WS_TABB + 128 * KiB;
constexpr size_t WS_WR = WS_GP + 8 * KiB;
constexpr size_t WS_TOPE = WS_WR + 32 * KiB;
constexpr size_t WS_TOPG = WS_TOPE + 128 * KiB;
constexpr size_t WS_CNT = WS_TOPG + 128 * KiB;
constexpr size_t WS_BUFTOK = WS_CNT + 8 * KiB;
constexpr size_t WS_BUFGATE = WS_BUFTOK + 136 * KiB;
constexpr size_t WS_POS = WS_BUFGATE + 136 * KiB;
constexpr size_t WS_BLKE = WS_POS + 128 * KiB;
constexpr size_t WS_RSTD3 = 256 * KiB;
constexpr size_t WS_BUFRS = 320 * KiB;
constexpr size_t WS_WIN = 4 * MiB;
constexpr size_t WS_WOUT = 16 * MiB;
constexpr size_t WS_WGU = 20 * MiB;
constexpr size_t WS_WD = 31 * MiB;
constexpr size_t WS_WP = 37 * MiB;
constexpr size_t WS_XB = 38 * MiB;
constexpr size_t WS_Q = 70 * MiB;
constexpr size_t WS_KN = 102 * MiB;
constexpr size_t WS_KDT = 134 * MiB;
constexpr size_t WS_VT = 166 * MiB;
constexpr size_t WS_G = 230 * MiB;
constexpr size_t WS_SB = 294 * MiB;
constexpr size_t WS_Y = 422 * MiB;
constexpr size_t WS_H1 = 70 * MiB;
constexpr size_t WS_PB = 158 * MiB;
constexpr size_t WS_X2 = 158 * MiB;
constexpr size_t WS_H1M = 70 * MiB;
constexpr size_t WS_WMGU = 308 * MiB;
constexpr size_t WS_WMD = 456 * MiB;
constexpr size_t WS_YB = 308 * MiB;
constexpr size_t WS_YBB = 4 * MiB;
constexpr size_t WS_END = 512 * MiB;
static_assert(WS_BUFRS + 136 * KiB <= WS_TABA && WS_BLKE + 4 * KiB <= WS_ROWSSP && WS_MODP + 8 * 12288 * 4 <= CT_BIAS_IN && CT_BIAS_GU + 4 * 5632 * 4 <= WS_WIN, "small region");
static_assert(WS_YBB + (size_t)224 * 65536 * 4 <= WS_H1M && WS_H1M + (size_t)CAP * DFE * 2 <= WS_WMGU && WS_YB + (size_t)CAP * D * 4 <= WS_WMD && WS_WMD + (size_t)NE * D * DFE * 2 <= WS_END, "moe map");
static_assert(WS_Y + (size_t)T * 2048 * 2 <= WS_END && WS_SB + (size_t)128 * 4 * 512 * 256 * 2 <= WS_Y, "ret map");

constexpr int LDS_BYTES = 147456;

struct Params {
    const float *x, *c, *ada_w, *ada_b, *norm_gain, *ret_w_in, *ret_gn_gain, *ret_w_out, *ffn_w_gate, *ffn_w_up, *ffn_w_down,
        *pool_w, *pool_b, *pool_scale, *moe_router, *moe_w_gate, *moe_w_up, *moe_w_down, *final_norm_gain;
    float* out; unsigned char* ws;
};

__device__ __forceinline__ unsigned f2bf(float f) { unsigned u = __builtin_bit_cast(unsigned, f); return (u + 0x7fffu + ((u >> 16) & 1u)) >> 16; }
typedef __bf16 bf16x2_t __attribute__((ext_vector_type(2)));
__device__ __forceinline__ unsigned pk2(float lo, float hi) { const f32x2 v = {lo, hi}; return __builtin_bit_cast(unsigned, __builtin_convertvector(v, bf16x2_t)); }
constexpr float F8_WSCALE = 32.0f, F8_DSCALE = 64.0f, F8_HSCALE = 4.0f;
__device__ __forceinline__ unsigned pk4f8(float a, float b, float c, float d) { int w = __builtin_amdgcn_cvt_pk_fp8_f32(a, b, 0, false); w = __builtin_amdgcn_cvt_pk_fp8_f32(c, d, w, true); return (unsigned)w; }
__device__ __forceinline__ float bf2f(unsigned b) { return __builtin_bit_cast(float, b << 16); }
__device__ __forceinline__ float bflo(unsigned w) { return __builtin_bit_cast(float, w << 16); }
__device__ __forceinline__ float bfhi(unsigned w) { return __builtin_bit_cast(float, w & 0xffff0000u); }
__device__ __forceinline__ float silu_f(float v) { return v * __builtin_amdgcn_rcpf(1.0f + __expf(-v)); }
__device__ __forceinline__ float rstd_of(float ss) { return __builtin_amdgcn_rsqf(ss * (1.0f / 1024.0f) + EPS); }
__device__ __forceinline__ float rstd_row(const float* rssp, int t) {
    const f32x4* q = (const f32x4*)(rssp + (size_t)t * 16); const f32x4 a = q[0], b = q[1], c = q[2], d = q[3];
    const float s = (((a.x + a.y) + (a.z + a.w)) + ((b.x + b.y) + (b.z + b.w))) + (((c.x + c.y) + (c.z + c.w)) + ((d.x + d.y) + (d.z + d.w)));
    return __builtin_amdgcn_rsqf(s * (1.0f / 1024.0f) + EPS);
}
__device__ __forceinline__ float wave_sum(float v) {
#pragma unroll
    for (int o = 1; o < 64; o <<= 1) v += __shfl_xor(v, o);
    return v;
}
__device__ __forceinline__ float ldv_f(const float* p) { return __builtin_bit_cast(float, __hip_atomic_load((const unsigned*)p, __ATOMIC_RELAXED, __HIP_MEMORY_SCOPE_AGENT)); }
__device__ __forceinline__ int ldv_i(const int* p) { return __hip_atomic_load(p, __ATOMIC_RELAXED, __HIP_MEMORY_SCOPE_AGENT); }
__device__ __forceinline__ float bias_sum(const float* b, int idx, int s1, int s2) { return (ldv_f(b + idx) + ldv_f(b + s1 + idx)) + (ldv_f(b + s2 + idx) + ldv_f(b + s2 + s1 + idx)); }
__device__ __forceinline__ void rstd_row_ld(const float* rssp, int t, float (&r)[16]) { const f32x4* q = (const f32x4*)(rssp + (size_t)t * 16);
#pragma unroll
    for (int i = 0; i < 4; ++i) { const f32x4 v = q[i]; r[4 * i] = v.x; r[4 * i + 1] = v.y; r[4 * i + 2] = v.z; r[4 * i + 3] = v.w; } }
__device__ __forceinline__ float rstd_row_fin(const float (&r)[16]) {
    const float s = (((r[0] + r[1]) + (r[2] + r[3])) + ((r[4] + r[5]) + (r[6] + r[7]))) + (((r[8] + r[9]) + (r[10] + r[11])) + ((r[12] + r[13]) + (r[14] + r[15])));
    return __builtin_amdgcn_rsqf(s * (1.0f / 1024.0f) + EPS); }
__device__ __forceinline__ void bias_sum_ld(const float* b, int idx, int s1, int s2, float (&r)[16]) { r[0] = ldv_f(b + idx); r[1] = ldv_f(b + s1 + idx); r[2] = ldv_f(b + s2 + idx); r[3] = ldv_f(b + s2 + s1 + idx); }
__device__ __forceinline__ float bias_sum_fin(const float (&r)[16]) { return (r[0] + r[1]) + (r[2] + r[3]); }

__device__ __forceinline__ int lane_id() { int l; asm volatile("v_mbcnt_lo_u32_b32 %0, -1, 0\n\tv_mbcnt_hi_u32_b32 %0, -1, %0" : "=v"(l)); return l; }

struct Unit { const bf16_t* A; const bf16_t* B; int pm, pn, aux, rowbase, nt; };

__device__ __forceinline__ void tile_order(int L, int nM, int nN, int& pm, int& pn) {
    const int nwg = nM * nN; int wgid = L;
    { const int q = nwg / 8, r = nwg % 8, xcd = wgid % 8, off = wgid / 8; wgid = (xcd < r ? xcd * (q + 1) : r * (q + 1) + (xcd - r) * q) + off; }
    const int nig = 8 * nN, gid = wgid / nig, fm = gid * 8, gsz = (nM - fm) < 8 ? (nM - fm) : 8;
    pm = fm + ((wgid % nig) % gsz); pn = (wgid % nig) / gsz;
}

template <bool GATE> struct DescG1a {
    static constexpr bool GATHER = false; static constexpr bool FP8 = false;
    const bf16_t* xb; const bf16_t* win; const int* tok; int lda, ldb, nt, ksa, ksb;
    __device__ __forceinline__ bool get(int L, Unit& u) const {
        if (L >= 64 * 8) return false; tile_order(L, 64, 8, u.pm, u.pn); if (GATE) u.pn += 8;
        const int wrow = u.pn < 8 ? u.pn * 256 : (u.pn + 8) * 256;
        u.A = xb + (size_t)u.pm * 256 * 1024; u.B = win + (size_t)wrow * 1024; u.aux = wrow; u.rowbase = u.pm * 256; u.nt = nt; return true; }
};
struct DescG1b {
    static constexpr bool GATHER = false; static constexpr bool FP8 = false;
    const bf16_t* xb; const bf16_t* win; const int* tok; int lda, ldb, nt, ksa, ksb;
    __device__ __forceinline__ bool get(int L, Unit& u) const {
        if (L >= 8 * 64) return false; tile_order(L, 8, 64, u.pm, u.pn); u.pm += 4;
        u.A = win + (size_t)(1024 + 256 * u.pm) * 1024; u.B = xb + (size_t)u.pn * 256 * 1024; u.aux = 0; u.rowbase = 0; u.nt = nt; return true; }
};
struct DescKV {
    static constexpr bool GATHER = false; static constexpr bool FP8 = false;
    const bf16_t* vt; const bf16_t* kdt; const int* tok; int lda, ldb, nt, ksa, ksb;
    __device__ __forceinline__ bool get(int L, Unit& u) const {
        if (L >= (NRC - 1) * 8) return false; const int mt = L & 1, h = (L >> 1) & 3, n = L >> 3;
        u.A = vt + (size_t)(h * 512 + 256 * mt) * T + n * RC; u.B = kdt + (size_t)(h * 256) * T + n * RC;
        u.pm = mt; u.pn = 0; u.aux = (n * 4 + h) * 2 + mt; u.rowbase = 0; u.nt = nt; return true; }
};
struct DescOut {
    static constexpr bool GATHER = false; static constexpr bool FP8 = false;
    const bf16_t* y; const bf16_t* w; const int* tok; int lda, ldb, nt, ksa, ksb;
    __device__ __forceinline__ bool get(int L, Unit& u) const {
        if (L >= 256) return false; tile_order(L, 64, 4, u.pm, u.pn);
        u.A = y + (size_t)u.pm * 256 * 2048; u.B = w + (size_t)u.pn * 256 * 2048; u.aux = 0; u.rowbase = u.pm * 256; u.nt = nt; return true; }
};
struct DescFfnUp {
    static constexpr bool GATHER = false; static constexpr bool FP8 = false;
    const bf16_t* xb; const bf16_t* w; const int* tok; int lda, ldb, nt, ksa, ksb;
    __device__ __forceinline__ bool get(int L, Unit& u) const {
        if (L >= 64 * 22) return false; tile_order(L, 64, 22, u.pm, u.pn);
        u.A = xb + (size_t)u.pm * 256 * 1024; u.B = w + (size_t)u.pn * 256 * 1024; u.aux = 256 * u.pn; u.rowbase = u.pm * 256; u.nt = nt; return true; }
};
struct DescFfnDown {
    static constexpr bool GATHER = false; static constexpr bool FP8 = true;
    const bf16_t* h1; const bf16_t* w; const int* tok; int lda, ldb, nt, ksa, ksb;
    __device__ __forceinline__ bool get(int L, Unit& u) const {
        if (L >= 256) return false; tile_order(L, 64, 4, u.pm, u.pn);
        u.A = h1 + (size_t)u.pm * 128 * DFF; u.B = w + (size_t)u.pn * 128 * DFF; u.aux = 0; u.rowbase = u.pm * 256; u.nt = nt; return true; }
};
struct DescMoeUp {
    static constexpr bool GATHER = true; static constexpr bool FP8 = true;
    const bf16_t* xb; const bf16_t* w; const int* tok; int lda, ldb, nt, ksa, ksb; const int* blke;
    __device__ __forceinline__ bool get(int L, Unit& u) const {
        const int nused = ldv_i(blke + NBLK); if (L >= nused * 28) return false; tile_order(L, nused, 28, u.pm, u.pn);
        const int e = ldv_i(blke + u.pm);
        u.A = xb; u.B = w + (size_t)(e * 7168 + 256 * u.pn) * 512; u.aux = e * 7168 + 256 * u.pn; u.rowbase = u.pm * 256; u.nt = nt; return true; }
};
__device__ __forceinline__ int moe_tail_spu(int ntail) { const int q = 256 / ntail; return q >= 14 ? 14 : 7; }
struct DescMoeDown {
    static constexpr bool GATHER = false; static constexpr bool FP8 = true;
    const bf16_t* h1; const bf16_t* w; const int* tok; int lda, ldb, nt, ksa, ksb; const int* blke; int G;
    __device__ __forceinline__ bool get(int L, Unit& u) const {
        const int nused = ldv_i(blke + NBLK); int k0 = 0, npair = 14; u.aux = 0;
        if (G != 256) { if (L >= nused * 4) return false; tile_order(L, nused, 4, u.pm, u.pn); }
        else { const int i = L >> 8, c = L & 255;
            if (i < 2) { const int x = c & 7, j = c >> 3; u.pm = (i * 8 + x) * 8 + (j & 7); u.pn = j >> 3; }
            else { const int ntail = (nused - 128) * 4; if (i > 2 || ntail <= 0) return false; const int spu = moe_tail_spu(ntail); if (c >= ntail * spu) return false;
                const int ut = c / spu, sl = c - ut * spu; u.pm = 128 + (ut >> 2); u.pn = ut & 3; npair = 14 / spu; k0 = sl * npair; u.aux = 1 + c; } }
        const int e = ldv_i(blke + u.pm);
        u.A = h1 + (size_t)u.pm * 128 * DFE + (size_t)k0 * 2 * 16384; u.B = w + (size_t)(e * 4 + u.pn) * 128 * DFE + (size_t)k0 * 2 * 16384;
        u.rowbase = u.pm * 256; u.nt = 2 * npair; return true; }
};

typedef f32x4 Acc[2][2][4][2];

__device__ __forceinline__ void store8bf(bf16_t* p, const float* v) {
    u32x4 w; w.x = pk2(v[0], v[1]); w.y = pk2(v[2], v[3]); w.z = pk2(v[4], v[5]); w.w = pk2(v[6], v[7]); *(u32x4*)p = w; }

template <bool GATE> struct EpiG1a {
    static constexpr bool PERM = true;
    const float* rowss; const float* bias; const f32x2* taba; const f32x2* tabb; bf16_t* Q; bf16_t* KN; bf16_t* Gb; const float* gp; bf16_t* KDT;
    __device__ __forceinline__ void pre_load(const Unit& u, int tid, float (&r)[16]) const { if (tid < 256) r[0] = ldv_f(rowss + (size_t)(u.pm * 256 + tid) * 16); else bias_sum_ld(bias, u.aux + tid - 256, NIN, 2 * NIN, r); }
    __device__ __forceinline__ void pre_store(const Unit&, LAS float* aux, int tid, const float (&r)[16]) const { aux[tid] = tid < 256 ? rstd_of(r[0]) : bias_sum_fin(r); }
    __device__ __forceinline__ void init(LAS float* auxb, int tid) const {
        if (!GATE && tid < 256) { const float v = ((const float*)tabb)[16 * 256 + tid]; auxb[512 + tid] = v; auxb[768 + 512 + tid] = v; } }
    __device__ __forceinline__ void operator()(const Acc& acc, const Unit& u, int wr, int wc, int fr, int fq, const LAS float* aux) const {
        asm volatile("" : "+v"(fr), "+v"(fq));
        const int pn = u.pn, d0 = wc * 32 + 8 * fq;
        float b[2][8];
#pragma unroll
        for (int bj = 0; bj < 2; ++bj) { const f32x4 x = *(const LAS f32x4*)(aux + 256 + 128 * bj + d0), y = *(const LAS f32x4*)(aux + 256 + 128 * bj + d0 + 4);
            b[bj][0] = x.x; b[bj][1] = x.y; b[bj][2] = x.z; b[bj][3] = x.w; b[bj][4] = y.x; b[bj][5] = y.y; b[bj][6] = y.z; b[bj][7] = y.w; }
        if constexpr (!GATE) {
            bf16_t* O = pn < 4 ? Q : KN; const int hcol = (pn & 3) * 256;
            f32x2 ta[8], tn[8], tb[8]; float dec[4];
            { const f32x2* tp0 = taba + (2 * u.pm) * 128 + d0; const f32x2* tpb = tabb + (64 * wr + fr) * 128 + d0;
#pragma unroll
              for (int q = 0; q < 8; ++q) { ta[q] = tp0[q]; tb[q] = tpb[q]; }
#pragma unroll
              for (int m = 0; m < 4; ++m) dec[m] = pn >= 4 ? gp[(pn - 4) * GPS + 127 - (64 * wr + 16 * m + fr)] : 0.f; }
            const float c128 = pn >= 4 ? gp[(pn - 4) * GPS + 128] : 0.f;
#pragma unroll
            for (int it = 0; it < 8; ++it) {
                const int ai = it >> 2, m = ai ? 3 - (it & 3) : (it & 3);
                if (it == 2) { const f32x2* tp1 = taba + (2 * u.pm + 1) * 128 + d0;
#pragma unroll
                    for (int q = 0; q < 8; ++q) tn[q] = tp1[q]; }
                if (it == 4) {
#pragma unroll
                    for (int q = 0; q < 8; ++q) ta[q] = tn[q]; }
                if ((it & 3) != 0) {
                    const float sg = ai ? -1.0f : 1.0f; int dl = 2 * d0; asm volatile("" : "+v"(dl));
#pragma unroll
                    for (int q2 = 0; q2 < 4; ++q2) { const f32x4 R2 = *(const LAS f32x4*)(aux + 512 + dl + 4 * q2);
                        { const f32x2 B = tb[2 * q2]; const float ry = sg * R2.y; tb[2 * q2].x = B.x * R2.x - B.y * ry; tb[2 * q2].y = B.y * R2.x + B.x * ry; }
                        { const f32x2 B = tb[2 * q2 + 1]; const float rw = sg * R2.w; tb[2 * q2 + 1].x = B.x * R2.z - B.y * rw; tb[2 * q2 + 1].y = B.y * R2.z + B.x * rw; } } }
                const int rl = 128 * ai + 64 * wr + 16 * m + fr, t = u.pm * 256 + rl; const float rs = aux[rl];
                float o1[8], o2[8];
#pragma unroll
                for (int q = 0; q < 8; ++q) {
                    const f32x2 A = ta[q], B = tb[q]; const float cs = A.x * B.x - A.y * B.y, sn = A.y * B.x + A.x * B.y;
                    const float v1 = rs * acc[ai][0][m][q >> 2][q & 3] + b[0][q], v2 = rs * acc[ai][1][m][q >> 2][q & 3] + b[1][q];
                    o1[q] = v1 * cs - v2 * sn; o2[q] = v1 * sn + v2 * cs; }
                store8bf(O + (size_t)t * 1024 + hcol + d0, o1); store8bf(O + (size_t)t * 1024 + hcol + 128 + d0, o2);
                if (pn >= 4) {
                    bf16_t* kd = KDT + (size_t)(hcol + d0) * T + t;
                    const float dk = ai ? dec[m] : dec[m] * c128;
#pragma unroll
                    for (int q = 0; q < 8; ++q) { kd[(size_t)q * T] = (bf16_t)(pk2(o1[q] * dk, 0.f) & 0xffffu); kd[(size_t)(128 + q) * T] = (bf16_t)(pk2(o2[q] * dk, 0.f) & 0xffffu); } }
            }
        } else {
#pragma unroll
            for (int ai = 0; ai < 2; ++ai)
#pragma unroll
                for (int m = 0; m < 4; ++m) {
                    const int rl = 128 * ai + 64 * wr + 16 * m + fr, t = u.pm * 256 + rl; const float rs = aux[rl];
#pragma unroll
                    for (int bj = 0; bj < 2; ++bj) { float o[8];
#pragma unroll
                        for (int q = 0; q < 8; ++q) o[q] = silu_f(rs * acc[ai][bj][m][q >> 2][q & 3] + b[bj][q]);
                        store8bf(Gb + (size_t)t * 2048 + (pn - 8) * 256 + 128 * bj + d0, o); }
                }
        }
    }
};
struct EpiG1b {
    static constexpr bool PERM = true;
    const float* rowss; const float* bias; const f32x2* taba; const f32x2* tabb; const float* gp; bf16_t* KDT; bf16_t* VT;
    __device__ __forceinline__ void pre_load(const Unit& u, int tid, float (&r)[16]) const { if (tid < 256) bias_sum_ld(bias, 1024 + 256 * u.pm + tid, NIN, 2 * NIN, r); else r[0] = ldv_f(rowss + (size_t)(u.pn * 256 + tid - 256) * 16); }
    __device__ __forceinline__ void pre_store(const Unit&, LAS float* aux, int tid, const float (&r)[16]) const { aux[tid] = tid < 256 ? bias_sum_fin(r) : rstd_of(r[0]); }
    __device__ __forceinline__ void init(LAS float*, int) const {}
    __device__ __forceinline__ void operator()(const Acc& acc, const Unit& u, int wr, int wc, int fr, int fq, const LAS float* aux) const {
        asm volatile("" : "+v"(fr), "+v"(fq));
        const int pmf = u.pm, tl0 = 32 * wc + 8 * fq, tk0 = u.pn * 256 + tl0;
        float rs[2][8];
#pragma unroll
        for (int bj = 0; bj < 2; ++bj) { const f32x4 x = *(const LAS f32x4*)(aux + 256 + 128 * bj + tl0), y = *(const LAS f32x4*)(aux + 256 + 128 * bj + tl0 + 4);
            rs[bj][0] = x.x; rs[bj][1] = x.y; rs[bj][2] = x.z; rs[bj][3] = x.w; rs[bj][4] = y.x; rs[bj][5] = y.y; rs[bj][6] = y.z; rs[bj][7] = y.w; }
        if (pmf < 4) {
            const int h = pmf;
#pragma unroll
            for (int m = 0; m < 4; ++m) {
                const int d = 64 * wr + 16 * m + fr; const float b1 = aux[d], b2 = aux[128 + d];
#pragma unroll
                for (int bj = 0; bj < 2; ++bj) { float o1[8], o2[8]; const f32x2 A = taba[(2 * u.pn + bj) * 128 + d]; const float4 dq0 = *(const float4*)(gp + h * GPS + 120 - tl0), dq1 = *(const float4*)(gp + h * GPS + 124 - tl0);
                    const float decs[8] = {dq1.w, dq1.z, dq1.y, dq1.x, dq0.w, dq0.z, dq0.y, dq0.x};
#pragma unroll
                    for (int q = 0; q < 8; ++q) { const f32x2 B = tabb[(tl0 + q) * 128 + d]; const float cs = A.x * B.x - A.y * B.y, sn = A.y * B.x + A.x * B.y;
                        const float v1 = rs[bj][q] * acc[0][bj][m][q >> 2][q & 3] + b1, v2 = rs[bj][q] * acc[1][bj][m][q >> 2][q & 3] + b2;
                        o1[q] = (v1 * cs - v2 * sn) * decs[q]; o2[q] = (v1 * sn + v2 * cs) * decs[q]; }
                    store8bf(KDT + (size_t)(256 * h + d) * T + tk0 + 128 * bj, o1); store8bf(KDT + (size_t)(256 * h + 128 + d) * T + tk0 + 128 * bj, o2); }
            }
        } else {
#pragma unroll
            for (int ai = 0; ai < 2; ++ai)
#pragma unroll
                for (int m = 0; m < 4; ++m) {
                    const int rl = 128 * ai + 64 * wr + 16 * m + fr, f = 256 * (pmf - 4) + rl; const float bs = aux[rl];
#pragma unroll
                    for (int bj = 0; bj < 2; ++bj) { float o[8];
#pragma unroll
                        for (int q = 0; q < 8; ++q) o[q] = rs[bj][q] * acc[ai][bj][m][q >> 2][q & 3] + bs;
                        store8bf(VT + (size_t)f * T + tk0 + 128 * bj, o); }
                }
        }
    }
};
struct EpiKV {
    static constexpr bool PERM = true;
    bf16_t* SB;
    __device__ __forceinline__ void pre_load(const Unit&, int, float (&)[16]) const {}
    __device__ __forceinline__ void pre_store(const Unit&, LAS float*, int, const float (&)[16]) const {}
    __device__ __forceinline__ void init(LAS float*, int) const {}
    __device__ __forceinline__ void operator()(const Acc& acc, const Unit& u, int wr, int wc, int fr, int fq, const LAS float*) const {
        asm volatile("" : "+v"(fr), "+v"(fq));
        const int mt = u.aux & 1, nh = u.aux >> 1; bf16_t* base = SB + ((size_t)nh * 512 + 256 * mt) * 256; const int d0 = wc * 32 + 8 * fq;
#pragma unroll
        for (int ai = 0; ai < 2; ++ai)
#pragma unroll
            for (int m = 0; m < 4; ++m) { const int r = 128 * ai + 64 * wr + 16 * m + fr;
#pragma unroll
                for (int bj = 0; bj < 2; ++bj) { float o[8];
#pragma unroll
                    for (int q = 0; q < 8; ++q) o[q] = acc[ai][bj][m][q >> 2][q & 3];
                    store8bf(base + (size_t)r * 256 + 128 * bj + d0, o); } }
    }
};
template <bool BASEB> struct EpiResid {
    static constexpr bool PERM = false;
    const float* base; const bf16_t* baseb; bf16_t* xb; float* rowss; const float* g; const float* cb; const float* cs; float accscale;
    __device__ __forceinline__ void pre_load(const Unit& u, int tid, float (&r)[16]) const {
        if (tid < 256) { const int c = 256 * u.pn + tid; r[0] = ldv_f(g + c); r[1] = cs ? cs[c] : 1.0f; } else { const int c = 256 * u.pn + tid - 256; r[0] = cb ? cb[c] : 0.f; r[1] = 1.0f; } }
    __device__ __forceinline__ void pre_store(const Unit&, LAS float* aux, int tid, const float (&r)[16]) const { aux[256 + tid] = r[0] * r[1] * (tid < 256 ? accscale : 1.0f); }
    __device__ __forceinline__ void init(LAS float*, int) const {}
    __device__ __forceinline__ void operator()(const Acc& acc, const Unit& u, int wr, int wc, int fr, int fq, const LAS float* aux) const {
        asm volatile("" : "+v"(fr), "+v"(fq));
        const int cl0 = 32 * wc + 4 * fq, col0 = 256 * u.pn + cl0;
        f32x4 gv[2][2], cbv[2][2];
#pragma unroll
        for (int bj = 0; bj < 2; ++bj)
#pragma unroll
            for (int n = 0; n < 2; ++n) { gv[bj][n] = *(const LAS f32x4*)(aux + 256 + cl0 + 128 * bj + 16 * n); cbv[bj][n] = *(const LAS f32x4*)(aux + 512 + cl0 + 128 * bj + 16 * n); }
        f32x4 bsv[2][4];
        const size_t o0 = (size_t)(u.pm * 256 + 64 * wr + fr) * 1024 + col0;
#define ER_LOADB(dst, off) do { if constexpr (BASEB) { const u32x2 _w = *(const u32x2*)(baseb + (off)); dst = (f32x4){bflo(_w.x), bfhi(_w.x), bflo(_w.y), bfhi(_w.y)}; } else dst = *(const f32x4*)(base + (off)); } while (0)
#pragma unroll
        for (int j = 0; j < 4; ++j) ER_LOADB(bsv[0][j], o0 + 128 * (j >> 1) + 16 * (j & 1));
#pragma unroll
        for (int it = 0; it < 8; ++it) { const int ai = it >> 2, m = it & 3; const int t = u.pm * 256 + 128 * ai + 64 * wr + 16 * m + fr; float s = 0.f;
            if (it < 7) { const int ai2 = (it + 1) >> 2, m2 = (it + 1) & 3; const size_t o2 = o0 + (size_t)(128 * ai2 + 16 * m2) * 1024;
#pragma unroll
                for (int j = 0; j < 4; ++j) ER_LOADB(bsv[(it + 1) & 1][j], o2 + 128 * (j >> 1) + 16 * (j & 1)); }
#pragma unroll
            for (int bj = 0; bj < 2; ++bj)
#pragma unroll
                for (int n = 0; n < 2; ++n) { const size_t o = (size_t)t * 1024 + col0 + 128 * bj + 16 * n;
                    const f32x4 xo = bsv[it & 1][2 * bj + n] + (acc[ai][bj][m][n] + cbv[bj][n]) * gv[bj][n];
                    s += (xo.x * xo.x + xo.y * xo.y) + (xo.z * xo.z + xo.w * xo.w);
                    { u32x2 w; w.x = pk2(xo.x, xo.y); w.y = pk2(xo.z, xo.w); *(u32x2*)(xb + o) = w; } }
            s += __shfl_xor(s, 16); s += __shfl_xor(s, 32);
            if (fq == 0) rowss[(size_t)t * 16 + u.pn * 4 + wc] = s; }
    }
#undef ER_LOADB
};
template <bool TILED, bool F8OUT = false> struct EpiSwiglu {
    static constexpr bool PERM = true;
    const float* rowss; const float* rowrs; const float* bias; bf16_t* Hout; int ldh, bs1, bs2;
    __device__ __forceinline__ void pre_load(const Unit& u, int tid, float (&r)[16]) const {
        if (tid < 256) { if (rowrs) r[0] = ldv_f(rowrs + u.rowbase + tid); else rstd_row_ld(rowss, u.rowbase + tid, r); } else bias_sum_ld(bias, u.aux + tid - 256, bs1, bs2, r); }
    __device__ __forceinline__ void pre_store(const Unit&, LAS float* aux, int tid, const float (&r)[16]) const { aux[tid] = tid < 256 ? (rowrs ? r[0] : rstd_row_fin(r)) : bias_sum_fin(r); }
    __device__ __forceinline__ void init(LAS float*, int) const {}
    __device__ __forceinline__ void operator()(const Acc& acc, const Unit& u, int wr, int wc, int fr, int fq, const LAS float* aux) const {
        asm volatile("" : "+v"(fr), "+v"(fq));
        const int d0 = wc * 32 + 8 * fq; float bg[8], bu[8];
        { const f32x4 x = *(const LAS f32x4*)(aux + 256 + d0), y = *(const LAS f32x4*)(aux + 256 + d0 + 4), z = *(const LAS f32x4*)(aux + 384 + d0), w = *(const LAS f32x4*)(aux + 384 + d0 + 4);
          bg[0] = x.x; bg[1] = x.y; bg[2] = x.z; bg[3] = x.w; bg[4] = y.x; bg[5] = y.y; bg[6] = y.z; bg[7] = y.w; bu[0] = z.x; bu[1] = z.y; bu[2] = z.z; bu[3] = z.w; bu[4] = w.x; bu[5] = w.y; bu[6] = w.z; bu[7] = w.w; }
        constexpr float KG = -1.4426950408889634f, KU = -0.6931471805599453f * (F8OUT ? F8_HSCALE : 1.0f);
#pragma unroll
        for (int q = 0; q < 8; ++q) { bg[q] *= KG; bu[q] *= KU; }
#pragma unroll
        for (int ai = 0; ai < 2; ++ai)
#pragma unroll
            for (int m = 0; m < 4; ++m) { const int rl = 128 * ai + 64 * wr + 16 * m + fr, row = u.rowbase + rl; const float rs = aux[rl], rsg = rs * KG, rsu = rs * KU; float o[8];
#pragma unroll
                for (int q = 0; q < 8; ++q) {
                    const float x = rsg * acc[ai][0][m][q >> 2][q & 3] + bg[q], y = rsu * acc[ai][1][m][q >> 2][q & 3] + bu[q];
                    o[q] = (x * __builtin_amdgcn_rcpf(1.0f + __builtin_amdgcn_exp2f(x))) * y; }
                if constexpr (F8OUT) {
#pragma unroll
                    for (int q = 0; q < 8; ++q) o[q] = __builtin_amdgcn_fmed3f(o[q], -448.0f, 448.0f);
                    u32x2 w8; w8.x = pk4f8(o[0], o[1], o[2], o[3]); w8.y = pk4f8(o[4], o[5], o[6], o[7]);
                    if (TILED) *(u32x2*)((unsigned char*)Hout + (((size_t)(row >> 8) * (ldh >> 7) + u.pn) * 256 + (row & 255)) * 128 + d0) = w8;
                    else *(u32x2*)((unsigned char*)Hout + (size_t)row * ldh + 128 * u.pn + d0) = w8; }
                else if (TILED) store8bf(Hout + (((size_t)(row >> 8) * (ldh >> 6) + 2 * u.pn + (d0 >> 6)) * 256 + (row & 255)) * 64 + (d0 & 63), o);
                else store8bf(Hout + (size_t)row * ldh + 128 * u.pn + d0, o); }
    }
};
struct EpiMoeDown {
    static constexpr bool PERM = true;
    const float* gate; bf16_t* YB; float* YBB;
    __device__ __forceinline__ void pre_load(const Unit& u, int tid, float (&r)[16]) const { if (tid < 256) r[0] = ldv_f(gate + u.rowbase + tid); }
    __device__ __forceinline__ void pre_store(const Unit&, LAS float* aux, int tid, const float (&r)[16]) const { if (tid < 256) aux[tid] = r[0] * (1.0f / (F8_DSCALE * F8_HSCALE)); }
    __device__ __forceinline__ void init(LAS float*, int) const {}
    __device__ __forceinline__ void operator()(const Acc& acc, const Unit& u, int wr, int wc, int fr, int fq, const LAS float* aux) const {
        asm volatile("" : "+v"(fr), "+v"(fq));
        const int col0 = 256 * u.pn + 32 * wc + 8 * fq;
#pragma unroll
        for (int ai = 0; ai < 2; ++ai)
#pragma unroll
            for (int m = 0; m < 4; ++m) { const int rl = 128 * ai + 64 * wr + 16 * m + fr, row = u.rowbase + rl; const float gt = aux[rl];
#pragma unroll
                for (int bj = 0; bj < 2; ++bj) {
                    if (u.aux == 0) { float o[8];
#pragma unroll
                        for (int q = 0; q < 8; ++q) o[q] = acc[ai][bj][m][q >> 2][q & 3] * gt;
                        store8bf(YB + (size_t)row * 1024 + col0 + 128 * bj, o); }
                    else { float* d = YBB + (size_t)(u.aux - 1) * 65536 + (size_t)rl * 256 + 32 * wc + 8 * fq + 128 * bj;
                        *(f32x4*)d = acc[ai][bj][m][0] * gt; *(f32x4*)(d + 4) = acc[ai][bj][m][1] * gt; } } }
    }
};

namespace pg8 {
constexpr int BM = 256, BK = 64, HALF = 128, HTB = HALF * BK * 2, STAGE_BYTES = 8 * HTB;
__device__ __forceinline__ int lds_byte(int r, int c) { const int st = (r >> 4) * 2 + (c >> 5), rr = r & 15, cc = c & 31, ob = rr * 64 + cc * 2; return st * 1024 + (ob ^ (((ob >> 9) & 1) << 5)); }
__device__ __forceinline__ void stage_rc(int b, int& R, int& C) { const int st = b / 1024, sb = b % 1024, swz = sb ^ (((sb >> 9) & 1) << 5); R = (st >> 1) * 16 + swz / 64; C = (st & 1) * 32 + (swz % 64) / 2; }
__device__ __forceinline__ int perm32(int rho) { const int n = rho >> 4, i = rho & 15; return 8 * (i >> 2) + 4 * n + (i & 3); }
}
typedef int i32x8 __attribute__((ext_vector_type(8)));
__device__ __forceinline__ void mfma_f8_inplace(f32x4& acc, const i32x8 a, const i32x8 b, int sc) {
    asm volatile("v_mfma_scale_f32_16x16x128_f8f6f4 %0, %1, %2, %0, %3, %3 op_sel_hi:[0,0,0]" : "+v"(acc) : "v"(a), "v"(b), "v"(sc)); }
template <class Desc, class Epi>
__device__ __forceinline__ void gemm_fast(LAS unsigned char* lds, const unsigned char* wsb, const Desc& Dc, const Epi& E, int c, int G, int wave_id) {
    using namespace pg8;
    constexpr bool GATHER = Desc::GATHER; constexpr bool FP8 = Desc::FP8;
    int lane_ = lane_id(); asm volatile("" : "+v"(lane_));
    const int wid = wave_id, lane = lane_, tid = wid * 64 + lane, wr = wid >> 2, wc = wid & 3, fr = lane & 15, fq = lane >> 4;
    unsigned vA[2][2], vAn[2][2], vB[2][2];
#pragma unroll
    for (int i = 0; i < 2; ++i) { int R, C; stage_rc(tid * 16 + i * 8192, R, C); const int Rb = Epi::PERM ? ((R & ~31) + perm32(R & 31)) : R;
#pragma unroll
        for (int h = 0; h < 2; ++h) { vA[h][i] = (unsigned)((h * HALF + R) * Dc.lda + C) * 2u; vB[h][i] = (unsigned)((h * HALF + Rb) * Dc.ldb + C) * 2u; vAn[h][i] = vA[h][i]; } }
    const unsigned ksA = (unsigned)Dc.ksa, ksB = (unsigned)Dc.ksb;
    const __amdgpu_buffer_rsrc_t rs = __builtin_amdgcn_make_buffer_rsrc((void*)wsb, (short)0, 0x7fffffff, 0x00020000);
    const unsigned ldsw = (unsigned)wid * 1024u;
    const int aoff = lds_byte(wr * 64 + fr, fq * 8), boff = lds_byte(wc * 32 + fr, fq * 8);
#define PG8_SA(b, h) (((b) * 2 + (h)) * HTB)
#define PG8_SB(b, h) ((4 + (b) * 2 + (h)) * HTB)
#define PG8_STAGE(bufoff, gbase, voff) do { _Pragma("unroll") for (int _i = 0; _i < 2; ++_i) \
        __builtin_amdgcn_raw_ptr_buffer_load_lds(rs, (LAS unsigned*)(lds + (bufoff) + ldsw + _i * 8192), 16, (int)(voff)[_i], (int)(gbase), 0, 0); } while (0)
#define PG8_LDA(dst, b, h) do { _Pragma("unroll") for (int m = 0; m < 4; ++m) _Pragma("unroll") for (int k = 0; k < 2; ++k) dst[m][k] = *(const LAS bf16x8*)(lds + PG8_SA(b, h) + aoff + m * 2048 + k * 1024); } while (0)
#define PG8_LDB(dst, b, h) do { _Pragma("unroll") for (int n = 0; n < 2; ++n) _Pragma("unroll") for (int k = 0; k < 2; ++k) dst[n][k] = *(const LAS bf16x8*)(lds + PG8_SB(b, h) + boff + n * 2048 + k * 1024); } while (0)
#define PG8_CAT(x) __builtin_shufflevector(__builtin_bit_cast(i32x4, x[0]), __builtin_bit_cast(i32x4, x[1]), 0, 1, 2, 3, 4, 5, 6, 7)
#define PG8_MMA(ai, bj, At, Bt) do { __builtin_amdgcn_s_setprio(1); if constexpr (FP8) { _Pragma("unroll") for (int m = 0; m < 4; ++m) _Pragma("unroll") for (int n = 0; n < 2; ++n) \
        mfma_f8_inplace(acc[ai][bj][m][n], PG8_CAT(Bt[n]), PG8_CAT(At[m]), f8sc); } else { \
        _Pragma("unroll") for (int m = 0; m < 4; ++m) _Pragma("unroll") for (int n = 0; n < 2; ++n) _Pragma("unroll") for (int k = 0; k < 2; ++k) \
        acc[ai][bj][m][n] = __builtin_amdgcn_mfma_f32_16x16x32_bf16(Bt[n][k], At[m][k], acc[ai][bj][m][n], 0, 0, 0); } __builtin_amdgcn_s_setprio(0); } while (0)
#define PG8_WAIT_V(n) asm volatile("s_waitcnt vmcnt(" #n ")" ::: "memory")
#define PG8_WAIT_L(n) asm volatile("s_waitcnt lgkmcnt(" #n ")" ::: "memory")
#define PG8_BAR __builtin_amdgcn_s_barrier()
#define PG8_SCHED __builtin_amdgcn_sched_barrier(0)
#define PG8_GATHER_OFFS(dst, un) do { const int _t = wid * 64 + lane_id(); _Pragma("unroll") for (int _i = 0; _i < 2; ++_i) { int _R, _C; stage_rc(_t * 16 + _i * 8192, _R, _C); \
        _Pragma("unroll") for (int _h = 0; _h < 2; ++_h) dst[_h][_i] = (unsigned)(ldv_i(Dc.tok + (un).rowbase + _h * HALF + _R) * Dc.lda + _C) * 2u; } } while (0)
    int f8sc = 0x7f7f7f7f; asm volatile("" : "+v"(f8sc));
    Unit cur, nxt; int ui = 0;
    if (!Dc.get(c, cur)) return;
    LAS float* const auxb = (LAS float*)(lds + 131072 + 1024);
    E.init(auxb, tid);
    { float r0[16]; E.pre_load(cur, tid, r0); E.pre_store(cur, auxb, tid, r0); }
    Acc acc;
#pragma unroll
    for (int a = 0; a < 2; ++a)
#pragma unroll
        for (int b = 0; b < 2; ++b)
#pragma unroll
            for (int m = 0; m < 4; ++m)
#pragma unroll
                for (int n = 0; n < 2; ++n) acc[a][b][m][n] = (f32x4){0.f, 0.f, 0.f, 0.f};
    bf16x8 At[4][2], B0[2][2], B1[2][2];
    unsigned cA = (unsigned)((const unsigned char*)cur.A - wsb), cB = (unsigned)((const unsigned char*)cur.B - wsb);
    if constexpr (GATHER) { PG8_GATHER_OFFS(vA, cur); }
    PG8_STAGE(PG8_SB(0, 0), cB, vB[0]); PG8_STAGE(PG8_SB(0, 1), cB, vB[1]); PG8_STAGE(PG8_SA(0, 0), cA, vA[0]); PG8_STAGE(PG8_SA(0, 1), cA, vA[1]);
    if (wr == 1) PG8_BAR;
    PG8_WAIT_V(2); PG8_BAR;
    PG8_STAGE(PG8_SB(1, 0), cB + ksB, vB[0]); PG8_STAGE(PG8_SA(1, 0), cA + ksA, vA[0]); PG8_STAGE(PG8_SB(1, 1), cB + ksB, vB[1]);
    PG8_WAIT_V(6); PG8_BAR;
    for (;;) {
        const bool has_next = Dc.get((ui + 1) * G + c, nxt);
        const unsigned nA = has_next ? (unsigned)((const unsigned char*)nxt.A - wsb) : cA, nB = has_next ? (unsigned)((const unsigned char*)nxt.B - wsb) : cB;
        if constexpr (GATHER) { if (has_next) { PG8_GATHER_OFFS(vAn, nxt); } else {
#pragma unroll
            for (int h = 0; h < 2; ++h)
#pragma unroll
                for (int i = 0; i < 2; ++i) vAn[h][i] = vA[h][i]; } }
        const int nt = cur.nt;
        for (int t = 0; t < nt; t += 2) {
            const bool last = (t == nt - 2);
            const unsigned a1 = cA + (unsigned)(t + 1) * ksA;
            const unsigned a2 = last ? nA : cA + (unsigned)(t + 2) * ksA, b2 = last ? nB : cB + (unsigned)(t + 2) * ksB;
            const unsigned a3 = a2 + ksA, b3 = b2 + ksB;
            unsigned x0[2], x1[2];
#pragma unroll
            for (int i = 0; i < 2; ++i) { x0[i] = (GATHER && last) ? vAn[0][i] : vA[0][i]; x1[i] = (GATHER && last) ? vAn[1][i] : vA[1][i]; }
            PG8_LDB(B0, 0, 0); PG8_LDB(B1, 0, 1); PG8_SCHED; PG8_LDA(At, 0, 0); PG8_STAGE(PG8_SA(1, 1), a1, vA[1]);
            PG8_WAIT_V(8); PG8_WAIT_L(0); PG8_BAR; PG8_MMA(0, 0, At, B0); PG8_MMA(0, 1, At, B1); PG8_BAR; PG8_SCHED;
            PG8_LDA(At, 0, 1); PG8_STAGE(PG8_SB(0, 0), b2, vB[0]); PG8_STAGE(PG8_SB(0, 1), b2, vB[1]); PG8_STAGE(PG8_SA(0, 0), a2, x0);
            PG8_WAIT_V(8); PG8_WAIT_L(0); PG8_BAR; PG8_MMA(1, 0, At, B0); PG8_MMA(1, 1, At, B1); PG8_BAR; PG8_SCHED;
            PG8_LDB(B0, 1, 0); PG8_LDB(B1, 1, 1); PG8_SCHED; PG8_LDA(At, 1, 0); PG8_STAGE(PG8_SA(0, 1), a2, x1);
            PG8_WAIT_V(8); PG8_WAIT_L(0); PG8_BAR; PG8_MMA(0, 0, At, B0); PG8_MMA(0, 1, At, B1); PG8_BAR; PG8_SCHED;
            PG8_LDA(At, 1, 1); PG8_STAGE(PG8_SB(1, 0), b3, vB[0]); PG8_STAGE(PG8_SB(1, 1), b3, vB[1]); PG8_STAGE(PG8_SA(1, 0), a3, x0);
            PG8_WAIT_V(8); PG8_WAIT_L(0); PG8_BAR; PG8_MMA(1, 0, At, B0); PG8_MMA(1, 1, At, B1); PG8_BAR; PG8_SCHED;
        }
        if constexpr (FP8) asm volatile("s_nop 15\n\ts_nop 15\n\ts_nop 15\n\ts_nop 15\n\ts_nop 15" ::: "memory");
        if (wr == 0) PG8_BAR;
        { const int l2 = lane_id(); float rn[16];
          if (has_next) E.pre_load(nxt, wid * 64 + l2, rn);
          E(acc, cur, wr, wc, l2 & 15, l2 >> 4, auxb + (ui & 1) * 768);
          if (has_next) E.pre_store(nxt, auxb + ((ui + 1) & 1) * 768, wid * 64 + l2, rn); }
        if (!has_next) break;
#pragma unroll
        for (int a = 0; a < 2; ++a)
#pragma unroll
            for (int b = 0; b < 2; ++b)
#pragma unroll
                for (int m = 0; m < 4; ++m)
#pragma unroll
                    for (int n = 0; n < 2; ++n) acc[a][b][m][n] = (f32x4){0.f, 0.f, 0.f, 0.f};
        cur = nxt; cA = nA; cB = nB; ++ui;
        if constexpr (GATHER) {
#pragma unroll
            for (int h = 0; h < 2; ++h)
#pragma unroll
                for (int i = 0; i < 2; ++i) vA[h][i] = vAn[h][i]; }
        if (wr == 1) PG8_BAR;
    }
    PG8_WAIT_V(0);
    PG8_BAR;
#undef PG8_SA
#undef PG8_SB
#undef PG8_STAGE
#undef PG8_LDA
#undef PG8_LDB
#undef PG8_MMA
#undef PG8_CAT
#undef PG8_WAIT_V
#undef PG8_WAIT_L
#undef PG8_BAR
#undef PG8_SCHED
#undef PG8_GATHER_OFFS
}

struct Frame {
    Params p; unsigned char* ws; LAS unsigned char* lds; int tid, lane, wave, c, G;
    __device__ __forceinline__ float* MOD() const { return (float*)(ws + CT_MOD); }
    __device__ __forceinline__ float* BIAS_IN() const { return (float*)(ws + CT_BIAS_IN); }
    __device__ __forceinline__ float* BIAS_GU() const { return (float*)(ws + CT_BIAS_GU); }
    __device__ __forceinline__ float* BIAS_R() const { return (float*)(ws + CT_BIAS_R); }
    __device__ __forceinline__ float* BIAS_MGU() const { return (float*)(ws + CT_BIAS_MGU); }
    __device__ __forceinline__ float* ROWSS() const { return (float*)(ws + WS_ROWSSP); }
    __device__ __forceinline__ float* MODP() const { return (float*)(ws + WS_MODP); }
    __device__ __forceinline__ f32x2* TABA() const { return (f32x2*)(ws + WS_TABA); }
    __device__ __forceinline__ f32x2* TABB() const { return (f32x2*)(ws + WS_TABB); }
    __device__ __forceinline__ float* GP() const { return (float*)(ws + WS_GP); }
    __device__ __forceinline__ float* WR() const { return (float*)(ws + WS_WR); }
    __device__ __forceinline__ int* TOPE() const { return (int*)(ws + WS_TOPE); }
    __device__ __forceinline__ float* TOPG() const { return (float*)(ws + WS_TOPG); }
    __device__ __forceinline__ int* CNT() const { return (int*)(ws + WS_CNT); }
    __device__ __forceinline__ int* BUFTOK() const { return (int*)(ws + WS_BUFTOK); }
    __device__ __forceinline__ float* BUFGATE() const { return (float*)(ws + WS_BUFGATE); }
    __device__ __forceinline__ int* POS() const { return (int*)(ws + WS_POS); }
    __device__ __forceinline__ int* BLKE() const { return (int*)(ws + WS_BLKE); }
    __device__ __forceinline__ float* RSTD3() const { return (float*)(ws + WS_RSTD3); }
    __device__ __forceinline__ float* BUFRS() const { return (float*)(ws + WS_BUFRS); }
    __device__ __forceinline__ bf16_t* WIN() const { return (bf16_t*)(ws + WS_WIN); }
    __device__ __forceinline__ bf16_t* WOUT() const { return (bf16_t*)(ws + WS_WOUT); }
    __device__ __forceinline__ bf16_t* WGU() const { return (bf16_t*)(ws + WS_WGU); }
    __device__ __forceinline__ bf16_t* WD() const { return (bf16_t*)(ws + WS_WD); }
    __device__ __forceinline__ bf16_t* WP() const { return (bf16_t*)(ws + WS_WP); }
    __device__ __forceinline__ bf16_t* XB() const { return (bf16_t*)(ws + WS_XB); }
    __device__ __forceinline__ bf16_t* Q() const { return (bf16_t*)(ws + WS_Q); }
    __device__ __forceinline__ bf16_t* KN() const { return (bf16_t*)(ws + WS_KN); }
    __device__ __forceinline__ bf16_t* KDT() const { return (bf16_t*)(ws + WS_KDT); }
    __device__ __forceinline__ bf16_t* VT() const { return (bf16_t*)(ws + WS_VT); }
    __device__ __forceinline__ bf16_t* Gb() const { return (bf16_t*)(ws + WS_G); }
    __device__ __forceinline__ bf16_t* SB() const { return (bf16_t*)(ws + WS_SB); }
    __device__ __forceinline__ bf16_t* Y() const { return (bf16_t*)(ws + WS_Y); }
    __device__ __forceinline__ bf16_t* H1() const { return (bf16_t*)(ws + WS_H1); }
    __device__ __forceinline__ bf16_t* PB() const { return (bf16_t*)(ws + WS_PB); }
    __device__ __forceinline__ bf16_t* H1M() const { return (bf16_t*)(ws + WS_H1M); }
    __device__ __forceinline__ bf16_t* WMGU() const { return (bf16_t*)(ws + WS_WMGU); }
    __device__ __forceinline__ bf16_t* WMD() const { return (bf16_t*)(ws + WS_WMD); }
    __device__ __forceinline__ bf16_t* YB() const { return (bf16_t*)(ws + WS_YB); }
    __device__ __forceinline__ float* YBB() const { return (float*)(ws + WS_YBB); }
    __device__ __forceinline__ float* X2() const { return (float*)(ws + WS_X2); }
};
__device__ __forceinline__ void frame_fresh(Frame& F) { int l = lane_id(); asm volatile("" : "+v"(l)); F.lane = l; F.tid = F.wave * 64 + l; }
__device__ __forceinline__ void frame_init(Frame& F, const Params& p, LAS unsigned char* lds, int c, int G) {
    F.p = p; F.ws = p.ws; F.lds = lds; F.tid = threadIdx.x; F.lane = F.tid & 63; F.wave = __builtin_amdgcn_readfirstlane(F.tid >> 6); F.c = c; F.G = G;
}

__device__ __forceinline__ void dsincos(double x, double& s, double& c) {
    const double k = rint(x * 0.6366197723675814); double y = fma(-k, 1.5707963267948966, x); y = fma(-k, 6.123233995736766e-17, y);
    const double z = y * y;
    double sp = -7.6471637318198164759e-13; sp = fma(sp, z, 1.6059043836821614599e-10); sp = fma(sp, z, -2.5052108385441718775e-8); sp = fma(sp, z, 2.7557319223985890653e-6);
    sp = fma(sp, z, -1.9841269841269841270e-4); sp = fma(sp, z, 8.3333333333333333333e-3); sp = fma(sp, z, -1.6666666666666666667e-1); const double sy = fma(sp * z, y, y);
    double cp = 4.7794773323873852974e-14; cp = fma(cp, z, -1.1470745597729724714e-11); cp = fma(cp, z, 2.0876756987868098979e-9); cp = fma(cp, z, -2.7557319223985890653e-7);
    cp = fma(cp, z, 2.4801587301587301587e-5); cp = fma(cp, z, -1.3888888888888888889e-3); cp = fma(cp, z, 4.1666666666666666667e-2); cp = fma(cp, z, -0.5); const double cy = fma(cp, z, 1.0);
    const int q = ((int)k) & 3;
    s = (q == 0) ? sy : (q == 1) ? cy : (q == 2) ? -sy : -cy;
    c = (q == 0) ? cy : (q == 1) ? -sy : (q == 2) ? -cy : sy;
}
__device__ __forceinline__ void phase_p0(Frame& F) {
    const Params& p = F.p; const int gw = F.c * NWAVE + F.wave, NGW = F.G * NWAVE, lane = F.lane;
    LAS float* cact = (LAS float*)F.lds;
    __syncthreads();
    for (int k = F.tid; k < 1024; k += NTHR) cact[k] = silu_f(p.c[k]);
    __syncthreads();
    for (int task = gw; task < 1536; task += NGW) {
        const int i = task / 768, rem = task % 768, cb = rem >> 3, ks = rem & 7, n = cb * 64 + lane;
        const float* w = p.ada_w + (size_t)i * 1024 * NIN + (size_t)(ks * 128) * NIN + n; float a = 0.f;
#pragma unroll
        for (int k0 = 0; k0 < 128; k0 += 32) { float wv[32];
#pragma unroll
            for (int k = 0; k < 32; ++k) wv[k] = w[(size_t)(k0 + k) * NIN];
#pragma unroll
            for (int k = 0; k < 32; ++k) a = fmaf(cact[ks * 128 + k0 + k], wv[k], a); }
        if (ks == 0) a += p.ada_b[i * NIN + n];
        F.MODP()[ks * 12288 + i * NIN + n] = a;
    }
    const int gt = F.c * NTHR + F.tid, NGT = F.G * NTHR;
    for (int e = gt; e < 32768 + 4; e += NGT) {
        if (e < 32768) {
            const int which = e >> 14, ab = (e >> 7) & 127, i = e & 127; double inv = 1.0;
            for (int q = 0; q < i; ++q) inv *= 0.93057204092969897929;
            const double ang = (double)(which == 0 ? 128 * ab : ab) * inv; double s, c2; dsincos(ang, s, c2);
            (which == 0 ? F.TABA() : F.TABB())[ab * 128 + i] = (f32x2){(float)c2, (float)s};
        } else {
            const int h = e - 32768; const double g = 1.0 - 1.0 / (double)(32 << h); double v = 1.0;
            for (int j = 0; j <= 256; ++j) { F.GP()[h * GPS + j] = (float)v; v *= g; }
        }
    }
    for (int row = 2 * gw; row < T; row += 2 * NGW) {
        f32x4 v[2][4];
#pragma unroll
        for (int r = 0; r < 2; ++r) { const f32x4* xr = (const f32x4*)(p.x + (size_t)(row + r) * D) + lane;
#pragma unroll
            for (int j = 0; j < 4; ++j) v[r][j] = xr[64 * j]; }
#pragma unroll
        for (int r = 0; r < 2; ++r) { float s = 0.f;
#pragma unroll
            for (int j = 0; j < 4; ++j) s += (v[r][j].x * v[r][j].x + v[r][j].y * v[r][j].y) + (v[r][j].z * v[r][j].z + v[r][j].w * v[r][j].w);
            s = wave_sum(s); if (lane < 16) F.ROWSS()[(size_t)(row + r) * 16 + lane] = (lane == 0) ? s : 0.f;
            u32x2* o = (u32x2*)(F.XB() + (size_t)(row + r) * D) + lane;
#pragma unroll
            for (int j = 0; j < 4; ++j) { u32x2 w; w.x = pk2(v[r][j].x, v[r][j].y); w.y = pk2(v[r][j].z, v[r][j].w); o[64 * j] = w; } }
    }
}

template <bool F8 = false>
__device__ __forceinline__ void conv_strip(const float* W, int ldw, int kb0, int nkb, int n0, bf16_t* WT, int ldt, int drow0, const LAS float* gsl, const LAS float* shl,
                                           float* bias, float cscale, LAS float* scr, int lane, int tiled_nkt = 0, float wmul = 1.0f) {
    f32x4 bacc = (f32x4){0.f, 0.f, 0.f, 0.f}; f32x4 w[8];
    const int lr = lane >> 3, lc = 4 * (lane & 7);
    const float* wp = W + (size_t)(kb0 * 64 + lr) * ldw + n0 + lc;
#pragma unroll
    for (int i = 0; i < 8; ++i) w[i] = *(const f32x4*)(wp + (size_t)(8 * i) * ldw);
    for (int kb = kb0; kb < kb0 + nkb; ++kb) {
        const int k0 = kb * 64; f32x4 wn[8];
        if (kb + 1 < kb0 + nkb) {
#pragma unroll
            for (int i = 0; i < 8; ++i) wn[i] = *(const f32x4*)(wp + (size_t)(64 * (kb + 1 - kb0) + 8 * i) * ldw);
        } else {
#pragma unroll
            for (int i = 0; i < 8; ++i) wn[i] = (f32x4){0.f, 0.f, 0.f, 0.f};
        }
#pragma unroll
        for (int i = 0; i < 8; ++i) { const int kk = lr + 8 * i;
            float gsv = cscale * wmul; if (gsl) { gsv *= gsl[k0 + kk]; const float sv = shl[k0 + kk]; bacc = bacc + w[i] * sv; }
            *(LAS f32x4*)(scr + kk * 36 + 4 * ((lane & 7) ^ i)) = w[i] * gsv; }
        asm volatile("s_waitcnt lgkmcnt(0)" ::: "memory");
        const int cc = lane & 7;
#pragma unroll
        for (int j = 0; j < 4; ++j) { const int n = (lane >> 3) + 8 * j; const LAS float* s = scr + (8 * cc) * 36 + 4 * ((n >> 2) ^ cc) + (n & 3);
            const int nr = drow0 + n;
            if constexpr (F8) { u32x2 o8; o8.x = pk4f8(s[0 * 36], s[1 * 36], s[2 * 36], s[3 * 36]); o8.y = pk4f8(s[4 * 36], s[5 * 36], s[6 * 36], s[7 * 36]);
                if (tiled_nkt) *(u32x2*)((unsigned char*)WT + (((size_t)(nr >> 8) * tiled_nkt + (kb >> 1)) * 256 + (nr & 255)) * 128 + (kb & 1) * 64 + 8 * cc) = o8;
                else *(u32x2*)((unsigned char*)WT + (size_t)nr * ldt + k0 + 8 * cc) = o8;
                continue; }
            u32x4 o; o.x = pk2(s[0 * 36], s[1 * 36]); o.y = pk2(s[2 * 36], s[3 * 36]); o.z = pk2(s[4 * 36], s[5 * 36]); o.w = pk2(s[6 * 36], s[7 * 36]);
            if (tiled_nkt) *(u32x4*)(WT + (((size_t)(nr >> 8) * tiled_nkt + kb) * 256 + (nr & 255)) * 64 + 8 * cc) = o;
            else *(u32x4*)(WT + (size_t)nr * ldt + k0 + 8 * cc) = o; }
        asm volatile("s_waitcnt lgkmcnt(0)" ::: "memory");
#pragma unroll
        for (int i = 0; i < 8; ++i) w[i] = wn[i];
    }
    if (bias) {
#pragma unroll
        for (int o = 8; o < 64; o <<= 1) { bacc.x += __shfl_xor(bacc.x, o); bacc.y += __shfl_xor(bacc.y, o); bacc.z += __shfl_xor(bacc.z, o); bacc.w += __shfl_xor(bacc.w, o); }
        if (lane < 8) *(f32x4*)(bias + drow0 + lc) = bacc * cscale; }
}
__device__ __forceinline__ void phase_p1(Frame& F) {
    const Params& p = F.p; const int gw = F.c * NWAVE + F.wave, NGW = F.G * NWAVE, lane = F.lane;
    LAS float* modl = (LAS float*)F.lds;
    LAS float* scr = (LAS float*)(F.lds + 49152 + F.wave * 9216);
    __syncthreads();
    for (int idx = F.tid; idx < 12288; idx += NTHR) { float v = 0.f;
#pragma unroll
        for (int ks = 0; ks < 8; ++ks) v += F.MODP()[ks * 12288 + idx];
        modl[idx] = v; if ((idx % F.G) == F.c) F.MOD()[idx] = v; }
    __syncthreads();
    const LAS float* MOD0 = modl; const LAS float* MOD1 = modl + NIN; const LAS float* nul = nullptr;
    LAS float* gs_in = modl + 2048; LAS float* gs_ffn = modl + 5120; LAS float* gs_pool = modl + NIN + 2048;
    for (int k = F.tid; k < 1024; k += NTHR) { gs_in[k] = p.norm_gain[k] * (1.0f + MOD0[1024 + k]); gs_ffn[k] = p.norm_gain[1024 + k] * (1.0f + MOD0[4 * 1024 + k]); gs_pool[k] = p.norm_gain[2048 + k] * (1.0f + MOD1[1024 + k]); }
    __syncthreads();
    constexpr int S_IN = 192 * 4, S_G = 88 * 4, I_OUT = 32 * 32, I_D = 44 * 32, I_P = 4 * 4 * 8;
    constexpr int NIT = S_IN + 2 * S_G + I_OUT + I_D + I_P + 1;
    for (int it = gw; it < NIT; it += NGW) {
        int r = it;
        if (r < S_IN) { const int part = r / 192, n0 = (r % 192) * 32; const float cs = (n0 >= 1024 && n0 < 2048) ? 0.0625f : 1.0f;
            conv_strip(p.ret_w_in, NIN, 4 * part, 4, n0, F.WIN(), 1024, n0, gs_in, MOD0, F.BIAS_IN() + part * NIN, cs, scr, lane); continue; } r -= S_IN;
        if (r < 2 * S_G) { const int up = r >= S_G; if (up) r -= S_G; const int part = r / 88, n0 = (r % 88) * 32, drow = (n0 >> 7) * 256 + (up ? 128 : 0) + (n0 & 127);
            conv_strip(up ? p.ffn_w_up : p.ffn_w_gate, DFF, 4 * part, 4, n0, F.WGU(), 1024, drow, gs_ffn, MOD0 + 3 * 1024, F.BIAS_GU() + part * 5632, 1.0f, scr, lane); continue; } r -= 2 * S_G;
        if (r < I_OUT) { const int kb = r / 32, nb = r % 32; conv_strip(p.ret_w_out, 1024, kb, 1, nb * 32, F.WOUT(), 2048, nb * 32, nul, nul, nullptr, 1.0f, scr, lane); continue; } r -= I_OUT;
        if (r < I_D) { const int kb = r / 32, nb = r % 32; conv_strip<true>(p.ffn_w_down, 1024, kb, 1, nb * 32, F.WD(), DFF, nb * 32, nul, nul, nullptr, 1.0f, scr, lane, 22, F8_DSCALE); continue; } r -= I_D;
        if (r < I_P) { const int g = r / 32, q = r % 32, kb = q / 8, nb = q % 8;
            conv_strip(p.pool_w + (size_t)g * 65536, 256, kb, 1, nb * 32, F.WP() + (size_t)g * 65536, 256, nb * 32, gs_pool + g * 256, MOD1 + g * 256, nullptr, 1.0f, scr, lane); continue; }
        { float ba = 0.f; const int e = lane & 7;
            for (int k0 = lane >> 3; k0 < 1024; k0 += 128) { float w[16], gn[16];
#pragma unroll
                for (int j = 0; j < 16; ++j) { const int k = k0 + 8 * j; w[j] = p.moe_router[k * 8 + e]; gn[j] = p.norm_gain[3 * 1024 + k]; }
#pragma unroll
                for (int j = 0; j < 16; ++j) { const int k = k0 + 8 * j; F.WR()[k * 8 + e] = w[j] * (gn[j] * (1.0f + MOD1[4 * 1024 + k])); ba = fmaf(MOD1[3 * 1024 + k], w[j], ba); } }
            ba += __shfl_xor(ba, 8); ba += __shfl_xor(ba, 16); ba += __shfl_xor(ba, 32);
            if (lane < 8) F.BIAS_R()[lane] = ba; }
    }
}
constexpr int PX_SG = 112 * 4, PX_EARLY = 1024;
__device__ __forceinline__ void px_tables(Frame& F) {
    const Params& p = F.p;
    LAS float* gsl = (LAS float*)(F.lds + 8 * 9216 + 1024);
    LAS float* shl = gsl + 1024;
    const float* MOD1 = F.MOD() + NIN;
    for (int k = F.tid; k < 1024; k += NTHR) { gsl[k] = p.norm_gain[3 * 1024 + k] * (1.0f + ldv_f(MOD1 + 4 * 1024 + k)); shl[k] = ldv_f(MOD1 + 3 * 1024 + k); }
    __syncthreads();
}
__device__ __forceinline__ void px_gu_item(Frame& F, int it, int lane) {
    const Params& p = F.p;
    LAS float* scr = (LAS float*)(F.lds + F.wave * 9216);
    LAS float* gsl = (LAS float*)(F.lds + 8 * 9216 + 1024); LAS float* shl = gsl + 1024;
    const int e = it / (2 * PX_SG); int r = it % (2 * PX_SG); const int up = r >= PX_SG; if (up) r -= PX_SG;
    const int part = r / 112, n0 = (r % 112) * 32, drow = e * 7168 + (n0 >> 7) * 256 + (up ? 128 : 0) + (n0 & 127);
    conv_strip<true>((up ? p.moe_w_up : p.moe_w_gate) + (size_t)e * 1024 * DFE, DFE, 4 * part, 4, n0, F.WMGU(), 1024, drow, gsl, shl,
                     F.BIAS_MGU() + (part >> 1) * 262144 + (part & 1) * 57344, 1.0f, scr, lane, 0, F8_WSCALE);
}
__device__ __forceinline__ void phase_px(Frame& F) {
    const Params& p = F.p; const int gw = F.c * NWAVE + F.wave, NGW = F.G * NWAVE, lane = F.lane;
    LAS float* scr = (LAS float*)(F.lds + F.wave * 9216);
    const LAS float* nul = nullptr;
    px_tables(F);
    constexpr int I_D = 14 * 32;
    for (int it = (F.G == 256 ? PX_EARLY : 0) + gw; it < NE * 2 * PX_SG; it += NGW) px_gu_item(F, it, lane);
    const int lane2 = lane_id();
    for (int it = gw; it < NE * I_D; it += NGW) {
        const int e = it / I_D, r = it % I_D, kg = r / 32, nb = r % 32;
        conv_strip<true>(p.moe_w_down + (size_t)e * DFE * 1024, 1024, 4 * kg, 4, nb * 32, (bf16_t*)((unsigned char*)F.WMD() + (size_t)e * 1024 * DFE), DFE, nb * 32, nul, nul, nullptr, 1.0f, scr, lane2, 28, F8_DSCALE);
    }
}

__device__ __forceinline__ void phase_scan(Frame& F) {
    const int gt = F.c * NTHR + F.tid, NGT = F.G * NTHR;
    for (int v = gt; v < 131072; v += NGT) {
        const int h = v >> 15; const float dec = F.GP()[h * GPS + RC]; float s0 = 0.f, s1 = 0.f, s2 = 0.f, s3 = 0.f;
        u32x2* ptr = (u32x2*)(F.SB() + (size_t)v * 4);
        for (int n0 = 0; n0 < NRC; n0 += 16) {
            u32x2 kv[16];
#pragma unroll
            for (int j = 0; j < 16; ++j) { kv[j] = (u32x2){0u, 0u}; if (n0 + j < NRC - 1) kv[j] = ptr[(size_t)(n0 + j) * 131072]; }
#pragma unroll
            for (int j = 0; j < 16; ++j) {
                u32x2 o; o.x = pk2(s0, s1); o.y = pk2(s2, s3); ptr[(size_t)(n0 + j) * 131072] = o;
                s0 = s0 * dec + bflo(kv[j].x); s1 = s1 * dec + bfhi(kv[j].x); s2 = s2 * dec + bflo(kv[j].y); s3 = s3 * dec + bfhi(kv[j].y); }
        }
    }
}

namespace ret {
constexpr int BUFB = 40960, OFF_B = 8192, OFF_P = 81920, OFF_RED = 114688, OFF_GP = 118784;
__device__ __forceinline__ int swz(int o) { return o ^ (((o >> 9) & 1) << 5); }
}
#define RET_WAITV(n) asm volatile("s_waitcnt vmcnt(" #n ")" ::: "memory")
#define RET_WAITL0() asm volatile("s_waitcnt lgkmcnt(0)" ::: "memory")
#define RET_BAR() do { asm volatile("" ::: "memory"); __builtin_amdgcn_s_barrier(); asm volatile("" ::: "memory"); } while (0)
__device__ __forceinline__ void phase_ret_fast(Frame& F) {
    using namespace ret;
    const Params& p = F.p; LAS unsigned char* lds = F.lds;
    const int tid = F.tid, lane = tid & 63, wid = F.wave, wr = wid >> 2, wc = wid & 3, fr = lane & 15, fq = lane >> 4;
    const int foff = swz(fr * 64 + fq * 16);
    const int srow = lane >> 2, scol = ((lane & 3) * 8) ^ (((lane >> 5) & 1) * 16);
    LAS float* gps = (LAS float*)(lds + OFF_GP); LAS f32x2* red = (LAS f32x2*)(lds + OFF_RED);
    __syncthreads();
    for (int i = tid; i < 4 * GPS; i += NTHR) gps[i] = F.GP()[i];
    __syncthreads();
    const __amdgpu_buffer_rsrc_t rs = __builtin_amdgcn_make_buffer_rsrc((void*)F.ws, (short)0, 0x7fffffff, 0x00020000);
    const unsigned qoff = (unsigned)((16 * wid + srow) * 1024 + scol) * 2u;
    unsigned soff[4], voff[4];
#pragma unroll
    for (int i = 0; i < 4; ++i) { soff[i] = (unsigned)((16 * (wid + 8 * i) + srow) * 256 + scol) * 2u; voff[i] = (unsigned)((16 * (wid + 8 * i) + srow) * T + scol) * 2u; }
#define RET_GLDS(uoff, loff, dst) __builtin_amdgcn_raw_ptr_buffer_load_lds(rs, (LAS unsigned*)(lds + (dst)), 16, (int)(loff), (int)(uoff), 0, 0)
#define RET_LOADS(kind, ks, b, hh, nn, nk) do { const unsigned _qk = (unsigned)((nn) * 128 * 1024 + (hh) * 256 + 32 * (ks)) * 2u, _kk = (unsigned)((nk) * 128 * 1024 + (hh) * 256 + 32 * (ks)) * 2u; \
        if ((kind) != 2) RET_GLDS((unsigned)WS_Q + _qk, qoff, (b) * BUFB + wid * 1024); \
        if ((kind) == 0) RET_GLDS((unsigned)WS_KN + _kk, qoff, (b) * BUFB + OFF_B + wid * 1024); \
        if ((kind) == 1) { const unsigned _sb = (unsigned)WS_SB + (unsigned)((((nn) >> 1) * 4 + (hh)) * 512 * 256 + 32 * (ks)) * 2u; _Pragma("unroll") for (int _i = 0; _i < 4; ++_i) \
            RET_GLDS(_sb, soff[_i], (b) * BUFB + OFF_B + (wid + 8 * _i) * 1024); } \
        if ((kind) == 2) { const unsigned _vb = (unsigned)WS_VT + (unsigned)((hh) * 512 * T + (nk) * 128 + 32 * (ks)) * 2u; _Pragma("unroll") for (int _i = 0; _i < 4; ++_i) \
            RET_GLDS(_vb, voff[_i], (b) * BUFB + OFF_B + (wid + 8 * _i) * 1024); } } while (0)
    int u = F.c;
    if (u >= 512) return;
#define RET_NOF(uu) ((((uu) >> 4) << 2) | ((((uu) >> 2) & 1) << 1) | ((((uu) >> 3) ^ ((uu) >> 8)) & 1))
    { const int h = u & 3, n = RET_NOF(u); RET_LOADS(0, 0, 0, h, n, n); }
    for (; u < 512; u += F.G) {
        const int h = u & 3, n = RET_NOF(u), t0 = n * 128; const int un = u + F.G; const bool has_next = un < 512; const int hn = un & 3, nn = RET_NOF(un);
        const bool half = (n & 1) != 0;
        f32x4 pacc[4][2];
#pragma unroll
        for (int m = 0; m < 4; ++m)
#pragma unroll
            for (int q = 0; q < 2; ++q) pacc[m][q] = (f32x4){0.f, 0.f, 0.f, 0.f};
#pragma unroll
        for (int ks = 0; ks < 8; ++ks) {
            const int b = ks & 1;
            if (ks < 7) { RET_LOADS(0, ks + 1, b ^ 1, h, n, n); RET_WAITV(2); } else { RET_LOADS(1, 0, b ^ 1, h, n, n); RET_WAITV(5); }
            RET_BAR();
            bf16x8 af[4], bf[2];
#pragma unroll
            for (int m = 0; m < 4; ++m) af[m] = *(const LAS bf16x8*)(lds + b * BUFB + (4 * wr + m) * 1024 + foff);
#pragma unroll
            for (int q = 0; q < 2; ++q) bf[q] = *(const LAS bf16x8*)(lds + b * BUFB + OFF_B + (2 * wc + q) * 1024 + foff);
            RET_WAITL0(); RET_BAR();
#pragma unroll
            for (int m = 0; m < 4; ++m)
#pragma unroll
                for (int q = 0; q < 2; ++q) pacc[m][q] = __builtin_amdgcn_mfma_f32_16x16x32_bf16(bf[q], af[m], pacc[m][q], 0, 0, 0);
            __builtin_amdgcn_sched_barrier(0);
        }
        { int l2 = lane; asm volatile("" : "+v"(l2)); const int fr = l2 & 15, fq = l2 >> 4;
#pragma unroll
        for (int m = 0; m < 4; ++m)
#pragma unroll
            for (int q = 0; q < 2; ++q) { const int r = 64 * wr + 16 * m + fr, cc = 32 * wc + 16 * q + 4 * fq; float v[4];
#pragma unroll
                for (int j = 0; j < 4; ++j) { const int dd = r - (cc + j); v[j] = dd >= 0 ? pacc[m][q][j] * gps[h * GPS + dd] : 0.f; }
                u32x2 w; w.x = pk2(v[0], v[1]); w.y = pk2(v[2], v[3]);
                *(LAS u32x2*)(lds + OFF_P + wc * 8192 + (4 * wr + m) * 1024 + swz(fr * 64 + 32 * q + 8 * fq)) = w; } }
        f32x4 acc[4][8];
#pragma unroll
        for (int m = 0; m < 4; ++m)
#pragma unroll
            for (int q = 0; q < 8; ++q) acc[m][q] = (f32x4){0.f, 0.f, 0.f, 0.f};
#pragma unroll
        for (int ks = 0; ks < 8; ++ks) {
            const int b = ks & 1;
            if (ks < 7) { RET_LOADS(1, ks + 1, b ^ 1, h, n, n); RET_WAITV(5); } else { RET_LOADS(2, 0, b ^ 1, h, n, n); RET_WAITV(4); }
            RET_BAR();
            bf16x8 af[4], bf[8];
#pragma unroll
            for (int m = 0; m < 4; ++m) af[m] = *(const LAS bf16x8*)(lds + b * BUFB + (4 * wr + m) * 1024 + foff);
#pragma unroll
            for (int q = 0; q < 8; ++q) bf[q] = *(const LAS bf16x8*)(lds + b * BUFB + OFF_B + (8 * wc + q) * 1024 + foff);
            RET_WAITL0(); RET_BAR();
#pragma unroll
            for (int m = 0; m < 4; ++m)
#pragma unroll
                for (int q = 0; q < 8; ++q) acc[m][q] = __builtin_amdgcn_mfma_f32_16x16x32_bf16(bf[q], af[m], acc[m][q], 0, 0, 0);
            __builtin_amdgcn_sched_barrier(0);
        }
        { int l3 = lane; asm volatile("" : "+v"(l3)); const int fr = l3 & 15;
#pragma unroll
        for (int m = 0; m < 4; ++m) { const float qd = gps[h * GPS + 64 * wr + 16 * m + fr + 1] * (half ? gps[h * GPS + 128] : 1.0f);
#pragma unroll
            for (int q = 0; q < 8; ++q) acc[m][q] = acc[m][q] * qd; } }
#pragma unroll
        for (int ks = 0; ks < 4; ++ks) {
            const int b = ks & 1;
            if (ks < 3) { RET_LOADS(2, ks + 1, b ^ 1, h, n, n); RET_WAITV(4); }
            else if (half) { RET_LOADS(0, 0, b ^ 1, h, n, n - 1); RET_WAITV(2); }
            else if (has_next) { RET_LOADS(0, 0, b ^ 1, hn, nn, nn); RET_WAITV(2); }
            else { RET_WAITV(0); }
            RET_BAR();
            bf16x8 af[4], bf[8];
#pragma unroll
            for (int m = 0; m < 4; ++m) af[m] = *(const LAS bf16x8*)(lds + OFF_P + ks * 8192 + (4 * wr + m) * 1024 + foff);
#pragma unroll
            for (int q = 0; q < 8; ++q) bf[q] = *(const LAS bf16x8*)(lds + b * BUFB + OFF_B + (8 * wc + q) * 1024 + foff);
            RET_WAITL0(); RET_BAR();
#pragma unroll
            for (int m = 0; m < 4; ++m)
#pragma unroll
                for (int q = 0; q < 8; ++q) acc[m][q] = __builtin_amdgcn_mfma_f32_16x16x32_bf16(bf[q], af[m], acc[m][q], 0, 0, 0);
            __builtin_amdgcn_sched_barrier(0);
        }
        if (half) {
#pragma unroll
            for (int m = 0; m < 4; ++m)
#pragma unroll
                for (int q = 0; q < 2; ++q) pacc[m][q] = (f32x4){0.f, 0.f, 0.f, 0.f};
#pragma unroll
            for (int ks = 0; ks < 8; ++ks) {
                const int b = ks & 1;
                if (ks < 7) { RET_LOADS(0, ks + 1, b ^ 1, h, n, n - 1); RET_WAITV(2); } else { RET_LOADS(2, 0, b ^ 1, h, n, n - 1); RET_WAITV(4); }
                RET_BAR();
                bf16x8 af[4], bf[2];
#pragma unroll
                for (int m = 0; m < 4; ++m) af[m] = *(const LAS bf16x8*)(lds + b * BUFB + (4 * wr + m) * 1024 + foff);
#pragma unroll
                for (int q = 0; q < 2; ++q) bf[q] = *(const LAS bf16x8*)(lds + b * BUFB + OFF_B + (2 * wc + q) * 1024 + foff);
                RET_WAITL0(); RET_BAR();
#pragma unroll
                for (int m = 0; m < 4; ++m)
#pragma unroll
                    for (int q = 0; q < 2; ++q) pacc[m][q] = __builtin_amdgcn_mfma_f32_16x16x32_bf16(bf[q], af[m], pacc[m][q], 0, 0, 0);
                __builtin_amdgcn_sched_barrier(0);
            }
            { int l6 = lane; asm volatile("" : "+v"(l6)); const int fr = l6 & 15, fq = l6 >> 4;
#pragma unroll
            for (int m = 0; m < 4; ++m)
#pragma unroll
                for (int q = 0; q < 2; ++q) { const int r = 64 * wr + 16 * m + fr, cc = 32 * wc + 16 * q + 4 * fq; float v[4];
#pragma unroll
                    for (int j = 0; j < 4; ++j) v[j] = pacc[m][q][j] * gps[h * GPS + 128 + r - (cc + j)];
                    u32x2 w; w.x = pk2(v[0], v[1]); w.y = pk2(v[2], v[3]);
                    *(LAS u32x2*)(lds + OFF_P + wc * 8192 + (4 * wr + m) * 1024 + swz(fr * 64 + 32 * q + 8 * fq)) = w; } }
            RET_WAITL0();
#pragma unroll
            for (int ks = 0; ks < 4; ++ks) {
                const int b = ks & 1;
                if (ks < 3) { RET_LOADS(2, ks + 1, b ^ 1, h, n, n - 1); RET_WAITV(4); }
                else if (has_next) { RET_LOADS(0, 0, b ^ 1, hn, nn, nn); RET_WAITV(2); }
                else { RET_WAITV(0); }
                RET_BAR();
                bf16x8 af[4], bf[8];
    #pragma unroll
                for (int m = 0; m < 4; ++m) af[m] = *(const LAS bf16x8*)(lds + OFF_P + ks * 8192 + (4 * wr + m) * 1024 + foff);
    #pragma unroll
                for (int q = 0; q < 8; ++q) bf[q] = *(const LAS bf16x8*)(lds + b * BUFB + OFF_B + (8 * wc + q) * 1024 + foff);
                RET_WAITL0(); RET_BAR();
    #pragma unroll
                for (int m = 0; m < 4; ++m)
    #pragma unroll
                    for (int q = 0; q < 8; ++q) acc[m][q] = __builtin_amdgcn_mfma_f32_16x16x32_bf16(bf[q], af[m], acc[m][q], 0, 0, 0);
                __builtin_amdgcn_sched_barrier(0);
            }
        }
        { int l4 = lane; asm volatile("" : "+v"(l4)); const int fr = l4 & 15, fq = l4 >> 4;
#pragma unroll
        for (int m = 0; m < 4; ++m) { float s1 = 0.f, s2 = 0.f;
#pragma unroll
            for (int q = 0; q < 8; ++q) { const f32x4 v = acc[m][q]; s1 += (v.x + v.y) + (v.z + v.w); s2 += (v.x * v.x + v.y * v.y) + (v.z * v.z + v.w * v.w); }
            s1 += __shfl_xor(s1, 16); s1 += __shfl_xor(s1, 32); s2 += __shfl_xor(s2, 16); s2 += __shfl_xor(s2, 32);
            if (fq == 0) red[(64 * wr + 16 * m + fr) * 4 + wc] = (f32x2){s1, s2}; }
        RET_WAITL0(); RET_BAR();
#pragma unroll
        for (int m = 0; m < 4; ++m) { const int r = 64 * wr + 16 * m + fr; const f32x2 a = red[r * 4 + 0], b2 = red[r * 4 + 1], c2 = red[r * 4 + 2], d2 = red[r * 4 + 3];
            const float mu = ((a.x + b2.x) + (c2.x + d2.x)) * (1.0f / 512.0f), ex2 = ((a.y + b2.y) + (c2.y + d2.y)) * (1.0f / 512.0f);
            const float rs = 1.0f / sqrtf(ex2 - mu * mu + EPS); const size_t rowoff = (size_t)(t0 + r) * 2048 + h * 512 + 128 * wc + 4 * fq;
#pragma unroll
            for (int q = 0; q < 8; ++q) { const u32x2 gw = *(const u32x2*)(F.Gb() + rowoff + 16 * q); const f32x4 gn = *(const f32x4*)(p.ret_gn_gain + h * 512 + 128 * wc + 16 * q + 4 * fq);
                const f32x4 v = acc[m][q]; u32x2 w;
                w.x = pk2((v.x - mu) * rs * gn.x * bflo(gw.x), (v.y - mu) * rs * gn.y * bfhi(gw.x)); w.y = pk2((v.z - mu) * rs * gn.z * bflo(gw.y), (v.w - mu) * rs * gn.w * bfhi(gw.y));
                *(u32x2*)(F.Y() + rowoff + 16 * q) = w; }
             } }
        RET_BAR();
    }
    RET_WAITV(0); RET_BAR();
#undef RET_GLDS
#undef RET_NOF
#undef RET_LOADS
}

namespace pf { constexpr int XTP = 132, OFF_RS = 42496, OFF_PT = 43008, OFF_WB = 59392, OFF_END = 124928; }
template <int W>
__device__ __forceinline__ void pf_pool(LAS unsigned char* lds, int t0, int tid) {
    using namespace pf; const LAS float* XT = (const LAS float*)lds; const LAS float* RS = (const LAS float*)(lds + OFF_RS);
    const int cp = tid & 63, tb = tid >> 6, r0 = 8 * tb, ch = 2 * cp; float s0 = 0.f, s1 = 0.f;
#pragma unroll
    for (int i = 1; i < W; ++i) { const int rr = 16 + r0 - i; const f32x2 xv = *(const LAS f32x2*)(XT + rr * XTP + ch); const float rs = RS[rr]; s0 += xv.x * rs; s1 += xv.y * rs; }
#pragma unroll
    for (int j = 0; j < 8; ++j) { const int r = r0 + j, rr = 16 + r; const f32x2 xv = *(const LAS f32x2*)(XT + rr * XTP + ch); const float rs = RS[rr]; const float a0 = xv.x * rs, a1 = xv.y * rs;
        s0 += a0; s1 += a1; const int t = t0 + r; const float ic = 1.0f / (float)((t + 1) < W ? (t + 1) : W);
        *(LAS unsigned*)(lds + OFF_PT + (ch >> 5) * 4096 + (r >> 4) * 1024 + ret::swz((r & 15) * 64 + (ch & 31) * 2)) = pk2(s0 * ic - a0, s1 * ic - a1);
        const int ro = rr - W + 1; const f32x2 xo = *(const LAS f32x2*)(XT + ro * XTP + ch); const float rso = RS[ro]; s0 -= xo.x * rso; s1 -= xo.y * rso; }
}
__device__ __forceinline__ void phase_pool_fused(Frame& F) {
    using namespace pf;
    const Params& p = F.p; LAS unsigned char* lds = F.lds; const int tid = F.tid, lane = F.lane, wid = F.wave;
    const bf16_t* X2 = F.XB(); const float* rss = F.ROWSS();     const float* g1 = F.MOD() + NIN + 2 * 1024; const float* WRg = F.WR();
    LAS float* XT = (LAS float*)lds; LAS float* RS = (LAS float*)(lds + OFF_RS);
    const int foff = ret::swz((lane & 15) * 64 + (lane >> 4) * 16);
    const int srow = lane >> 2, scol = ((lane & 3) * 8) ^ (((lane >> 5) & 1) * 16);
    const __amdgpu_buffer_rsrc_t rs_ws = __builtin_amdgcn_make_buffer_rsrc((void*)F.ws, (short)0, 0x7fffffff, 0x00020000);
    unsigned loff[2];
#pragma unroll
    for (int i = 0; i < 2; ++i) loff[i] = (unsigned)((16 * (wid + 8 * i) + srow) * 256 + scol) * 2u;
    for (int seg = F.c; seg < 256; seg += F.G) {
        const int t0 = seg * 64;
        float ss[4], lg[4][8];
#pragma unroll
        for (int m = 0; m < 4; ++m) { ss[m] = 0.f;
#pragma unroll
            for (int e = 0; e < 8; ++e) lg[m][e] = 0.f; }
        __syncthreads();
        if (tid < 80) { const int tt = t0 - 16 + tid; RS[tid] = tt >= 0 ? rstd_row(rss, tt) : 0.f; }
        f32x4 acc[4][2]; u32x2 xv[5];
#define PF_LOADX(gg, kk) do { int _tl = tid; asm volatile("" : "+v"(_tl)); _Pragma("unroll") for (int _i = 0; _i < 5; ++_i) { const int _idx = _tl + 512 * _i, _rr = _idx >> 5, _c4 = (_idx & 31) * 4; const int _tt = t0 - 16 + _rr; \
            xv[_i] = *(const u32x2*)(X2 + (size_t)(_tt < 0 ? 0 : _tt) * 1024 + 256 * (gg) + 128 * (kk) + _c4); } } while (0)
        PF_LOADX(0, 0);
#pragma unroll 1
        for (int it = 0; it < 8; ++it) {
            const int g = it >> 1, kh = it & 1;
            if (kh == 0) {
#pragma unroll
                for (int m = 0; m < 4; ++m) { acc[m][0] = (f32x4){0.f, 0.f, 0.f, 0.f}; acc[m][1] = (f32x4){0.f, 0.f, 0.f, 0.f}; } }
            {
                __syncthreads();
                int tl = tid; asm volatile("" : "+v"(tl));
#pragma unroll
                for (int i = 0; i < 5; ++i) { const int idx = tl + 512 * i, rr = idx >> 5, c4 = (idx & 31) * 4; *(LAS f32x4*)(XT + rr * XTP + c4) = (f32x4){bflo(xv[i].x), bfhi(xv[i].x), bflo(xv[i].y), bfhi(xv[i].y)}; }
#pragma unroll
                for (int kc = 0; kc < 4; ++kc)
#pragma unroll
                    for (int i = 0; i < 2; ++i)
                        __builtin_amdgcn_raw_ptr_buffer_load_lds(rs_ws, (LAS unsigned*)(lds + OFF_WB + kc * 16384 + (wid + 8 * i) * 1024), 16, (int)loff[i], (int)((unsigned)WS_WP + (unsigned)(g * 65536 + kh * 128 + 32 * kc) * 2u), 0, 0);
                { const int itn = it < 7 ? it + 1 : 7; PF_LOADX(itn >> 1, itn & 1); }
                __syncthreads();
                if (g == 0) pf_pool<2>(lds, t0, tl); else if (g == 1) pf_pool<4>(lds, t0, tl); else if (g == 2) pf_pool<8>(lds, t0, tl); else pf_pool<16>(lds, t0, tl);
                asm volatile("s_waitcnt vmcnt(5)" ::: "memory");
                __syncthreads();
#pragma unroll
                for (int kc = 0; kc < 4; ++kc) { bf16x8 af[4], bf[2];
#pragma unroll
                    for (int m = 0; m < 4; ++m) af[m] = *(const LAS bf16x8*)(lds + OFF_PT + kc * 4096 + m * 1024 + foff);
#pragma unroll
                    for (int n = 0; n < 2; ++n) bf[n] = *(const LAS bf16x8*)(lds + OFF_WB + kc * 16384 + (2 * wid + n) * 1024 + foff);
#pragma unroll
                    for (int m = 0; m < 4; ++m)
#pragma unroll
                        for (int n = 0; n < 2; ++n) acc[m][n] = __builtin_amdgcn_mfma_f32_16x16x32_bf16(bf[n], af[m], acc[m][n], 0, 0, 0); }
            }
            if (kh == 0) continue;
            { int l5 = lane; asm volatile("" : "+v"(l5)); const int fr = l5 & 15, fq = l5 >> 4;
              f32x4 x2a[2][4];
#pragma unroll
              for (int n = 0; n < 2; ++n)
#pragma unroll
                for (int m = 0; m < 4; ++m) { const u32x2 w2 = *(const u32x2*)(X2 + (size_t)(t0 + 16 * m + fr) * 1024 + 256 * g + 32 * wid + 16 * n + 4 * fq); x2a[n][m] = (f32x4){bflo(w2.x), bfhi(w2.x), bflo(w2.y), bfhi(w2.y)}; }
              f32x4 bva[2], sva[2], gva[2], wra[2][4], wrb[2][4];
#pragma unroll
              for (int n = 0; n < 2; ++n) { const int cg = 256 * g + 32 * wid + 16 * n + 4 * fq;
                bva[n] = *(const f32x4*)(p.pool_b + cg); sva[n] = *(const f32x4*)(p.pool_scale + cg); gva[n].x = ldv_f(g1 + cg); gva[n].y = ldv_f(g1 + cg + 1); gva[n].z = ldv_f(g1 + cg + 2); gva[n].w = ldv_f(g1 + cg + 3);
#pragma unroll
                for (int j = 0; j < 4; ++j) { wra[n][j] = *(const f32x4*)(WRg + (cg + j) * 8); wrb[n][j] = *(const f32x4*)(WRg + (cg + j) * 8 + 4); } }
#pragma unroll
              for (int n = 0; n < 2; ++n) { const int cg = 256 * g + 32 * wid + 16 * n + 4 * fq;
                const f32x4 bv = bva[n], sv = sva[n], gv = gva[n];
                f32x4 wr0[4], wr1[4];
#pragma unroll
                for (int j = 0; j < 4; ++j) { wr0[j] = wra[n][j]; wr1[j] = wrb[n][j]; }
#pragma unroll
                for (int m = 0; m < 4; ++m) { const size_t o = (size_t)(t0 + 16 * m + fr) * 1024 + cg;
                    const f32x4 xo = x2a[n][m] + gv * ((acc[m][n] + bv) * sv);
                    *(f32x4*)(p.out + o) = xo; *(unsigned*)((unsigned char*)F.Gb() + o) = pk4f8(xo.x, xo.y, xo.z, xo.w);
                    ss[m] += (xo.x * xo.x + xo.y * xo.y) + (xo.z * xo.z + xo.w * xo.w);
                    lg[m][0] += xo.x * wr0[0].x + xo.y * wr0[1].x + xo.z * wr0[2].x + xo.w * wr0[3].x; lg[m][1] += xo.x * wr0[0].y + xo.y * wr0[1].y + xo.z * wr0[2].y + xo.w * wr0[3].y;
                    lg[m][2] += xo.x * wr0[0].z + xo.y * wr0[1].z + xo.z * wr0[2].z + xo.w * wr0[3].z; lg[m][3] += xo.x * wr0[0].w + xo.y * wr0[1].w + xo.z * wr0[2].w + xo.w * wr0[3].w;
                    lg[m][4] += xo.x * wr1[0].x + xo.y * wr1[1].x + xo.z * wr1[2].x + xo.w * wr1[3].x; lg[m][5] += xo.x * wr1[0].y + xo.y * wr1[1].y + xo.z * wr1[2].y + xo.w * wr1[3].y;
                    lg[m][6] += xo.x * wr1[0].z + xo.y * wr1[1].z + xo.z * wr1[2].z + xo.w * wr1[3].z; lg[m][7] += xo.x * wr1[0].w + xo.y * wr1[1].w + xo.z * wr1[2].w + xo.w * wr1[3].w; } } }
        }
#undef PF_LOADX
#pragma unroll
        for (int m = 0; m < 4; ++m) { ss[m] += __shfl_xor(ss[m], 16); ss[m] += __shfl_xor(ss[m], 32);
#pragma unroll
            for (int e = 0; e < 8; ++e) { lg[m][e] += __shfl_xor(lg[m][e], 16); lg[m][e] += __shfl_xor(lg[m][e], 32); } }
        __syncthreads();
        { LAS float* red = (LAS float*)lds; int l6 = lane; asm volatile("" : "+v"(l6)); const int fr = l6 & 15;
          if ((l6 >> 4) == 0) {
#pragma unroll
            for (int m = 0; m < 4; ++m) { LAS float* q = red + ((16 * m + fr) * 8 + wid) * 12; q[0] = ss[m];
#pragma unroll
                for (int e = 0; e < 8; ++e) q[1 + e] = lg[m][e]; } }
          LAS int* cnt = (LAS int*)(lds + OFF_RS);
          if (tid < 8) cnt[tid] = 0;
          __syncthreads();
          if (tid < 64) { float sq = 0.f, a[8];
#pragma unroll
            for (int e = 0; e < 8; ++e) a[e] = 0.f;
#pragma unroll
            for (int w = 0; w < 8; ++w) { const LAS float* q = red + (tid * 8 + w) * 12; sq += q[0];
#pragma unroll
                for (int e = 0; e < 8; ++e) a[e] += q[1 + e]; }
            const int t = t0 + tid; const float rs = rstd_of(sq); float lgt[8]; F.RSTD3()[t] = rs;
#pragma unroll
            for (int e = 0; e < 8; ++e) lgt[e] = rs * a[e] + ldv_f(F.BIAS_R() + e);
            int e0 = 0; float l0 = lgt[0];
#pragma unroll
            for (int e = 1; e < 8; ++e) if (lgt[e] > l0) { l0 = lgt[e]; e0 = e; }
            int e1 = -1; float l1 = -3.0e38f;
#pragma unroll
            for (int e = 0; e < 8; ++e) if (e != e0 && lgt[e] > l1) { l1 = lgt[e]; e1 = e; }
            const float g0 = 1.0f / (1.0f + __expf(l1 - l0));
            F.TOPE()[t * 2] = e0; F.TOPE()[t * 2 + 1] = e1; F.TOPG()[t * 2] = g0; F.TOPG()[t * 2 + 1] = 1.0f - g0;
            atomicAdd((int*)(cnt + e0), 1); atomicAdd((int*)(cnt + e1), 1); }
          __syncthreads();
          if (tid < 8) F.CNT()[seg * 8 + tid] = cnt[tid]; }
    }
    __syncthreads();
}

__device__ __forceinline__ void phase_route2(Frame& F) {
    const int tid = F.tid;
    LAS int* cn = (LAS int*)F.lds;
    LAS int* part = cn + 2048;
    LAS int* tot = part + 512;
    LAS int* te = tot + 32;
    __syncthreads();
    for (int i = tid; i < 2048; i += NTHR) cn[i] = ldv_i(F.CNT() + i);
    __syncthreads();
    { const int e = tid & 7, pq = tid >> 3; part[pq * 8 + e] = cn[(4 * pq) * 8 + e] + cn[(4 * pq + 1) * 8 + e] + cn[(4 * pq + 2) * 8 + e] + cn[(4 * pq + 3) * 8 + e]; }
    __syncthreads();
    if (tid < 8) { int run = 0; for (int q = 0; q < 64; ++q) { const int v = part[q * 8 + tid]; part[q * 8 + tid] = run; run += v; } tot[tid] = run; }
    __syncthreads();
    { const int e = tid & 7, pq = tid >> 3; int run = part[pq * 8 + e];
#pragma unroll
        for (int j = 0; j < 4; ++j) { const int v = cn[(4 * pq + j) * 8 + e]; cn[(4 * pq + j) * 8 + e] = run; run += v; } }
    if (tid == 0) { int sp = 0; for (int e = 0; e < 8; ++e) { const int pd = (tot[e] + 255) / 256 * 256; tot[8 + e] = sp; tot[16 + e] = pd; sp += pd; } tot[24] = sp / 256; }
    __syncthreads();
    for (int seg = F.c; seg < 256; seg += F.G) {
        int e = -1; if (tid < 128) e = ldv_i(F.TOPE() + seg * 128 + tid);
        int rank = 0;
#pragma unroll
        for (int ee = 0; ee < 8; ++ee) { const unsigned long long m = __ballot(e == ee); if (e == ee) rank = __popcll(m & ((1ull << F.lane) - 1ull)); if (tid == 0) te[ee] = __popcll(m); }
        __syncthreads();
        if (tid < 128) { if (tid >= 64) rank += te[e];
            const int pos = tot[8 + e] + cn[seg * 8 + e] + rank, idx = seg * 128 + tid;
            const float gt = ldv_f(F.TOPG() + idx), rsd = ldv_f(F.RSTD3() + (idx >> 1));
            F.BUFTOK()[pos] = idx >> 1; F.BUFGATE()[pos] = gt; F.BUFRS()[pos] = rsd * (1.0f / F8_WSCALE); F.POS()[idx] = pos; }
        __syncthreads();
    }
    if (F.c < 8) { const int e = F.c; const int b0 = tot[8 + e] + tot[e], b1 = tot[8 + e] + tot[16 + e]; for (int r = b0 + tid; r < b1; r += NTHR) { F.BUFTOK()[r] = 0; F.BUFGATE()[r] = 0.f; F.BUFRS()[r] = 0.f; } }
    if (F.c == (8 % F.G)) { if (tid < NBLK) { int e = 0; for (int q = 0; q < 8; ++q) if (tid * 256 >= tot[8 + q] + tot[16 + q]) ++e; F.BLKE()[tid] = e < 7 ? e : 7; } if (tid == NBLK) F.BLKE()[NBLK] = tot[24]; }
}

__device__ __forceinline__ void phase_final(Frame& F) {
    const Params& p = F.p; const int gw = F.c * NWAVE + F.wave, NGW = F.G * NWAVE, lane = F.lane; const float* g2 = F.MOD() + NIN + 5 * 1024;
    const int nused = ldv_i(F.BLKE() + NBLK); const int ntail = (F.G == 256) ? (nused - 128) * 4 : 0; const int spu = ntail > 0 ? moe_tail_spu(ntail) : 1;
    f32x4 gv[4], fg[4];
#pragma unroll
    for (int j = 0; j < 4; ++j) { gv[j] = *((const f32x4*)g2 + lane + 64 * j); fg[j] = *((const f32x4*)p.final_norm_gain + lane + 64 * j); }
    for (int row = 2 * gw; row < T; row += 2 * NGW) {
        f32x4 xv[2][4]; f32x4 fa[2][4];
#pragma unroll
        for (int r = 0; r < 2; ++r) {
            const f32x4* xr = (const f32x4*)(p.out + (size_t)(row + r) * D) + lane;
#pragma unroll
            for (int j = 0; j < 4; ++j) { xv[r][j] = xr[64 * j]; fa[r][j] = (f32x4){0.f, 0.f, 0.f, 0.f}; }
#pragma unroll
            for (int a = 0; a < 2; ++a) { const int pos = ldv_i(F.POS() + (row + r) * 2 + a); const int blk = pos >> 8;
                if (ntail > 0 && blk >= 128) {
#pragma unroll
                    for (int j = 0; j < 4; ++j) { const float* sl = F.YBB() + (size_t)(((blk - 128) * 4 + j) * spu) * 65536 + (size_t)(pos & 255) * 256 + 4 * lane;
                        for (int q = 0; q < spu; ++q) fa[r][j] = fa[r][j] + *(const f32x4*)(sl + (size_t)q * 65536); }
                } else { const u32x2* y = (const u32x2*)(F.YB() + (size_t)pos * D) + lane;
#pragma unroll
                    for (int j = 0; j < 4; ++j) { const u32x2 w = y[64 * j]; fa[r][j] = fa[r][j] + (f32x4){bflo(w.x), bfhi(w.x), bflo(w.y), bfhi(w.y)}; } } } }
#pragma unroll
        for (int r = 0; r < 2; ++r) { f32x4 v[4]; float s = 0.f;
#pragma unroll
            for (int j = 0; j < 4; ++j) { v[j] = xv[r][j] + gv[j] * fa[r][j]; s += (v[j].x * v[j].x + v[j].y * v[j].y) + (v[j].z * v[j].z + v[j].w * v[j].w); }
            s = wave_sum(s); const float rs = rstd_of(s);
            f32x4* o = (f32x4*)(p.out + (size_t)(row + r) * D) + lane;
#pragma unroll
            for (int j = 0; j < 4; ++j) o[64 * j] = v[j] * rs * fg[j]; }
    }
}

template <class Desc, class Epi> __device__ __forceinline__ void run_gemm(Frame& F, const Desc& Dc, const Epi& E) {
    gemm_fast(F.lds, F.ws, Dc, E, F.c, F.G, F.wave);
}

__device__ __forceinline__ void phase_g1(Frame& F) {
    { DescG1a<false> d{F.XB(), F.WIN(), nullptr, 1024, 1024, 16, 128, 128}; EpiG1a<false> e{F.ROWSS(), F.BIAS_IN(), F.TABA(), F.TABB(), F.Q(), F.KN(), F.Gb(), F.GP(), F.KDT()}; run_gemm(F, d, e); }
    { DescG1a<true> d{F.XB(), F.WIN(), nullptr, 1024, 1024, 16, 128, 128}; EpiG1a<true> e{F.ROWSS(), F.BIAS_IN(), F.TABA(), F.TABB(), F.Q(), F.KN(), F.Gb(), F.GP(), F.KDT()}; run_gemm(F, d, e); }
    { DescG1b d{F.XB(), F.WIN(), nullptr, 1024, 1024, 16, 128, 128}; EpiG1b e{F.ROWSS(), F.BIAS_IN(), F.TABA(), F.TABB(), F.GP(), F.KDT(), F.VT()}; run_gemm(F, d, e); }
}
__device__ __forceinline__ void phase_kv(Frame& F) { DescKV d{F.VT(), F.KDT(), nullptr, T, T, 4, 128, 128}; EpiKV e{F.SB()}; run_gemm(F, d, e); }
__device__ __forceinline__ void phase_outproj(Frame& F) {
    DescOut d{F.Y(), F.WOUT(), nullptr, 2048, 2048, 32, 128, 128}; EpiResid<false> e{F.p.x, nullptr, F.XB(), F.ROWSS(), F.MOD() + 2 * 1024, nullptr, nullptr, 1.0f}; run_gemm(F, d, e); }
__device__ __forceinline__ void phase_ffn_up(Frame& F) {
    DescFfnUp d{F.XB(), F.WGU(), nullptr, 1024, 1024, 16, 128, 128}; EpiSwiglu<true, true> e{F.ROWSS(), nullptr, F.BIAS_GU(), F.H1(), DFF, 5632, 2 * 5632}; run_gemm(F, d, e);
    if (F.G == 256 && F.c >= 128) {
        frame_fresh(F); px_tables(F); px_gu_item(F, (F.c - 128) * NWAVE + F.wave, F.lane); __syncthreads(); } }
__device__ __forceinline__ void phase_ffn_down(Frame& F) {
    DescFfnDown d{F.H1(), F.WD(), nullptr, 64, 64, 22, 32768, 32768};     EpiResid<true> e{nullptr, F.XB(), F.XB(), F.ROWSS(), F.MOD() + 5 * 1024, nullptr, nullptr, 1.0f / (F8_DSCALE * F8_HSCALE)}; run_gemm(F, d, e); }
__device__ __forceinline__ void phase_moe_up(Frame& F) {
    DescMoeUp d{F.Gb(), F.WMGU(), F.BUFTOK(), 512, 512, 8, 128, 128, F.BLKE()};     EpiSwiglu<true, true> e{F.ROWSS(), F.BUFRS(), F.BIAS_MGU(), F.H1M(), DFE, 57344, 262144}; run_gemm(F, d, e); }
__device__ __forceinline__ void phase_moe_down(Frame& F) {
    DescMoeDown d{F.H1M(), F.WMD(), nullptr, 64, 64, 28, 32768, 32768, F.BLKE(), F.G}; EpiMoeDown e{F.BUFGATE(), F.YB(), F.YBB()}; run_gemm(F, d, e); }

#define XB_TMO      128
#define XB_XCNT(j)  (256  + 64 * (j))
#define XB_XSUB(j)  (1280 + 64 * (j))
#define XB_XGEN(j)  (2304 + 64 * (j))
#define XB_TOP      3328
#define XB_TOPGEN   3392
#define XCD_BAR_WORDS 3456
#define XB_SPIN_CAP (1u << 18)
__device__ __forceinline__ unsigned xb_ld(unsigned* p)              { return __hip_atomic_load(p, __ATOMIC_RELAXED, __HIP_MEMORY_SCOPE_AGENT); }
__device__ __forceinline__ unsigned xb_add(unsigned* p, unsigned v) { return __hip_atomic_fetch_add(p, v, __ATOMIC_RELAXED, __HIP_MEMORY_SCOPE_AGENT); }
__device__ __forceinline__ unsigned xb_xcc_id() { return (unsigned)__builtin_amdgcn_s_getreg((3 << 11) | 20) & 0xFu; }
#define XB_SPIN(cond, bar) do { unsigned _sp = 0; while (cond) { __builtin_amdgcn_s_sleep(1); \
    if ((++_sp & 255u) == 0u) { if (xb_ld(&(bar)[XB_TMO])) break; if (_sp > XB_SPIN_CAP) { atomicAdd(&(bar)[XB_TMO], 1u); break; } } } } while (0)
struct XcdBarrier { unsigned* bar; unsigned x; volatile LAS unsigned* st; int wave; };
__device__ __forceinline__ XcdBarrier xcd_barrier_post(unsigned* bar, volatile LAS unsigned* st, int wave) {
    XcdBarrier b; b.bar = bar; b.x = xb_xcc_id(); b.st = st; b.wave = wave;
    if (wave == 0 && lane_id() == 0) (void)xb_add(&bar[XB_XCNT(b.x)], 1u);
    return b;
}
__device__ __forceinline__ void xcd_barrier_complete(unsigned* bar, unsigned x, unsigned& nloc, unsigned& nx) {
    const unsigned G = gridDim.x * gridDim.y * gridDim.z;
    unsigned sum, cnt, mine, sp = 0u;
    for (;;) {
        sum = 0u; cnt = 0u; mine = 0u;
#pragma unroll
        for (unsigned j = 0; j < 16; ++j) { const unsigned c = xb_ld(&bar[XB_XCNT(j)]); sum += c; cnt += (c > 0u) ? 1u : 0u; mine = (j == x) ? c : mine; }
        if (sum == G) break;
        __builtin_amdgcn_s_sleep(1);
        if ((++sp & 255u) == 0u) { if (xb_ld(&bar[XB_TMO])) break; if (sp > XB_SPIN_CAP) { atomicAdd(&bar[XB_TMO], 1u); break; } }
    }
    nloc = mine > 0u ? mine : 1u; nx = cnt > 0u ? cnt : 1u;
}
__device__ __forceinline__ void xcd_barrier(const XcdBarrier& b) {
    asm volatile("s_waitcnt vmcnt(0)" ::: "memory");
    __syncthreads();
    if (b.wave == 0 && lane_id() == 0) {
        unsigned* bar = b.bar;
        __builtin_amdgcn_s_waitcnt(0);
        unsigned nloc = b.st[0], nx = b.st[1];
        if (nloc == 0u) { xcd_barrier_complete(bar, b.x, nloc, nx); b.st[0] = nloc; b.st[1] = nx; }
        const unsigned old = xb_add(&bar[XB_XSUB(b.x)], 1u);
        const unsigned gen = old / nloc;
        if (old + 1u == (gen + 1u) * nloc) {
            __builtin_amdgcn_fence(__ATOMIC_RELEASE, "agent");
            asm volatile("s_waitcnt vmcnt(0)" ::: "memory");
            const unsigned og = xb_add(&bar[XB_TOP], 1u);
            const unsigned tg = og / nx;
            if (og + 1u == (tg + 1u) * nx) xb_add(&bar[XB_TOPGEN], 1u);
            else XB_SPIN(xb_ld(&bar[XB_TOPGEN]) == tg, bar);
            __builtin_amdgcn_fence(__ATOMIC_ACQUIRE, "agent");
            xb_add(&bar[XB_XGEN(b.x)], 1u);
            asm volatile("s_waitcnt vmcnt(0)" ::: "memory");
        } else {
            XB_SPIN(xb_ld(&bar[XB_XGEN(b.x)]) == gen, bar);
            __builtin_amdgcn_fence(__ATOMIC_ACQUIRE, "agent");
            asm volatile("s_waitcnt vmcnt(0)" ::: "memory");
        }
    }
    __syncthreads();
}

constexpr int LDSCTL_OFF = 131072;
__global__ void __launch_bounds__(NTHR, 2) k_mega(Params p) {
    extern __shared__ __attribute__((aligned(16))) unsigned char lds_raw[];
    Frame F; frame_init(F, p, (LAS unsigned char*)lds_raw, (int)blockIdx.x, (int)gridDim.x);
    for (int u = F.tid; u < (LDS_BYTES - LDSCTL_OFF) / 4; u += NTHR) ((LAS unsigned*)(F.lds + LDSCTL_OFF))[u] = 0u;
    __syncthreads();
    const XcdBarrier bar = xcd_barrier_post((unsigned*)(p.ws + CT_BAR), (volatile LAS unsigned*)(F.lds + LDSCTL_OFF + 32), F.wave);
#define GRID_BAR() xcd_barrier(bar)

    frame_fresh(F); phase_p0(F); GRID_BAR();
    frame_fresh(F); phase_p1(F); GRID_BAR();
    frame_fresh(F); phase_g1(F); GRID_BAR();
    frame_fresh(F); phase_kv(F); GRID_BAR();
    frame_fresh(F); phase_scan(F); GRID_BAR();
    frame_fresh(F); phase_ret_fast(F); GRID_BAR();
    frame_fresh(F); phase_outproj(F); GRID_BAR();
    frame_fresh(F); phase_ffn_up(F); GRID_BAR();
    frame_fresh(F); phase_ffn_down(F); GRID_BAR();
    if ((F.c >> 3) & 1) { frame_fresh(F); phase_px(F); __syncthreads(); frame_fresh(F); phase_pool_fused(F); } else { frame_fresh(F); phase_pool_fused(F); frame_fresh(F); phase_px(F); }
    GRID_BAR();
    frame_fresh(F); phase_route2(F); GRID_BAR();
    frame_fresh(F); phase_moe_up(F); GRID_BAR();
    frame_fresh(F); phase_moe_down(F); GRID_BAR();
    frame_fresh(F); phase_final(F);
#undef GRID_BAR
}

extern "C" void kernel_launch(void* const* d_in, const int* in_sizes, int n_in, void* d_out, int out_size, void* d_ws, size_t ws_size, hipStream_t stream) {
    static int grid = 0;
    if (grid == 0) {
        if (n_in != 19 || out_size != T * D || ws_size < WS_END) { fprintf(stderr, "kernel_launch: unexpected shapes (n_in %d out %d ws %zu)\n", n_in, out_size, ws_size); grid = -1; return; }
        int dev = 0, cus = 0, per_cu = 0;
        if (hipGetDevice(&dev) != hipSuccess || hipDeviceGetAttribute(&cus, hipDeviceAttributeMultiprocessorCount, dev) != hipSuccess) { grid = -1; return; }
        if (hipFuncSetAttribute((const void*)k_mega, hipFuncAttributeMaxDynamicSharedMemorySize, LDS_BYTES) != hipSuccess) { fprintf(stderr, "kernel_launch: hipFuncSetAttribute failed\n"); grid = -1; return; }
        if (hipOccupancyMaxActiveBlocksPerMultiprocessor(&per_cu, (const void*)k_mega, NTHR, LDS_BYTES) != hipSuccess || per_cu < 1) { fprintf(stderr, "kernel_launch: occupancy query says %d blocks per CU\n", per_cu); (void)hipGetLastError(); grid = -1; return; }
        grid = cus * (per_cu < 1 ? 1 : 1);
    }
    if (grid < 0) return;
    Params p{};
    const float** pp = (const float**)&p;
    for (int i = 0; i < 19; ++i) pp[i] = (const float*)d_in[i];
    p.out = (float*)d_out; p.ws = (unsigned char*)d_ws;
    (void)hipMemsetAsync((char*)d_ws + WS_CTL, 0, 64 * KiB, stream);
    void* args[] = {&p};
    hipError_t e = hipLaunchCooperativeKernel((const void*)k_mega, dim3(grid), dim3(NTHR), args, LDS_BYTES, stream);
    if (e != hipSuccess) fprintf(stderr, "kernel_launch: cooperative launch failed: %s (grid %d)\n", hipGetErrorString(e), grid);
}
```

```cpp
#include <hip/hip_runtime.h>
#include <cstdio>

#define GAS __attribute__((address_space(1)))
#define LAS __attribute__((address_space(3)))
typedef unsigned short bf16_t;
typedef short bf16x8 __attribute__((ext_vector_type(8)));
typedef float f32x4 __attribute__((ext_vector_type(4)));
typedef float f32x2 __attribute__((ext_vector_type(2)));
typedef unsigned u32x4 __attribute__((ext_vector_type(4)));
typedef int i32x4 __attribute__((ext_vector_type(4)));
typedef unsigned u32x2 __attribute__((ext_vector_type(2)));

#ifndef FAST_GEMM
#define FAST_GEMM 1
#endif

constexpr int T = 16384, D = 1024, NH = 4, DK = 256, DV = 512, CH = 128, NCH = 128;
constexpr int NIN = 6144, DFF = 2816, NE = 8, DFE = 3584, CAP = 34816, NBLK = 136;
constexpr float EPS = 1e-6f;
constexpr int GPS = 260, RC = 256, NRC = 64;
constexpr int NTHR = 512, NWAVE = 8;

constexpr size_t KiB = 1024, MiB = 1u << 20;
constexpr size_t WS_CTL = 0, CTL_BYTES = 1 * MiB;
constexpr size_t CT_BAR = 16 * KiB;
constexpr size_t CT_MOD = 64 * KiB;
constexpr size_t CT_BIAS_R = 158 * KiB;
constexpr size_t WS_ROWSSP = 2 * MiB;
constexpr size_t WS_MODP = 3 * MiB;
constexpr size_t CT_BIAS_IN = 3584 * KiB;
constexpr size_t CT_BIAS_GU = 3584 * KiB + 96 * KiB;
constexpr size_t CT_BIAS_MGU = 36 * MiB + 512 * KiB;
constexpr size_t WS_TABA = 1 * MiB;
constexpr size_t WS_TABB = WS_TABA + 128 * KiB;
constexpr size_t WS_GP = WS_TABB + 128 * KiB;
constexpr size_t WS_WR = WS_GP + 8 * KiB;
constexpr size_t WS_TOPE = WS_WR + 32 * KiB;
constexpr size_t WS_TOPG = WS_TOPE + 128 * KiB;
constexpr size_t WS_CNT = WS_TOPG + 128 * KiB;
constexpr size_t WS_BUFTOK = WS_CNT + 8 * KiB;
constexpr size_t WS_BUFGATE = WS_BUFTOK + 136 * KiB;
constexpr size_t WS_POS = WS_BUFGATE + 136 * KiB;
constexpr size_t WS_BLKE = WS_POS + 128 * KiB;
constexpr size_t WS_RSTD3 = 256 * KiB;
constexpr size_t WS_BUFRS = 320 * KiB;
constexpr size_t WS_WIN = 4 * MiB;
constexpr size_t WS_WOUT = 16 * MiB;
constexpr size_t WS_WGU = 20 * MiB;
constexpr size_t WS_WD = 31 * MiB;
constexpr size_t WS_WP = 37 * MiB;
constexpr size_t WS_XB = 38 * MiB;
constexpr size_t WS_Q = 70 * MiB;
constexpr size_t WS_KN = 102 * MiB;
constexpr size_t WS_KDT = 134 * MiB;
constexpr size_t WS_VT = 166 * MiB;
constexpr size_t WS_G = 230 * MiB;
constexpr size_t WS_SB = 294 * MiB;
constexpr size_t WS_Y = 422 * MiB;
constexpr size_t WS_H1 = 70 * MiB;
constexpr size_t WS_PB = 158 * MiB;
constexpr size_t WS_X2 = 158 * MiB;
constexpr size_t WS_H1M = 70 * MiB;
constexpr size_t WS_WMGU = 308 * MiB;
constexpr size_t WS_WMD = 456 * MiB;
constexpr size_t WS_YB = 308 * MiB;
constexpr size_t WS_YBB = 4 * MiB;
constexpr size_t WS_END = 512 * MiB;
static_assert(WS_BUFRS + 136 * KiB <= WS_TABA && WS_BLKE + 4 * KiB <= WS_ROWSSP && WS_MODP + 8 * 12288 * 4 <= CT_BIAS_IN && CT_BIAS_GU + 4 * 5632 * 4 <= WS_WIN, "small region");
static_assert(WS_YBB + (size_t)224 * 65536 * 4 <= WS_H1M && WS_H1M + (size_t)CAP * DFE * 2 <= WS_WMGU && WS_YB + (size_t)CAP * D * 4 <= WS_WMD && WS_WMD + (size_t)NE * D * DFE * 2 <= WS_END, "moe map");
static_assert(WS_Y + (size_t)T * 2048 * 2 <= WS_END && WS_SB + (size_t)128 * 4 * 512 * 256 * 2 <= WS_Y, "ret map");

constexpr int LDS_BYTES = 147456;

struct Params {
    const float *x, *c, *ada_w, *ada_b, *norm_gain, *ret_w_in, *ret_gn_gain, *ret_w_out, *ffn_w_gate, *ffn_w_up, *ffn_w_down,
        *pool_w, *pool_b, *pool_scale, *moe_router, *moe_w_gate, *moe_w_up, *moe_w_down, *final_norm_gain;
    float* out; unsigned char* ws;
};

__device__ __forceinline__ unsigned f2bf(float f) { unsigned u = __builtin_bit_cast(unsigned, f); return (u + 0x7fffu + ((u >> 16) & 1u)) >> 16; }
typedef __bf16 bf16x2_t __attribute__((ext_vector_type(2)));
__device__ __forceinline__ unsigned pk2(float lo, float hi) { const f32x2 v = {lo, hi}; return __builtin_bit_cast(unsigned, __builtin_convertvector(v, bf16x2_t)); }
constexpr float F8_WSCALE = 32.0f, F8_DSCALE = 64.0f, F8_HSCALE = 4.0f;
__device__ __forceinline__ unsigned pk4f8(float a, float b, float c, float d) { int w = __builtin_amdgcn_cvt_pk_fp8_f32(a, b, 0, false); w = __builtin_amdgcn_cvt_pk_fp8_f32(c, d, w, true); return (unsigned)w; }
__device__ __forceinline__ float bf2f(unsigned b) { return __builtin_bit_cast(float, b << 16); }
__device__ __forceinline__ float bflo(unsigned w) { return __builtin_bit_cast(float, w << 16); }
__device__ __forceinline__ float bfhi(unsigned w) { return __builtin_bit_cast(float, w & 0xffff0000u); }
__device__ __forceinline__ float silu_f(float v) { return v * __builtin_amdgcn_rcpf(1.0f + __expf(-v)); }
__device__ __forceinline__ float rstd_of(float ss) { return __builtin_amdgcn_rsqf(ss * (1.0f / 1024.0f) + EPS); }
__device__ __forceinline__ float rstd_row(const float* rssp, int t) {
    const f32x4* q = (const f32x4*)(rssp + (size_t)t * 16); const f32x4 a = q[0], b = q[1], c = q[2], d = q[3];
    const float s = (((a.x + a.y) + (a.z + a.w)) + ((b.x + b.y) + (b.z + b.w))) + (((c.x + c.y) + (c.z + c.w)) + ((d.x + d.y) + (d.z + d.w)));
    return __builtin_amdgcn_rsqf(s * (1.0f / 1024.0f) + EPS);
}
__device__ __forceinline__ float wave_sum(float v) {
#pragma unroll
    for (int o = 1; o < 64; o <<= 1) v += __shfl_xor(v, o);
    return v;
}
__device__ __forceinline__ float ldv_f(const float* p) { return __builtin_bit_cast(float, __hip_atomic_load((const unsigned*)p, __ATOMIC_RELAXED, __HIP_MEMORY_SCOPE_AGENT)); }
__device__ __forceinline__ int ldv_i(const int* p) { return __hip_atomic_load(p, __ATOMIC_RELAXED, __HIP_MEMORY_SCOPE_AGENT); }
__device__ __forceinline__ float bias_sum(const float* b, int idx, int s1, int s2) { return (ldv_f(b + idx) + ldv_f(b + s1 + idx)) + (ldv_f(b + s2 + idx) + ldv_f(b + s2 + s1 + idx)); }
__device__ __forceinline__ void rstd_row_ld(const float* rssp, int t, float (&r)[16]) { const f32x4* q = (const f32x4*)(rssp + (size_t)t * 16);
#pragma unroll
    for (int i = 0; i < 4; ++i) { const f32x4 v = q[i]; r[4 * i] = v.x; r[4 * i + 1] = v.y; r[4 * i + 2] = v.z; r[4 * i + 3] = v.w; } }
__device__ __forceinline__ float rstd_row_fin(const float (&r)[16]) {
    const float s = (((r[0] + r[1]) + (r[2] + r[3])) + ((r[4] + r[5]) + (r[6] + r[7]))) + (((r[8] + r[9]) + (r[10] + r[11])) + ((r[12] + r[13]) + (r[14] + r[15])));
    return __builtin_amdgcn_rsqf(s * (1.0f / 1024.0f) + EPS); }
__device__ __forceinline__ void bias_sum_ld(const float* b, int idx, int s1, int s2, float (&r)[16]) { r[0] = ldv_f(b + idx); r[1] = ldv_f(b + s1 + idx); r[2] = ldv_f(b + s2 + idx); r[3] = ldv_f(b + s2 + s1 + idx); }
__device__ __forceinline__ float bias_sum_fin(const float (&r)[16]) { return (r[0] + r[1]) + (r[2] + r[3]); }

__device__ __forceinline__ int lane_id() { int l; asm volatile("v_mbcnt_lo_u32_b32 %0, -1, 0\n\tv_mbcnt_hi_u32_b32 %0, -1, %0" : "=v"(l)); return l; }

struct Unit { const bf16_t* A; const bf16_t* B; int pm, pn, aux, rowbase, nt; };

__device__ __forceinline__ void tile_order(int L, int nM, int nN, int& pm, int& pn) {
    const int nwg = nM * nN; int wgid = L;
    { const int q = nwg / 8, r = nwg % 8, xcd = wgid % 8, off = wgid / 8; wgid = (xcd < r ? xcd * (q + 1) : r * (q + 1) + (xcd - r) * q) + off; }
    const int nig = 8 * nN, gid = wgid / nig, fm = gid * 8, gsz = (nM - fm) < 8 ? (nM - fm) : 8;
    pm = fm + ((wgid % nig) % gsz); pn = (wgid % nig) / gsz;
}

template <bool GATE> struct DescG1a {
    static constexpr bool GATHER = false; static constexpr bool FP8 = false;
    const bf16_t* xb; const bf16_t* win; const int* tok; int lda, ldb, nt, ksa, ksb;
    __device__ __forceinline__ bool get(int L, Unit& u) const {
        if (L >= 64 * 8) return false; tile_order(L, 64, 8, u.pm, u.pn); if (GATE) u.pn += 8;
        const int wrow = u.pn < 8 ? u.pn * 256 : (u.pn + 8) * 256;
        u.A = xb + (size_t)u.pm * 256 * 1024; u.B = win + (size_t)wrow * 1024; u.aux = wrow; u.rowbase = u.pm * 256; u.nt = nt; return true; }
};
struct DescG1b {
    static constexpr bool GATHER = false; static constexpr bool FP8 = false;
    const bf16_t* xb; const bf16_t* win; const int* tok; int lda, ldb, nt, ksa, ksb;
    __device__ __forceinline__ bool get(int L, Unit& u) const {
        if (L >= 8 * 64) return false; tile_order(L, 8, 64, u.pm, u.pn); u.pm += 4;
        u.A = win + (size_t)(1024 + 256 * u.pm) * 1024; u.B = xb + (size_t)u.pn * 256 * 1024; u.aux = 0; u.rowbase = 0; u.nt = nt; return true; }
};
struct DescKV {
    static constexpr bool GATHER = false; static constexpr bool FP8 = false;
    const bf16_t* vt; const bf16_t* kdt; const int* tok; int lda, ldb, nt, ksa, ksb;
    __device__ __forceinline__ bool get(int L, Unit& u) const {
        if (L >= (NRC - 1) * 8) return false; const int mt = L & 1, h = (L >> 1) & 3, n = L >> 3;
        u.A = vt + (size_t)(h * 512 + 256 * mt) * T + n * RC; u.B = kdt + (size_t)(h * 256) * T + n * RC;
        u.pm = mt; u.pn = 0; u.aux = (n * 4 + h) * 2 + mt; u.rowbase = 0; u.nt = nt; return true; }
};
struct DescOut {
    static constexpr bool GATHER = false; static constexpr bool FP8 = false;
    const bf16_t* y; const bf16_t* w; const int* tok; int lda, ldb, nt, ksa, ksb;
    __device__ __forceinline__ bool get(int L, Unit& u) const {
        if (L >= 256) return false; tile_order(L, 64, 4, u.pm, u.pn);
        u.A = y + (size_t)u.pm * 256 * 2048; u.B = w + (size_t)u.pn * 256 * 2048; u.aux = 0; u.rowbase = u.pm * 256; u.nt = nt; return true; }
};
struct DescFfnUp {
    static constexpr bool GATHER = false; static constexpr bool FP8 = false;
    const bf16_t* xb; const bf16_t* w; const int* tok; int lda, ldb, nt, ksa, ksb;
    __device__ __forceinline__ bool get(int L, Unit& u) const {
        if (L >= 64 * 22) return false; tile_order(L, 64, 22, u.pm, u.pn);
        u.A = xb + (size_t)u.pm * 256 * 1024; u.B = w + (size_t)u.pn * 256 * 1024; u.aux = 256 * u.pn; u.rowbase = u.pm * 256; u.nt = nt; return true; }
};
struct DescFfnDown {
    static constexpr bool GATHER = false; static constexpr bool FP8 = true;
    const bf16_t* h1; const bf16_t* w; const int* tok; int lda, ldb, nt, ksa, ksb;
    __device__ __forceinline__ bool get(int L, Unit& u) const {
        if (L >= 256) return false; tile_order(L, 64, 4, u.pm, u.pn);
        u.A = h1 + (size_t)u.pm * 128 * DFF; u.B = w + (size_t)u.pn * 128 * DFF; u.aux = 0; u.rowbase = u.pm * 256; u.nt = nt; return true; }
};
struct DescMoeUp {
    static constexpr bool GATHER = true; static constexpr bool FP8 = true;
    const bf16_t* xb; const bf16_t* w; const int* tok; int lda, ldb, nt, ksa, ksb; const int* blke;
    __device__ __forceinline__ bool get(int L, Unit& u) const {
        const int nused = ldv_i(blke + NBLK); if (L >= nused * 28) return false; tile_order(L, nused, 28, u.pm, u.pn);
        const int e = ldv_i(blke + u.pm);
        u.A = xb; u.B = w + (size_t)(e * 7168 + 256 * u.pn) * 512; u.aux = e * 7168 + 256 * u.pn; u.rowbase = u.pm * 256; u.nt = nt; return true; }
};
__device__ __forceinline__ int moe_tail_spu(int ntail) { const int q = 256 / ntail; return q >= 14 ? 14 : 7; }
struct DescMoeDown {
    static constexpr bool GATHER = false; static constexpr bool FP8 = true;
    const bf16_t* h1; const bf16_t* w; const int* tok; int lda, ldb, nt, ksa, ksb; const int* blke; int G;
    __device__ __forceinline__ bool get(int L, Unit& u) const {
        const int nused = ldv_i(blke + NBLK); int k0 = 0, npair = 14; u.aux = 0;
        if (G != 256) { if (L >= nused * 4) return false; tile_order(L, nused, 4, u.pm, u.pn); }
        else { const int i = L >> 8, c = L & 255;
            if (i < 2) { const int x = c & 7, j = c >> 3; u.pm = (i * 8 + x) * 8 + (j & 7); u.pn = j >> 3; }
            else { const int ntail = (nused - 128) * 4; if (i > 2 || ntail <= 0) return false; const int spu = moe_tail_spu(ntail); if (c >= ntail * spu) return false;
                const int ut = c / spu, sl = c - ut * spu; u.pm = 128 + (ut >> 2); u.pn = ut & 3; npair = 14 / spu; k0 = sl * npair; u.aux = 1 + c; } }
        const int e = ldv_i(blke + u.pm);
        u.A = h1 + (size_t)u.pm * 128 * DFE + (size_t)k0 * 2 * 16384; u.B = w + (size_t)(e * 4 + u.pn) * 128 * DFE + (size_t)k0 * 2 * 16384;
        u.rowbase = u.pm * 256; u.nt = 2 * npair; return true; }
};

typedef f32x4 Acc[2][2][4][2];

__device__ __forceinline__ void store8bf(bf16_t* p, const float* v) {
    u32x4 w; w.x = pk2(v[0], v[1]); w.y = pk2(v[2], v[3]); w.z = pk2(v[4], v[5]); w.w = pk2(v[6], v[7]); *(u32x4*)p = w; }

template <bool GATE> struct EpiG1a {
    static constexpr bool PERM = true;
    const float* rowss; const float* bias; const f32x2* taba; const f32x2* tabb; bf16_t* Q; bf16_t* KN; bf16_t* Gb; const float* gp; bf16_t* KDT;
    __device__ __forceinline__ void pre_load(const Unit& u, int tid, float (&r)[16]) const { if (tid < 256) r[0] = ldv_f(rowss + (size_t)(u.pm * 256 + tid) * 16); else bias_sum_ld(bias, u.aux + tid - 256, NIN, 2 * NIN, r); }
    __device__ __forceinline__ void pre_store(const Unit&, LAS float* aux, int tid, const float (&r)[16]) const { aux[tid] = tid < 256 ? rstd_of(r[0]) : bias_sum_fin(r); }
    __device__ __forceinline__ void init(LAS float* auxb, int tid) const {
        if (!GATE && tid < 256) { const float v = ((const float*)tabb)[16 * 256 + tid]; auxb[512 + tid] = v; auxb[768 + 512 + tid] = v; } }
    __device__ __forceinline__ void operator()(const Acc& acc, const Unit& u, int wr, int wc, int fr, int fq, const LAS float* aux) const {
        asm volatile("" : "+v"(fr), "+v"(fq));
        const int pn = u.pn, d0 = wc * 32 + 8 * fq;
        float b[2][8];
#pragma unroll
        for (int bj = 0; bj < 2; ++bj) { const f32x4 x = *(const LAS f32x4*)(aux + 256 + 128 * bj + d0), y = *(const LAS f32x4*)(aux + 256 + 128 * bj + d0 + 4);
            b[bj][0] = x.x; b[bj][1] = x.y; b[bj][2] = x.z; b[bj][3] = x.w; b[bj][4] = y.x; b[bj][5] = y.y; b[bj][6] = y.z; b[bj][7] = y.w; }
        if constexpr (!GATE) {
            bf16_t* O = pn < 4 ? Q : KN; const int hcol = (pn & 3) * 256;
            f32x2 ta[8], tn[8], tb[8]; float dec[4];
            { const f32x2* tp0 = taba + (2 * u.pm) * 128 + d0; const f32x2* tpb = tabb + (64 * wr + fr) * 128 + d0;
#pragma unroll
              for (int q = 0; q < 8; ++q) { ta[q] = tp0[q]; tb[q] = tpb[q]; }
#pragma unroll
              for (int m = 0; m < 4; ++m) dec[m] = pn >= 4 ? gp[(pn - 4) * GPS + 127 - (64 * wr + 16 * m + fr)] : 0.f; }
            const float c128 = pn >= 4 ? gp[(pn - 4) * GPS + 128] : 0.f;
#pragma unroll
            for (int it = 0; it < 8; ++it) {
                const int ai = it >> 2, m = ai ? 3 - (it & 3) : (it & 3);
                if (it == 2) { const f32x2* tp1 = taba + (2 * u.pm + 1) * 128 + d0;
#pragma unroll
                    for (int q = 0; q < 8; ++q) tn[q] = tp1[q]; }
                if (it == 4) {
#pragma unroll
                    for (int q = 0; q < 8; ++q) ta[q] = tn[q]; }
                if ((it & 3) != 0) {
                    const float sg = ai ? -1.0f : 1.0f; int dl = 2 * d0; asm volatile("" : "+v"(dl));
#pragma unroll
                    for (int q2 = 0; q2 < 4; ++q2) { const f32x4 R2 = *(const LAS f32x4*)(aux + 512 + dl + 4 * q2);
                        { const f32x2 B = tb[2 * q2]; const float ry = sg * R2.y; tb[2 * q2].x = B.x * R2.x - B.y * ry; tb[2 * q2].y = B.y * R2.x + B.x * ry; }
                        { const f32x2 B = tb[2 * q2 + 1]; const float rw = sg * R2.w; tb[2 * q2 + 1].x = B.x * R2.z - B.y * rw; tb[2 * q2 + 1].y = B.y * R2.z + B.x * rw; } } }
                const int rl = 128 * ai + 64 * wr + 16 * m + fr, t = u.pm * 256 + rl; const float rs = aux[rl];
                float o1[8], o2[8];
#pragma unroll
                for (int q = 0; q < 8; ++q) {
                    const f32x2 A = ta[q], B = tb[q]; const float cs = A.x * B.x - A.y * B.y, sn = A.y * B.x + A.x * B.y;
                    const float v1 = rs * acc[ai][0][m][q >> 2][q & 3] + b[0][q], v2 = rs * acc[ai][1][m][q >> 2][q & 3] + b[1][q];
                    o1[q] = v1 * cs - v2 * sn; o2[q] = v1 * sn + v2 * cs; }
                store8bf(O + (size_t)t * 1024 + hcol + d0, o1); store8bf(O + (size_t)t * 1024 + hcol + 128 + d0, o2);
                if (pn >= 4) {
                    bf16_t* kd = KDT + (size_t)(hcol + d0) * T + t;
                    const float dk = ai ? dec[m] : dec[m] * c128;
#pragma unroll
                    for (int q = 0; q < 8; ++q) { kd[(size_t)q * T] = (bf16_t)(pk2(o1[q] * dk, 0.f) & 0xffffu); kd[(size_t)(128 + q) * T] = (bf16_t)(pk2(o2[q] * dk, 0.f) & 0xffffu); } }
            }
        } else {
#pragma unroll
            for (int ai = 0; ai < 2; ++ai)
#pragma unroll
                for (int m = 0; m < 4; ++m) {
                    const int rl = 128 * ai + 64 * wr + 16 * m + fr, t = u.pm * 256 + rl; const float rs = aux[rl];
#pragma unroll
                    for (int bj = 0; bj < 2; ++bj) { float o[8];
#pragma unroll
                        for (int q = 0; q < 8; ++q) o[q] = silu_f(rs * acc[ai][bj][m][q >> 2][q & 3] + b[bj][q]);
                        store8bf(Gb + (size_t)t * 2048 + (pn - 8) * 256 + 128 * bj + d0, o); }
                }
        }
    }
};
struct EpiG1b {
    static constexpr bool PERM = true;
    const float* rowss; const float* bias; const f32x2* taba; const f32x2* tabb; const float* gp; bf16_t* KDT; bf16_t* VT;
    __device__ __forceinline__ void pre_load(const Unit& u, int tid, float (&r)[16]) const { if (tid < 256) bias_sum_ld(bias, 1024 + 256 * u.pm + tid, NIN, 2 * NIN, r); else r[0] = ldv_f(rowss + (size_t)(u.pn * 256 + tid - 256) * 16); }
    __device__ __forceinline__ void pre_store(const Unit&, LAS float* aux, int tid, const float (&r)[16]) const { aux[tid] = tid < 256 ? bias_sum_fin(r) : rstd_of(r[0]); }
    __device__ __forceinline__ void init(LAS float*, int) const {}
    __device__ __forceinline__ void operator()(const Acc& acc, const Unit& u, int wr, int wc, int fr, int fq, const LAS float* aux) const {
        asm volatile("" : "+v"(fr), "+v"(fq));
        const int pmf = u.pm, tl0 = 32 * wc + 8 * fq, tk0 = u.pn * 256 + tl0;
        float rs[2][8];
#pragma unroll
        for (int bj = 0; bj < 2; ++bj) { const f32x4 x = *(const LAS f32x4*)(aux + 256 + 128 * bj + tl0), y = *(const LAS f32x4*)(aux + 256 + 128 * bj + tl0 + 4);
            rs[bj][0] = x.x; rs[bj][1] = x.y; rs[bj][2] = x.z; rs[bj][3] = x.w; rs[bj][4] = y.x; rs[bj][5] = y.y; rs[bj][6] = y.z; rs[bj][7] = y.w; }
        if (pmf < 4) {
            const int h = pmf;
#pragma unroll
            for (int m = 0; m < 4; ++m) {
                const int d = 64 * wr + 16 * m + fr; const float b1 = aux[d], b2 = aux[128 + d];
#pragma unroll
                for (int bj = 0; bj < 2; ++bj) { float o1[8], o2[8]; const f32x2 A = taba[(2 * u.pn + bj) * 128 + d]; const float4 dq0 = *(const float4*)(gp + h * GPS + 120 - tl0), dq1 = *(const float4*)(gp + h * GPS + 124 - tl0);
                    const float decs[8] = {dq1.w, dq1.z, dq1.y, dq1.x, dq0.w, dq0.z, dq0.y, dq0.x};
#pragma unroll
                    for (int q = 0; q < 8; ++q) { const f32x2 B = tabb[(tl0 + q) * 128 + d]; const float cs = A.x * B.x - A.y * B.y, sn = A.y * B.x + A.x * B.y;
                        const float v1 = rs[bj][q] * acc[0][bj][m][q >> 2][q & 3] + b1, v2 = rs[bj][q] * acc[1][bj][m][q >> 2][q & 3] + b2;
                        o1[q] = (v1 * cs - v2 * sn) * decs[q]; o2[q] = (v1 * sn + v2 * cs) * decs[q]; }
                    store8bf(KDT + (size_t)(256 * h + d) * T + tk0 + 128 * bj, o1); store8bf(KDT + (size_t)(256 * h + 128 + d) * T + tk0 + 128 * bj, o2); }
            }
        } else {
#pragma unroll
            for (int ai = 0; ai < 2; ++ai)
#pragma unroll
                for (int m = 0; m < 4; ++m) {
                    const int rl = 128 * ai + 64 * wr + 16 * m + fr, f = 256 * (pmf - 4) + rl; const float bs = aux[rl];
#pragma unroll
                    for (int bj = 0; bj < 2; ++bj) { float o[8];
#pragma unroll
                        for (int q = 0; q < 8; ++q) o[q] = rs[bj][q] * acc[ai][bj][m][q >> 2][q & 3] + bs;
                        store8bf(VT + (size_t)f * T + tk0 + 128 * bj, o); }
                }
        }
    }
};
struct EpiKV {
    static constexpr bool PERM = true;
    bf16_t* SB;
    __device__ __forceinline__ void pre_load(const Unit&, int, float (&)[16]) const {}
    __device__ __forceinline__ void pre_store(const Unit&, LAS float*, int, const float (&)[16]) const {}
    __device__ __forceinline__ void init(LAS float*, int) const {}
    __device__ __forceinline__ void operator()(const Acc& acc, const Unit& u, int wr, int wc, int fr, int fq, const LAS float*) const {
        asm volatile("" : "+v"(fr), "+v"(fq));
        const int mt = u.aux & 1, nh = u.aux >> 1; bf16_t* base = SB + ((size_t)nh * 512 + 256 * mt) * 256; const int d0 = wc * 32 + 8 * fq;
#pragma unroll
        for (int ai = 0; ai < 2; ++ai)
#pragma unroll
            for (int m = 0; m < 4; ++m) { const int r = 128 * ai + 64 * wr + 16 * m + fr;
#pragma unroll
                for (int bj = 0; bj < 2; ++bj) { float o[8];
#pragma unroll
                    for (int q = 0; q < 8; ++q) o[q] = acc[ai][bj][m][q >> 2][q & 3];
                    store8bf(base + (size_t)r * 256 + 128 * bj + d0, o); } }
    }
};
template <bool BASEB> struct EpiResid {
    static constexpr bool PERM = false;
    const float* base; const bf16_t* baseb; bf16_t* xb; float* rowss; const float* g; const float* cb; const float* cs; float accscale;
    __device__ __forceinline__ void pre_load(const Unit& u, int tid, float (&r)[16]) const {
        if (tid < 256) { const int c = 256 * u.pn + tid; r[0] = ldv_f(g + c); r[1] = cs ? cs[c] : 1.0f; } else { const int c = 256 * u.pn + tid - 256; r[0] = cb ? cb[c] : 0.f; r[1] = 1.0f; } }
    __device__ __forceinline__ void pre_store(const Unit&, LAS float* aux, int tid, const float (&r)[16]) const { aux[256 + tid] = r[0] * r[1] * (tid < 256 ? accscale : 1.0f); }
    __device__ __forceinline__ void init(LAS float*, int) const {}
    __device__ __forceinline__ void operator()(const Acc& acc, const Unit& u, int wr, int wc, int fr, int fq, const LAS float* aux) const {
        asm volatile("" : "+v"(fr), "+v"(fq));
        const int cl0 = 32 * wc + 4 * fq, col0 = 256 * u.pn + cl0;
        f32x4 gv[2][2], cbv[2][2];
#pragma unroll
        for (int bj = 0; bj < 2; ++bj)
#pragma unroll
            for (int n = 0; n < 2; ++n) { gv[bj][n] = *(const LAS f32x4*)(aux + 256 + cl0 + 128 * bj + 16 * n); cbv[bj][n] = *(const LAS f32x4*)(aux + 512 + cl0 + 128 * bj + 16 * n); }
        f32x4 bsv[2][4];
        const size_t o0 = (size_t)(u.pm * 256 + 64 * wr + fr) * 1024 + col0;
#define ER_LOADB(dst, off) do { if constexpr (BASEB) { const u32x2 _w = *(const u32x2*)(baseb + (off)); dst = (f32x4){bflo(_w.x), bfhi(_w.x), bflo(_w.y), bfhi(_w.y)}; } else dst = *(const f32x4*)(base + (off)); } while (0)
#pragma unroll
        for (int j = 0; j < 4; ++j) ER_LOADB(bsv[0][j], o0 + 128 * (j >> 1) + 16 * (j & 1));
#pragma unroll
        for (int it = 0; it < 8; ++it) { const int ai = it >> 2, m = it & 3; const int t = u.pm * 256 + 128 * ai + 64 * wr + 16 * m + fr; float s = 0.f;
            if (it < 7) { const int ai2 = (it + 1) >> 2, m2 = (it + 1) & 3; const size_t o2 = o0 + (size_t)(128 * ai2 + 16 * m2) * 1024;
#pragma unroll
                for (int j = 0; j < 4; ++j) ER_LOADB(bsv[(it + 1) & 1][j], o2 + 128 * (j >> 1) + 16 * (j & 1)); }
#pragma unroll
            for (int bj = 0; bj < 2; ++bj)
#pragma unroll
                for (int n = 0; n < 2; ++n) { const size_t o = (size_t)t * 1024 + col0 + 128 * bj + 16 * n;
                    const f32x4 xo = bsv[it & 1][2 * bj + n] + (acc[ai][bj][m][n] + cbv[bj][n]) * gv[bj][n];
                    s += (xo.x * xo.x + xo.y * xo.y) + (xo.z * xo.z + xo.w * xo.w);
                    { u32x2 w; w.x = pk2(xo.x, xo.y); w.y = pk2(xo.z, xo.w); *(u32x2*)(xb + o) = w; } }
            s += __shfl_xor(s, 16); s += __shfl_xor(s, 32);
            if (fq == 0) rowss[(size_t)t * 16 + u.pn * 4 + wc] = s; }
    }
#undef ER_LOADB
};
template <bool TILED, bool F8OUT = false> struct EpiSwiglu {
    static constexpr bool PERM = true;
    const float* rowss; const float* rowrs; const float* bias; bf16_t* Hout; int ldh, bs1, bs2;
    __device__ __forceinline__ void pre_load(const Unit& u, int tid, float (&r)[16]) const {
        if (tid < 256) { if (rowrs) r[0] = ldv_f(rowrs + u.rowbase + tid); else rstd_row_ld(rowss, u.rowbase + tid, r); } else bias_sum_ld(bias, u.aux + tid - 256, bs1, bs2, r); }
    __device__ __forceinline__ void pre_store(const Unit&, LAS float* aux, int tid, const float (&r)[16]) const { aux[tid] = tid < 256 ? (rowrs ? r[0] : rstd_row_fin(r)) : bias_sum_fin(r); }
    __device__ __forceinline__ void init(LAS float*, int) const {}
    __device__ __forceinline__ void operator()(const Acc& acc, const Unit& u, int wr, int wc, int fr, int fq, const LAS float* aux) const {
        asm volatile("" : "+v"(fr), "+v"(fq));
        const int d0 = wc * 32 + 8 * fq; float bg[8], bu[8];
        { const f32x4 x = *(const LAS f32x4*)(aux + 256 + d0), y = *(const LAS f32x4*)(aux + 256 + d0 + 4), z = *(const LAS f32x4*)(aux + 384 + d0), w = *(const LAS f32x4*)(aux + 384 + d0 + 4);
          bg[0] = x.x; bg[1] = x.y; bg[2] = x.z; bg[3] = x.w; bg[4] = y.x; bg[5] = y.y; bg[6] = y.z; bg[7] = y.w; bu[0] = z.x; bu[1] = z.y; bu[2] = z.z; bu[3] = z.w; bu[4] = w.x; bu[5] = w.y; bu[6] = w.z; bu[7] = w.w; }
        constexpr float KG = -1.4426950408889634f, KU = -0.6931471805599453f * (F8OUT ? F8_HSCALE : 1.0f);
#pragma unroll
        for (int q = 0; q < 8; ++q) { bg[q] *= KG; bu[q] *= KU; }
#pragma unroll
        for (int ai = 0; ai < 2; ++ai)
#pragma unroll
            for (int m = 0; m < 4; ++m) { const int rl = 128 * ai + 64 * wr + 16 * m + fr, row = u.rowbase + rl; const float rs = aux[rl], rsg = rs * KG, rsu = rs * KU; float o[8];
#pragma unroll
                for (int q = 0; q < 8; ++q) {
                    const float x = rsg * acc[ai][0][m][q >> 2][q & 3] + bg[q], y = rsu * acc[ai][1][m][q >> 2][q & 3] + bu[q];
                    o[q] = (x * __builtin_amdgcn_rcpf(1.0f + __builtin_amdgcn_exp2f(x))) * y; }
                if constexpr (F8OUT) {
#pragma unroll
                    for (int q = 0; q < 8; ++q) o[q] = __builtin_amdgcn_fmed3f(o[q], -448.0f, 448.0f);
                    u32x2 w8; w8.x = pk4f8(o[0], o[1], o[2], o[3]); w8.y = pk4f8(o[4], o[5], o[6], o[7]);
                    if (TILED) *(u32x2*)((unsigned char*)Hout + (((size_t)(row >> 8) * (ldh >> 7) + u.pn) * 256 + (row & 255)) * 128 + d0) = w8;
                    else *(u32x2*)((unsigned char*)Hout + (size_t)row * ldh + 128 * u.pn + d0) = w8; }
                else if (TILED) store8bf(Hout + (((size_t)(row >> 8) * (ldh >> 6) + 2 * u.pn + (d0 >> 6)) * 256 + (row & 255)) * 64 + (d0 & 63), o);
                else store8bf(Hout + (size_t)row * ldh + 128 * u.pn + d0, o); }
    }
};
struct EpiMoeDown {
    static constexpr bool PERM = true;
    const float* gate; bf16_t* YB; float* YBB;
    __device__ __forceinline__ void pre_load(const Unit& u, int tid, float (&r)[16]) const { if (tid < 256) r[0] = ldv_f(gate + u.rowbase + tid); }
    __device__ __forceinline__ void pre_store(const Unit&, LAS float* aux, int tid, const float (&r)[16]) const { if (tid < 256) aux[tid] = r[0] * (1.0f / (F8_DSCALE * F8_HSCALE)); }
    __device__ __forceinline__ void init(LAS float*, int) const {}
    __device__ __forceinline__ void operator()(const Acc& acc, const Unit& u, int wr, int wc, int fr, int fq, const LAS float* aux) const {
        asm volatile("" : "+v"(fr), "+v"(fq));
        const int col0 = 256 * u.pn + 32 * wc + 8 * fq;
#pragma unroll
        for (int ai = 0; ai < 2; ++ai)
#pragma unroll
            for (int m = 0; m < 4; ++m) { const int rl = 128 * ai + 64 * wr + 16 * m + fr, row = u.rowbase + rl; const float gt = aux[rl];
#pragma unroll
                for (int bj = 0; bj < 2; ++bj) {
                    if (u.aux == 0) { float o[8];
#pragma unroll
                        for (int q = 0; q < 8; ++q) o[q] = acc[ai][bj][m][q >> 2][q & 3] * gt;
                        store8bf(YB + (size_t)row * 1024 + col0 + 128 * bj, o); }
                    else { float* d = YBB + (size_t)(u.aux - 1) * 65536 + (size_t)rl * 256 + 32 * wc + 8 * fq + 128 * bj;
                        *(f32x4*)d = acc[ai][bj][m][0] * gt; *(f32x4*)(d + 4) = acc[ai][bj][m][1] * gt; } } }
    }
};

namespace pg8 {
constexpr int BM = 256, BK = 64, HALF = 128, HTB = HALF * BK * 2, STAGE_BYTES = 8 * HTB;
__device__ __forceinline__ int lds_byte(int r, int c) { const int st = (r >> 4) * 2 + (c >> 5), rr = r & 15, cc = c & 31, ob = rr * 64 + cc * 2; return st * 1024 + (ob ^ (((ob >> 9) & 1) << 5)); }
__device__ __forceinline__ void stage_rc(int b, int& R, int& C) { const int st = b / 1024, sb = b % 1024, swz = sb ^ (((sb >> 9) & 1) << 5); R = (st >> 1) * 16 + swz / 64; C = (st & 1) * 32 + (swz % 64) / 2; }
__device__ __forceinline__ int perm32(int rho) { const int n = rho >> 4, i = rho & 15; return 8 * (i >> 2) + 4 * n + (i & 3); }
}
typedef int i32x8 __attribute__((ext_vector_type(8)));
__device__ __forceinline__ void mfma_f8_inplace(f32x4& acc, const i32x8 a, const i32x8 b, int sc) {
    asm volatile("v_mfma_scale_f32_16x16x128_f8f6f4 %0, %1, %2, %0, %3, %3 op_sel_hi:[0,0,0]" : "+v"(acc) : "v"(a), "v"(b), "v"(sc)); }
template <class Desc, class Epi>
__device__ __forceinline__ void gemm_fast(LAS unsigned char* lds, const unsigned char* wsb, const Desc& Dc, const Epi& E, int c, int G, int wave_id) {
    using namespace pg8;
    constexpr bool GATHER = Desc::GATHER; constexpr bool FP8 = Desc::FP8;
    int lane_ = lane_id(); asm volatile("" : "+v"(lane_));
    const int wid = wave_id, lane = lane_, tid = wid * 64 + lane, wr = wid >> 2, wc = wid & 3, fr = lane & 15, fq = lane >> 4;
    unsigned vA[2][2], vAn[2][2], vB[2][2];
#pragma unroll
    for (int i = 0; i < 2; ++i) { int R, C; stage_rc(tid * 16 + i * 8192, R, C); const int Rb = Epi::PERM ? ((R & ~31) + perm32(R & 31)) : R;
#pragma unroll
        for (int h = 0; h < 2; ++h) { vA[h][i] = (unsigned)((h * HALF + R) * Dc.lda + C) * 2u; vB[h][i] = (unsigned)((h * HALF + Rb) * Dc.ldb + C) * 2u; vAn[h][i] = vA[h][i]; } }
    const unsigned ksA = (unsigned)Dc.ksa, ksB = (unsigned)Dc.ksb;
    const __amdgpu_buffer_rsrc_t rs = __builtin_amdgcn_make_buffer_rsrc((void*)wsb, (short)0, 0x7fffffff, 0x00020000);
    const unsigned ldsw = (unsigned)wid * 1024u;
    const int aoff = lds_byte(wr * 64 + fr, fq * 8), boff = lds_byte(wc * 32 + fr, fq * 8);
#define PG8_SA(b, h) (((b) * 2 + (h)) * HTB)
#define PG8_SB(b, h) ((4 + (b) * 2 + (h)) * HTB)
#define PG8_STAGE(bufoff, gbase, voff) do { _Pragma("unroll") for (int _i = 0; _i < 2; ++_i) \
        __builtin_amdgcn_raw_ptr_buffer_load_lds(rs, (LAS unsigned*)(lds + (bufoff) + ldsw + _i * 8192), 16, (int)(voff)[_i], (int)(gbase), 0, 0); } while (0)
#define PG8_LDA(dst, b, h) do { _Pragma("unroll") for (int m = 0; m < 4; ++m) _Pragma("unroll") for (int k = 0; k < 2; ++k) dst[m][k] = *(const LAS bf16x8*)(lds + PG8_SA(b, h) + aoff + m * 2048 + k * 1024); } while (0)
#define PG8_LDB(dst, b, h) do { _Pragma("unroll") for (int n = 0; n < 2; ++n) _Pragma("unroll") for (int k = 0; k < 2; ++k) dst[n][k] = *(const LAS bf16x8*)(lds + PG8_SB(b, h) + boff + n * 2048 + k * 1024); } while (0)
#define PG8_CAT(x) __builtin_shufflevector(__builtin_bit_cast(i32x4, x[0]), __builtin_bit_cast(i32x4, x[1]), 0, 1, 2, 3, 4, 5, 6, 7)
#define PG8_MMA(ai, bj, At, Bt) do { __builtin_amdgcn_s_setprio(1); if constexpr (FP8) { _Pragma("unroll") for (int m = 0; m < 4; ++m) _Pragma("unroll") for (int n = 0; n < 2; ++n) \
        mfma_f8_inplace(acc[ai][bj][m][n], PG8_CAT(Bt[n]), PG8_CAT(At[m]), f8sc); } else { \
        _Pragma("unroll") for (int m = 0; m < 4; ++m) _Pragma("unroll") for (int n = 0; n < 2; ++n) _Pragma("unroll") for (int k = 0; k < 2; ++k) \
        acc[ai][bj][m][n] = __builtin_amdgcn_mfma_f32_16x16x32_bf16(Bt[n][k], At[m][k], acc[ai][bj][m][n], 0, 0, 0); } __builtin_amdgcn_s_setprio(0); } while (0)
#define PG8_WAIT_V(n) asm volatile("s_waitcnt vmcnt(" #n ")" ::: "memory")
#define PG8_WAIT_L(n) asm volatile("s_waitcnt lgkmcnt(" #n ")" ::: "memory")
#define PG8_BAR __builtin_amdgcn_s_barrier()
#define PG8_SCHED __builtin_amdgcn_sched_barrier(0)
#define PG8_GATHER_OFFS(dst, un) do { const int _t = wid * 64 + lane_id(); _Pragma("unroll") for (int _i = 0; _i < 2; ++_i) { int _R, _C; stage_rc(_t * 16 + _i * 8192, _R, _C); \
        _Pragma("unroll") for (int _h = 0; _h < 2; ++_h) dst[_h][_i] = (unsigned)(ldv_i(Dc.tok + (un).rowbase + _h * HALF + _R) * Dc.lda + _C) * 2u; } } while (0)
    int f8sc = 0x7f7f7f7f; asm volatile("" : "+v"(f8sc));
    Unit cur, nxt; int ui = 0;
    if (!Dc.get(c, cur)) return;
    LAS float* const auxb = (LAS float*)(lds + 131072 + 1024);
    E.init(auxb, tid);
    { float r0[16]; E.pre_load(cur, tid, r0); E.pre_store(cur, auxb, tid, r0); }
    Acc acc;
#pragma unroll
    for (int a = 0; a < 2; ++a)
#pragma unroll
        for (int b = 0; b < 2; ++b)
#pragma unroll
            for (int m = 0; m < 4; ++m)
#pragma unroll
                for (int n = 0; n < 2; ++n) acc[a][b][m][n] = (f32x4){0.f, 0.f, 0.f, 0.f};
    bf16x8 At[4][2], B0[2][2], B1[2][2];
    unsigned cA = (unsigned)((const unsigned char*)cur.A - wsb), cB = (unsigned)((const unsigned char*)cur.B - wsb);
    if constexpr (GATHER) { PG8_GATHER_OFFS(vA, cur); }
    PG8_STAGE(PG8_SB(0, 0), cB, vB[0]); PG8_STAGE(PG8_SB(0, 1), cB, vB[1]); PG8_STAGE(PG8_SA(0, 0), cA, vA[0]); PG8_STAGE(PG8_SA(0, 1), cA, vA[1]);
    if (wr == 1) PG8_BAR;
    PG8_WAIT_V(2); PG8_BAR;
    PG8_STAGE(PG8_SB(1, 0), cB + ksB, vB[0]); PG8_STAGE(PG8_SA(1, 0), cA + ksA, vA[0]); PG8_STAGE(PG8_SB(1, 1), cB + ksB, vB[1]);
    PG8_WAIT_V(6); PG8_BAR;
    for (;;) {
        const bool has_next = Dc.get((ui + 1) * G + c, nxt);
        const unsigned nA = has_next ? (unsigned)((const unsigned char*)nxt.A - wsb) : cA, nB = has_next ? (unsigned)((const unsigned char*)nxt.B - wsb) : cB;
        if constexpr (GATHER) { if (has_next) { PG8_GATHER_OFFS(vAn, nxt); } else {
#pragma unroll
            for (int h = 0; h < 2; ++h)
#pragma unroll
                for (int i = 0; i < 2; ++i) vAn[h][i] = vA[h][i]; } }
        const int nt = cur.nt;
        for (int t = 0; t < nt; t += 2) {
            const bool last = (t == nt - 2);
            const unsigned a1 = cA + (unsigned)(t + 1) * ksA;
            const unsigned a2 = last ? nA : cA + (unsigned)(t + 2) * ksA, b2 = last ? nB : cB + (unsigned)(t + 2) * ksB;
            const unsigned a3 = a2 + ksA, b3 = b2 + ksB;
            unsigned x0[2], x1[2];
#pragma unroll
            for (int i = 0; i < 2; ++i) { x0[i] = (GATHER && last) ? vAn[0][i] : vA[0][i]; x1[i] = (GATHER && last) ? vAn[1][i] : vA[1][i]; }
            PG8_LDB(B0, 0, 0); PG8_LDB(B1, 0, 1); PG8_SCHED; PG8_LDA(At, 0, 0); PG8_STAGE(PG8_SA(1, 1), a1, vA[1]);
            PG8_WAIT_V(8); PG8_WAIT_L(0); PG8_BAR; PG8_MMA(0, 0, At, B0); PG8_MMA(0, 1, At, B1); PG8_BAR; PG8_SCHED;
            PG8_LDA(At, 0, 1); PG8_STAGE(PG8_SB(0, 0), b2, vB[0]); PG8_STAGE(PG8_SB(0, 1), b2, vB[1]); PG8_STAGE(PG8_SA(0, 0), a2, x0);
            PG8_WAIT_V(8); PG8_WAIT_L(0); PG8_BAR; PG8_MMA(1, 0, At, B0); PG8_MMA(1, 1, At, B1); PG8_BAR; PG8_SCHED;
            PG8_LDB(B0, 1, 0); PG8_LDB(B1, 1, 1); PG8_SCHED; PG8_LDA(At, 1, 0); PG8_STAGE(PG8_SA(0, 1), a2, x1);
            PG8_WAIT_V(8); PG8_WAIT_L(0); PG8_BAR; PG8_MMA(0, 0, At, B0); PG8_MMA(0, 1, At, B1); PG8_BAR; PG8_SCHED;
            PG8_LDA(At, 1, 1); PG8_STAGE(PG8_SB(1, 0), b3, vB[0]); PG8_STAGE(PG8_SB(1, 1), b3, vB[1]); PG8_STAGE(PG8_SA(1, 0), a3, x0);
            PG8_WAIT_V(8); PG8_WAIT_L(0); PG8_BAR; PG8_MMA(1, 0, At, B0); PG8_MMA(1, 1, At, B1); PG8_BAR; PG8_SCHED;
        }
        if constexpr (FP8) asm volatile("s_nop 15\n\ts_nop 15\n\ts_nop 15\n\ts_nop 15\n\ts_nop 15" ::: "memory");
        if (wr == 0) PG8_BAR;
        { const int l2 = lane_id(); float rn[16];
          if (has_next) E.pre_load(nxt, wid * 64 + l2, rn);
          E(acc, cur, wr, wc, l2 & 15, l2 >> 4, auxb + (ui & 1) * 768);
          if (has_next) E.pre_store(nxt, auxb + ((ui + 1) & 1) * 768, wid * 64 + l2, rn); }
        if (!has_next) break;
#pragma unroll
        for (int a = 0; a < 2; ++a)
#pragma unroll
            for (int b = 0; b < 2; ++b)
#pragma unroll
                for (int m = 0; m < 4; ++m)
#pragma unroll
                    for (int n = 0; n < 2; ++n) acc[a][b][m][n] = (f32x4){0.f, 0.f, 0.f, 0.f};
        cur = nxt; cA = nA; cB = nB; ++ui;
        if constexpr (GATHER) {
#pragma unroll
            for (int h = 0; h < 2; ++h)
#pragma unroll
                for (int i = 0; i < 2; ++i) vA[h][i] = vAn[h][i]; }
        if (wr == 1) PG8_BAR;
    }
    PG8_WAIT_V(0);
    PG8_BAR;
#undef PG8_SA
#undef PG8_SB
#undef PG8_STAGE
#undef PG8_LDA
#undef PG8_LDB
#undef PG8_MMA
#undef PG8_CAT
#undef PG8_WAIT_V
#undef PG8_WAIT_L
#undef PG8_BAR
#undef PG8_SCHED
#undef PG8_GATHER_OFFS
}

struct Frame {
    Params p; unsigned char* ws; LAS unsigned char* lds; int tid, lane, wave, c, G;
    __device__ __forceinline__ float* MOD() const { return (float*)(ws + CT_MOD); }
    __device__ __forceinline__ float* BIAS_IN() const { return (float*)(ws + CT_BIAS_IN); }
    __device__ __forceinline__ float* BIAS_GU() const { return (float*)(ws + CT_BIAS_GU); }
    __device__ __forceinline__ float* BIAS_R() const { return (float*)(ws + CT_BIAS_R); }
    __device__ __forceinline__ float* BIAS_MGU() const { return (float*)(ws + CT_BIAS_MGU); }
    __device__ __forceinline__ float* ROWSS() const { return (float*)(ws + WS_ROWSSP); }
    __device__ __forceinline__ float* MODP() const { return (float*)(ws + WS_MODP); }
    __device__ __forceinline__ f32x2* TABA() const { return (f32x2*)(ws + WS_TABA); }
    __device__ __forceinline__ f32x2* TABB() const { return (f32x2*)(ws + WS_TABB); }
    __device__ __forceinline__ float* GP() const { return (float*)(ws + WS_GP); }
    __device__ __forceinline__ float* WR() const { return (float*)(ws + WS_WR); }
    __device__ __forceinline__ int* TOPE() const { return (int*)(ws + WS_TOPE); }
    __device__ __forceinline__ float* TOPG() const { return (float*)(ws + WS_TOPG); }
    __device__ __forceinline__ int* CNT() const { return (int*)(ws + WS_CNT); }
    __device__ __forceinline__ int* BUFTOK() const { return (int*)(ws + WS_BUFTOK); }
    __device__ __forceinline__ float* BUFGATE() const { return (float*)(ws + WS_BUFGATE); }
    __device__ __forceinline__ int* POS() const { return (int*)(ws + WS_POS); }
    __device__ __forceinline__ int* BLKE() const { return (int*)(ws + WS_BLKE); }
    __device__ __forceinline__ float* RSTD3() const { return (float*)(ws + WS_RSTD3); }
    __device__ __forceinline__ float* BUFRS() const { return (float*)(ws + WS_BUFRS); }
    __device__ __forceinline__ bf16_t* WIN() const { return (bf16_t*)(ws + WS_WIN); }
    __device__ __forceinline__ bf16_t* WOUT() const { return (bf16_t*)(ws + WS_WOUT); }
    __device__ __forceinline__ bf16_t* WGU() const { return (bf16_t*)(ws + WS_WGU); }
    __device__ __forceinline__ bf16_t* WD() const { return (bf16_t*)(ws + WS_WD); }
    __device__ __forceinline__ bf16_t* WP() const { return (bf16_t*)(ws + WS_WP); }
    __device__ __forceinline__ bf16_t* XB() const { return (bf16_t*)(ws + WS_XB); }
    __device__ __forceinline__ bf16_t* Q() const { return (bf16_t*)(ws + WS_Q); }
    __device__ __forceinline__ bf16_t* KN() const { return (bf16_t*)(ws + WS_KN); }
    __device__ __forceinline__ bf16_t* KDT() const { return (bf16_t*)(ws + WS_KDT); }
    __device__ __forceinline__ bf16_t* VT() const { return (bf16_t*)(ws + WS_VT); }
    __device__ __forceinline__ bf16_t* Gb() const { return (bf16_t*)(ws + WS_G); }
    __device__ __forceinline__ bf16_t* SB() const { return (bf16_t*)(ws + WS_SB); }
    __device__ __forceinline__ bf16_t* Y() const { return (bf16_t*)(ws + WS_Y); }
    __device__ __forceinline__ bf16_t* H1() const { return (bf16_t*)(ws + WS_H1); }
    __device__ __forceinline__ bf16_t* PB() const { return (bf16_t*)(ws + WS_PB); }
    __device__ __forceinline__ bf16_t* H1M() const { return (bf16_t*)(ws + WS_H1M); }
    __device__ __forceinline__ bf16_t* WMGU() const { return (bf16_t*)(ws + WS_WMGU); }
    __device__ __forceinline__ bf16_t* WMD() const { return (bf16_t*)(ws + WS_WMD); }
    __device__ __forceinline__ bf16_t* YB() const { return (bf16_t*)(ws + WS_YB); }
    __device__ __forceinline__ float* YBB() const { return (float*)(ws + WS_YBB); }
    __device__ __forceinline__ float* X2() const { return (float*)(ws + WS_X2); }
    __device__ __forceinline__ bf16_t* X3B() const { return (bf16_t*)(ws + WS_G + 32 * MiB); }
};
__device__ __forceinline__ void frame_fresh(Frame& F) { int l = lane_id(); asm volatile("" : "+v"(l)); F.lane = l; F.tid = F.wave * 64 + l; }
__device__ __forceinline__ void frame_init(Frame& F, const Params& p, LAS unsigned char* lds, int c, int G) {
    F.p = p; F.ws = p.ws; F.lds = lds; F.tid = threadIdx.x; F.lane = F.tid & 63; F.wave = __builtin_amdgcn_readfirstlane(F.tid >> 6); F.c = c; F.G = G;
}

__device__ __forceinline__ void dsincos(double x, double& s, double& c) {
    const double k = rint(x * 0.6366197723675814); double y = fma(-k, 1.5707963267948966, x); y = fma(-k, 6.123233995736766e-17, y);
    const double z = y * y;
    double sp = -7.6471637318198164759e-13; sp = fma(sp, z, 1.6059043836821614599e-10); sp = fma(sp, z, -2.5052108385441718775e-8); sp = fma(sp, z, 2.7557319223985890653e-6);
    sp = fma(sp, z, -1.9841269841269841270e-4); sp = fma(sp, z, 8.3333333333333333333e-3); sp = fma(sp, z, -1.6666666666666666667e-1); const double sy = fma(sp * z, y, y);
    double cp = 4.7794773323873852974e-14; cp = fma(cp, z, -1.1470745597729724714e-11); cp = fma(cp, z, 2.0876756987868098979e-9); cp = fma(cp, z, -2.7557319223985890653e-7);
    cp = fma(cp, z, 2.4801587301587301587e-5); cp = fma(cp, z, -1.3888888888888888889e-3); cp = fma(cp, z, 4.1666666666666666667e-2); cp = fma(cp, z, -0.5); const double cy = fma(cp, z, 1.0);
    const int q = ((int)k) & 3;
    s = (q == 0) ? sy : (q == 1) ? cy : (q == 2) ? -sy : -cy;
    c = (q == 0) ? cy : (q == 1) ? -sy : (q == 2) ? -cy : sy;
}
__device__ __forceinline__ void phase_p0(Frame& F) {
    const Params& p = F.p; const int gw = F.c * NWAVE + F.wave, NGW = F.G * NWAVE, lane = F.lane;
    LAS float* cact = (LAS float*)F.lds;
    __syncthreads();
    for (int k = F.tid; k < 1024; k += NTHR) cact[k] = silu_f(p.c[k]);
    __syncthreads();
    for (int task = gw; task < 1536; task += NGW) {
        const int i = task / 768, rem = task % 768, cb = rem >> 3, ks = rem & 7, n = cb * 64 + lane;
        const float* w = p.ada_w + (size_t)i * 1024 * NIN + (size_t)(ks * 128) * NIN + n; float a = 0.f;
#pragma unroll
        for (int k0 = 0; k0 < 128; k0 += 32) { float wv[32];
#pragma unroll
            for (int k = 0; k < 32; ++k) wv[k] = w[(size_t)(k0 + k) * NIN];
#pragma unroll
            for (int k = 0; k < 32; ++k) a = fmaf(cact[ks * 128 + k0 + k], wv[k], a); }
        if (ks == 0) a += p.ada_b[i * NIN + n];
        F.MODP()[ks * 12288 + i * NIN + n] = a;
    }
    const int gt = F.c * NTHR + F.tid, NGT = F.G * NTHR;
    for (int e = gt; e < 32768 + 4; e += NGT) {
        if (e < 32768) {
            const int which = e >> 14, ab = (e >> 7) & 127, i = e & 127; double inv = 1.0;
            for (int q = 0; q < i; ++q) inv *= 0.93057204092969897929;
            const double ang = (double)(which == 0 ? 128 * ab : ab) * inv; double s, c2; dsincos(ang, s, c2);
            (which == 0 ? F.TABA() : F.TABB())[ab * 128 + i] = (f32x2){(float)c2, (float)s};
        } else {
            const int h = e - 32768; const double g = 1.0 - 1.0 / (double)(32 << h); double v = 1.0;
            for (int j = 0; j <= 256; ++j) { F.GP()[h * GPS + j] = (float)v; v *= g; }
        }
    }
    for (int row = 2 * gw; row < T; row += 2 * NGW) {
        f32x4 v[2][4];
#pragma unroll
        for (int r = 0; r < 2; ++r) { const f32x4* xr = (const f32x4*)(p.x + (size_t)(row + r) * D) + lane;
#pragma unroll
            for (int j = 0; j < 4; ++j) v[r][j] = xr[64 * j]; }
#pragma unroll
        for (int r = 0; r < 2; ++r) { float s = 0.f;
#pragma unroll
            for (int j = 0; j < 4; ++j) s += (v[r][j].x * v[r][j].x + v[r][j].y * v[r][j].y) + (v[r][j].z * v[r][j].z + v[r][j].w * v[r][j].w);
            s = wave_sum(s); if (lane < 16) F.ROWSS()[(size_t)(row + r) * 16 + lane] = (lane == 0) ? s : 0.f;
            u32x2* o = (u32x2*)(F.XB() + (size_t)(row + r) * D) + lane;
#pragma unroll
            for (int j = 0; j < 4; ++j) { u32x2 w; w.x = pk2(v[r][j].x, v[r][j].y); w.y = pk2(v[r][j].z, v[r][j].w); o[64 * j] = w; } }
    }
}

template <bool F8 = false>
__device__ __forceinline__ void conv_strip(const float* W, int ldw, int kb0, int nkb, int n0, bf16_t* WT, int ldt, int drow0, const LAS float* gsl, const LAS float* shl,
                                           float* bias, float cscale, LAS float* scr, int lane, int tiled_nkt = 0, float wmul = 1.0f) {
    f32x4 bacc = (f32x4){0.f, 0.f, 0.f, 0.f}; f32x4 w[8];
    const int lr = lane >> 3, lc = 4 * (lane & 7);
    const float* wp = W + (size_t)(kb0 * 64 + lr) * ldw + n0 + lc;
#pragma unroll
    for (int i = 0; i < 8; ++i) w[i] = *(const f32x4*)(wp + (size_t)(8 * i) * ldw);
    for (int kb = kb0; kb < kb0 + nkb; ++kb) {
        const int k0 = kb * 64; f32x4 wn[8];
        if (kb + 1 < kb0 + nkb) {
#pragma unroll
            for (int i = 0; i < 8; ++i) wn[i] = *(const f32x4*)(wp + (size_t)(64 * (kb + 1 - kb0) + 8 * i) * ldw);
        } else {
#pragma unroll
            for (int i = 0; i < 8; ++i) wn[i] = (f32x4){0.f, 0.f, 0.f, 0.f};
        }
#pragma unroll
        for (int i = 0; i < 8; ++i) { const int kk = lr + 8 * i;
            float gsv = cscale * wmul; if (gsl) { gsv *= gsl[k0 + kk]; const float sv = shl[k0 + kk]; bacc = bacc + w[i] * sv; }
            *(LAS f32x4*)(scr + kk * 36 + 4 * ((lane & 7) ^ i)) = w[i] * gsv; }
        asm volatile("s_waitcnt lgkmcnt(0)" ::: "memory");
        const int cc = lane & 7;
#pragma unroll
        for (int j = 0; j < 4; ++j) { const int n = (lane >> 3) + 8 * j; const LAS float* s = scr + (8 * cc) * 36 + 4 * ((n >> 2) ^ cc) + (n & 3);
            const int nr = drow0 + n;
            if constexpr (F8) { u32x2 o8; o8.x = pk4f8(s[0 * 36], s[1 * 36], s[2 * 36], s[3 * 36]); o8.y = pk4f8(s[4 * 36], s[5 * 36], s[6 * 36], s[7 * 36]);
                if (tiled_nkt) *(u32x2*)((unsigned char*)WT + (((size_t)(nr >> 8) * tiled_nkt + (kb >> 1)) * 256 + (nr & 255)) * 128 + (kb & 1) * 64 + 8 * cc) = o8;
                else *(u32x2*)((unsigned char*)WT + (size_t)nr * ldt + k0 + 8 * cc) = o8;
                continue; }
            u32x4 o; o.x = pk2(s[0 * 36], s[1 * 36]); o.y = pk2(s[2 * 36], s[3 * 36]); o.z = pk2(s[4 * 36], s[5 * 36]); o.w = pk2(s[6 * 36], s[7 * 36]);
            if (tiled_nkt) *(u32x4*)(WT + (((size_t)(nr >> 8) * tiled_nkt + kb) * 256 + (nr & 255)) * 64 + 8 * cc) = o;
            else *(u32x4*)(WT + (size_t)nr * ldt + k0 + 8 * cc) = o; }
        asm volatile("s_waitcnt lgkmcnt(0)" ::: "memory");
#pragma unroll
        for (int i = 0; i < 8; ++i) w[i] = wn[i];
    }
    if (bias) {
#pragma unroll
        for (int o = 8; o < 64; o <<= 1) { bacc.x += __shfl_xor(bacc.x, o); bacc.y += __shfl_xor(bacc.y, o); bacc.z += __shfl_xor(bacc.z, o); bacc.w += __shfl_xor(bacc.w, o); }
        if (lane < 8) *(f32x4*)(bias + drow0 + lc) = bacc * cscale; }
}
__device__ __forceinline__ void phase_p1(Frame& F) {
    const Params& p = F.p; const int gw = F.c * NWAVE + F.wave, NGW = F.G * NWAVE, lane = F.lane;
    LAS float* modl = (LAS float*)F.lds;
    LAS float* scr = (LAS float*)(F.lds + 49152 + F.wave * 9216);
    __syncthreads();
    for (int idx = F.tid; idx < 12288; idx += NTHR) { float v = 0.f;
#pragma unroll
        for (int ks = 0; ks < 8; ++ks) v += F.MODP()[ks * 12288 + idx];
        modl[idx] = v; if ((idx % F.G) == F.c) F.MOD()[idx] = v; }
    __syncthreads();
    const LAS float* MOD0 = modl; const LAS float* MOD1 = modl + NIN; const LAS float* nul = nullptr;
    LAS float* gs_in = modl + 2048; LAS float* gs_ffn = modl + 5120; LAS float* gs_pool = modl + NIN + 2048;
    for (int k = F.tid; k < 1024; k += NTHR) { gs_in[k] = p.norm_gain[k] * (1.0f + MOD0[1024 + k]); gs_ffn[k] = p.norm_gain[1024 + k] * (1.0f + MOD0[4 * 1024 + k]); gs_pool[k] = p.norm_gain[2048 + k] * (1.0f + MOD1[1024 + k]); }
    __syncthreads();
    constexpr int S_IN = 192 * 4, S_G = 88 * 4, I_OUT = 32 * 32, I_D = 44 * 32, I_P = 4 * 4 * 8;
    constexpr int NIT = S_IN + 2 * S_G + I_OUT + I_D + I_P + 1;
    for (int it = gw; it < NIT; it += NGW) {
        int r = it;
        if (r < S_IN) { const int part = r / 192, n0 = (r % 192) * 32; const float cs = (n0 >= 1024 && n0 < 2048) ? 0.0625f : 1.0f;
            conv_strip(p.ret_w_in, NIN, 4 * part, 4, n0, F.WIN(), 1024, n0, gs_in, MOD0, F.BIAS_IN() + part * NIN, cs, scr, lane); continue; } r -= S_IN;
        if (r < 2 * S_G) { const int up = r >= S_G; if (up) r -= S_G; const int part = r / 88, n0 = (r % 88) * 32, drow = (n0 >> 7) * 256 + (up ? 128 : 0) + (n0 & 127);
            conv_strip(up ? p.ffn_w_up : p.ffn_w_gate, DFF, 4 * part, 4, n0, F.WGU(), 1024, drow, gs_ffn, MOD0 + 3 * 1024, F.BIAS_GU() + part * 5632, 1.0f, scr, lane); continue; } r -= 2 * S_G;
        if (r < I_OUT) { const int kb = r / 32, nb = r % 32; conv_strip(p.ret_w_out, 1024, kb, 1, nb * 32, F.WOUT(), 2048, nb * 32, nul, nul, nullptr, 1.0f, scr, lane); continue; } r -= I_OUT;
        if (r < I_D) { const int kb = r / 32, nb = r % 32; conv_strip<true>(p.ffn_w_down, 1024, kb, 1, nb * 32, F.WD(), DFF, nb * 32, nul, nul, nullptr, 1.0f, scr, lane, 22, F8_DSCALE); continue; } r -= I_D;
        if (r < I_P) { const int g = r / 32, q = r % 32, kb = q / 8, nb = q % 8;
            conv_strip(p.pool_w + (size_t)g * 65536, 256, kb, 1, nb * 32, F.WP() + (size_t)g * 65536, 256, nb * 32, gs_pool + g * 256, MOD1 + g * 256, nullptr, 1.0f, scr, lane); continue; }
        { float ba = 0.f; const int e = lane & 7;
            for (int k0 = lane >> 3; k0 < 1024; k0 += 128) { float w[16], gn[16];
#pragma unroll
                for (int j = 0; j < 16; ++j) { const int k = k0 + 8 * j; w[j] = p.moe_router[k * 8 + e]; gn[j] = p.norm_gain[3 * 1024 + k]; }
#pragma unroll
                for (int j = 0; j < 16; ++j) { const int k = k0 + 8 * j; F.WR()[k * 8 + e] = w[j] * (gn[j] * (1.0f + MOD1[4 * 1024 + k])); ba = fmaf(MOD1[3 * 1024 + k], w[j], ba); } }
            ba += __shfl_xor(ba, 8); ba += __shfl_xor(ba, 16); ba += __shfl_xor(ba, 32);
            if (lane < 8) F.BIAS_R()[lane] = ba; }
    }
}
constexpr int PX_SG = 112 * 4, PX_EARLY = 1024;
__device__ __forceinline__ void px_tables(Frame& F) {
    const Params& p = F.p;
    LAS float* gsl = (LAS float*)(F.lds + 8 * 9216 + 1024);
    LAS float* shl = gsl + 1024;
    const float* MOD1 = F.MOD() + NIN;
    for (int k = F.tid; k < 1024; k += NTHR) { gsl[k] = p.norm_gain[3 * 1024 + k] * (1.0f + ldv_f(MOD1 + 4 * 1024 + k)); shl[k] = ldv_f(MOD1 + 3 * 1024 + k); }
    __syncthreads();
}
__device__ __forceinline__ void px_gu_item(Frame& F, int it, int lane) {
    const Params& p = F.p;
    LAS float* scr = (LAS float*)(F.lds + F.wave * 9216);
    LAS float* gsl = (LAS float*)(F.lds + 8 * 9216 + 1024); LAS float* shl = gsl + 1024;
    const int e = it / (2 * PX_SG); int r = it % (2 * PX_SG); const int up = r >= PX_SG; if (up) r -= PX_SG;
    const int part = r / 112, n0 = (r % 112) * 32, drow = e * 7168 + (n0 >> 7) * 256 + (up ? 128 : 0) + (n0 & 127);
    conv_strip<true>((up ? p.moe_w_up : p.moe_w_gate) + (size_t)e * 1024 * DFE, DFE, 4 * part, 4, n0, F.WMGU(), 1024, drow, gsl, shl,
                     F.BIAS_MGU() + (part >> 1) * 262144 + (part & 1) * 57344, 1.0f, scr, lane, 0, F8_WSCALE);
}
__device__ __forceinline__ void phase_px(Frame& F) {
    const Params& p = F.p; const int gw = F.c * NWAVE + F.wave, NGW = F.G * NWAVE, lane = F.lane;
    LAS float* scr = (LAS float*)(F.lds + F.wave * 9216);
    const LAS float* nul = nullptr;
    px_tables(F);
    constexpr int I_D = 14 * 32;
    for (int it = (F.G == 256 ? PX_EARLY : 0) + gw; it < NE * 2 * PX_SG; it += NGW) px_gu_item(F, it, lane);
    const int lane2 = lane_id();
    for (int it = gw; it < NE * I_D; it += NGW) {
        const int e = it / I_D, r = it % I_D, kg = r / 32, nb = r % 32;
        conv_strip<true>(p.moe_w_down + (size_t)e * DFE * 1024, 1024, 4 * kg, 4, nb * 32, (bf16_t*)((unsigned char*)F.WMD() + (size_t)e * 1024 * DFE), DFE, nb * 32, nul, nul, nullptr, 1.0f, scr, lane2, 28, F8_DSCALE);
    }
}

__device__ __forceinline__ void phase_scan(Frame& F) {
    const int gt = F.c * NTHR + F.tid, NGT = F.G * NTHR;
    for (int v = gt; v < 131072; v += NGT) {
        const int h = v >> 15; const float dec = F.GP()[h * GPS + RC]; float s0 = 0.f, s1 = 0.f, s2 = 0.f, s3 = 0.f;
        u32x2* ptr = (u32x2*)(F.SB() + (size_t)v * 4);
        for (int n0 = 0; n0 < NRC; n0 += 16) {
            u32x2 kv[16];
#pragma unroll
            for (int j = 0; j < 16; ++j) { kv[j] = (u32x2){0u, 0u}; if (n0 + j < NRC - 1) kv[j] = ptr[(size_t)(n0 + j) * 131072]; }
#pragma unroll
            for (int j = 0; j < 16; ++j) {
                u32x2 o; o.x = pk2(s0, s1); o.y = pk2(s2, s3); ptr[(size_t)(n0 + j) * 131072] = o;
                s0 = s0 * dec + bflo(kv[j].x); s1 = s1 * dec + bfhi(kv[j].x); s2 = s2 * dec + bflo(kv[j].y); s3 = s3 * dec + bfhi(kv[j].y); }
        }
    }
}

namespace ret {
constexpr int BUFB = 40960, OFF_B = 8192, OFF_P = 81920, OFF_RED = 114688, OFF_GP = 118784;
__device__ __forceinline__ int swz(int o) { return o ^ (((o >> 9) & 1) << 5); }
}
#define RET_WAITV(n) asm volatile("s_waitcnt vmcnt(" #n ")" ::: "memory")
#define RET_WAITL0() asm volatile("s_waitcnt lgkmcnt(0)" ::: "memory")
#define RET_BAR() do { asm volatile("" ::: "memory"); __builtin_amdgcn_s_barrier(); asm volatile("" ::: "memory"); } while (0)
__device__ __forceinline__ void phase_ret_fast(Frame& F) {
    using namespace ret;
    const Params& p = F.p; LAS unsigned char* lds = F.lds;
    const int tid = F.tid, lane = tid & 63, wid = F.wave, wr = wid >> 2, wc = wid & 3, fr = lane & 15, fq = lane >> 4;
    const int foff = swz(fr * 64 + fq * 16);
    const int srow = lane >> 2, scol = ((lane & 3) * 8) ^ (((lane >> 5) & 1) * 16);
    LAS float* gps = (LAS float*)(lds + OFF_GP); LAS f32x2* red = (LAS f32x2*)(lds + OFF_RED);
    __syncthreads();
    for (int i = tid; i < 4 * GPS; i += NTHR) gps[i] = F.GP()[i];
    __syncthreads();
    const __amdgpu_buffer_rsrc_t rs = __builtin_amdgcn_make_buffer_rsrc((void*)F.ws, (short)0, 0x7fffffff, 0x00020000);
    const unsigned qoff = (unsigned)((16 * wid + srow) * 1024 + scol) * 2u;
    unsigned soff[4], voff[4];
#pragma unroll
    for (int i = 0; i < 4; ++i) { soff[i] = (unsigned)((16 * (wid + 8 * i) + srow) * 256 + scol) * 2u; voff[i] = (unsigned)((16 * (wid + 8 * i) + srow) * T + scol) * 2u; }
#define RET_GLDS(uoff, loff, dst) __builtin_amdgcn_raw_ptr_buffer_load_lds(rs, (LAS unsigned*)(lds + (dst)), 16, (int)(loff), (int)(uoff), 0, 0)
#define RET_LOADS(kind, ks, b, hh, nn, nk) do { const unsigned _qk = (unsigned)((nn) * 128 * 1024 + (hh) * 256 + 32 * (ks)) * 2u, _kk = (unsigned)((nk) * 128 * 1024 + (hh) * 256 + 32 * (ks)) * 2u; \
        if ((kind) != 2) RET_GLDS((unsigned)WS_Q + _qk, qoff, (b) * BUFB + wid * 1024); \
        if ((kind) == 0) RET_GLDS((unsigned)WS_KN + _kk, qoff, (b) * BUFB + OFF_B + wid * 1024); \
        if ((kind) == 1) { const unsigned _sb = (unsigned)WS_SB + (unsigned)((((nn) >> 1) * 4 + (hh)) * 512 * 256 + 32 * (ks)) * 2u; _Pragma("unroll") for (int _i = 0; _i < 4; ++_i) \
            RET_GLDS(_sb, soff[_i], (b) * BUFB + OFF_B + (wid + 8 * _i) * 1024); } \
        if ((kind) == 2) { const unsigned _vb = (unsigned)WS_VT + (unsigned)((hh) * 512 * T + (nk) * 128 + 32 * (ks)) * 2u; _Pragma("unroll") for (int _i = 0; _i < 4; ++_i) \
            RET_GLDS(_vb, voff[_i], (b) * BUFB + OFF_B + (wid + 8 * _i) * 1024); } } while (0)
    int u = F.c;
    if (u >= 512) return;
#define RET_NOF(uu) ((((uu) >> 4) << 2) | ((((uu) >> 2) & 1) << 1) | ((((uu) >> 3) ^ ((uu) >> 8)) & 1))
    { const int h = u & 3, n = RET_NOF(u); RET_LOADS(0, 0, 0, h, n, n); }
    for (; u < 512; u += F.G) {
        const int h = u & 3, n = RET_NOF(u), t0 = n * 128; const int un = u + F.G; const bool has_next = un < 512; const int hn = un & 3, nn = RET_NOF(un);
        const bool half = (n & 1) != 0;
        f32x4 pacc[4][2];
#pragma unroll
        for (int m = 0; m < 4; ++m)
#pragma unroll
            for (int q = 0; q < 2; ++q) pacc[m][q] = (f32x4){0.f, 0.f, 0.f, 0.f};
#pragma unroll
        for (int ks = 0; ks < 8; ++ks) {
            const int b = ks & 1;
            if (ks < 7) { RET_LOADS(0, ks + 1, b ^ 1, h, n, n); RET_WAITV(2); } else { RET_LOADS(1, 0, b ^ 1, h, n, n); RET_WAITV(5); }
            RET_BAR();
            bf16x8 af[4], bf[2];
#pragma unroll
            for (int m = 0; m < 4; ++m) af[m] = *(const LAS bf16x8*)(lds + b * BUFB + (4 * wr + m) * 1024 + foff);
#pragma unroll
            for (int q = 0; q < 2; ++q) bf[q] = *(const LAS bf16x8*)(lds + b * BUFB + OFF_B + (2 * wc + q) * 1024 + foff);
            RET_WAITL0(); RET_BAR();
#pragma unroll
            for (int m = 0; m < 4; ++m)
#pragma unroll
                for (int q = 0; q < 2; ++q) pacc[m][q] = __builtin_amdgcn_mfma_f32_16x16x32_bf16(bf[q], af[m], pacc[m][q], 0, 0, 0);
            __builtin_amdgcn_sched_barrier(0);
        }
        { int l2 = lane; asm volatile("" : "+v"(l2)); const int fr = l2 & 15, fq = l2 >> 4;
#pragma unroll
        for (int m = 0; m < 4; ++m)
#pragma unroll
            for (int q = 0; q < 2; ++q) { const int r = 64 * wr + 16 * m + fr, cc = 32 * wc + 16 * q + 4 * fq; float v[4];
#pragma unroll
                for (int j = 0; j < 4; ++j) { const int dd = r - (cc + j); v[j] = dd >= 0 ? pacc[m][q][j] * gps[h * GPS + dd] : 0.f; }
                u32x2 w; w.x = pk2(v[0], v[1]); w.y = pk2(v[2], v[3]);
                *(LAS u32x2*)(lds + OFF_P + wc * 8192 + (4 * wr + m) * 1024 + swz(fr * 64 + 32 * q + 8 * fq)) = w; } }
        f32x4 acc[4][8];
#pragma unroll
        for (int m = 0; m < 4; ++m)
#pragma unroll
            for (int q = 0; q < 8; ++q) acc[m][q] = (f32x4){0.f, 0.f, 0.f, 0.f};
#pragma unroll
        for (int ks = 0; ks < 8; ++ks) {
            const int b = ks & 1;
            if (ks < 7) { RET_LOADS(1, ks + 1, b ^ 1, h, n, n); RET_WAITV(5); } else { RET_LOADS(2, 0, b ^ 1, h, n, n); RET_WAITV(4); }
            RET_BAR();
            bf16x8 af[4], bf[8];
#pragma unroll
            for (int m = 0; m < 4; ++m) af[m] = *(const LAS bf16x8*)(lds + b * BUFB + (4 * wr + m) * 1024 + foff);
#pragma unroll
            for (int q = 0; q < 8; ++q) bf[q] = *(const LAS bf16x8*)(lds + b * BUFB + OFF_B + (8 * wc + q) * 1024 + foff);
            RET_WAITL0(); RET_BAR();
#pragma unroll
            for (int m = 0; m < 4; ++m)
#pragma unroll
                for (int q = 0; q < 8; ++q) acc[m][q] = __builtin_amdgcn_mfma_f32_16x16x32_bf16(bf[q], af[m], acc[m][q], 0, 0, 0);
            __builtin_amdgcn_sched_barrier(0);
        }
        { int l3 = lane; asm volatile("" : "+v"(l3)); const int fr = l3 & 15;
#pragma unroll
        for (int m = 0; m < 4; ++m) { const float qd = gps[h * GPS + 64 * wr + 16 * m + fr + 1] * (half ? gps[h * GPS + 128] : 1.0f);
#pragma unroll
            for (int q = 0; q < 8; ++q) acc[m][q] = acc[m][q] * qd; } }
#pragma unroll
        for (int ks = 0; ks < 4; ++ks) {
            const int b = ks & 1;
            if (ks < 3) { RET_LOADS(2, ks + 1, b ^ 1, h, n, n); RET_WAITV(4); }
            else if (half) { RET_LOADS(0, 0, b ^ 1, h, n, n - 1); RET_WAITV(2); }
            else if (has_next) { RET_LOADS(0, 0, b ^ 1, hn, nn, nn); RET_WAITV(2); }
            else { RET_WAITV(0); }
            RET_BAR();
            bf16x8 af[4], bf[8];
#pragma unroll
            for (int m = 0; m < 4; ++m) af[m] = *(const LAS bf16x8*)(lds + OFF_P + ks * 8192 + (4 * wr + m) * 1024 + foff);
#pragma unroll
            for (int q = 0; q < 8; ++q) bf[q] = *(const LAS bf16x8*)(lds + b * BUFB + OFF_B + (8 * wc + q) * 1024 + foff);
            RET_WAITL0(); RET_BAR();
#pragma unroll
            for (int m = 0; m < 4; ++m)
#pragma unroll
                for (int q = 0; q < 8; ++q) acc[m][q] = __builtin_amdgcn_mfma_f32_16x16x32_bf16(bf[q], af[m], acc[m][q], 0, 0, 0);
            __builtin_amdgcn_sched_barrier(0);
        }
        if (half) {
#pragma unroll
            for (int m = 0; m < 4; ++m)
#pragma unroll
                for (int q = 0; q < 2; ++q) pacc[m][q] = (f32x4){0.f, 0.f, 0.f, 0.f};
#pragma unroll
            for (int ks = 0; ks < 8; ++ks) {
                const int b = ks & 1;
                if (ks < 7) { RET_LOADS(0, ks + 1, b ^ 1, h, n, n - 1); RET_WAITV(2); } else { RET_LOADS(2, 0, b ^ 1, h, n, n - 1); RET_WAITV(4); }
                RET_BAR();
                bf16x8 af[4], bf[2];
#pragma unroll
                for (int m = 0; m < 4; ++m) af[m] = *(const LAS bf16x8*)(lds + b * BUFB + (4 * wr + m) * 1024 + foff);
#pragma unroll
                for (int q = 0; q < 2; ++q) bf[q] = *(const LAS bf16x8*)(lds + b * BUFB + OFF_B + (2 * wc + q) * 1024 + foff);
                RET_WAITL0(); RET_BAR();
#pragma unroll
                for (int m = 0; m < 4; ++m)
#pragma unroll
                    for (int q = 0; q < 2; ++q) pacc[m][q] = __builtin_amdgcn_mfma_f32_16x16x32_bf16(bf[q], af[m], pacc[m][q], 0, 0, 0);
                __builtin_amdgcn_sched_barrier(0);
            }
            { int l6 = lane; asm volatile("" : "+v"(l6)); const int fr = l6 & 15, fq = l6 >> 4;
#pragma unroll
            for (int m = 0; m < 4; ++m)
#pragma unroll
                for (int q = 0; q < 2; ++q) { const int r = 64 * wr + 16 * m + fr, cc = 32 * wc + 16 * q + 4 * fq; float v[4];
#pragma unroll
                    for (int j = 0; j < 4; ++j) v[j] = pacc[m][q][j] * gps[h * GPS + 128 + r - (cc + j)];
                    u32x2 w; w.x = pk2(v[0], v[1]); w.y = pk2(v[2], v[3]);
                    *(LAS u32x2*)(lds + OFF_P + wc * 8192 + (4 * wr + m) * 1024 + swz(fr * 64 + 32 * q + 8 * fq)) = w; } }
            RET_WAITL0();
#pragma unroll
            for (int ks = 0; ks < 4; ++ks) {
                const int b = ks & 1;
                if (ks < 3) { RET_LOADS(2, ks + 1, b ^ 1, h, n, n - 1); RET_WAITV(4); }
                else if (has_next) { RET_LOADS(0, 0, b ^ 1, hn, nn, nn); RET_WAITV(2); }
                else { RET_WAITV(0); }
                RET_BAR();
                bf16x8 af[4], bf[8];
    #pragma unroll
                for (int m = 0; m < 4; ++m) af[m] = *(const LAS bf16x8*)(lds + OFF_P + ks * 8192 + (4 * wr + m) * 1024 + foff);
    #pragma unroll
                for (int q = 0; q < 8; ++q) bf[q] = *(const LAS bf16x8*)(lds + b * BUFB + OFF_B + (8 * wc + q) * 1024 + foff);
                RET_WAITL0(); RET_BAR();
    #pragma unroll
                for (int m = 0; m < 4; ++m)
    #pragma unroll
                    for (int q = 0; q < 8; ++q) acc[m][q] = __builtin_amdgcn_mfma_f32_16x16x32_bf16(bf[q], af[m], acc[m][q], 0, 0, 0);
                __builtin_amdgcn_sched_barrier(0);
            }
        }
        { int l4 = lane; asm volatile("" : "+v"(l4)); const int fr = l4 & 15, fq = l4 >> 4;
#pragma unroll
        for (int m = 0; m < 4; ++m) { float s1 = 0.f, s2 = 0.f;
#pragma unroll
            for (int q = 0; q < 8; ++q) { const f32x4 v = acc[m][q]; s1 += (v.x + v.y) + (v.z + v.w); s2 += (v.x * v.x + v.y * v.y) + (v.z * v.z + v.w * v.w); }
            s1 += __shfl_xor(s1, 16); s1 += __shfl_xor(s1, 32); s2 += __shfl_xor(s2, 16); s2 += __shfl_xor(s2, 32);
            if (fq == 0) red[(64 * wr + 16 * m + fr) * 4 + wc] = (f32x2){s1, s2}; }
        RET_WAITL0(); RET_BAR();
#pragma unroll
        for (int m = 0; m < 4; ++m) { const int r = 64 * wr + 16 * m + fr; const f32x2 a = red[r * 4 + 0], b2 = red[r * 4 + 1], c2 = red[r * 4 + 2], d2 = red[r * 4 + 3];
            const float mu = ((a.x + b2.x) + (c2.x + d2.x)) * (1.0f / 512.0f), ex2 = ((a.y + b2.y) + (c2.y + d2.y)) * (1.0f / 512.0f);
            const float rs = 1.0f / sqrtf(ex2 - mu * mu + EPS); const size_t rowoff = (size_t)(t0 + r) * 2048 + h * 512 + 128 * wc + 4 * fq;
#pragma unroll
            for (int q = 0; q < 8; ++q) { const u32x2 gw = *(const u32x2*)(F.Gb() + rowoff + 16 * q); const f32x4 gn = *(const f32x4*)(p.ret_gn_gain + h * 512 + 128 * wc + 16 * q + 4 * fq);
                const f32x4 v = acc[m][q]; u32x2 w;
                w.x = pk2((v.x - mu) * rs * gn.x * bflo(gw.x), (v.y - mu) * rs * gn.y * bfhi(gw.x)); w.y = pk2((v.z - mu) * rs * gn.z * bflo(gw.y), (v.w - mu) * rs * gn.w * bfhi(gw.y));
                *(u32x2*)(F.Y() + rowoff + 16 * q) = w; }
             } }
        RET_BAR();
    }
    RET_WAITV(0); RET_BAR();
#undef RET_GLDS
#undef RET_NOF
#undef RET_LOADS
}

namespace pf { constexpr int XTP = 132, OFF_RS = 42496, OFF_PT = 43008, OFF_WB = 59392, OFF_END = 124928; }
template <int W>
__device__ __forceinline__ void pf_pool(LAS unsigned char* lds, int t0, int tid) {
    using namespace pf; const LAS float* XT = (const LAS float*)lds; const LAS float* RS = (const LAS float*)(lds + OFF_RS);
    const int cp = tid & 63, tb = tid >> 6, r0 = 8 * tb, ch = 2 * cp; float s0 = 0.f, s1 = 0.f;
#pragma unroll
    for (int i = 1; i < W; ++i) { const int rr = 16 + r0 - i; const f32x2 xv = *(const LAS f32x2*)(XT + rr * XTP + ch); const float rs = RS[rr]; s0 += xv.x * rs; s1 += xv.y * rs; }
#pragma unroll
    for (int j = 0; j < 8; ++j) { const int r = r0 + j, rr = 16 + r; const f32x2 xv = *(const LAS f32x2*)(XT + rr * XTP + ch); const float rs = RS[rr]; const float a0 = xv.x * rs, a1 = xv.y * rs;
        s0 += a0; s1 += a1; const int t = t0 + r; const float ic = 1.0f / (float)((t + 1) < W ? (t + 1) : W);
        *(LAS unsigned*)(lds + OFF_PT + (ch >> 5) * 4096 + (r >> 4) * 1024 + ret::swz((r & 15) * 64 + (ch & 31) * 2)) = pk2(s0 * ic - a0, s1 * ic - a1);
        const int ro = rr - W + 1; const f32x2 xo = *(const LAS f32x2*)(XT + ro * XTP + ch); const float rso = RS[ro]; s0 -= xo.x * rso; s1 -= xo.y * rso; }
}
__device__ __forceinline__ void phase_pool_fused(Frame& F) {
    using namespace pf;
    const Params& p = F.p; LAS unsigned char* lds = F.lds; const int tid = F.tid, lane = F.lane, wid = F.wave;
    const bf16_t* X2 = F.XB(); const float* rss = F.ROWSS();     const float* g1 = F.MOD() + NIN + 2 * 1024; const float* WRg = F.WR();
    LAS float* XT = (LAS float*)lds; LAS float* RS = (LAS float*)(lds + OFF_RS);
    const int foff = ret::swz((lane & 15) * 64 + (lane >> 4) * 16);
    const int srow = lane >> 2, scol = ((lane & 3) * 8) ^ (((lane >> 5) & 1) * 16);
    const __amdgpu_buffer_rsrc_t rs_ws = __builtin_amdgcn_make_buffer_rsrc((void*)F.ws, (short)0, 0x7fffffff, 0x00020000);
    unsigned loff[2];
#pragma unroll
    for (int i = 0; i < 2; ++i) loff[i] = (unsigned)((16 * (wid + 8 * i) + srow) * 256 + scol) * 2u;
    for (int seg = F.c; seg < 256; seg += F.G) {
        const int t0 = seg * 64;
        float ss[4], lg[4][8];
#pragma unroll
        for (int m = 0; m < 4; ++m) { ss[m] = 0.f;
#pragma unroll
            for (int e = 0; e < 8; ++e) lg[m][e] = 0.f; }
        __syncthreads();
        if (tid < 80) { const int tt = t0 - 16 + tid; RS[tid] = tt >= 0 ? rstd_row(rss, tt) : 0.f; }
        f32x4 acc[4][2]; u32x2 xv[5];
#define PF_LOADX(gg, kk) do { int _tl = tid; asm volatile("" : "+v"(_tl)); _Pragma("unroll") for (int _i = 0; _i < 5; ++_i) { const int _idx = _tl + 512 * _i, _rr = _idx >> 5, _c4 = (_idx & 31) * 4; const int _tt = t0 - 16 + _rr; \
            xv[_i] = *(const u32x2*)(X2 + (size_t)(_tt < 0 ? 0 : _tt) * 1024 + 256 * (gg) + 128 * (kk) + _c4); } } while (0)
        PF_LOADX(0, 0);
#pragma unroll 1
        for (int it = 0; it < 8; ++it) {
            const int g = it >> 1, kh = it & 1;
            if (kh == 0) {
#pragma unroll
                for (int m = 0; m < 4; ++m) { acc[m][0] = (f32x4){0.f, 0.f, 0.f, 0.f}; acc[m][1] = (f32x4){0.f, 0.f, 0.f, 0.f}; } }
            {
                __syncthreads();
                int tl = tid; asm volatile("" : "+v"(tl));
#pragma unroll
                for (int i = 0; i < 5; ++i) { const int idx = tl + 512 * i, rr = idx >> 5, c4 = (idx & 31) * 4; *(LAS f32x4*)(XT + rr * XTP + c4) = (f32x4){bflo(xv[i].x), bfhi(xv[i].x), bflo(xv[i].y), bfhi(xv[i].y)}; }
#pragma unroll
                for (int kc = 0; kc < 4; ++kc)
#pragma unroll
                    for (int i = 0; i < 2; ++i)
                        __builtin_amdgcn_raw_ptr_buffer_load_lds(rs_ws, (LAS unsigned*)(lds + OFF_WB + kc * 16384 + (wid + 8 * i) * 1024), 16, (int)loff[i], (int)((unsigned)WS_WP + (unsigned)(g * 65536 + kh * 128 + 32 * kc) * 2u), 0, 0);
                { const int itn = it < 7 ? it + 1 : 7; PF_LOADX(itn >> 1, itn & 1); }
                __syncthreads();
                if (g == 0) pf_pool<2>(lds, t0, tl); else if (g == 1) pf_pool<4>(lds, t0, tl); else if (g == 2) pf_pool<8>(lds, t0, tl); else pf_pool<16>(lds, t0, tl);
                asm volatile("s_waitcnt vmcnt(5)" ::: "memory");
                __syncthreads();
#pragma unroll
                for (int kc = 0; kc < 4; ++kc) { bf16x8 af[4], bf[2];
#pragma unroll
                    for (int m = 0; m < 4; ++m) af[m] = *(const LAS bf16x8*)(lds + OFF_PT + kc * 4096 + m * 1024 + foff);
#pragma unroll
                    for (int n = 0; n < 2; ++n) bf[n] = *(const LAS bf16x8*)(lds + OFF_WB + kc * 16384 + (2 * wid + n) * 1024 + foff);
#pragma unroll
                    for (int m = 0; m < 4; ++m)
#pragma unroll
                        for (int n = 0; n < 2; ++n) acc[m][n] = __builtin_amdgcn_mfma_f32_16x16x32_bf16(bf[n], af[m], acc[m][n], 0, 0, 0); }
            }
            if (kh == 0) continue;
            { int l5 = lane; asm volatile("" : "+v"(l5)); const int fr = l5 & 15, fq = l5 >> 4;
              f32x4 x2a[2][4];
#pragma unroll
              for (int n = 0; n < 2; ++n)
#pragma unroll
                for (int m = 0; m < 4; ++m) { const u32x2 w2 = *(const u32x2*)(X2 + (size_t)(t0 + 16 * m + fr) * 1024 + 256 * g + 32 * wid + 16 * n + 4 * fq); x2a[n][m] = (f32x4){bflo(w2.x), bfhi(w2.x), bflo(w2.y), bfhi(w2.y)}; }
              f32x4 bva[2], sva[2], gva[2], wra[2][4], wrb[2][4];
#pragma unroll
              for (int n = 0; n < 2; ++n) { const int cg = 256 * g + 32 * wid + 16 * n + 4 * fq;
                bva[n] = *(const f32x4*)(p.pool_b + cg); sva[n] = *(const f32x4*)(p.pool_scale + cg); gva[n].x = ldv_f(g1 + cg); gva[n].y = ldv_f(g1 + cg + 1); gva[n].z = ldv_f(g1 + cg + 2); gva[n].w = ldv_f(g1 + cg + 3);
#pragma unroll
                for (int j = 0; j < 4; ++j) { wra[n][j] = *(const f32x4*)(WRg + (cg + j) * 8); wrb[n][j] = *(const f32x4*)(WRg + (cg + j) * 8 + 4); } }
#pragma unroll
              for (int n = 0; n < 2; ++n) { const int cg = 256 * g + 32 * wid + 16 * n + 4 * fq;
                const f32x4 bv = bva[n], sv = sva[n], gv = gva[n];
                f32x4 wr0[4], wr1[4];
#pragma unroll
                for (int j = 0; j < 4; ++j) { wr0[j] = wra[n][j]; wr1[j] = wrb[n][j]; }
#pragma unroll
                for (int m = 0; m < 4; ++m) { const size_t o = (size_t)(t0 + 16 * m + fr) * 1024 + cg;
                    const f32x4 xo = x2a[n][m] + gv * ((acc[m][n] + bv) * sv);
                    { u32x2 w3; w3.x = pk2(xo.x, xo.y); w3.y = pk2(xo.z, xo.w); *(u32x2*)(F.X3B() + o) = w3; }
                    *(unsigned*)((unsigned char*)F.Gb() + o) = pk4f8(xo.x, xo.y, xo.z, xo.w);
                    ss[m] += (xo.x * xo.x + xo.y * xo.y) + (xo.z * xo.z + xo.w * xo.w);
                    lg[m][0] += xo.x * wr0[0].x + xo.y * wr0[1].x + xo.z * wr0[2].x + xo.w * wr0[3].x; lg[m][1] += xo.x * wr0[0].y + xo.y * wr0[1].y + xo.z * wr0[2].y + xo.w * wr0[3].y;
                    lg[m][2] += xo.x * wr0[0].z + xo.y * wr0[1].z + xo.z * wr0[2].z + xo.w * wr0[3].z; lg[m][3] += xo.x * wr0[0].w + xo.y * wr0[1].w + xo.z * wr0[2].w + xo.w * wr0[3].w;
                    lg[m][4] += xo.x * wr1[0].x + xo.y * wr1[1].x + xo.z * wr1[2].x + xo.w * wr1[3].x; lg[m][5] += xo.x * wr1[0].y + xo.y * wr1[1].y + xo.z * wr1[2].y + xo.w * wr1[3].y;
                    lg[m][6] += xo.x * wr1[0].z + xo.y * wr1[1].z + xo.z * wr1[2].z + xo.w * wr1[3].z; lg[m][7] += xo.x * wr1[0].w + xo.y * wr1[1].w + xo.z * wr1[2].w + xo.w * wr1[3].w; } } }
        }
#undef PF_LOADX
#pragma unroll
        for (int m = 0; m < 4; ++m) { ss[m] += __shfl_xor(ss[m], 16); ss[m] += __shfl_xor(ss[m], 32);
#pragma unroll
            for (int e = 0; e < 8; ++e) { lg[m][e] += __shfl_xor(lg[m][e], 16); lg[m][e] += __shfl_xor(lg[m][e], 32); } }
        __syncthreads();
        { LAS float* red = (LAS float*)lds; int l6 = lane; asm volatile("" : "+v"(l6)); const int fr = l6 & 15;
          if ((l6 >> 4) == 0) {
#pragma unroll
            for (int m = 0; m < 4; ++m) { LAS float* q = red + ((16 * m + fr) * 8 + wid) * 12; q[0] = ss[m];
#pragma unroll
                for (int e = 0; e < 8; ++e) q[1 + e] = lg[m][e]; } }
          LAS int* cnt = (LAS int*)(lds + OFF_RS);
          if (tid < 8) cnt[tid] = 0;
          __syncthreads();
          if (tid < 64) { float sq = 0.f, a[8];
#pragma unroll
            for (int e = 0; e < 8; ++e) a[e] = 0.f;
#pragma unroll
            for (int w = 0; w < 8; ++w) { const LAS float* q = red + (tid * 8 + w) * 12; sq += q[0];
#pragma unroll
                for (int e = 0; e < 8; ++e) a[e] += q[1 + e]; }
            const int t = t0 + tid; const float rs = rstd_of(sq); float lgt[8]; F.RSTD3()[t] = rs;
#pragma unroll
            for (int e = 0; e < 8; ++e) lgt[e] = rs * a[e] + ldv_f(F.BIAS_R() + e);
            int e0 = 0; float l0 = lgt[0];
#pragma unroll
            for (int e = 1; e < 8; ++e) if (lgt[e] > l0) { l0 = lgt[e]; e0 = e; }
            int e1 = -1; float l1 = -3.0e38f;
#pragma unroll
            for (int e = 0; e < 8; ++e) if (e != e0 && lgt[e] > l1) { l1 = lgt[e]; e1 = e; }
            const float g0 = 1.0f / (1.0f + __expf(l1 - l0));
            F.TOPE()[t * 2] = e0; F.TOPE()[t * 2 + 1] = e1; F.TOPG()[t * 2] = g0; F.TOPG()[t * 2 + 1] = 1.0f - g0;
            atomicAdd((int*)(cnt + e0), 1); atomicAdd((int*)(cnt + e1), 1); }
          __syncthreads();
          if (tid < 8) F.CNT()[seg * 8 + tid] = cnt[tid]; }
    }
    __syncthreads();
}

__device__ __forceinline__ void phase_route2(Frame& F) {
    const int tid = F.tid;
    LAS int* cn = (LAS int*)F.lds;
    LAS int* part = cn + 2048;
    LAS int* tot = part + 512;
    LAS int* te = tot + 32;
    __syncthreads();
    for (int i = tid; i < 2048; i += NTHR) cn[i] = ldv_i(F.CNT() + i);
    __syncthreads();
    { const int e = tid & 7, pq = tid >> 3; part[pq * 8 + e] = cn[(4 * pq) * 8 + e] + cn[(4 * pq + 1) * 8 + e] + cn[(4 * pq + 2) * 8 + e] + cn[(4 * pq + 3) * 8 + e]; }
    __syncthreads();
    if (tid < 8) { int run = 0; for (int q = 0; q < 64; ++q) { const int v = part[q * 8 + tid]; part[q * 8 + tid] = run; run += v; } tot[tid] = run; }
    __syncthreads();
    { const int e = tid & 7, pq = tid >> 3; int run = part[pq * 8 + e];
#pragma unroll
        for (int j = 0; j < 4; ++j) { const int v = cn[(4 * pq + j) * 8 + e]; cn[(4 * pq + j) * 8 + e] = run; run += v; } }
    if (tid == 0) { int sp = 0; for (int e = 0; e < 8; ++e) { const int pd = (tot[e] + 255) / 256 * 256; tot[8 + e] = sp; tot[16 + e] = pd; sp += pd; } tot[24] = sp / 256; }
    __syncthreads();
    for (int seg = F.c; seg < 256; seg += F.G) {
        int e = -1; if (tid < 128) e = ldv_i(F.TOPE() + seg * 128 + tid);
        int rank = 0;
#pragma unroll
        for (int ee = 0; ee < 8; ++ee) { const unsigned long long m = __ballot(e == ee); if (e == ee) rank = __popcll(m & ((1ull << F.lane) - 1ull)); if (tid == 0) te[ee] = __popcll(m); }
        __syncthreads();
        if (tid < 128) { if (tid >= 64) rank += te[e];
            const int pos = tot[8 + e] + cn[seg * 8 + e] + rank, idx = seg * 128 + tid;
            const float gt = ldv_f(F.TOPG() + idx), rsd = ldv_f(F.RSTD3() + (idx >> 1));
            F.BUFTOK()[pos] = idx >> 1; F.BUFGATE()[pos] = gt; F.BUFRS()[pos] = rsd * (1.0f / F8_WSCALE); F.POS()[idx] = pos; }
        __syncthreads();
    }
    if (F.c < 8) { const int e = F.c; const int b0 = tot[8 + e] + tot[e], b1 = tot[8 + e] + tot[16 + e]; for (int r = b0 + tid; r < b1; r += NTHR) { F.BUFTOK()[r] = 0; F.BUFGATE()[r] = 0.f; F.BUFRS()[r] = 0.f; } }
    if (F.c == (8 % F.G)) { if (tid < NBLK) { int e = 0; for (int q = 0; q < 8; ++q) if (tid * 256 >= tot[8 + q] + tot[16 + q]) ++e; F.BLKE()[tid] = e < 7 ? e : 7; } if (tid == NBLK) F.BLKE()[NBLK] = tot[24]; }
}

__device__ __forceinline__ void phase_final(Frame& F) {
    const Params& p = F.p; const int gw = F.c * NWAVE + F.wave, NGW = F.G * NWAVE, lane = F.lane; const float* g2 = F.MOD() + NIN + 5 * 1024;
    const int nused = ldv_i(F.BLKE() + NBLK); const int ntail = (F.G == 256) ? (nused - 128) * 4 : 0; const int spu = ntail > 0 ? moe_tail_spu(ntail) : 1;
    f32x4 gv[4], fg[4];
#pragma unroll
    for (int j = 0; j < 4; ++j) { gv[j] = *((const f32x4*)g2 + lane + 64 * j); fg[j] = *((const f32x4*)p.final_norm_gain + lane + 64 * j); }
    for (int row = 2 * gw; row < T; row += 2 * NGW) {
        f32x4 xv[2][4]; f32x4 fa[2][4];
#pragma unroll
        for (int r = 0; r < 2; ++r) {
            const u32x2* xr = (const u32x2*)(F.X3B() + (size_t)(row + r) * D) + lane;
#pragma unroll
            for (int j = 0; j < 4; ++j) { const u32x2 w3 = xr[64 * j]; xv[r][j] = (f32x4){bflo(w3.x), bfhi(w3.x), bflo(w3.y), bfhi(w3.y)}; fa[r][j] = (f32x4){0.f, 0.f, 0.f, 0.f}; }
#pragma unroll
            for (int a = 0; a < 2; ++a) { const int pos = ldv_i(F.POS() + (row + r) * 2 + a); const int blk = pos >> 8;
                if (ntail > 0 && blk >= 128) {
#pragma unroll
                    for (int j = 0; j < 4; ++j) { const float* sl = F.YBB() + (size_t)(((blk - 128) * 4 + j) * spu) * 65536 + (size_t)(pos & 255) * 256 + 4 * lane;
                        for (int q = 0; q < spu; ++q) fa[r][j] = fa[r][j] + *(const f32x4*)(sl + (size_t)q * 65536); }
                } else { const u32x2* y = (const u32x2*)(F.YB() + (size_t)pos * D) + lane;
#pragma unroll
                    for (int j = 0; j < 4; ++j) { const u32x2 w = y[64 * j]; fa[r][j] = fa[r][j] + (f32x4){bflo(w.x), bfhi(w.x), bflo(w.y), bfhi(w.y)}; } } } }
#pragma unroll
        for (int r = 0; r < 2; ++r) { f32x4 v[4]; float s = 0.f;
#pragma unroll
            for (int j = 0; j < 4; ++j) { v[j] = xv[r][j] + gv[j] * fa[r][j]; s += (v[j].x * v[j].x + v[j].y * v[j].y) + (v[j].z * v[j].z + v[j].w * v[j].w); }
            s = wave_sum(s); const float rs = rstd_of(s);
            f32x4* o = (f32x4*)(p.out + (size_t)(row + r) * D) + lane;
#pragma unroll
            for (int j = 0; j < 4; ++j) o[64 * j] = v[j] * rs * fg[j]; }
    }
}

template <class Desc, class Epi> __device__ __forceinline__ void run_gemm(Frame& F, const Desc& Dc, const Epi& E) {
    gemm_fast(F.lds, F.ws, Dc, E, F.c, F.G, F.wave);
}

__device__ __forceinline__ void phase_g1(Frame& F) {
    { DescG1a<false> d{F.XB(), F.WIN(), nullptr, 1024, 1024, 16, 128, 128}; EpiG1a<false> e{F.ROWSS(), F.BIAS_IN(), F.TABA(), F.TABB(), F.Q(), F.KN(), F.Gb(), F.GP(), F.KDT()}; run_gemm(F, d, e); }
    { DescG1a<true> d{F.XB(), F.WIN(), nullptr, 1024, 1024, 16, 128, 128}; EpiG1a<true> e{F.ROWSS(), F.BIAS_IN(), F.TABA(), F.TABB(), F.Q(), F.KN(), F.Gb(), F.GP(), F.KDT()}; run_gemm(F, d, e); }
    { DescG1b d{F.XB(), F.WIN(), nullptr, 1024, 1024, 16, 128, 128}; EpiG1b e{F.ROWSS(), F.BIAS_IN(), F.TABA(), F.TABB(), F.GP(), F.KDT(), F.VT()}; run_gemm(F, d, e); }
}
__device__ __forceinline__ void phase_kv(Frame& F) { DescKV d{F.VT(), F.KDT(), nullptr, T, T, 4, 128, 128}; EpiKV e{F.SB()}; run_gemm(F, d, e); }
__device__ __forceinline__ void phase_outproj(Frame& F) {
    DescOut d{F.Y(), F.WOUT(), nullptr, 2048, 2048, 32, 128, 128}; EpiResid<false> e{F.p.x, nullptr, F.XB(), F.ROWSS(), F.MOD() + 2 * 1024, nullptr, nullptr, 1.0f}; run_gemm(F, d, e); }
__device__ __forceinline__ void phase_ffn_up(Frame& F) {
    DescFfnUp d{F.XB(), F.WGU(), nullptr, 1024, 1024, 16, 128, 128}; EpiSwiglu<true, true> e{F.ROWSS(), nullptr, F.BIAS_GU(), F.H1(), DFF, 5632, 2 * 5632}; run_gemm(F, d, e);
    if (F.G == 256 && F.c >= 128) {
        frame_fresh(F); px_tables(F); px_gu_item(F, (F.c - 128) * NWAVE + F.wave, F.lane); __syncthreads(); } }
__device__ __forceinline__ void phase_ffn_down(Frame& F) {
    DescFfnDown d{F.H1(), F.WD(), nullptr, 64, 64, 22, 32768, 32768};     EpiResid<true> e{nullptr, F.XB(), F.XB(), F.ROWSS(), F.MOD() + 5 * 1024, nullptr, nullptr, 1.0f / (F8_DSCALE * F8_HSCALE)}; run_gemm(F, d, e); }
__device__ __forceinline__ void phase_moe_up(Frame& F) {
    DescMoeUp d{F.Gb(), F.WMGU(), F.BUFTOK(), 512, 512, 8, 128, 128, F.BLKE()};     EpiSwiglu<true, true> e{F.ROWSS(), F.BUFRS(), F.BIAS_MGU(), F.H1M(), DFE, 57344, 262144}; run_gemm(F, d, e); }
__device__ __forceinline__ void phase_moe_down(Frame& F) {
    DescMoeDown d{F.H1M(), F.WMD(), nullptr, 64, 64, 28, 32768, 32768, F.BLKE(), F.G}; EpiMoeDown e{F.BUFGATE(), F.YB(), F.YBB()}; run_gemm(F, d, e); }

#define XB_TMO      128
#define XB_XCNT(j)  (256  + 64 * (j))
#define XB_XSUB(j)  (1280 + 64 * (j))
#define XB_XGEN(j)  (2304 + 64 * (j))
#define XB_TOP      3328
#define XB_TOPGEN   3392
#define XCD_BAR_WORDS 3456
#define XB_SPIN_CAP (1u << 18)
__device__ __forceinline__ unsigned xb_ld(unsigned* p)              { return __hip_atomic_load(p, __ATOMIC_RELAXED, __HIP_MEMORY_SCOPE_AGENT); }
__device__ __forceinline__ unsigned xb_add(unsigned* p, unsigned v) { return __hip_atomic_fetch_add(p, v, __ATOMIC_RELAXED, __HIP_MEMORY_SCOPE_AGENT); }
__device__ __forceinline__ unsigned xb_xcc_id() { return (unsigned)__builtin_amdgcn_s_getreg((3 << 11) | 20) & 0xFu; }
#define XB_SPIN(cond, bar) do { unsigned _sp = 0; while (cond) { __builtin_amdgcn_s_sleep(1); \
    if ((++_sp & 255u) == 0u) { if (xb_ld(&(bar)[XB_TMO])) break; if (_sp > XB_SPIN_CAP) { atomicAdd(&(bar)[XB_TMO], 1u); break; } } } } while (0)
struct XcdBarrier { unsigned* bar; unsigned x; volatile LAS unsigned* st; int wave; };
__device__ __forceinline__ XcdBarrier xcd_barrier_post(unsigned* bar, volatile LAS unsigned* st, int wave) {
    XcdBarrier b; b.bar = bar; b.x = xb_xcc_id(); b.st = st; b.wave = wave;
    if (wave == 0 && lane_id() == 0) (void)xb_add(&bar[XB_XCNT(b.x)], 1u);
    return b;
}
__device__ __forceinline__ void xcd_barrier_complete(unsigned* bar, unsigned x, unsigned& nloc, unsigned& nx) {
    const unsigned G = gridDim.x * gridDim.y * gridDim.z;
    unsigned sum, cnt, mine, sp = 0u;
    for (;;) {
        sum = 0u; cnt = 0u; mine = 0u;
#pragma unroll
        for (unsigned j = 0; j < 16; ++j) { const unsigned c = xb_ld(&bar[XB_XCNT(j)]); sum += c; cnt += (c > 0u) ? 1u : 0u; mine = (j == x) ? c : mine; }
        if (sum == G) break;
        __builtin_amdgcn_s_sleep(1);
        if ((++sp & 255u) == 0u) { if (xb_ld(&bar[XB_TMO])) break; if (sp > XB_SPIN_CAP) { atomicAdd(&bar[XB_TMO], 1u); break; } }
    }
    nloc = mine > 0u ? mine : 1u; nx = cnt > 0u ? cnt : 1u;
}
__device__ __forceinline__ void xcd_barrier(const XcdBarrier& b) {
    asm volatile("s_waitcnt vmcnt(0)" ::: "memory");
    __syncthreads();
    if (b.wave == 0 && lane_id() == 0) {
        unsigned* bar = b.bar;
        __builtin_amdgcn_s_waitcnt(0);
        unsigned nloc = b.st[0], nx = b.st[1];
        if (nloc == 0u) { xcd_barrier_complete(bar, b.x, nloc, nx); b.st[0] = nloc; b.st[1] = nx; }
        const unsigned old = xb_add(&bar[XB_XSUB(b.x)], 1u);
        const unsigned gen = old / nloc;
        if (old + 1u == (gen + 1u) * nloc) {
            __builtin_amdgcn_fence(__ATOMIC_RELEASE, "agent");
            asm volatile("s_waitcnt vmcnt(0)" ::: "memory");
            const unsigned og = xb_add(&bar[XB_TOP], 1u);
            const unsigned tg = og / nx;
            if (og + 1u == (tg + 1u) * nx) xb_add(&bar[XB_TOPGEN], 1u);
            else XB_SPIN(xb_ld(&bar[XB_TOPGEN]) == tg, bar);
            __builtin_amdgcn_fence(__ATOMIC_ACQUIRE, "agent");
            xb_add(&bar[XB_XGEN(b.x)], 1u);
            asm volatile("s_waitcnt vmcnt(0)" ::: "memory");
        } else {
            XB_SPIN(xb_ld(&bar[XB_XGEN(b.x)]) == gen, bar);
            __builtin_amdgcn_fence(__ATOMIC_ACQUIRE, "agent");
            asm volatile("s_waitcnt vmcnt(0)" ::: "memory");
        }
    }
    __syncthreads();
}

constexpr int LDSCTL_OFF = 131072;
__global__ void __launch_bounds__(NTHR, 2) k_mega(Params p) {
    extern __shared__ __attribute__((aligned(16))) unsigned char lds_raw[];
    Frame F; frame_init(F, p, (LAS unsigned char*)lds_raw, (int)blockIdx.x, (int)gridDim.x);
    for (int u = F.tid; u < (LDS_BYTES - LDSCTL_OFF) / 4; u += NTHR) ((LAS unsigned*)(F.lds + LDSCTL_OFF))[u] = 0u;
    __syncthreads();
    const XcdBarrier bar = xcd_barrier_post((unsigned*)(p.ws + CT_BAR), (volatile LAS unsigned*)(F.lds + LDSCTL_OFF + 32), F.wave);
#define GRID_BAR() xcd_barrier(bar)

    frame_fresh(F); phase_p0(F); GRID_BAR();
    frame_fresh(F); phase_p1(F); GRID_BAR();
    frame_fresh(F); phase_g1(F); GRID_BAR();
    frame_fresh(F); phase_kv(F); GRID_BAR();
    frame_fresh(F); phase_scan(F); GRID_BAR();
    frame_fresh(F); phase_ret_fast(F); GRID_BAR();
    frame_fresh(F); phase_outproj(F); GRID_BAR();
    frame_fresh(F); phase_ffn_up(F); GRID_BAR();
    frame_fresh(F); phase_ffn_down(F); GRID_BAR();
    if ((F.c >> 3) & 1) { frame_fresh(F); phase_px(F); __syncthreads(); frame_fresh(F); phase_pool_fused(F); } else { frame_fresh(F); phase_pool_fused(F); frame_fresh(F); phase_px(F); }
    GRID_BAR();
    frame_fresh(F); phase_route2(F); GRID_BAR();
    frame_fresh(F); phase_moe_up(F); GRID_BAR();
    frame_fresh(F); phase_moe_down(F); GRID_BAR();
    frame_fresh(F); phase_final(F);
#undef GRID_BAR
}

extern "C" void kernel_launch(void* const* d_in, const int* in_sizes, int n_in, void* d_out, int out_size, void* d_ws, size_t ws_size, hipStream_t stream) {
    static int grid = 0;
    if (grid == 0) {
        if (n_in != 19 || out_size != T * D || ws_size < WS_END) { fprintf(stderr, "kernel_launch: unexpected shapes (n_in %d out %d ws %zu)\n", n_in, out_size, ws_size); grid = -1; return; }
        int dev = 0, cus = 0, per_cu = 0;
        if (hipGetDevice(&dev) != hipSuccess || hipDeviceGetAttribute(&cus, hipDeviceAttributeMultiprocessorCount, dev) != hipSuccess) { grid = -1; return; }
        if (hipFuncSetAttribute((const void*)k_mega, hipFuncAttributeMaxDynamicSharedMemorySize, LDS_BYTES) != hipSuccess) { fprintf(stderr, "kernel_launch: hipFuncSetAttribute failed\n"); grid = -1; return; }
        if (hipOccupancyMaxActiveBlocksPerMultiprocessor(&per_cu, (const void*)k_mega, NTHR, LDS_BYTES) != hipSuccess || per_cu < 1) { fprintf(stderr, "kernel_launch: occupancy query says %d blocks per CU\n", per_cu); (void)hipGetLastError(); grid = -1; return; }
        grid = cus * (per_cu < 1 ? 1 : 1);
    }
    if (grid < 0) return;
    Params p{};
    const float** pp = (const float**)&p;
    for (int i = 0; i < 19; ++i) pp[i] = (const float*)d_in[i];
    p.out = (float*)d_out; p.ws = (unsigned char*)d_ws;
    (void)hipMemsetAsync((char*)d_ws + WS_CTL, 0, 64 * KiB, stream);
    void* args[] = {&p};
    hipError_t e = hipLaunchCooperativeKernel((const void*)k_mega, dim3(grid), dim3(NTHR), args, LDS_BYTES, stream);
    if (e != hipSuccess) fprintf(stderr, "kernel_launch: cooperative launch failed: %s (grid %d)\n", hipGetErrorString(e), grid);
}
```

```cpp
#include <hip/hip_runtime.h>
#include <cstdio>

#define GAS __attribute__((address_space(1)))
#define LAS __attribute__((address_space(3)))
typedef unsigned short bf16_t;
typedef short bf16x8 __attribute__((ext_vector_type(8)));
typedef float f32x4 __attribute__((ext_vector_type(4)));
typedef float f32x2 __attribute__((ext_vector_type(2)));
typedef unsigned u32x4 __attribute__((ext_vector_type(4)));
typedef int i32x4 __attribute__((ext_vector_type(4)));
typedef unsigned u32x2 __attribute__((ext_vector_type(2)));

#ifndef FAST_GEMM
#define FAST_GEMM 1
#endif

constexpr int T = 16384, D = 1024, NH = 4, DK = 256, DV = 512, CH = 128, NCH = 128;
constexpr int NIN = 6144, DFF = 2816, NE = 8, DFE = 3584, CAP = 34816, NBLK = 136;
constexpr float EPS = 1e-6f;
constexpr int GPS = 260, RC = 256, NRC = 64;
constexpr int NTHR = 512, NWAVE = 8;

constexpr size_t KiB = 1024, MiB = 1u << 20;
constexpr size_t WS_CTL = 0, CTL_BYTES = 1 * MiB;
constexpr size_t CT_BAR = 16 * KiB;
constexpr size_t CT_MOD = 64 * KiB;
constexpr size_t CT_BIAS_R = 158 * KiB;
constexpr size_t WS_ROWSSP = 2 * MiB;
constexpr size_t WS_MODP = 3 * MiB;
constexpr size_t CT_BIAS_IN = 3584 * KiB;
constexpr size_t CT_BIAS_GU = 3584 * KiB + 96 * KiB;
constexpr size_t CT_BIAS_MGU = 36 * MiB + 512 * KiB;
constexpr size_t WS_TABA = 1 * MiB;
constexpr size_t WS_TABB = WS_TABA + 128 * KiB;
constexpr size_t WS_GP = WS_TABB + 128 * KiB;
constexpr size_t WS_WR = WS_GP + 8 * KiB;
constexpr size_t WS_TOPE = WS_WR + 32 * KiB;
constexpr size_t WS_TOPG = WS_TOPE + 128 * KiB;
constexpr size_t WS_CNT = WS_TOPG + 128 * KiB;
constexpr size_t WS_BUFTOK = WS_CNT + 8 * KiB;
constexpr size_t WS_BUFGATE = WS_BUFTOK + 136 * KiB;
constexpr size_t WS_POS = WS_BUFGATE + 136 * KiB;
constexpr size_t WS_BLKE = WS_POS + 128 * KiB;
constexpr size_t WS_RSTD3 = 256 * KiB;
constexpr size_t WS_BUFRS = 320 * KiB;
constexpr size_t WS_WIN = 4 * MiB;
constexpr size_t WS_WOUT = 16 * MiB;
constexpr size_t WS_WGU = 20 * MiB;
constexpr size_t WS_WD = 31 * MiB;
constexpr size_t WS_WP = 37 * MiB;
constexpr size_t WS_XB = 38 * MiB;
constexpr size_t WS_Q = 70 * MiB;
constexpr size_t WS_KN = 102 * MiB;
constexpr size_t WS_KDT = 134 * MiB;
constexpr size_t WS_VT = 166 * MiB;
constexpr size_t WS_G = 230 * MiB;
constexpr size_t WS_SB = 294 * MiB;
constexpr size_t WS_Y = 422 * MiB;
constexpr size_t WS_H1 = 70 * MiB;
constexpr size_t WS_PB = 158 * MiB;
constexpr size_t WS_X2 = 158 * MiB;
constexpr size_t WS_H1M = 70 * MiB;
constexpr size_t WS_WMGU = 308 * MiB;
constexpr size_t WS_WMD = 456 * MiB;
constexpr size_t WS_YB = 308 * MiB;
constexpr size_t WS_YBB = 4 * MiB;
constexpr size_t WS_END = 512 * MiB;
static_assert(WS_BUFRS + 136 * KiB <= WS_TABA && WS_BLKE + 4 * KiB <= WS_ROWSSP && WS_MODP + 8 * 12288 * 4 <= CT_BIAS_IN && CT_BIAS_GU + 4 * 5632 * 4 <= WS_WIN, "small region");
static_assert(WS_YBB + (size_t)224 * 65536 * 4 <= WS_H1M && WS_H1M + (size_t)CAP * DFE * 2 <= WS_WMGU && WS_YB + (size_t)CAP * D * 4 <= WS_WMD && WS_WMD + (size_t)NE * D * DFE * 2 <= WS_END, "moe map");
static_assert(WS_Y + (size_t)T * 2048 * 2 <= WS_END && WS_SB + (size_t)128 * 4 * 512 * 256 * 2 <= WS_Y, "ret map");

constexpr int LDS_BYTES = 147456;

struct Params {
    const float *x, *c, *ada_w, *ada_b, *norm_gain, *ret_w_in, *ret_gn_gain, *ret_w_out, *ffn_w_gate, *ffn_w_up, *ffn_w_down,
        *pool_w, *pool_b, *pool_scale, *moe_router, *moe_w_gate, *moe_w_up, *moe_w_down, *final_norm_gain;
    float* out; unsigned char* ws;
};

__device__ __forceinline__ unsigned f2bf(float f) { unsigned u = __builtin_bit_cast(unsigned, f); return (u + 0x7fffu + ((u >> 16) & 1u)) >> 16; }
typedef __bf16 bf16x2_t __attribute__((ext_vector_type(2)));
__device__ __forceinline__ unsigned pk2(float lo, float hi) { const f32x2 v = {lo, hi}; return __builtin_bit_cast(unsigned, __builtin_convertvector(v, bf16x2_t)); }
constexpr float F8_WSCALE = 32.0f, F8_DSCALE = 64.0f, F8_HSCALE = 4.0f;
__device__ __forceinline__ unsigned pk4f8(float a, float b, float c, float d) { int w = __builtin_amdgcn_cvt_pk_fp8_f32(a, b, 0, false); w = __builtin_amdgcn_cvt_pk_fp8_f32(c, d, w, true); return (unsigned)w; }
__device__ __forceinline__ float bf2f(unsigned b) { return __builtin_bit_cast(float, b << 16); }
__device__ __forceinline__ float bflo(unsigned w) { return __builtin_bit_cast(float, w << 16); }
__device__ __forceinline__ float bfhi(unsigned w) { return __builtin_bit_cast(float, w & 0xffff0000u); }
__device__ __forceinline__ float silu_f(float v) { return v * __builtin_amdgcn_rcpf(1.0f + __expf(-v)); }
__device__ __forceinline__ float rstd_of(float ss) { return __builtin_amdgcn_rsqf(ss * (1.0f / 1024.0f) + EPS); }
__device__ __forceinline__ float rstd_row(const float* rssp, int t) {
    const f32x4* q = (const f32x4*)(rssp + (size_t)t * 16); const f32x4 a = q[0], b = q[1], c = q[2], d = q[3];
    const float s = (((a.x + a.y) + (a.z + a.w)) + ((b.x + b.y) + (b.z + b.w))) + (((c.x + c.y) + (c.z + c.w)) + ((d.x + d.y) + (d.z + d.w)));
    return __builtin_amdgcn_rsqf(s * (1.0f / 1024.0f) + EPS);
}
__device__ __forceinline__ float wave_sum(float v) {
#pragma unroll
    for (int o = 1; o < 64; o <<= 1) v += __shfl_xor(v, o);
    return v;
}
__device__ __forceinline__ float ldv_f(const float* p) { return __builtin_bit_cast(float, __hip_atomic_load((const unsigned*)p, __ATOMIC_RELAXED, __HIP_MEMORY_SCOPE_AGENT)); }
__device__ __forceinline__ int ldv_i(const int* p) { return __hip_atomic_load(p, __ATOMIC_RELAXED, __HIP_MEMORY_SCOPE_AGENT); }
__device__ __forceinline__ float bias_sum(const float* b, int idx, int s1, int s2) { return (ldv_f(b + idx) + ldv_f(b + s1 + idx)) + (ldv_f(b + s2 + idx) + ldv_f(b + s2 + s1 + idx)); }
__device__ __forceinline__ void rstd_row_ld(const float* rssp, int t, float (&r)[16]) { const f32x4* q = (const f32x4*)(rssp + (size_t)t * 16);
#pragma unroll
    for (int i = 0; i < 4; ++i) { const f32x4 v = q[i]; r[4 * i] = v.x; r[4 * i + 1] = v.y; r[4 * i + 2] = v.z; r[4 * i + 3] = v.w; } }
__device__ __forceinline__ float rstd_row_fin(const float (&r)[16]) {
    const float s = (((r[0] + r[1]) + (r[2] + r[3])) + ((r[4] + r[5]) + (r[6] + r[7]))) + (((r[8] + r[9]) + (r[10] + r[11])) + ((r[12] + r[13]) + (r[14] + r[15])));
    return __builtin_amdgcn_rsqf(s * (1.0f / 1024.0f) + EPS); }
__device__ __forceinline__ void bias_sum_ld(const float* b, int idx, int s1, int s2, float (&r)[16]) { r[0] = ldv_f(b + idx); r[1] = ldv_f(b + s1 + idx); r[2] = ldv_f(b + s2 + idx); r[3] = ldv_f(b + s2 + s1 + idx); }
__device__ __forceinline__ float bias_sum_fin(const float (&r)[16]) { return (r[0] + r[1]) + (r[2] + r[3]); }

__device__ __forceinline__ int lane_id() { int l; asm volatile("v_mbcnt_lo_u32_b32 %0, -1, 0\n\tv_mbcnt_hi_u32_b32 %0, -1, %0" : "=v"(l)); return l; }

struct Unit { const bf16_t* A; const bf16_t* B; int pm, pn, aux, rowbase, nt; };

__device__ __forceinline__ void tile_order(int L, int nM, int nN, int& pm, int& pn) {
    const int nwg = nM * nN; int wgid = L;
    { const int q = nwg / 8, r = nwg % 8, xcd = wgid % 8, off = wgid / 8; wgid = (xcd < r ? xcd * (q + 1) : r * (q + 1) + (xcd - r) * q) + off; }
    const int nig = 8 * nN, gid = wgid / nig, fm = gid * 8, gsz = (nM - fm) < 8 ? (nM - fm) : 8;
    pm = fm + ((wgid % nig) % gsz); pn = (wgid % nig) / gsz;
}

template <bool GATE> struct DescG1a {
    static constexpr bool GATHER = false; static constexpr bool FP8 = false;
    const bf16_t* xb; const bf16_t* win; const int* tok; int lda, ldb, nt, ksa, ksb;
    __device__ __forceinline__ bool get(int L, Unit& u) const {
        if (L >= 64 * 8) return false; tile_order(L, 64, 8, u.pm, u.pn); if (GATE) u.pn += 8;
        const int wrow = u.pn < 8 ? u.pn * 256 : (u.pn + 8) * 256;
        u.A = xb + (size_t)u.pm * 256 * 1024; u.B = win + (size_t)wrow * 1024; u.aux = wrow; u.rowbase = u.pm * 256; u.nt = nt; return true; }
};
struct DescG1b {
    static constexpr bool GATHER = false; static constexpr bool FP8 = false;
    const bf16_t* xb; const bf16_t* win; const int* tok; int lda, ldb, nt, ksa, ksb;
    __device__ __forceinline__ bool get(int L, Unit& u) const {
        if (L >= 8 * 64) return false; tile_order(L, 8, 64, u.pm, u.pn); u.pm += 4;
        u.A = win + (size_t)(1024 + 256 * u.pm) * 1024; u.B = xb + (size_t)u.pn * 256 * 1024; u.aux = 0; u.rowbase = 0; u.nt = nt; return true; }
};
struct DescKV {
    static constexpr bool GATHER = false; static constexpr bool FP8 = false;
    const bf16_t* vt; const bf16_t* kdt; const int* tok; int lda, ldb, nt, ksa, ksb;
    __device__ __forceinline__ bool get(int L, Unit& u) const {
        if (L >= (NRC - 1) * 8) return false; const int mt = L & 1, h = (L >> 1) & 3, n = L >> 3;
        u.A = vt + (size_t)(h * 512 + 256 * mt) * T + n * RC; u.B = kdt + (size_t)(h * 256) * T + n * RC;
        u.pm = mt; u.pn = 0; u.aux = (n * 4 + h) * 2 + mt; u.rowbase = 0; u.nt = nt; return true; }
};
struct DescOut {
    static constexpr bool GATHER = false; static constexpr bool FP8 = false;
    const bf16_t* y; const bf16_t* w; const int* tok; int lda, ldb, nt, ksa, ksb;
    __device__ __forceinline__ bool get(int L, Unit& u) const {
        if (L >= 256) return false; tile_order(L, 64, 4, u.pm, u.pn);
        u.A = y + (size_t)u.pm * 256 * 2048; u.B = w + (size_t)u.pn * 256 * 2048; u.aux = 0; u.rowbase = u.pm * 256; u.nt = nt; return true; }
};
struct DescFfnUp {
    static constexpr bool GATHER = false; static constexpr bool FP8 = false;
    const bf16_t* xb; const bf16_t* w; const int* tok; int lda, ldb, nt, ksa, ksb;
    __device__ __forceinline__ bool get(int L, Unit& u) const {
        if (L >= 64 * 22) return false; tile_order(L, 64, 22, u.pm, u.pn);
        u.A = xb + (size_t)u.pm * 256 * 1024; u.B = w + (size_t)u.pn * 256 * 1024; u.aux = 256 * u.pn; u.rowbase = u.pm * 256; u.nt = nt; return true; }
};
struct DescFfnDown {
    static constexpr bool GATHER = false; static constexpr bool FP8 = true;
    const bf16_t* h1; const bf16_t* w; const int* tok; int lda, ldb, nt, ksa, ksb;
    __device__ __forceinline__ bool get(int L, Unit& u) const {
        if (L >= 256) return false; tile_order(L, 64, 4, u.pm, u.pn);
        u.A = h1 + (size_t)u.pm * 128 * DFF; u.B = w + (size_t)u.pn * 128 * DFF; u.aux = 0; u.rowbase = u.pm * 256; u.nt = nt; return true; }
};
struct DescMoeUp {
    static constexpr bool GATHER = true; static constexpr bool FP8 = true;
    const bf16_t* xb; const bf16_t* w; const int* tok; int lda, ldb, nt, ksa, ksb; const int* blke;
    __device__ __forceinline__ bool get(int L, Unit& u) const {
        const int nused = ldv_i(blke + NBLK); if (L >= nused * 28) return false; tile_order(L, nused, 28, u.pm, u.pn);
        const int e = ldv_i(blke + u.pm);
        u.A = xb; u.B = w + (size_t)(e * 7168 + 256 * u.pn) * 512; u.aux = e * 7168 + 256 * u.pn; u.rowbase = u.pm * 256; u.nt = nt; return true; }
};
__device__ __forceinline__ int moe_tail_spu(int ntail) { const int q = 256 / ntail; return q >= 7 ? 7 : 2; }
struct DescMoeDown {
    static constexpr bool GATHER = false; static constexpr bool FP8 = true;
    const bf16_t* h1; const bf16_t* w; const int* tok; int lda, ldb, nt, ksa, ksb; const int* blke; int G;
    __device__ __forceinline__ bool get(int L, Unit& u) const {
        const int nused = ldv_i(blke + NBLK); int k0 = 0, npair = 14; u.aux = 0;
        if (G != 256) { if (L >= nused * 4) return false; tile_order(L, nused, 4, u.pm, u.pn); }
        else { const int i = L >> 8, c = L & 255;
            if (i < 2) { const int x = c & 7, j = c >> 3; u.pm = (i * 8 + x) * 8 + (j & 7); u.pn = j >> 3; }
            else { const int ntail = (nused - 128) * 4; if (i > 2 || ntail <= 0) return false; const int spu = moe_tail_spu(ntail); if (c >= ntail * spu) return false;
                const int ut = c / spu, sl = c - ut * spu; u.pm = 128 + (ut >> 2); u.pn = ut & 3; npair = 14 / spu; k0 = sl * npair; u.aux = 1 + c; } }
        const int e = ldv_i(blke + u.pm);
        u.A = h1 + (size_t)u.pm * 128 * DFE + (size_t)k0 * 2 * 16384; u.B = w + (size_t)(e * 4 + u.pn) * 128 * DFE + (size_t)k0 * 2 * 16384;
        u.rowbase = u.pm * 256; u.nt = 2 * npair; return true; }
};

typedef f32x4 Acc[2][2][4][2];

__device__ __forceinline__ void store8bf(bf16_t* p, const float* v) {
    u32x4 w; w.x = pk2(v[0], v[1]); w.y = pk2(v[2], v[3]); w.z = pk2(v[4], v[5]); w.w = pk2(v[6], v[7]); *(u32x4*)p = w; }

template <bool GATE> struct EpiG1a {
    static constexpr bool PERM = true;
    const float* rowss; const float* bias; const f32x2* taba; const f32x2* tabb; bf16_t* Q; bf16_t* KN; bf16_t* Gb; const float* gp; bf16_t* KDT;
    __device__ __forceinline__ void pre_load(const Unit& u, int tid, float (&r)[16]) const { if (tid < 256) r[0] = ldv_f(rowss + (size_t)(u.pm * 256 + tid) * 16); else bias_sum_ld(bias, u.aux + tid - 256, NIN, 2 * NIN, r); }
    __device__ __forceinline__ void pre_store(const Unit&, LAS float* aux, int tid, const float (&r)[16]) const { aux[tid] = tid < 256 ? rstd_of(r[0]) : bias_sum_fin(r); }
    __device__ __forceinline__ void init(LAS float* auxb, int tid) const {
        if (!GATE && tid < 256) { const float v = ((const float*)tabb)[16 * 256 + tid]; auxb[512 + tid] = v; auxb[768 + 512 + tid] = v; } }
    __device__ __forceinline__ void operator()(const Acc& acc, const Unit& u, int wr, int wc, int fr, int fq, const LAS float* aux) const {
        asm volatile("" : "+v"(fr), "+v"(fq));
        const int pn = u.pn, d0 = wc * 32 + 8 * fq;
        float b[2][8];
#pragma unroll
        for (int bj = 0; bj < 2; ++bj) { const f32x4 x = *(const LAS f32x4*)(aux + 256 + 128 * bj + d0), y = *(const LAS f32x4*)(aux + 256 + 128 * bj + d0 + 4);
            b[bj][0] = x.x; b[bj][1] = x.y; b[bj][2] = x.z; b[bj][3] = x.w; b[bj][4] = y.x; b[bj][5] = y.y; b[bj][6] = y.z; b[bj][7] = y.w; }
        if constexpr (!GATE) {
            bf16_t* O = pn < 4 ? Q : KN; const int hcol = (pn & 3) * 256;
            f32x2 ta[8], tn[8], tb[8]; float dec[4];
            { const f32x2* tp0 = taba + (2 * u.pm) * 128 + d0; const f32x2* tpb = tabb + (64 * wr + fr) * 128 + d0;
#pragma unroll
              for (int q = 0; q < 8; ++q) { ta[q] = tp0[q]; tb[q] = tpb[q]; }
#pragma unroll
              for (int m = 0; m < 4; ++m) dec[m] = pn >= 4 ? gp[(pn - 4) * GPS + 127 - (64 * wr + 16 * m + fr)] : 0.f; }
            const float c128 = pn >= 4 ? gp[(pn - 4) * GPS + 128] : 0.f;
#pragma unroll
            for (int it = 0; it < 8; ++it) {
                const int ai = it >> 2, m = ai ? 3 - (it & 3) : (it & 3);
                if (it == 2) { const f32x2* tp1 = taba + (2 * u.pm + 1) * 128 + d0;
#pragma unroll
                    for (int q = 0; q < 8; ++q) tn[q] = tp1[q]; }
                if (it == 4) {
#pragma unroll
                    for (int q = 0; q < 8; ++q) ta[q] = tn[q]; }
                if ((it & 3) != 0) {
                    const float sg = ai ? -1.0f : 1.0f; int dl = 2 * d0; asm volatile("" : "+v"(dl));
#pragma unroll
                    for (int q2 = 0; q2 < 4; ++q2) { const f32x4 R2 = *(const LAS f32x4*)(aux + 512 + dl + 4 * q2);
                        { const f32x2 B = tb[2 * q2]; const float ry = sg * R2.y; tb[2 * q2].x = B.x * R2.x - B.y * ry; tb[2 * q2].y = B.y * R2.x + B.x * ry; }
                        { const f32x2 B = tb[2 * q2 + 1]; const float rw = sg * R2.w; tb[2 * q2 + 1].x = B.x * R2.z - B.y * rw; tb[2 * q2 + 1].y = B.y * R2.z + B.x * rw; } } }
                const int rl = 128 * ai + 64 * wr + 16 * m + fr, t = u.pm * 256 + rl; const float rs = aux[rl];
                float o1[8], o2[8];
#pragma unroll
                for (int q = 0; q < 8; ++q) {
                    const f32x2 A = ta[q], B = tb[q]; const float cs = A.x * B.x - A.y * B.y, sn = A.y * B.x + A.x * B.y;
                    const float v1 = rs * acc[ai][0][m][q >> 2][q & 3] + b[0][q], v2 = rs * acc[ai][1][m][q >> 2][q & 3] + b[1][q];
                    o1[q] = v1 * cs - v2 * sn; o2[q] = v1 * sn + v2 * cs; }
                store8bf(O + (size_t)t * 1024 + hcol + d0, o1); store8bf(O + (size_t)t * 1024 + hcol + 128 + d0, o2);
                if (pn >= 4) {
                    bf16_t* kd = KDT + (size_t)(hcol + d0) * T + t;
                    const float dk = ai ? dec[m] : dec[m] * c128;
#pragma unroll
                    for (int q = 0; q < 8; ++q) { kd[(size_t)q * T] = (bf16_t)(pk2(o1[q] * dk, 0.f) & 0xffffu); kd[(size_t)(128 + q) * T] = (bf16_t)(pk2(o2[q] * dk, 0.f) & 0xffffu); } }
            }
        } else {
#pragma unroll
            for (int ai = 0; ai < 2; ++ai)
#pragma unroll
                for (int m = 0; m < 4; ++m) {
                    const int rl = 128 * ai + 64 * wr + 16 * m + fr, t = u.pm * 256 + rl; const float rs = aux[rl];
#pragma unroll
                    for (int bj = 0; bj < 2; ++bj) { float o[8];
#pragma unroll
                        for (int q = 0; q < 8; ++q) o[q] = silu_f(rs * acc[ai][bj][m][q >> 2][q & 3] + b[bj][q]);
                        store8bf(Gb + (size_t)t * 2048 + (pn - 8) * 256 + 128 * bj + d0, o); }
                }
        }
    }
};
struct EpiG1b {
    static constexpr bool PERM = true;
    const float* rowss; const float* bias; const f32x2* taba; const f32x2* tabb; const float* gp; bf16_t* KDT; bf16_t* VT;
    __device__ __forceinline__ void pre_load(const Unit& u, int tid, float (&r)[16]) const { if (tid < 256) bias_sum_ld(bias, 1024 + 256 * u.pm + tid, NIN, 2 * NIN, r); else r[0] = ldv_f(rowss + (size_t)(u.pn * 256 + tid - 256) * 16); }
    __device__ __forceinline__ void pre_store(const Unit&, LAS float* aux, int tid, const float (&r)[16]) const { aux[tid] = tid < 256 ? bias_sum_fin(r) : rstd_of(r[0]); }
    __device__ __forceinline__ void init(LAS float*, int) const {}
    __device__ __forceinline__ void operator()(const Acc& acc, const Unit& u, int wr, int wc, int fr, int fq, const LAS float* aux) const {
        asm volatile("" : "+v"(fr), "+v"(fq));
        const int pmf = u.pm, tl0 = 32 * wc + 8 * fq, tk0 = u.pn * 256 + tl0;
        float rs[2][8];
#pragma unroll
        for (int bj = 0; bj < 2; ++bj) { const f32x4 x = *(const LAS f32x4*)(aux + 256 + 128 * bj + tl0), y = *(const LAS f32x4*)(aux + 256 + 128 * bj + tl0 + 4);
            rs[bj][0] = x.x; rs[bj][1] = x.y; rs[bj][2] = x.z; rs[bj][3] = x.w; rs[bj][4] = y.x; rs[bj][5] = y.y; rs[bj][6] = y.z; rs[bj][7] = y.w; }
        if (pmf < 4) {
            const int h = pmf;
#pragma unroll
            for (int m = 0; m < 4; ++m) {
                const int d = 64 * wr + 16 * m + fr; const float b1 = aux[d], b2 = aux[128 + d];
#pragma unroll
                for (int bj = 0; bj < 2; ++bj) { float o1[8], o2[8]; const f32x2 A = taba[(2 * u.pn + bj) * 128 + d]; const float4 dq0 = *(const float4*)(gp + h * GPS + 120 - tl0), dq1 = *(const float4*)(gp + h * GPS + 124 - tl0);
                    const float decs[8] = {dq1.w, dq1.z, dq1.y, dq1.x, dq0.w, dq0.z, dq0.y, dq0.x};
#pragma unroll
                    for (int q = 0; q < 8; ++q) { const f32x2 B = tabb[(tl0 + q) * 128 + d]; const float cs = A.x * B.x - A.y * B.y, sn = A.y * B.x + A.x * B.y;
                        const float v1 = rs[bj][q] * acc[0][bj][m][q >> 2][q & 3] + b1, v2 = rs[bj][q] * acc[1][bj][m][q >> 2][q & 3] + b2;
                        o1[q] = (v1 * cs - v2 * sn) * decs[q]; o2[q] = (v1 * sn + v2 * cs) * decs[q]; }
                    store8bf(KDT + (size_t)(256 * h + d) * T + tk0 + 128 * bj, o1); store8bf(KDT + (size_t)(256 * h + 128 + d) * T + tk0 + 128 * bj, o2); }
            }
        } else {
#pragma unroll
            for (int ai = 0; ai < 2; ++ai)
#pragma unroll
                for (int m = 0; m < 4; ++m) {
                    const int rl = 128 * ai + 64 * wr + 16 * m + fr, f = 256 * (pmf - 4) + rl; const float bs = aux[rl];
#pragma unroll
                    for (int bj = 0; bj < 2; ++bj) { float o[8];
#pragma unroll
                        for (int q = 0; q < 8; ++q) o[q] = rs[bj][q] * acc[ai][bj][m][q >> 2][q & 3] + bs;
                        store8bf(VT + (size_t)f * T + tk0 + 128 * bj, o); }
                }
        }
    }
};
struct EpiKV {
    static constexpr bool PERM = true;
    bf16_t* SB;
    __device__ __forceinline__ void pre_load(const Unit&, int, float (&)[16]) const {}
    __device__ __forceinline__ void pre_store(const Unit&, LAS float*, int, const float (&)[16]) const {}
    __device__ __forceinline__ void init(LAS float*, int) const {}
    __device__ __forceinline__ void operator()(const Acc& acc, const Unit& u, int wr, int wc, int fr, int fq, const LAS float*) const {
        asm volatile("" : "+v"(fr), "+v"(fq));
        const int mt = u.aux & 1, nh = u.aux >> 1; bf16_t* base = SB + ((size_t)nh * 512 + 256 * mt) * 256; const int d0 = wc * 32 + 8 * fq;
#pragma unroll
        for (int ai = 0; ai < 2; ++ai)
#pragma unroll
            for (int m = 0; m < 4; ++m) { const int r = 128 * ai + 64 * wr + 16 * m + fr;
#pragma unroll
                for (int bj = 0; bj < 2; ++bj) { float o[8];
#pragma unroll
                    for (int q = 0; q < 8; ++q) o[q] = acc[ai][bj][m][q >> 2][q & 3];
                    store8bf(base + (size_t)r * 256 + 128 * bj + d0, o); } }
    }
};
template <bool BASEB> struct EpiResid {
    static constexpr bool PERM = false;
    const float* base; const bf16_t* baseb; bf16_t* xb; float* rowss; const float* g; const float* cb; const float* cs; float accscale;
    __device__ __forceinline__ void pre_load(const Unit& u, int tid, float (&r)[16]) const {
        if (tid < 256) { const int c = 256 * u.pn + tid; r[0] = ldv_f(g + c); r[1] = cs ? cs[c] : 1.0f; } else { const int c = 256 * u.pn + tid - 256; r[0] = cb ? cb[c] : 0.f; r[1] = 1.0f; } }
    __device__ __forceinline__ void pre_store(const Unit&, LAS float* aux, int tid, const float (&r)[16]) const { aux[256 + tid] = r[0] * r[1] * (tid < 256 ? accscale : 1.0f); }
    __device__ __forceinline__ void init(LAS float*, int) const {}
    __device__ __forceinline__ void operator()(const Acc& acc, const Unit& u, int wr, int wc, int fr, int fq, const LAS float* aux) const {
        asm volatile("" : "+v"(fr), "+v"(fq));
        const int cl0 = 32 * wc + 4 * fq, col0 = 256 * u.pn + cl0;
        f32x4 gv[2][2], cbv[2][2];
#pragma unroll
        for (int bj = 0; bj < 2; ++bj)
#pragma unroll
            for (int n = 0; n < 2; ++n) { gv[bj][n] = *(const LAS f32x4*)(aux + 256 + cl0 + 128 * bj + 16 * n); cbv[bj][n] = *(const LAS f32x4*)(aux + 512 + cl0 + 128 * bj + 16 * n); }
        f32x4 bsv[2][4];
        const size_t o0 = (size_t)(u.pm * 256 + 64 * wr + fr) * 1024 + col0;
#define ER_LOADB(dst, off) do { if constexpr (BASEB) { const u32x2 _w = *(const u32x2*)(baseb + (off)); dst = (f32x4){bflo(_w.x), bfhi(_w.x), bflo(_w.y), bfhi(_w.y)}; } else dst = *(const f32x4*)(base + (off)); } while (0)
#pragma unroll
        for (int j = 0; j < 4; ++j) ER_LOADB(bsv[0][j], o0 + 128 * (j >> 1) + 16 * (j & 1));
#pragma unroll
        for (int it = 0; it < 8; ++it) { const int ai = it >> 2, m = it & 3; const int t = u.pm * 256 + 128 * ai + 64 * wr + 16 * m + fr; float s = 0.f;
            if (it < 7) { const int ai2 = (it + 1) >> 2, m2 = (it + 1) & 3; const size_t o2 = o0 + (size_t)(128 * ai2 + 16 * m2) * 1024;
#pragma unroll
                for (int j = 0; j < 4; ++j) ER_LOADB(bsv[(it + 1) & 1][j], o2 + 128 * (j >> 1) + 16 * (j & 1)); }
#pragma unroll
            for (int bj = 0; bj < 2; ++bj)
#pragma unroll
                for (int n = 0; n < 2; ++n) { const size_t o = (size_t)t * 1024 + col0 + 128 * bj + 16 * n;
                    const f32x4 xo = bsv[it & 1][2 * bj + n] + (acc[ai][bj][m][n] + cbv[bj][n]) * gv[bj][n];
                    s += (xo.x * xo.x + xo.y * xo.y) + (xo.z * xo.z + xo.w * xo.w);
                    { u32x2 w; w.x = pk2(xo.x, xo.y); w.y = pk2(xo.z, xo.w); *(u32x2*)(xb + o) = w; } }
            s += __shfl_xor(s, 16); s += __shfl_xor(s, 32);
            if (fq == 0) rowss[(size_t)t * 16 + u.pn * 4 + wc] = s; }
    }
#undef ER_LOADB
};
template <bool TILED, bool F8OUT = false> struct EpiSwiglu {
    static constexpr bool PERM = true;
    const float* rowss; const float* rowrs; const float* bias; bf16_t* Hout; int ldh, bs1, bs2;
    __device__ __forceinline__ void pre_load(const Unit& u, int tid, float (&r)[16]) const {
        if (tid < 256) { if (rowrs) r[0] = ldv_f(rowrs + u.rowbase + tid); else rstd_row_ld(rowss, u.rowbase + tid, r); } else bias_sum_ld(bias, u.aux + tid - 256, bs1, bs2, r); }
    __device__ __forceinline__ void pre_store(const Unit&, LAS float* aux, int tid, const float (&r)[16]) const { aux[tid] = tid < 256 ? (rowrs ? r[0] : rstd_row_fin(r)) : bias_sum_fin(r); }
    __device__ __forceinline__ void init(LAS float*, int) const {}
    __device__ __forceinline__ void operator()(const Acc& acc, const Unit& u, int wr, int wc, int fr, int fq, const LAS float* aux) const {
        asm volatile("" : "+v"(fr), "+v"(fq));
        const int d0 = wc * 32 + 8 * fq; float bg[8], bu[8];
        { const f32x4 x = *(const LAS f32x4*)(aux + 256 + d0), y = *(const LAS f32x4*)(aux + 256 + d0 + 4), z = *(const LAS f32x4*)(aux + 384 + d0), w = *(const LAS f32x4*)(aux + 384 + d0 + 4);
          bg[0] = x.x; bg[1] = x.y; bg[2] = x.z; bg[3] = x.w; bg[4] = y.x; bg[5] = y.y; bg[6] = y.z; bg[7] = y.w; bu[0] = z.x; bu[1] = z.y; bu[2] = z.z; bu[3] = z.w; bu[4] = w.x; bu[5] = w.y; bu[6] = w.z; bu[7] = w.w; }
        constexpr float KG = -1.4426950408889634f, KU = -0.6931471805599453f * (F8OUT ? F8_HSCALE : 1.0f);
#pragma unroll
        for (int q = 0; q < 8; ++q) { bg[q] *= KG; bu[q] *= KU; }
#pragma unroll
        for (int ai = 0; ai < 2; ++ai)
#pragma unroll
            for (int m = 0; m < 4; ++m) { const int rl = 128 * ai + 64 * wr + 16 * m + fr, row = u.rowbase + rl; const float rs = aux[rl], rsg = rs * KG, rsu = rs * KU; float o[8];
#pragma unroll
                for (int q = 0; q < 8; ++q) {
                    const float x = rsg * acc[ai][0][m][q >> 2][q & 3] + bg[q], y = rsu * acc[ai][1][m][q >> 2][q & 3] + bu[q];
                    o[q] = (x * __builtin_amdgcn_rcpf(1.0f + __builtin_amdgcn_exp2f(x))) * y; }
                if constexpr (F8OUT) {
#pragma unroll
                    for (int q = 0; q < 8; ++q) o[q] = __builtin_amdgcn_fmed3f(o[q], -448.0f, 448.0f);
                    u32x2 w8; w8.x = pk4f8(o[0], o[1], o[2], o[3]); w8.y = pk4f8(o[4], o[5], o[6], o[7]);
                    if (TILED) *(u32x2*)((unsigned char*)Hout + (((size_t)(row >> 8) * (ldh >> 7) + u.pn) * 256 + (row & 255)) * 128 + d0) = w8;
                    else *(u32x2*)((unsigned char*)Hout + (size_t)row * ldh + 128 * u.pn + d0) = w8; }
                else if (TILED) store8bf(Hout + (((size_t)(row >> 8) * (ldh >> 6) + 2 * u.pn + (d0 >> 6)) * 256 + (row & 255)) * 64 + (d0 & 63), o);
                else store8bf(Hout + (size_t)row * ldh + 128 * u.pn + d0, o); }
    }
};
struct EpiMoeDown {
    static constexpr bool PERM = true;
    const float* gate; bf16_t* YB; float* YBB;
    __device__ __forceinline__ void pre_load(const Unit& u, int tid, float (&r)[16]) const { if (tid < 256) r[0] = ldv_f(gate + u.rowbase + tid); }
    __device__ __forceinline__ void pre_store(const Unit&, LAS float* aux, int tid, const float (&r)[16]) const { if (tid < 256) aux[tid] = r[0] * (1.0f / (F8_DSCALE * F8_HSCALE)); }
    __device__ __forceinline__ void init(LAS float*, int) const {}
    __device__ __forceinline__ void operator()(const Acc& acc, const Unit& u, int wr, int wc, int fr, int fq, const LAS float* aux) const {
        asm volatile("" : "+v"(fr), "+v"(fq));
        const int col0 = 256 * u.pn + 32 * wc + 8 * fq;
#pragma unroll
        for (int ai = 0; ai < 2; ++ai)
#pragma unroll
            for (int m = 0; m < 4; ++m) { const int rl = 128 * ai + 64 * wr + 16 * m + fr, row = u.rowbase + rl; const float gt = aux[rl];
#pragma unroll
                for (int bj = 0; bj < 2; ++bj) {
                    if (u.aux == 0) { float o[8];
#pragma unroll
                        for (int q = 0; q < 8; ++q) o[q] = acc[ai][bj][m][q >> 2][q & 3] * gt;
                        store8bf(YB + (size_t)row * 1024 + col0 + 128 * bj, o); }
                    else { float* d = YBB + (size_t)(u.aux - 1) * 65536 + (size_t)rl * 256 + 32 * wc + 8 * fq + 128 * bj;
                        *(f32x4*)d = acc[ai][bj][m][0] * gt; *(f32x4*)(d + 4) = acc[ai][bj][m][1] * gt; } } }
    }
};

namespace pg8 {
constexpr int BM = 256, BK = 64, HALF = 128, HTB = HALF * BK * 2, STAGE_BYTES = 8 * HTB;
__device__ __forceinline__ int lds_byte(int r, int c) { const int st = (r >> 4) * 2 + (c >> 5), rr = r & 15, cc = c & 31, ob = rr * 64 + cc * 2; return st * 1024 + (ob ^ (((ob >> 9) & 1) << 5)); }
__device__ __forceinline__ void stage_rc(int b, int& R, int& C) { const int st = b / 1024, sb = b % 1024, swz = sb ^ (((sb >> 9) & 1) << 5); R = (st >> 1) * 16 + swz / 64; C = (st & 1) * 32 + (swz % 64) / 2; }
__device__ __forceinline__ int perm32(int rho) { const int n = rho >> 4, i = rho & 15; return 8 * (i >> 2) + 4 * n + (i & 3); }
}
typedef int i32x8 __attribute__((ext_vector_type(8)));
__device__ __forceinline__ void mfma_f8_inplace(f32x4& acc, const i32x8 a, const i32x8 b, int sc) {
    asm volatile("v_mfma_scale_f32_16x16x128_f8f6f4 %0, %1, %2, %0, %3, %3 op_sel_hi:[0,0,0]" : "+v"(acc) : "v"(a), "v"(b), "v"(sc)); }
template <class Desc, class Epi>
__device__ __forceinline__ void gemm_fast(LAS unsigned char* lds, const unsigned char* wsb, const Desc& Dc, const Epi& E, int c, int G, int wave_id) {
    using namespace pg8;
    constexpr bool GATHER = Desc::GATHER; constexpr bool FP8 = Desc::FP8;
    int lane_ = lane_id(); asm volatile("" : "+v"(lane_));
    const int wid = wave_id, lane = lane_, tid = wid * 64 + lane, wr = wid >> 2, wc = wid & 3, fr = lane & 15, fq = lane >> 4;
    unsigned vA[2][2], vAn[2][2], vB[2][2];
#pragma unroll
    for (int i = 0; i < 2; ++i) { int R, C; stage_rc(tid * 16 + i * 8192, R, C); const int Rb = Epi::PERM ? ((R & ~31) + perm32(R & 31)) : R;
#pragma unroll
        for (int h = 0; h < 2; ++h) { vA[h][i] = (unsigned)((h * HALF + R) * Dc.lda + C) * 2u; vB[h][i] = (unsigned)((h * HALF + Rb) * Dc.ldb + C) * 2u; vAn[h][i] = vA[h][i]; } }
    const unsigned ksA = (unsigned)Dc.ksa, ksB = (unsigned)Dc.ksb;
    const __amdgpu_buffer_rsrc_t rs = __builtin_amdgcn_make_buffer_rsrc((void*)wsb, (short)0, 0x7fffffff, 0x00020000);
    const unsigned ldsw = (unsigned)wid * 1024u;
    const int aoff = lds_byte(wr * 64 + fr, fq * 8), boff = lds_byte(wc * 32 + fr, fq * 8);
#define PG8_SA(b, h) (((b) * 2 + (h)) * HTB)
#define PG8_SB(b, h) ((4 + (b) * 2 + (h)) * HTB)
#define PG8_STAGE(bufoff, gbase, voff) do { _Pragma("unroll") for (int _i = 0; _i < 2; ++_i) \
        __builtin_amdgcn_raw_ptr_buffer_load_lds(rs, (LAS unsigned*)(lds + (bufoff) + ldsw + _i * 8192), 16, (int)(voff)[_i], (int)(gbase), 0, 0); } while (0)
#define PG8_LDA(dst, b, h) do { _Pragma("unroll") for (int m = 0; m < 4; ++m) _Pragma("unroll") for (int k = 0; k < 2; ++k) dst[m][k] = *(const LAS bf16x8*)(lds + PG8_SA(b, h) + aoff + m * 2048 + k * 1024); } while (0)
#define PG8_LDB(dst, b, h) do { _Pragma("unroll") for (int n = 0; n < 2; ++n) _Pragma("unroll") for (int k = 0; k < 2; ++k) dst[n][k] = *(const LAS bf16x8*)(lds + PG8_SB(b, h) + boff + n * 2048 + k * 1024); } while (0)
#define PG8_CAT(x) __builtin_shufflevector(__builtin_bit_cast(i32x4, x[0]), __builtin_bit_cast(i32x4, x[1]), 0, 1, 2, 3, 4, 5, 6, 7)
#define PG8_MMA(ai, bj, At, Bt) do { __builtin_amdgcn_s_setprio(1); if constexpr (FP8) { _Pragma("unroll") for (int m = 0; m < 4; ++m) _Pragma("unroll") for (int n = 0; n < 2; ++n) \
        mfma_f8_inplace(acc[ai][bj][m][n], PG8_CAT(Bt[n]), PG8_CAT(At[m]), f8sc); } else { \
        _Pragma("unroll") for (int m = 0; m < 4; ++m) _Pragma("unroll") for (int n = 0; n < 2; ++n) _Pragma("unroll") for (int k = 0; k < 2; ++k) \
        acc[ai][bj][m][n] = __builtin_amdgcn_mfma_f32_16x16x32_bf16(Bt[n][k], At[m][k], acc[ai][bj][m][n], 0, 0, 0); } __builtin_amdgcn_s_setprio(0); } while (0)
#define PG8_WAIT_V(n) asm volatile("s_waitcnt vmcnt(" #n ")" ::: "memory")
#define PG8_WAIT_L(n) asm volatile("s_waitcnt lgkmcnt(" #n ")" ::: "memory")
#define PG8_BAR __builtin_amdgcn_s_barrier()
#define PG8_SCHED __builtin_amdgcn_sched_barrier(0)
#define PG8_GATHER_OFFS(dst, un) do { const int _t = wid * 64 + lane_id(); _Pragma("unroll") for (int _i = 0; _i < 2; ++_i) { int _R, _C; stage_rc(_t * 16 + _i * 8192, _R, _C); \
        _Pragma("unroll") for (int _h = 0; _h < 2; ++_h) dst[_h][_i] = (unsigned)(ldv_i(Dc.tok + (un).rowbase + _h * HALF + _R) * Dc.lda + _C) * 2u; } } while (0)
    int f8sc = 0x7f7f7f7f; asm volatile("" : "+v"(f8sc));
    Unit cur, nxt; int ui = 0;
    if (!Dc.get(c, cur)) return;
    LAS float* const auxb = (LAS float*)(lds + 131072 + 1024);
    E.init(auxb, tid);
    { float r0[16]; E.pre_load(cur, tid, r0); E.pre_store(cur, auxb, tid, r0); }
    Acc acc;
#pragma unroll
    for (int a = 0; a < 2; ++a)
#pragma unroll
        for (int b = 0; b < 2; ++b)
#pragma unroll
            for (int m = 0; m < 4; ++m)
#pragma unroll
                for (int n = 0; n < 2; ++n) acc[a][b][m][n] = (f32x4){0.f, 0.f, 0.f, 0.f};
    bf16x8 At[4][2], B0[2][2], B1[2][2];
    unsigned cA = (unsigned)((const unsigned char*)cur.A - wsb), cB = (unsigned)((const unsigned char*)cur.B - wsb);
    if constexpr (GATHER) { PG8_GATHER_OFFS(vA, cur); }
    PG8_STAGE(PG8_SB(0, 0), cB, vB[0]); PG8_STAGE(PG8_SB(0, 1), cB, vB[1]); PG8_STAGE(PG8_SA(0, 0), cA, vA[0]); PG8_STAGE(PG8_SA(0, 1), cA, vA[1]);
    if (wr == 1) PG8_BAR;
    PG8_WAIT_V(2); PG8_BAR;
    PG8_STAGE(PG8_SB(1, 0), cB + ksB, vB[0]); PG8_STAGE(PG8_SA(1, 0), cA + ksA, vA[0]); PG8_STAGE(PG8_SB(1, 1), cB + ksB, vB[1]);
    PG8_WAIT_V(6); PG8_BAR;
    for (;;) {
        const bool has_next = Dc.get((ui + 1) * G + c, nxt);
        const unsigned nA = has_next ? (unsigned)((const unsigned char*)nxt.A - wsb) : cA, nB = has_next ? (unsigned)((const unsigned char*)nxt.B - wsb) : cB;
        if constexpr (GATHER) { if (has_next) { PG8_GATHER_OFFS(vAn, nxt); } else {
#pragma unroll
            for (int h = 0; h < 2; ++h)
#pragma unroll
                for (int i = 0; i < 2; ++i) vAn[h][i] = vA[h][i]; } }
        const int nt = cur.nt;
        for (int t = 0; t < nt; t += 2) {
            const bool last = (t == nt - 2);
            const unsigned a1 = cA + (unsigned)(t + 1) * ksA;
            const unsigned a2 = last ? nA : cA + (unsigned)(t + 2) * ksA, b2 = last ? nB : cB + (unsigned)(t + 2) * ksB;
            const unsigned a3 = a2 + ksA, b3 = b2 + ksB;
            unsigned x0[2], x1[2];
#pragma unroll
            for (int i = 0; i < 2; ++i) { x0[i] = (GATHER && last) ? vAn[0][i] : vA[0][i]; x1[i] = (GATHER && last) ? vAn[1][i] : vA[1][i]; }
            PG8_LDB(B0, 0, 0); PG8_LDB(B1, 0, 1); PG8_SCHED; PG8_LDA(At, 0, 0); PG8_STAGE(PG8_SA(1, 1), a1, vA[1]);
            PG8_WAIT_V(8); PG8_WAIT_L(0); PG8_BAR; PG8_MMA(0, 0, At, B0); PG8_MMA(0, 1, At, B1); PG8_BAR; PG8_SCHED;
            PG8_LDA(At, 0, 1); PG8_STAGE(PG8_SB(0, 0), b2, vB[0]); PG8_STAGE(PG8_SB(0, 1), b2, vB[1]); PG8_STAGE(PG8_SA(0, 0), a2, x0);
            PG8_WAIT_V(8); PG8_WAIT_L(0); PG8_BAR; PG8_MMA(1, 0, At, B0); PG8_MMA(1, 1, At, B1); PG8_BAR; PG8_SCHED;
            PG8_LDB(B0, 1, 0); PG8_LDB(B1, 1, 1); PG8_SCHED; PG8_LDA(At, 1, 0); PG8_STAGE(PG8_SA(0, 1), a2, x1);
            PG8_WAIT_V(8); PG8_WAIT_L(0); PG8_BAR; PG8_MMA(0, 0, At, B0); PG8_MMA(0, 1, At, B1); PG8_BAR; PG8_SCHED;
            PG8_LDA(At, 1, 1); PG8_STAGE(PG8_SB(1, 0), b3, vB[0]); PG8_STAGE(PG8_SB(1, 1), b3, vB[1]); PG8_STAGE(PG8_SA(1, 0), a3, x0);
            PG8_WAIT_V(8); PG8_WAIT_L(0); PG8_BAR; PG8_MMA(1, 0, At, B0); PG8_MMA(1, 1, At, B1); PG8_BAR; PG8_SCHED;
        }
        if constexpr (FP8) asm volatile("s_nop 15\n\ts_nop 15\n\ts_nop 15\n\ts_nop 15\n\ts_nop 15" ::: "memory");
        if (wr == 0) PG8_BAR;
        { const int l2 = lane_id(); float rn[16];
          if (has_next) E.pre_load(nxt, wid * 64 + l2, rn);
          E(acc, cur, wr, wc, l2 & 15, l2 >> 4, auxb + (ui & 1) * 768);
          if (has_next) E.pre_store(nxt, auxb + ((ui + 1) & 1) * 768, wid * 64 + l2, rn); }
        if (!has_next) break;
#pragma unroll
        for (int a = 0; a < 2; ++a)
#pragma unroll
            for (int b = 0; b < 2; ++b)
#pragma unroll
                for (int m = 0; m < 4; ++m)
#pragma unroll
                    for (int n = 0; n < 2; ++n) acc[a][b][m][n] = (f32x4){0.f, 0.f, 0.f, 0.f};
        cur = nxt; cA = nA; cB = nB; ++ui;
        if constexpr (GATHER) {
#pragma unroll
            for (int h = 0; h < 2; ++h)
#pragma unroll
                for (int i = 0; i < 2; ++i) vA[h][i] = vAn[h][i]; }
        if (wr == 1) PG8_BAR;
    }
    PG8_WAIT_V(0);
    PG8_BAR;
#undef PG8_SA
#undef PG8_SB
#undef PG8_STAGE
#undef PG8_LDA
#undef PG8_LDB
#undef PG8_MMA
#undef PG8_CAT
#undef PG8_WAIT_V
#undef PG8_WAIT_L
#undef PG8_BAR
#undef PG8_SCHED
#undef PG8_GATHER_OFFS
}

struct Frame {
    Params p; unsigned char* ws; LAS unsigned char* lds; int tid, lane, wave, c, G;
    __device__ __forceinline__ float* MOD() const { return (float*)(ws + CT_MOD); }
    __device__ __forceinline__ float* BIAS_IN() const { return (float*)(ws + CT_BIAS_IN); }
    __device__ __forceinline__ float* BIAS_GU() const { return (float*)(ws + CT_BIAS_GU); }
    __device__ __forceinline__ float* BIAS_R() const { return (float*)(ws + CT_BIAS_R); }
    __device__ __forceinline__ float* BIAS_MGU() const { return (float*)(ws + CT_BIAS_MGU); }
    __device__ __forceinline__ float* ROWSS() const { return (float*)(ws + WS_ROWSSP); }
    __device__ __forceinline__ float* MODP() const { return (float*)(ws + WS_MODP); }
    __device__ __forceinline__ f32x2* TABA() const { return (f32x2*)(ws + WS_TABA); }
    __device__ __forceinline__ f32x2* TABB() const { return (f32x2*)(ws + WS_TABB); }
    __device__ __forceinline__ float* GP() const { return (float*)(ws + WS_GP); }
    __device__ __forceinline__ float* WR() const { return (float*)(ws + WS_WR); }
    __device__ __forceinline__ int* TOPE() const { return (int*)(ws + WS_TOPE); }
    __device__ __forceinline__ float* TOPG() const { return (float*)(ws + WS_TOPG); }
    __device__ __forceinline__ int* CNT() const { return (int*)(ws + WS_CNT); }
    __device__ __forceinline__ int* BUFTOK() const { return (int*)(ws + WS_BUFTOK); }
    __device__ __forceinline__ float* BUFGATE() const { return (float*)(ws + WS_BUFGATE); }
    __device__ __forceinline__ int* POS() const { return (int*)(ws + WS_POS); }
    __device__ __forceinline__ int* BLKE() const { return (int*)(ws + WS_BLKE); }
    __device__ __forceinline__ float* RSTD3() const { return (float*)(ws + WS_RSTD3); }
    __device__ __forceinline__ float* BUFRS() const { return (float*)(ws + WS_BUFRS); }
    __device__ __forceinline__ bf16_t* WIN() const { return (bf16_t*)(ws + WS_WIN); }
    __device__ __forceinline__ bf16_t* WOUT() const { return (bf16_t*)(ws + WS_WOUT); }
    __device__ __forceinline__ bf16_t* WGU() const { return (bf16_t*)(ws + WS_WGU); }
    __device__ __forceinline__ bf16_t* WD() const { return (bf16_t*)(ws + WS_WD); }
    __device__ __forceinline__ bf16_t* WP() const { return (bf16_t*)(ws + WS_WP); }
    __device__ __forceinline__ bf16_t* XB() const { return (bf16_t*)(ws + WS_XB); }
    __device__ __forceinline__ bf16_t* Q() const { return (bf16_t*)(ws + WS_Q); }
    __device__ __forceinline__ bf16_t* KN() const { return (bf16_t*)(ws + WS_KN); }
    __device__ __forceinline__ bf16_t* KDT() const { return (bf16_t*)(ws + WS_KDT); }
    __device__ __forceinline__ bf16_t* VT() const { return (bf16_t*)(ws + WS_VT); }
    __device__ __forceinline__ bf16_t* Gb() const { return (bf16_t*)(ws + WS_G); }
    __device__ __forceinline__ bf16_t* SB() const { return (bf16_t*)(ws + WS_SB); }
    __device__ __forceinline__ bf16_t* Y() const { return (bf16_t*)(ws + WS_Y); }
    __device__ __forceinline__ bf16_t* H1() const { return (bf16_t*)(ws + WS_H1); }
    __device__ __forceinline__ bf16_t* PB() const { return (bf16_t*)(ws + WS_PB); }
    __device__ __forceinline__ bf16_t* H1M() const { return (bf16_t*)(ws + WS_H1M); }
    __device__ __forceinline__ bf16_t* WMGU() const { return (bf16_t*)(ws + WS_WMGU); }
    __device__ __forceinline__ bf16_t* WMD() const { return (bf16_t*)(ws + WS_WMD); }
    __device__ __forceinline__ bf16_t* YB() const { return (bf16_t*)(ws + WS_YB); }
    __device__ __forceinline__ float* YBB() const { return (float*)(ws + WS_YBB); }
    __device__ __forceinline__ float* X2() const { return (float*)(ws + WS_X2); }
    __device__ __forceinline__ bf16_t* X3B() const { return (bf16_t*)(ws + WS_G + 32 * MiB); }
};
__device__ __forceinline__ void frame_fresh(Frame& F) { int l = lane_id(); asm volatile("" : "+v"(l)); F.lane = l; F.tid = F.wave * 64 + l; }
__device__ __forceinline__ void frame_init(Frame& F, const Params& p, LAS unsigned char* lds, int c, int G) {
    F.p = p; F.ws = p.ws; F.lds = lds; F.tid = threadIdx.x; F.lane = F.tid & 63; F.wave = __builtin_amdgcn_readfirstlane(F.tid >> 6); F.c = c; F.G = G;
}

__device__ __forceinline__ void dsincos(double x, double& s, double& c) {
    const double k = rint(x * 0.6366197723675814); double y = fma(-k, 1.5707963267948966, x); y = fma(-k, 6.123233995736766e-17, y);
    const double z = y * y;
    double sp = -7.6471637318198164759e-13; sp = fma(sp, z, 1.6059043836821614599e-10); sp = fma(sp, z, -2.5052108385441718775e-8); sp = fma(sp, z, 2.7557319223985890653e-6);
    sp = fma(sp, z, -1.9841269841269841270e-4); sp = fma(sp, z, 8.3333333333333333333e-3); sp = fma(sp, z, -1.6666666666666666667e-1); const double sy = fma(sp * z, y, y);
    double cp = 4.7794773323873852974e-14; cp = fma(cp, z, -1.1470745597729724714e-11); cp = fma(cp, z, 2.0876756987868098979e-9); cp = fma(cp, z, -2.7557319223985890653e-7);
    cp = fma(cp, z, 2.4801587301587301587e-5); cp = fma(cp, z, -1.3888888888888888889e-3); cp = fma(cp, z, 4.1666666666666666667e-2); cp = fma(cp, z, -0.5); const double cy = fma(cp, z, 1.0);
    const int q = ((int)k) & 3;
    s = (q == 0) ? sy : (q == 1) ? cy : (q == 2) ? -sy : -cy;
    c = (q == 0) ? cy : (q == 1) ? -sy : (q == 2) ? -cy : sy;
}
__device__ __forceinline__ void phase_p0(Frame& F) {
    const Params& p = F.p; const int gw = F.c * NWAVE + F.wave, NGW = F.G * NWAVE, lane = F.lane;
    LAS float* cact = (LAS float*)F.lds;
    __syncthreads();
    for (int k = F.tid; k < 1024; k += NTHR) cact[k] = silu_f(p.c[k]);
    __syncthreads();
    for (int task = gw; task < 1536; task += NGW) {
        const int i = task / 768, rem = task % 768, cb = rem >> 3, ks = rem & 7, n = cb * 64 + lane;
        const float* w = p.ada_w + (size_t)i * 1024 * NIN + (size_t)(ks * 128) * NIN + n; float a = 0.f;
#pragma unroll
        for (int k0 = 0; k0 < 128; k0 += 32) { float wv[32];
#pragma unroll
            for (int k = 0; k < 32; ++k) wv[k] = w[(size_t)(k0 + k) * NIN];
#pragma unroll
            for (int k = 0; k < 32; ++k) a = fmaf(cact[ks * 128 + k0 + k], wv[k], a); }
        if (ks == 0) a += p.ada_b[i * NIN + n];
        F.MODP()[ks * 12288 + i * NIN + n] = a;
    }
    const int gt = F.c * NTHR + F.tid, NGT = F.G * NTHR;
    for (int e = gt; e < 32768 + 4; e += NGT) {
        if (e < 32768) {
            const int which = e >> 14, ab = (e >> 7) & 127, i = e & 127; double inv = 1.0;
            for (int q = 0; q < i; ++q) inv *= 0.93057204092969897929;
            const double ang = (double)(which == 0 ? 128 * ab : ab) * inv; double s, c2; dsincos(ang, s, c2);
            (which == 0 ? F.TABA() : F.TABB())[ab * 128 + i] = (f32x2){(float)c2, (float)s};
        } else {
            const int h = e - 32768; const double g = 1.0 - 1.0 / (double)(32 << h); double v = 1.0;
            for (int j = 0; j <= 256; ++j) { F.GP()[h * GPS + j] = (float)v; v *= g; }
        }
    }
    for (int row = 2 * gw; row < T; row += 2 * NGW) {
        f32x4 v[2][4];
#pragma unroll
        for (int r = 0; r < 2; ++r) { const f32x4* xr = (const f32x4*)(p.x + (size_t)(row + r) * D) + lane;
#pragma unroll
            for (int j = 0; j < 4; ++j) v[r][j] = xr[64 * j]; }
#pragma unroll
        for (int r = 0; r < 2; ++r) { float s = 0.f;
#pragma unroll
            for (int j = 0; j < 4; ++j) s += (v[r][j].x * v[r][j].x + v[r][j].y * v[r][j].y) + (v[r][j].z * v[r][j].z + v[r][j].w * v[r][j].w);
            s = wave_sum(s); if (lane < 16) F.ROWSS()[(size_t)(row + r) * 16 + lane] = (lane == 0) ? s : 0.f;
            u32x2* o = (u32x2*)(F.XB() + (size_t)(row + r) * D) + lane;
#pragma unroll
            for (int j = 0; j < 4; ++j) { u32x2 w; w.x = pk2(v[r][j].x, v[r][j].y); w.y = pk2(v[r][j].z, v[r][j].w); o[64 * j] = w; } }
    }
}

template <bool F8 = false>
__device__ __forceinline__ void conv_strip(const float* W, int ldw, int kb0, int nkb, int n0, bf16_t* WT, int ldt, int drow0, const LAS float* gsl, const LAS float* shl,
                                           float* bias, float cscale, LAS float* scr, int lane, int tiled_nkt = 0, float wmul = 1.0f) {
    f32x4 bacc = (f32x4){0.f, 0.f, 0.f, 0.f}; f32x4 w[8];
    const int lr = lane >> 3, lc = 4 * (lane & 7);
    const float* wp = W + (size_t)(kb0 * 64 + lr) * ldw + n0 + lc;
#pragma unroll
    for (int i = 0; i < 8; ++i) w[i] = *(const f32x4*)(wp + (size_t)(8 * i) * ldw);
    for (int kb = kb0; kb < kb0 + nkb; ++kb) {
        const int k0 = kb * 64; f32x4 wn[8];
        if (kb + 1 < kb0 + nkb) {
#pragma unroll
            for (int i = 0; i < 8; ++i) wn[i] = *(const f32x4*)(wp + (size_t)(64 * (kb + 1 - kb0) + 8 * i) * ldw);
        } else {
#pragma unroll
            for (int i = 0; i < 8; ++i) wn[i] = (f32x4){0.f, 0.f, 0.f, 0.f};
        }
#pragma unroll
        for (int i = 0; i < 8; ++i) { const int kk = lr + 8 * i;
            float gsv = cscale * wmul; if (gsl) { gsv *= gsl[k0 + kk]; const float sv = shl[k0 + kk]; bacc = bacc + w[i] * sv; }
            *(LAS f32x4*)(scr + kk * 36 + 4 * ((lane & 7) ^ i)) = w[i] * gsv; }
        asm volatile("s_waitcnt lgkmcnt(0)" ::: "memory");
        const int cc = lane & 7;
#pragma unroll
        for (int j = 0; j < 4; ++j) { const int n = (lane >> 3) + 8 * j; const LAS float* s = scr + (8 * cc) * 36 + 4 * ((n >> 2) ^ cc) + (n & 3);
            const int nr = drow0 + n;
            if constexpr (F8) { u32x2 o8; o8.x = pk4f8(s[0 * 36], s[1 * 36], s[2 * 36], s[3 * 36]); o8.y = pk4f8(s[4 * 36], s[5 * 36], s[6 * 36], s[7 * 36]);
                if (tiled_nkt) *(u32x2*)((unsigned char*)WT + (((size_t)(nr >> 8) * tiled_nkt + (kb >> 1)) * 256 + (nr & 255)) * 128 + (kb & 1) * 64 + 8 * cc) = o8;
                else *(u32x2*)((unsigned char*)WT + (size_t)nr * ldt + k0 + 8 * cc) = o8;
                continue; }
            u32x4 o; o.x = pk2(s[0 * 36], s[1 * 36]); o.y = pk2(s[2 * 36], s[3 * 36]); o.z = pk2(s[4 * 36], s[5 * 36]); o.w = pk2(s[6 * 36], s[7 * 36]);
            if (tiled_nkt) *(u32x4*)(WT + (((size_t)(nr >> 8) * tiled_nkt + kb) * 256 + (nr & 255)) * 64 + 8 * cc) = o;
            else *(u32x4*)(WT + (size_t)nr * ldt + k0 + 8 * cc) = o; }
        asm volatile("s_waitcnt lgkmcnt(0)" ::: "memory");
#pragma unroll
        for (int i = 0; i < 8; ++i) w[i] = wn[i];
    }
    if (bias) {
#pragma unroll
        for (int o = 8; o < 64; o <<= 1) { bacc.x += __shfl_xor(bacc.x, o); bacc.y += __shfl_xor(bacc.y, o); bacc.z += __shfl_xor(bacc.z, o); bacc.w += __shfl_xor(bacc.w, o); }
        if (lane < 8) *(f32x4*)(bias + drow0 + lc) = bacc * cscale; }
}
__device__ __forceinline__ void phase_p1(Frame& F) {
    const Params& p = F.p; const int gw = F.c * NWAVE + F.wave, NGW = F.G * NWAVE, lane = F.lane;
    LAS float* modl = (LAS float*)F.lds;
    LAS float* scr = (LAS float*)(F.lds + 49152 + F.wave * 9216);
    __syncthreads();
    for (int idx = F.tid; idx < 12288; idx += NTHR) { float v = 0.f;
#pragma unroll
        for (int ks = 0; ks < 8; ++ks) v += F.MODP()[ks * 12288 + idx];
        modl[idx] = v; if ((idx % F.G) == F.c) F.MOD()[idx] = v; }
    __syncthreads();
    const LAS float* MOD0 = modl; const LAS float* MOD1 = modl + NIN; const LAS float* nul = nullptr;
    LAS float* gs_in = modl + 2048; LAS float* gs_ffn = modl + 5120; LAS float* gs_pool = modl + NIN + 2048;
    for (int k = F.tid; k < 1024; k += NTHR) { gs_in[k] = p.norm_gain[k] * (1.0f + MOD0[1024 + k]); gs_ffn[k] = p.norm_gain[1024 + k] * (1.0f + MOD0[4 * 1024 + k]); gs_pool[k] = p.norm_gain[2048 + k] * (1.0f + MOD1[1024 + k]); }
    __syncthreads();
    constexpr int S_IN = 192 * 4, S_G = 88 * 4, I_OUT = 32 * 32, I_D = 44 * 32, I_P = 4 * 4 * 8;
    constexpr int NIT = S_IN + 2 * S_G + I_OUT + I_D + I_P + 1;
    for (int it = gw; it < NIT; it += NGW) {
        int r = it;
        if (r < S_IN) { const int part = r / 192, n0 = (r % 192) * 32; const float cs = (n0 >= 1024 && n0 < 2048) ? 0.0625f : 1.0f;
            conv_strip(p.ret_w_in, NIN, 4 * part, 4, n0, F.WIN(), 1024, n0, gs_in, MOD0, F.BIAS_IN() + part * NIN, cs, scr, lane); continue; } r -= S_IN;
        if (r < 2 * S_G) { const int up = r >= S_G; if (up) r -= S_G; const int part = r / 88, n0 = (r % 88) * 32, drow = (n0 >> 7) * 256 + (up ? 128 : 0) + (n0 & 127);
            conv_strip(up ? p.ffn_w_up : p.ffn_w_gate, DFF, 4 * part, 4, n0, F.WGU(), 1024, drow, gs_ffn, MOD0 + 3 * 1024, F.BIAS_GU() + part * 5632, 1.0f, scr, lane); continue; } r -= 2 * S_G;
        if (r < I_OUT) { const int kb = r / 32, nb = r % 32; conv_strip(p.ret_w_out, 1024, kb, 1, nb * 32, F.WOUT(), 2048, nb * 32, nul, nul, nullptr, 1.0f, scr, lane); continue; } r -= I_OUT;
        if (r < I_D) { const int kb = r / 32, nb = r % 32; conv_strip<true>(p.ffn_w_down, 1024, kb, 1, nb * 32, F.WD(), DFF, nb * 32, nul, nul, nullptr, 1.0f, scr, lane, 22, F8_DSCALE); continue; } r -= I_D;
        if (r < I_P) { const int g = r / 32, q = r % 32, kb = q / 8, nb = q % 8;
            conv_strip(p.pool_w + (size_t)g * 65536, 256, kb, 1, nb * 32, F.WP() + (size_t)g * 65536, 256, nb * 32, gs_pool + g * 256, MOD1 + g * 256, nullptr, 1.0f, scr, lane); continue; }
        { float ba = 0.f; const int e = lane & 7;
            for (int k0 = lane >> 3; k0 < 1024; k0 += 128) { float w[16], gn[16];
#pragma unroll
                for (int j = 0; j < 16; ++j) { const int k = k0 + 8 * j; w[j] = p.moe_router[k * 8 + e]; gn[j] = p.norm_gain[3 * 1024 + k]; }
#pragma unroll
                for (int j = 0; j < 16; ++j) { const int k = k0 + 8 * j; F.WR()[k * 8 + e] = w[j] * (gn[j] * (1.0f + MOD1[4 * 1024 + k])); ba = fmaf(MOD1[3 * 1024 + k], w[j], ba); } }
            ba += __shfl_xor(ba, 8); ba += __shfl_xor(ba, 16); ba += __shfl_xor(ba, 32);
            if (lane < 8) F.BIAS_R()[lane] = ba; }
    }
}
constexpr int PX_SG = 112 * 4, PX_EARLY = 1024;
__device__ __forceinline__ void px_tables(Frame& F) {
    const Params& p = F.p;
    LAS float* gsl = (LAS float*)(F.lds + 8 * 9216 + 1024);
    LAS float* shl = gsl + 1024;
    const float* MOD1 = F.MOD() + NIN;
    for (int k = F.tid; k < 1024; k += NTHR) { gsl[k] = p.norm_gain[3 * 1024 + k] * (1.0f + ldv_f(MOD1 + 4 * 1024 + k)); shl[k] = ldv_f(MOD1 + 3 * 1024 + k); }
    __syncthreads();
}
__device__ __forceinline__ void px_gu_item(Frame& F, int it, int lane) {
    const Params& p = F.p;
    LAS float* scr = (LAS float*)(F.lds + F.wave * 9216);
    LAS float* gsl = (LAS float*)(F.lds + 8 * 9216 + 1024); LAS float* shl = gsl + 1024;
    const int e = it / (2 * PX_SG); int r = it % (2 * PX_SG); const int up = r >= PX_SG; if (up) r -= PX_SG;
    const int part = r / 112, n0 = (r % 112) * 32, drow = e * 7168 + (n0 >> 7) * 256 + (up ? 128 : 0) + (n0 & 127);
    conv_strip<true>((up ? p.moe_w_up : p.moe_w_gate) + (size_t)e * 1024 * DFE, DFE, 4 * part, 4, n0, F.WMGU(), 1024, drow, gsl, shl,
                     F.BIAS_MGU() + (part >> 1) * 262144 + (part & 1) * 57344, 1.0f, scr, lane, 0, F8_WSCALE);
}
__device__ __forceinline__ void phase_px(Frame& F) {
    const Params& p = F.p; const int gw = F.c * NWAVE + F.wave, NGW = F.G * NWAVE, lane = F.lane;
    LAS float* scr = (LAS float*)(F.lds + F.wave * 9216);
    const LAS float* nul = nullptr;
    px_tables(F);
    constexpr int I_D = 14 * 32;
    for (int it = (F.G == 256 ? PX_EARLY : 0) + gw; it < NE * 2 * PX_SG; it += NGW) px_gu_item(F, it, lane);
    const int lane2 = lane_id();
    for (int it = gw; it < NE * I_D; it += NGW) {
        const int e = it / I_D, r = it % I_D, kg = r / 32, nb = r % 32;
        conv_strip<true>(p.moe_w_down + (size_t)e * DFE * 1024, 1024, 4 * kg, 4, nb * 32, (bf16_t*)((unsigned char*)F.WMD() + (size_t)e * 1024 * DFE), DFE, nb * 32, nul, nul, nullptr, 1.0f, scr, lane2, 28, F8_DSCALE);
    }
}

__device__ __forceinline__ void phase_scan(Frame& F) {
    const int gt = F.c * NTHR + F.tid, NGT = F.G * NTHR;
    for (int v = gt; v < 131072; v += NGT) {
        const int h = v >> 15; const float dec = F.GP()[h * GPS + RC]; float s0 = 0.f, s1 = 0.f, s2 = 0.f, s3 = 0.f;
        u32x2* ptr = (u32x2*)(F.SB() + (size_t)v * 4);
        for (int n0 = 0; n0 < NRC; n0 += 16) {
            u32x2 kv[16];
#pragma unroll
            for (int j = 0; j < 16; ++j) { kv[j] = (u32x2){0u, 0u}; if (n0 + j < NRC - 1) kv[j] = ptr[(size_t)(n0 + j) * 131072]; }
#pragma unroll
            for (int j = 0; j < 16; ++j) {
                u32x2 o; o.x = pk2(s0, s1); o.y = pk2(s2, s3); ptr[(size_t)(n0 + j) * 131072] = o;
                s0 = s0 * dec + bflo(kv[j].x); s1 = s1 * dec + bfhi(kv[j].x); s2 = s2 * dec + bflo(kv[j].y); s3 = s3 * dec + bfhi(kv[j].y); }
        }
    }
}

namespace ret {
constexpr int BUFB = 40960, OFF_B = 8192, OFF_P = 81920, OFF_RED = 114688, OFF_GP = 118784;
__device__ __forceinline__ int swz(int o) { return o ^ (((o >> 9) & 1) << 5); }
}
#define RET_WAITV(n) asm volatile("s_waitcnt vmcnt(" #n ")" ::: "memory")
#define RET_WAITL0() asm volatile("s_waitcnt lgkmcnt(0)" ::: "memory")
#define RET_BAR() do { asm volatile("" ::: "memory"); __builtin_amdgcn_s_barrier(); asm volatile("" ::: "memory"); } while (0)
__device__ __forceinline__ void phase_ret_fast(Frame& F) {
    using namespace ret;
    const Params& p = F.p; LAS unsigned char* lds = F.lds;
    const int tid = F.tid, lane = tid & 63, wid = F.wave, wr = wid >> 2, wc = wid & 3, fr = lane & 15, fq = lane >> 4;
    const int foff = swz(fr * 64 + fq * 16);
    const int srow = lane >> 2, scol = ((lane & 3) * 8) ^ (((lane >> 5) & 1) * 16);
    LAS float* gps = (LAS float*)(lds + OFF_GP); LAS f32x2* red = (LAS f32x2*)(lds + OFF_RED);
    __syncthreads();
    for (int i = tid; i < 4 * GPS; i += NTHR) gps[i] = F.GP()[i];
    __syncthreads();
    const __amdgpu_buffer_rsrc_t rs = __builtin_amdgcn_make_buffer_rsrc((void*)F.ws, (short)0, 0x7fffffff, 0x00020000);
    const unsigned qoff = (unsigned)((16 * wid + srow) * 1024 + scol) * 2u;
    unsigned soff[4], voff[4];
#pragma unroll
    for (int i = 0; i < 4; ++i) { soff[i] = (unsigned)((16 * (wid + 8 * i) + srow) * 256 + scol) * 2u; voff[i] = (unsigned)((16 * (wid + 8 * i) + srow) * T + scol) * 2u; }
#define RET_GLDS(uoff, loff, dst) __builtin_amdgcn_raw_ptr_buffer_load_lds(rs, (LAS unsigned*)(lds + (dst)), 16, (int)(loff), (int)(uoff), 0, 0)
#define RET_LOADS(kind, ks, b, hh, nn, nk) do { const unsigned _qk = (unsigned)((nn) * 128 * 1024 + (hh) * 256 + 32 * (ks)) * 2u, _kk = (unsigned)((nk) * 128 * 1024 + (hh) * 256 + 32 * (ks)) * 2u; \
        if ((kind) != 2) RET_GLDS((unsigned)WS_Q + _qk, qoff, (b) * BUFB + wid * 1024); \
        if ((kind) == 0) RET_GLDS((unsigned)WS_KN + _kk, qoff, (b) * BUFB + OFF_B + wid * 1024); \
        if ((kind) == 1) { const unsigned _sb = (unsigned)WS_SB + (unsigned)((((nn) >> 1) * 4 + (hh)) * 512 * 256 + 32 * (ks)) * 2u; _Pragma("unroll") for (int _i = 0; _i < 4; ++_i) \
            RET_GLDS(_sb, soff[_i], (b) * BUFB + OFF_B + (wid + 8 * _i) * 1024); } \
        if ((kind) == 2) { const unsigned _vb = (unsigned)WS_VT + (unsigned)((hh) * 512 * T + (nk) * 128 + 32 * (ks)) * 2u; _Pragma("unroll") for (int _i = 0; _i < 4; ++_i) \
            RET_GLDS(_vb, voff[_i], (b) * BUFB + OFF_B + (wid + 8 * _i) * 1024); } } while (0)
    int u = F.c;
    if (u >= 512) return;
#define RET_NOF(uu) ((((uu) >> 4) << 2) | ((((uu) >> 2) & 1) << 1) | ((((uu) >> 3) ^ ((uu) >> 8)) & 1))
    { const int h = u & 3, n = RET_NOF(u); RET_LOADS(0, 0, 0, h, n, n); }
    for (; u < 512; u += F.G) {
        const int h = u & 3, n = RET_NOF(u), t0 = n * 128; const int un = u + F.G; const bool has_next = un < 512; const int hn = un & 3, nn = RET_NOF(un);
        const bool half = (n & 1) != 0;
        f32x4 pacc[4][2];
#pragma unroll
        for (int m = 0; m < 4; ++m)
#pragma unroll
            for (int q = 0; q < 2; ++q) pacc[m][q] = (f32x4){0.f, 0.f, 0.f, 0.f};
#pragma unroll
        for (int ks = 0; ks < 8; ++ks) {
            const int b = ks & 1;
            if (ks < 7) { RET_LOADS(0, ks + 1, b ^ 1, h, n, n); RET_WAITV(2); } else { RET_LOADS(1, 0, b ^ 1, h, n, n); RET_WAITV(5); }
            RET_BAR();
            bf16x8 af[4], bf[2];
#pragma unroll
            for (int m = 0; m < 4; ++m) af[m] = *(const LAS bf16x8*)(lds + b * BUFB + (4 * wr + m) * 1024 + foff);
#pragma unroll
            for (int q = 0; q < 2; ++q) bf[q] = *(const LAS bf16x8*)(lds + b * BUFB + OFF_B + (2 * wc + q) * 1024 + foff);
            RET_WAITL0(); RET_BAR();
#pragma unroll
            for (int m = 0; m < 4; ++m)
#pragma unroll
                for (int q = 0; q < 2; ++q) pacc[m][q] = __builtin_amdgcn_mfma_f32_16x16x32_bf16(bf[q], af[m], pacc[m][q], 0, 0, 0);
            __builtin_amdgcn_sched_barrier(0);
        }
        { int l2 = lane; asm volatile("" : "+v"(l2)); const int fr = l2 & 15, fq = l2 >> 4;
#pragma unroll
        for (int m = 0; m < 4; ++m)
#pragma unroll
            for (int q = 0; q < 2; ++q) { const int r = 64 * wr + 16 * m + fr, cc = 32 * wc + 16 * q + 4 * fq; float v[4];
#pragma unroll
                for (int j = 0; j < 4; ++j) { const int dd = r - (cc + j); v[j] = dd >= 0 ? pacc[m][q][j] * gps[h * GPS + dd] : 0.f; }
                u32x2 w; w.x = pk2(v[0], v[1]); w.y = pk2(v[2], v[3]);
                *(LAS u32x2*)(lds + OFF_P + wc * 8192 + (4 * wr + m) * 1024 + swz(fr * 64 + 32 * q + 8 * fq)) = w; } }
        f32x4 acc[4][8];
#pragma unroll
        for (int m = 0; m < 4; ++m)
#pragma unroll
            for (int q = 0; q < 8; ++q) acc[m][q] = (f32x4){0.f, 0.f, 0.f, 0.f};
#pragma unroll
        for (int ks = 0; ks < 8; ++ks) {
            const int b = ks & 1;
            if (ks < 7) { RET_LOADS(1, ks + 1, b ^ 1, h, n, n); RET_WAITV(5); } else { RET_LOADS(2, 0, b ^ 1, h, n, n); RET_WAITV(4); }
            RET_BAR();
            bf16x8 af[4], bf[8];
#pragma unroll
            for (int m = 0; m < 4; ++m) af[m] = *(const LAS bf16x8*)(lds + b * BUFB + (4 * wr + m) * 1024 + foff);
#pragma unroll
            for (int q = 0; q < 8; ++q) bf[q] = *(const LAS bf16x8*)(lds + b * BUFB + OFF_B + (8 * wc + q) * 1024 + foff);
            RET_WAITL0(); RET_BAR();
#pragma unroll
            for (int m = 0; m < 4; ++m)
#pragma unroll
                for (int q = 0; q < 8; ++q) acc[m][q] = __builtin_amdgcn_mfma_f32_16x16x32_bf16(bf[q], af[m], acc[m][q], 0, 0, 0);
            __builtin_amdgcn_sched_barrier(0);
        }
        { int l3 = lane; asm volatile("" : "+v"(l3)); const int fr = l3 & 15;
#pragma unroll
        for (int m = 0; m < 4; ++m) { const float qd = gps[h * GPS + 64 * wr + 16 * m + fr + 1] * (half ? gps[h * GPS + 128] : 1.0f);
#pragma unroll
            for (int q = 0; q < 8; ++q) acc[m][q] = acc[m][q] * qd; } }
#pragma unroll
        for (int ks = 0; ks < 4; ++ks) {
            const int b = ks & 1;
            if (ks < 3) { RET_LOADS(2, ks + 1, b ^ 1, h, n, n); RET_WAITV(4); }
            else if (half) { RET_LOADS(0, 0, b ^ 1, h, n, n - 1); RET_WAITV(2); }
            else if (has_next) { RET_LOADS(0, 0, b ^ 1, hn, nn, nn); RET_WAITV(2); }
            else { RET_WAITV(0); }
            RET_BAR();
            bf16x8 af[4], bf[8];
#pragma unroll
            for (int m = 0; m < 4; ++m) af[m] = *(const LAS bf16x8*)(lds + OFF_P + ks * 8192 + (4 * wr + m) * 1024 + foff);
#pragma unroll
            for (int q = 0; q < 8; ++q) bf[q] = *(const LAS bf16x8*)(lds + b * BUFB + OFF_B + (8 * wc + q) * 1024 + foff);
            RET_WAITL0(); RET_BAR();
#pragma unroll
            for (int m = 0; m < 4; ++m)
#pragma unroll
                for (int q = 0; q < 8; ++q) acc[m][q] = __builtin_amdgcn_mfma_f32_16x16x32_bf16(bf[q], af[m], acc[m][q], 0, 0, 0);
            __builtin_amdgcn_sched_barrier(0);
        }
        if (half) {
#pragma unroll
            for (int m = 0; m < 4; ++m)
#pragma unroll
                for (int q = 0; q < 2; ++q) pacc[m][q] = (f32x4){0.f, 0.f, 0.f, 0.f};
#pragma unroll
            for (int ks = 0; ks < 8; ++ks) {
                const int b = ks & 1;
                if (ks < 7) { RET_LOADS(0, ks + 1, b ^ 1, h, n, n - 1); RET_WAITV(2); } else { RET_LOADS(2, 0, b ^ 1, h, n, n - 1); RET_WAITV(4); }
                RET_BAR();
                bf16x8 af[4], bf[2];
#pragma unroll
                for (int m = 0; m < 4; ++m) af[m] = *(const LAS bf16x8*)(lds + b * BUFB + (4 * wr + m) * 1024 + foff);
#pragma unroll
                for (int q = 0; q < 2; ++q) bf[q] = *(const LAS bf16x8*)(lds + b * BUFB + OFF_B + (2 * wc + q) * 1024 + foff);
                RET_WAITL0(); RET_BAR();
#pragma unroll
                for (int m = 0; m < 4; ++m)
#pragma unroll
                    for (int q = 0; q < 2; ++q) pacc[m][q] = __builtin_amdgcn_mfma_f32_16x16x32_bf16(bf[q], af[m], pacc[m][q], 0, 0, 0);
                __builtin_amdgcn_sched_barrier(0);
            }
            { int l6 = lane; asm volatile("" : "+v"(l6)); const int fr = l6 & 15, fq = l6 >> 4;
#pragma unroll
            for (int m = 0; m < 4; ++m)
#pragma unroll
                for (int q = 0; q < 2; ++q) { const int r = 64 * wr + 16 * m + fr, cc = 32 * wc + 16 * q + 4 * fq; float v[4];
#pragma unroll
                    for (int j = 0; j < 4; ++j) v[j] = pacc[m][q][j] * gps[h * GPS + 128 + r - (cc + j)];
                    u32x2 w; w.x = pk2(v[0], v[1]); w.y = pk2(v[2], v[3]);
                    *(LAS u32x2*)(lds + OFF_P + wc * 8192 + (4 * wr + m) * 1024 + swz(fr * 64 + 32 * q + 8 * fq)) = w; } }
            RET_WAITL0();
#pragma unroll
            for (int ks = 0; ks < 4; ++ks) {
                const int b = ks & 1;
                if (ks < 3) { RET_LOADS(2, ks + 1, b ^ 1, h, n, n - 1); RET_WAITV(4); }
                else if (has_next) { RET_LOADS(0, 0, b ^ 1, hn, nn, nn); RET_WAITV(2); }
                else { RET_WAITV(0); }
                RET_BAR();
                bf16x8 af[4], bf[8];
    #pragma unroll
                for (int m = 0; m < 4; ++m) af[m] = *(const LAS bf16x8*)(lds + OFF_P + ks * 8192 + (4 * wr + m) * 1024 + foff);
    #pragma unroll
                for (int q = 0; q < 8; ++q) bf[q] = *(const LAS bf16x8*)(lds + b * BUFB + OFF_B + (8 * wc + q) * 1024 + foff);
                RET_WAITL0(); RET_BAR();
    #pragma unroll
                for (int m = 0; m < 4; ++m)
    #pragma unroll
                    for (int q = 0; q < 8; ++q) acc[m][q] = __builtin_amdgcn_mfma_f32_16x16x32_bf16(bf[q], af[m], acc[m][q], 0, 0, 0);
                __builtin_amdgcn_sched_barrier(0);
            }
        }
        { int l4 = lane; asm volatile("" : "+v"(l4)); const int fr = l4 & 15, fq = l4 >> 4;
#pragma unroll
        for (int m = 0; m < 4; ++m) { float s1 = 0.f, s2 = 0.f;
#pragma unroll
            for (int q = 0; q < 8; ++q) { const f32x4 v = acc[m][q]; s1 += (v.x + v.y) + (v.z + v.w); s2 += (v.x * v.x + v.y * v.y) + (v.z * v.z + v.w * v.w); }
            s1 += __shfl_xor(s1, 16); s1 += __shfl_xor(s1, 32); s2 += __shfl_xor(s2, 16); s2 += __shfl_xor(s2, 32);
            if (fq == 0) red[(64 * wr + 16 * m + fr) * 4 + wc] = (f32x2){s1, s2}; }
        RET_WAITL0(); RET_BAR();
#pragma unroll
        for (int m = 0; m < 4; ++m) { const int r = 64 * wr + 16 * m + fr; const f32x2 a = red[r * 4 + 0], b2 = red[r * 4 + 1], c2 = red[r * 4 + 2], d2 = red[r * 4 + 3];
            const float mu = ((a.x + b2.x) + (c2.x + d2.x)) * (1.0f / 512.0f), ex2 = ((a.y + b2.y) + (c2.y + d2.y)) * (1.0f / 512.0f);
            const float rs = 1.0f / sqrtf(ex2 - mu * mu + EPS); const size_t rowoff = (size_t)(t0 + r) * 2048 + h * 512 + 128 * wc + 4 * fq;
#pragma unroll
            for (int q = 0; q < 8; ++q) { const u32x2 gw = *(const u32x2*)(F.Gb() + rowoff + 16 * q); const f32x4 gn = *(const f32x4*)(p.ret_gn_gain + h * 512 + 128 * wc + 16 * q + 4 * fq);
                const f32x4 v = acc[m][q]; u32x2 w;
                w.x = pk2((v.x - mu) * rs * gn.x * bflo(gw.x), (v.y - mu) * rs * gn.y * bfhi(gw.x)); w.y = pk2((v.z - mu) * rs * gn.z * bflo(gw.y), (v.w - mu) * rs * gn.w * bfhi(gw.y));
                *(u32x2*)(F.Y() + rowoff + 16 * q) = w; }
             } }
        RET_BAR();
    }
    RET_WAITV(0); RET_BAR();
#undef RET_GLDS
#undef RET_NOF
#undef RET_LOADS
}

namespace pf { constexpr int XTP = 132, OFF_RS = 42496, OFF_PT = 43008, OFF_WB = 59392, OFF_END = 124928; }
template <int W>
__device__ __forceinline__ void pf_pool(LAS unsigned char* lds, int t0, int tid) {
    using namespace pf; const LAS float* XT = (const LAS float*)lds; const LAS float* RS = (const LAS float*)(lds + OFF_RS);
    const int cp = tid & 63, tb = tid >> 6, r0 = 8 * tb, ch = 2 * cp; float s0 = 0.f, s1 = 0.f;
#pragma unroll
    for (int i = 1; i < W; ++i) { const int rr = 16 + r0 - i; const f32x2 xv = *(const LAS f32x2*)(XT + rr * XTP + ch); const float rs = RS[rr]; s0 += xv.x * rs; s1 += xv.y * rs; }
#pragma unroll
    for (int j = 0; j < 8; ++j) { const int r = r0 + j, rr = 16 + r; const f32x2 xv = *(const LAS f32x2*)(XT + rr * XTP + ch); const float rs = RS[rr]; const float a0 = xv.x * rs, a1 = xv.y * rs;
        s0 += a0; s1 += a1; const int t = t0 + r; const float ic = 1.0f / (float)((t + 1) < W ? (t + 1) : W);
        *(LAS unsigned*)(lds + OFF_PT + (ch >> 5) * 4096 + (r >> 4) * 1024 + ret::swz((r & 15) * 64 + (ch & 31) * 2)) = pk2(s0 * ic - a0, s1 * ic - a1);
        const int ro = rr - W + 1; const f32x2 xo = *(const LAS f32x2*)(XT + ro * XTP + ch); const float rso = RS[ro]; s0 -= xo.x * rso; s1 -= xo.y * rso; }
}
__device__ __forceinline__ void phase_pool_fused(Frame& F) {
    using namespace pf;
    const Params& p = F.p; LAS unsigned char* lds = F.lds; const int tid = F.tid, lane = F.lane, wid = F.wave;
    const bf16_t* X2 = F.XB(); const float* rss = F.ROWSS();     const float* g1 = F.MOD() + NIN + 2 * 1024; const float* WRg = F.WR();
    LAS float* XT = (LAS float*)lds; LAS float* RS = (LAS float*)(lds + OFF_RS);
    const int foff = ret::swz((lane & 15) * 64 + (lane >> 4) * 16);
    const int srow = lane >> 2, scol = ((lane & 3) * 8) ^ (((lane >> 5) & 1) * 16);
    const __amdgpu_buffer_rsrc_t rs_ws = __builtin_amdgcn_make_buffer_rsrc((void*)F.ws, (short)0, 0x7fffffff, 0x00020000);
    unsigned loff[2];
#pragma unroll
    for (int i = 0; i < 2; ++i) loff[i] = (unsigned)((16 * (wid + 8 * i) + srow) * 256 + scol) * 2u;
    for (int seg = F.c; seg < 256; seg += F.G) {
        const int t0 = seg * 64;
        float ss[4], lg[4][8];
#pragma unroll
        for (int m = 0; m < 4; ++m) { ss[m] = 0.f;
#pragma unroll
            for (int e = 0; e < 8; ++e) lg[m][e] = 0.f; }
        __syncthreads();
        if (tid < 80) { const int tt = t0 - 16 + tid; RS[tid] = tt >= 0 ? rstd_row(rss, tt) : 0.f; }
        f32x4 acc[4][2]; u32x2 xv[5];
#define PF_LOADX(gg, kk) do { int _tl = tid; asm volatile("" : "+v"(_tl)); _Pragma("unroll") for (int _i = 0; _i < 5; ++_i) { const int _idx = _tl + 512 * _i, _rr = _idx >> 5, _c4 = (_idx & 31) * 4; const int _tt = t0 - 16 + _rr; \
            xv[_i] = *(const u32x2*)(X2 + (size_t)(_tt < 0 ? 0 : _tt) * 1024 + 256 * (gg) + 128 * (kk) + _c4); } } while (0)
        PF_LOADX(0, 0);
#pragma unroll 1
        for (int it = 0; it < 8; ++it) {
            const int g = it >> 1, kh = it & 1;
            if (kh == 0) {
#pragma unroll
                for (int m = 0; m < 4; ++m) { acc[m][0] = (f32x4){0.f, 0.f, 0.f, 0.f}; acc[m][1] = (f32x4){0.f, 0.f, 0.f, 0.f}; } }
            {
                __syncthreads();
                int tl = tid; asm volatile("" : "+v"(tl));
#pragma unroll
                for (int i = 0; i < 5; ++i) { const int idx = tl + 512 * i, rr = idx >> 5, c4 = (idx & 31) * 4; *(LAS f32x4*)(XT + rr * XTP + c4) = (f32x4){bflo(xv[i].x), bfhi(xv[i].x), bflo(xv[i].y), bfhi(xv[i].y)}; }
#pragma unroll
                for (int kc = 0; kc < 4; ++kc)
#pragma unroll
                    for (int i = 0; i < 2; ++i)
                        __builtin_amdgcn_raw_ptr_buffer_load_lds(rs_ws, (LAS unsigned*)(lds + OFF_WB + kc * 16384 + (wid + 8 * i) * 1024), 16, (int)loff[i], (int)((unsigned)WS_WP + (unsigned)(g * 65536 + kh * 128 + 32 * kc) * 2u), 0, 0);
                { const int itn = it < 7 ? it + 1 : 7; PF_LOADX(itn >> 1, itn & 1); }
                __syncthreads();
                if (g == 0) pf_pool<2>(lds, t0, tl); else if (g == 1) pf_pool<4>(lds, t0, tl); else if (g == 2) pf_pool<8>(lds, t0, tl); else pf_pool<16>(lds, t0, tl);
                asm volatile("s_waitcnt vmcnt(5)" ::: "memory");
                __syncthreads();
#pragma unroll
                for (int kc = 0; kc < 4; ++kc) { bf16x8 af[4], bf[2];
#pragma unroll
                    for (int m = 0; m < 4; ++m) af[m] = *(const LAS bf16x8*)(lds + OFF_PT + kc * 4096 + m * 1024 + foff);
#pragma unroll
                    for (int n = 0; n < 2; ++n) bf[n] = *(const LAS bf16x8*)(lds + OFF_WB + kc * 16384 + (2 * wid + n) * 1024 + foff);
#pragma unroll
                    for (int m = 0; m < 4; ++m)
#pragma unroll
                        for (int n = 0; n < 2; ++n) acc[m][n] = __builtin_amdgcn_mfma_f32_16x16x32_bf16(bf[n], af[m], acc[m][n], 0, 0, 0); }
            }
            if (kh == 0) continue;
            { int l5 = lane; asm volatile("" : "+v"(l5)); const int fr = l5 & 15, fq = l5 >> 4;
              f32x4 x2a[2][4];
#pragma unroll
              for (int n = 0; n < 2; ++n)
#pragma unroll
                for (int m = 0; m < 4; ++m) { const u32x2 w2 = *(const u32x2*)(X2 + (size_t)(t0 + 16 * m + fr) * 1024 + 256 * g + 32 * wid + 16 * n + 4 * fq); x2a[n][m] = (f32x4){bflo(w2.x), bfhi(w2.x), bflo(w2.y), bfhi(w2.y)}; }
              f32x4 bva[2], sva[2], gva[2], wra[2][4], wrb[2][4];
#pragma unroll
              for (int n = 0; n < 2; ++n) { const int cg = 256 * g + 32 * wid + 16 * n + 4 * fq;
                bva[n] = *(const f32x4*)(p.pool_b + cg); sva[n] = *(const f32x4*)(p.pool_scale + cg); gva[n].x = ldv_f(g1 + cg); gva[n].y = ldv_f(g1 + cg + 1); gva[n].z = ldv_f(g1 + cg + 2); gva[n].w = ldv_f(g1 + cg + 3);
#pragma unroll
                for (int j = 0; j < 4; ++j) { wra[n][j] = *(const f32x4*)(WRg + (cg + j) * 8); wrb[n][j] = *(const f32x4*)(WRg + (cg + j) * 8 + 4); } }
#pragma unroll
              for (int n = 0; n < 2; ++n) { const int cg = 256 * g + 32 * wid + 16 * n + 4 * fq;
                const f32x4 bv = bva[n], sv = sva[n], gv = gva[n];
                f32x4 wr0[4], wr1[4];
#pragma unroll
                for (int j = 0; j < 4; ++j) { wr0[j] = wra[n][j]; wr1[j] = wrb[n][j]; }
#pragma unroll
                for (int m = 0; m < 4; ++m) { const size_t o = (size_t)(t0 + 16 * m + fr) * 1024 + cg;
                    const f32x4 xo = x2a[n][m] + gv * ((acc[m][n] + bv) * sv);
                    { u32x2 w3; w3.x = pk2(xo.x, xo.y); w3.y = pk2(xo.z, xo.w); *(u32x2*)(F.X3B() + o) = w3; }
                    *(unsigned*)((unsigned char*)F.Gb() + o) = pk4f8(xo.x, xo.y, xo.z, xo.w);
                    ss[m] += (xo.x * xo.x + xo.y * xo.y) + (xo.z * xo.z + xo.w * xo.w);
                    lg[m][0] += xo.x * wr0[0].x + xo.y * wr0[1].x + xo.z * wr0[2].x + xo.w * wr0[3].x; lg[m][1] += xo.x * wr0[0].y + xo.y * wr0[1].y + xo.z * wr0[2].y + xo.w * wr0[3].y;
                    lg[m][2] += xo.x * wr0[0].z + xo.y * wr0[1].z + xo.z * wr0[2].z + xo.w * wr0[3].z; lg[m][3] += xo.x * wr0[0].w + xo.y * wr0[1].w + xo.z * wr0[2].w + xo.w * wr0[3].w;
                    lg[m][4] += xo.x * wr1[0].x + xo.y * wr1[1].x + xo.z * wr1[2].x + xo.w * wr1[3].x; lg[m][5] += xo.x * wr1[0].y + xo.y * wr1[1].y + xo.z * wr1[2].y + xo.w * wr1[3].y;
                    lg[m][6] += xo.x * wr1[0].z + xo.y * wr1[1].z + xo.z * wr1[2].z + xo.w * wr1[3].z; lg[m][7] += xo.x * wr1[0].w + xo.y * wr1[1].w + xo.z * wr1[2].w + xo.w * wr1[3].w; } } }
        }
#undef PF_LOADX
#pragma unroll
        for (int m = 0; m < 4; ++m) { ss[m] += __shfl_xor(ss[m], 16); ss[m] += __shfl_xor(ss[m], 32);
#pragma unroll
            for (int e = 0; e < 8; ++e) { lg[m][e] += __shfl_xor(lg[m][e], 16); lg[m][e] += __shfl_xor(lg[m][e], 32); } }
        __syncthreads();
        { LAS float* red = (LAS float*)lds; int l6 = lane; asm volatile("" : "+v"(l6)); const int fr = l6 & 15;
          if ((l6 >> 4) == 0) {
#pragma unroll
            for (int m = 0; m < 4; ++m) { LAS float* q = red + ((16 * m + fr) * 8 + wid) * 12; q[0] = ss[m];
#pragma unroll
                for (int e = 0; e < 8; ++e) q[1 + e] = lg[m][e]; } }
          LAS int* cnt = (LAS int*)(lds + OFF_RS);
          if (tid < 8) cnt[tid] = 0;
          __syncthreads();
          if (tid < 64) { float sq = 0.f, a[8];
#pragma unroll
            for (int e = 0; e < 8; ++e) a[e] = 0.f;
#pragma unroll
            for (int w = 0; w < 8; ++w) { const LAS float* q = red + (tid * 8 + w) * 12; sq += q[0];
#pragma unroll
                for (int e = 0; e < 8; ++e) a[e] += q[1 + e]; }
            const int t = t0 + tid; const float rs = rstd_of(sq); float lgt[8]; F.RSTD3()[t] = rs;
#pragma unroll
            for (int e = 0; e < 8; ++e) lgt[e] = rs * a[e] + ldv_f(F.BIAS_R() + e);
            int e0 = 0; float l0 = lgt[0];
#pragma unroll
            for (int e = 1; e < 8; ++e) if (lgt[e] > l0) { l0 = lgt[e]; e0 = e; }
            int e1 = -1; float l1 = -3.0e38f;
#pragma unroll
            for (int e = 0; e < 8; ++e) if (e != e0 && lgt[e] > l1) { l1 = lgt[e]; e1 = e; }
            const float g0 = 1.0f / (1.0f + __expf(l1 - l0));
            F.TOPE()[t * 2] = e0; F.TOPE()[t * 2 + 1] = e1; F.TOPG()[t * 2] = g0; F.TOPG()[t * 2 + 1] = 1.0f - g0;
            atomicAdd((int*)(cnt + e0), 1); atomicAdd((int*)(cnt + e1), 1); }
          __syncthreads();
          if (tid < 8) F.CNT()[seg * 8 + tid] = cnt[tid]; }
    }
    __syncthreads();
}

__device__ __forceinline__ void phase_route2(Frame& F) {
    const int tid = F.tid;
    LAS int* cn = (LAS int*)F.lds;
    LAS int* part = cn + 2048;
    LAS int* tot = part + 512;
    LAS int* te = tot + 32;
    __syncthreads();
    for (int i = tid; i < 2048; i += NTHR) cn[i] = ldv_i(F.CNT() + i);
    __syncthreads();
    { const int e = tid & 7, pq = tid >> 3; part[pq * 8 + e] = cn[(4 * pq) * 8 + e] + cn[(4 * pq + 1) * 8 + e] + cn[(4 * pq + 2) * 8 + e] + cn[(4 * pq + 3) * 8 + e]; }
    __syncthreads();
    if (tid < 8) { int run = 0; for (int q = 0; q < 64; ++q) { const int v = part[q * 8 + tid]; part[q * 8 + tid] = run; run += v; } tot[tid] = run; }
    __syncthreads();
    { const int e = tid & 7, pq = tid >> 3; int run = part[pq * 8 + e];
#pragma unroll
        for (int j = 0; j < 4; ++j) { const int v = cn[(4 * pq + j) * 8 + e]; cn[(4 * pq + j) * 8 + e] = run; run += v; } }
    if (tid == 0) { int sp = 0; for (int e = 0; e < 8; ++e) { const int pd = (tot[e] + 255) / 256 * 256; tot[8 + e] = sp; tot[16 + e] = pd; sp += pd; } tot[24] = sp / 256; }
    __syncthreads();
    for (int seg = F.c; seg < 256; seg += F.G) {
        int e = -1; if (tid < 128) e = ldv_i(F.TOPE() + seg * 128 + tid);
        int rank = 0;
#pragma unroll
        for (int ee = 0; ee < 8; ++ee) { const unsigned long long m = __ballot(e == ee); if (e == ee) rank = __popcll(m & ((1ull << F.lane) - 1ull)); if (tid == 0) te[ee] = __popcll(m); }
        __syncthreads();
        if (tid < 128) { if (tid >= 64) rank += te[e];
            const int pos = tot[8 + e] + cn[seg * 8 + e] + rank, idx = seg * 128 + tid;
            const float gt = ldv_f(F.TOPG() + idx), rsd = ldv_f(F.RSTD3() + (idx >> 1));
            F.BUFTOK()[pos] = idx >> 1; F.BUFGATE()[pos] = gt; F.BUFRS()[pos] = rsd * (1.0f / F8_WSCALE); F.POS()[idx] = pos; }
        __syncthreads();
    }
    if (F.c < 8) { const int e = F.c; const int b0 = tot[8 + e] + tot[e], b1 = tot[8 + e] + tot[16 + e]; for (int r = b0 + tid; r < b1; r += NTHR) { F.BUFTOK()[r] = 0; F.BUFGATE()[r] = 0.f; F.BUFRS()[r] = 0.f; } }
    if (F.c == (8 % F.G)) { if (tid < NBLK) { int e = 0; for (int q = 0; q < 8; ++q) if (tid * 256 >= tot[8 + q] + tot[16 + q]) ++e; F.BLKE()[tid] = e < 7 ? e : 7; } if (tid == NBLK) F.BLKE()[NBLK] = tot[24]; }
}

__device__ __forceinline__ void phase_final(Frame& F) {
    const Params& p = F.p; const int gw = F.c * NWAVE + F.wave, NGW = F.G * NWAVE, lane = F.lane; const float* g2 = F.MOD() + NIN + 5 * 1024;
    const int nused = ldv_i(F.BLKE() + NBLK); const int ntail = (F.G == 256) ? (nused - 128) * 4 : 0; const int spu = ntail > 0 ? moe_tail_spu(ntail) : 1;
    f32x4 gv[4], fg[4];
#pragma unroll
    for (int j = 0; j < 4; ++j) { gv[j] = *((const f32x4*)g2 + lane + 64 * j); fg[j] = *((const f32x4*)p.final_norm_gain + lane + 64 * j); }
    for (int row = 2 * gw; row < T; row += 2 * NGW) {
        f32x4 xv[2][4]; f32x4 fa[2][4];
#pragma unroll
        for (int r = 0; r < 2; ++r) {
            const u32x2* xr = (const u32x2*)(F.X3B() + (size_t)(row + r) * D) + lane;
#pragma unroll
            for (int j = 0; j < 4; ++j) { const u32x2 w3 = xr[64 * j]; xv[r][j] = (f32x4){bflo(w3.x), bfhi(w3.x), bflo(w3.y), bfhi(w3.y)}; fa[r][j] = (f32x4){0.f, 0.f, 0.f, 0.f}; }
#pragma unroll
            for (int a = 0; a < 2; ++a) { const int pos = ldv_i(F.POS() + (row + r) * 2 + a); const int blk = pos >> 8;
                if (ntail > 0 && blk >= 128) {
#pragma unroll
                    for (int jp = 0; jp < 2; ++jp) {
                        const float* s0 = F.YBB() + (size_t)(((blk - 128) * 4 + 2 * jp) * spu) * 65536 + (size_t)(pos & 255) * 256 + 4 * lane; const float* s1 = s0 + (size_t)spu * 65536;
                        int q0 = 0;
                        for (; q0 + 7 <= spu; q0 += 7) { f32x4 t0[7], t1[7];
#pragma unroll
                            for (int q = 0; q < 7; ++q) { t0[q] = *(const f32x4*)(s0 + (size_t)(q0 + q) * 65536); t1[q] = *(const f32x4*)(s1 + (size_t)(q0 + q) * 65536); }
#pragma unroll
                            for (int q = 0; q < 7; ++q) { fa[r][2 * jp] = fa[r][2 * jp] + t0[q]; fa[r][2 * jp + 1] = fa[r][2 * jp + 1] + t1[q]; } }
                        for (; q0 < spu; ++q0) { fa[r][2 * jp] = fa[r][2 * jp] + *(const f32x4*)(s0 + (size_t)q0 * 65536); fa[r][2 * jp + 1] = fa[r][2 * jp + 1] + *(const f32x4*)(s1 + (size_t)q0 * 65536); } }
                } else { const u32x2* y = (const u32x2*)(F.YB() + (size_t)pos * D) + lane;
#pragma unroll
                    for (int j = 0; j < 4; ++j) { const u32x2 w = y[64 * j]; fa[r][j] = fa[r][j] + (f32x4){bflo(w.x), bfhi(w.x), bflo(w.y), bfhi(w.y)}; } } } }
#pragma unroll
        for (int r = 0; r < 2; ++r) { f32x4 v[4]; float s = 0.f;
#pragma unroll
            for (int j = 0; j < 4; ++j) { v[j] = xv[r][j] + gv[j] * fa[r][j]; s += (v[j].x * v[j].x + v[j].y * v[j].y) + (v[j].z * v[j].z + v[j].w * v[j].w); }
            s = wave_sum(s); const float rs = rstd_of(s);
            f32x4* o = (f32x4*)(p.out + (size_t)(row + r) * D) + lane;
#pragma unroll
            for (int j = 0; j < 4; ++j) o[64 * j] = v[j] * rs * fg[j]; }
    }
}

template <class Desc, class Epi> __device__ __forceinline__ void run_gemm(Frame& F, const Desc& Dc, const Epi& E) {
    gemm_fast(F.lds, F.ws, Dc, E, F.c, F.G, F.wave);
}

__device__ __forceinline__ void phase_g1(Frame& F) {
    { DescG1a<false> d{F.XB(), F.WIN(), nullptr, 1024, 1024, 16, 128, 128}; EpiG1a<false> e{F.ROWSS(), F.BIAS_IN(), F.TABA(), F.TABB(), F.Q(), F.KN(), F.Gb(), F.GP(), F.KDT()}; run_gemm(F, d, e); }
    { DescG1a<true> d{F.XB(), F.WIN(), nullptr, 1024, 1024, 16, 128, 128}; EpiG1a<true> e{F.ROWSS(), F.BIAS_IN(), F.TABA(), F.TABB(), F.Q(), F.KN(), F.Gb(), F.GP(), F.KDT()}; run_gemm(F, d, e); }
    { DescG1b d{F.XB(), F.WIN(), nullptr, 1024, 1024, 16, 128, 128}; EpiG1b e{F.ROWSS(), F.BIAS_IN(), F.TABA(), F.TABB(), F.GP(), F.KDT(), F.VT()}; run_gemm(F, d, e); }
}
__device__ __forceinline__ void phase_kv(Frame& F) { DescKV d{F.VT(), F.KDT(), nullptr, T, T, 4, 128, 128}; EpiKV e{F.SB()}; run_gemm(F, d, e); }
__device__ __forceinline__ void phase_outproj(Frame& F) {
    DescOut d{F.Y(), F.WOUT(), nullptr, 2048, 2048, 32, 128, 128}; EpiResid<false> e{F.p.x, nullptr, F.XB(), F.ROWSS(), F.MOD() + 2 * 1024, nullptr, nullptr, 1.0f}; run_gemm(F, d, e); }
__device__ __forceinline__ void phase_ffn_up(Frame& F) {
    DescFfnUp d{F.XB(), F.WGU(), nullptr, 1024, 1024, 16, 128, 128}; EpiSwiglu<true, true> e{F.ROWSS(), nullptr, F.BIAS_GU(), F.H1(), DFF, 5632, 2 * 5632}; run_gemm(F, d, e);
    if (F.G == 256 && F.c >= 128) {
        frame_fresh(F); px_tables(F); px_gu_item(F, (F.c - 128) * NWAVE + F.wave, F.lane); __syncthreads(); } }
__device__ __forceinline__ void phase_ffn_down(Frame& F) {
    DescFfnDown d{F.H1(), F.WD(), nullptr, 64, 64, 22, 32768, 32768};     EpiResid<true> e{nullptr, F.XB(), F.XB(), F.ROWSS(), F.MOD() + 5 * 1024, nullptr, nullptr, 1.0f / (F8_DSCALE * F8_HSCALE)}; run_gemm(F, d, e); }
__device__ __forceinline__ void phase_moe_up(Frame& F) {
    DescMoeUp d{F.Gb(), F.WMGU(), F.BUFTOK(), 512, 512, 8, 128, 128, F.BLKE()};     EpiSwiglu<true, true> e{F.ROWSS(), F.BUFRS(), F.BIAS_MGU(), F.H1M(), DFE, 57344, 262144}; run_gemm(F, d, e); }
__device__ __forceinline__ void phase_moe_down(Frame& F) {
    DescMoeDown d{F.H1M(), F.WMD(), nullptr, 64, 64, 28, 32768, 32768, F.BLKE(), F.G}; EpiMoeDown e{F.BUFGATE(), F.YB(), F.YBB()}; run_gemm(F, d, e); }

#define XB_TMO      128
#define XB_XCNT(j)  (256  + 64 * (j))
#define XB_XSUB(j)  (1280 + 64 * (j))
#define XB_XGEN(j)  (2304 + 64 * (j))
#define XB_TOP      3328
#define XB_TOPGEN   3392
#define XCD_BAR_WORDS 3456
#define XB_SPIN_CAP (1u << 18)
__device__ __forceinline__ unsigned xb_ld(unsigned* p)              { return __hip_atomic_load(p, __ATOMIC_RELAXED, __HIP_MEMORY_SCOPE_AGENT); }
__device__ __forceinline__ unsigned xb_add(unsigned* p, unsigned v) { return __hip_atomic_fetch_add(p, v, __ATOMIC_RELAXED, __HIP_MEMORY_SCOPE_AGENT); }
__device__ __forceinline__ unsigned xb_xcc_id() { return (unsigned)__builtin_amdgcn_s_getreg((3 << 11) | 20) & 0xFu; }
#define XB_SPIN(cond, bar) do { unsigned _sp = 0; while (cond) { __builtin_amdgcn_s_sleep(1); \
    if ((++_sp & 255u) == 0u) { if (xb_ld(&(bar)[XB_TMO])) break; if (_sp > XB_SPIN_CAP) { atomicAdd(&(bar)[XB_TMO], 1u); break; } } } } while (0)
struct XcdBarrier { unsigned* bar; unsigned x; volatile LAS unsigned* st; int wave; };
__device__ __forceinline__ XcdBarrier xcd_barrier_post(unsigned* bar, volatile LAS unsigned* st, int wave) {
    XcdBarrier b; b.bar = bar; b.x = xb_xcc_id(); b.st = st; b.wave = wave;
    if (wave == 0 && lane_id() == 0) (void)xb_add(&bar[XB_XCNT(b.x)], 1u);
    return b;
}
__device__ __forceinline__ void xcd_barrier_complete(unsigned* bar, unsigned x, unsigned& nloc, unsigned& nx) {
    const unsigned G = gridDim.x * gridDim.y * gridDim.z;
    unsigned sum, cnt, mine, sp = 0u;
    for (;;) {
        sum = 0u; cnt = 0u; mine = 0u;
#pragma unroll
        for (unsigned j = 0; j < 16; ++j) { const unsigned c = xb_ld(&bar[XB_XCNT(j)]); sum += c; cnt += (c > 0u) ? 1u : 0u; mine = (j == x) ? c : mine; }
        if (sum == G) break;
        __builtin_amdgcn_s_sleep(1);
        if ((++sp & 255u) == 0u) { if (xb_ld(&bar[XB_TMO])) break; if (sp > XB_SPIN_CAP) { atomicAdd(&bar[XB_TMO], 1u); break; } }
    }
    nloc = mine > 0u ? mine : 1u; nx = cnt > 0u ? cnt : 1u;
}
__device__ __forceinline__ void xcd_barrier(const XcdBarrier& b) {
    asm volatile("s_waitcnt vmcnt(0)" ::: "memory");
    __syncthreads();
    if (b.wave == 0 && lane_id() == 0) {
        unsigned* bar = b.bar;
        __builtin_amdgcn_s_waitcnt(0);
        unsigned nloc = b.st[0], nx = b.st[1];
        if (nloc == 0u) { xcd_barrier_complete(bar, b.x, nloc, nx); b.st[0] = nloc; b.st[1] = nx; }
        const unsigned old = xb_add(&bar[XB_XSUB(b.x)], 1u);
        const unsigned gen = old / nloc;
        if (old + 1u == (gen + 1u) * nloc) {
            __builtin_amdgcn_fence(__ATOMIC_RELEASE, "agent");
            asm volatile("s_waitcnt vmcnt(0)" ::: "memory");
            const unsigned og = xb_add(&bar[XB_TOP], 1u);
            const unsigned tg = og / nx;
            if (og + 1u == (tg + 1u) * nx) xb_add(&bar[XB_TOPGEN], 1u);
            else XB_SPIN(xb_ld(&bar[XB_TOPGEN]) == tg, bar);
            __builtin_amdgcn_fence(__ATOMIC_ACQUIRE, "agent");
            xb_add(&bar[XB_XGEN(b.x)], 1u);
            asm volatile("s_waitcnt vmcnt(0)" ::: "memory");
        } else {
            XB_SPIN(xb_ld(&bar[XB_XGEN(b.x)]) == gen, bar);
            __builtin_amdgcn_fence(__ATOMIC_ACQUIRE, "agent");
            asm volatile("s_waitcnt vmcnt(0)" ::: "memory");
        }
    }
    __syncthreads();
}

constexpr int LDSCTL_OFF = 131072;
__global__ void __launch_bounds__(NTHR, 2) k_mega(Params p) {
    extern __shared__ __attribute__((aligned(16))) unsigned char lds_raw[];
    Frame F; frame_init(F, p, (LAS unsigned char*)lds_raw, (int)blockIdx.x, (int)gridDim.x);
    for (int u = F.tid; u < (LDS_BYTES - LDSCTL_OFF) / 4; u += NTHR) ((LAS unsigned*)(F.lds + LDSCTL_OFF))[u] = 0u;
    __syncthreads();
    const XcdBarrier bar = xcd_barrier_post((unsigned*)(p.ws + CT_BAR), (volatile LAS unsigned*)(F.lds + LDSCTL_OFF + 32), F.wave);
#define GRID_BAR() xcd_barrier(bar)

    frame_fresh(F); phase_p0(F); GRID_BAR();
    frame_fresh(F); phase_p1(F); GRID_BAR();
    frame_fresh(F); phase_g1(F); GRID_BAR();
    frame_fresh(F); phase_kv(F); GRID_BAR();
    frame_fresh(F); phase_scan(F); GRID_BAR();
    frame_fresh(F); phase_ret_fast(F); GRID_BAR();
    frame_fresh(F); phase_outproj(F); GRID_BAR();
    frame_fresh(F); phase_ffn_up(F); GRID_BAR();
    frame_fresh(F); phase_ffn_down(F); GRID_BAR();
    if ((F.c >> 3) & 1) { frame_fresh(F); phase_px(F); __syncthreads(); frame_fresh(F); phase_pool_fused(F); } else { frame_fresh(F); phase_pool_fused(F); frame_fresh(F); phase_px(F); }
    GRID_BAR();
    frame_fresh(F); phase_route2(F); GRID_BAR();
    frame_fresh(F); phase_moe_up(F); GRID_BAR();
    frame_fresh(F); phase_moe_down(F); GRID_BAR();
    frame_fresh(F); phase_final(F);
#undef GRID_BAR
}

extern "C" void kernel_launch(void* const* d_in, const int* in_sizes, int n_in, void* d_out, int out_size, void* d_ws, size_t ws_size, hipStream_t stream) {
    static int grid = 0;
    if (grid == 0) {
        if (n_in != 19 || out_size != T * D || ws_size < WS_END) { fprintf(stderr, "kernel_launch: unexpected shapes (n_in %d out %d ws %zu)\n", n_in, out_size, ws_size); grid = -1; return; }
        int dev = 0, cus = 0, per_cu = 0;
        if (hipGetDevice(&dev) != hipSuccess || hipDeviceGetAttribute(&cus, hipDeviceAttributeMultiprocessorCount, dev) != hipSuccess) { grid = -1; return; }
        if (hipFuncSetAttribute((const void*)k_mega, hipFuncAttributeMaxDynamicSharedMemorySize, LDS_BYTES) != hipSuccess) { fprintf(stderr, "kernel_launch: hipFuncSetAttribute failed\n"); grid = -1; return; }
        if (hipOccupancyMaxActiveBlocksPerMultiprocessor(&per_cu, (const void*)k_mega, NTHR, LDS_BYTES) != hipSuccess || per_cu < 1) { fprintf(stderr, "kernel_launch: occupancy query says %d blocks per CU\n", per_cu); (void)hipGetLastError(); grid = -1; return; }
        grid = cus * (per_cu < 1 ? 1 : 1);
    }
    if (grid < 0) return;
    Params p{};
    const float** pp = (const float**)&p;
    for (int i = 0; i < 19; ++i) pp[i] = (const float*)d_in[i];
    p.out = (float*)d_out; p.ws = (unsigned char*)d_ws;
    (void)hipMemsetAsync((char*)d_ws + WS_CTL, 0, 64 * KiB, stream);
    void* args[] = {&p};
    hipError_t e = hipLaunchCooperativeKernel((const void*)k_mega, dim3(grid), dim3(NTHR), args, LDS_BYTES, stream);
    if (e != hipSuccess) fprintf(stderr, "kernel_launch: cooperative launch failed: %s (grid %d)\n", hipGetErrorString(e), grid);
}
```

```cpp
#include <hip/hip_runtime.h>
#include <cstdio>

#define GAS __attribute__((address_space(1)))
#define LAS __attribute__((address_space(3)))
typedef unsigned short bf16_t;
typedef short bf16x8 __attribute__((ext_vector_type(8)));
typedef float f32x4 __attribute__((ext_vector_type(4)));
typedef float f32x2 __attribute__((ext_vector_type(2)));
typedef unsigned u32x4 __attribute__((ext_vector_type(4)));
typedef int i32x4 __attribute__((ext_vector_type(4)));
typedef unsigned u32x2 __attribute__((ext_vector_type(2)));

#ifndef FAST_GEMM
#define FAST_GEMM 1
#endif

constexpr int T = 16384, D = 1024, NH = 4, DK = 256, DV = 512, CH = 128, NCH = 128;
constexpr int NIN = 6144, DFF = 2816, NE = 8, DFE = 3584, CAP = 34816, NBLK = 136;
constexpr float EPS = 1e-6f;
constexpr int GPS = 260, RC = 256, NRC = 64;
constexpr int NTHR = 512, NWAVE = 8;

constexpr size_t KiB = 1024, MiB = 1u << 20;
constexpr size_t WS_CTL = 0, CTL_BYTES = 1 * MiB;
constexpr size_t CT_BAR = 16 * KiB;
constexpr size_t CT_MOD = 64 * KiB;
constexpr size_t CT_BIAS_R = 158 * KiB;
constexpr size_t WS_ROWSSP = 2 * MiB;
constexpr size_t WS_MODP = 3 * MiB;
constexpr size_t CT_BIAS_IN = 3584 * KiB;
constexpr size_t CT_BIAS_GU = 3584 * KiB + 96 * KiB;
constexpr size_t CT_BIAS_MGU = 36 * MiB + 512 * KiB;
constexpr size_t WS_TABA = 1 * MiB;
constexpr size_t WS_TABB = WS_TABA + 128 * KiB;
constexpr size_t WS_GP = WS_TABB + 128 * KiB;
constexpr size_t WS_WR = WS_GP + 8 * KiB;
constexpr size_t WS_TOPE = WS_WR + 32 * KiB;
constexpr size_t WS_TOPG = WS_TOPE + 128 * KiB;
constexpr size_t WS_CNT = WS_TOPG + 128 * KiB;
constexpr size_t WS_BUFTOK = WS_CNT + 8 * KiB;
constexpr size_t WS_BUFGATE = WS_BUFTOK + 136 * KiB;
constexpr size_t WS_POS = WS_BUFGATE + 136 * KiB;
constexpr size_t WS_BLKE = WS_POS + 128 * KiB;
constexpr size_t WS_RSTD3 = 256 * KiB;
constexpr size_t WS_BUFRS = 320 * KiB;
constexpr size_t WS_WIN = 4 * MiB;
constexpr size_t WS_WOUT = 16 * MiB;
constexpr size_t WS_WGU = 20 * MiB;
constexpr size_t WS_WD = 31 * MiB;
constexpr size_t WS_WP = 37 * MiB;
constexpr size_t WS_XB = 38 * MiB;
constexpr size_t WS_Q = 70 * MiB;
constexpr size_t WS_KN = 102 * MiB;
constexpr size_t WS_KDT = 134 * MiB;
constexpr size_t WS_VT = 166 * MiB;
constexpr size_t WS_G = 230 * MiB;
constexpr size_t WS_SB = 294 * MiB;
constexpr size_t WS_Y = 422 * MiB;
constexpr size_t WS_H1 = 70 * MiB;
constexpr size_t WS_PB = 158 * MiB;
constexpr size_t WS_X2 = 158 * MiB;
constexpr size_t WS_H1M = 70 * MiB;
constexpr size_t WS_WMGU = 308 * MiB;
constexpr size_t WS_WMD = 456 * MiB;
constexpr size_t WS_YB = 308 * MiB;
constexpr size_t WS_YBB = 4 * MiB;
constexpr size_t WS_END = 512 * MiB;
static_assert(WS_BUFRS + 136 * KiB <= WS_TABA && WS_BLKE + 4 * KiB <= WS_ROWSSP && WS_MODP + 8 * 12288 * 4 <= CT_BIAS_IN && CT_BIAS_GU + 4 * 5632 * 4 <= WS_WIN, "small region");
static_assert(WS_YBB + (size_t)224 * 65536 * 4 <= WS_H1M && WS_H1M + (size_t)CAP * DFE * 2 <= WS_WMGU && WS_YB + (size_t)CAP * D * 4 <= WS_WMD && WS_WMD + (size_t)NE * D * DFE * 2 <= WS_END, "moe map");
static_assert(WS_Y + (size_t)T * 2048 * 2 <= WS_END && WS_SB + (size_t)128 * 4 * 512 * 256 * 2 <= WS_Y, "ret map");

constexpr int LDS_BYTES = 147456;

struct Params {
    const float *x, *c, *ada_w, *ada_b, *norm_gain, *ret_w_in, *ret_gn_gain, *ret_w_out, *ffn_w_gate, *ffn_w_up, *ffn_w_down,
        *pool_w, *pool_b, *pool_scale, *moe_router, *moe_w_gate, *moe_w_up, *moe_w_down, *final_norm_gain;
    float* out; unsigned char* ws;
};

__device__ __forceinline__ unsigned f2bf(float f) { unsigned u = __builtin_bit_cast(unsigned, f); return (u + 0x7fffu + ((u >> 16) & 1u)) >> 16; }
typedef __bf16 bf16x2_t __attribute__((ext_vector_type(2)));
__device__ __forceinline__ unsigned pk2(float lo, float hi) { const f32x2 v = {lo, hi}; return __builtin_bit_cast(unsigned, __builtin_convertvector(v, bf16x2_t)); }
constexpr float F8_WSCALE = 32.0f, F8_DSCALE = 64.0f, F8_HSCALE = 4.0f;
__device__ __forceinline__ unsigned pk4f8(float a, float b, float c, float d) { int w = __builtin_amdgcn_cvt_pk_fp8_f32(a, b, 0, false); w = __builtin_amdgcn_cvt_pk_fp8_f32(c, d, w, true); return (unsigned)w; }
__device__ __forceinline__ float bf2f(unsigned b) { return __builtin_bit_cast(float, b << 16); }
__device__ __forceinline__ float bflo(unsigned w) { return __builtin_bit_cast(float, w << 16); }
__device__ __forceinline__ float bfhi(unsigned w) { return __builtin_bit_cast(float, w & 0xffff0000u); }
__device__ __forceinline__ float silu_f(float v) { return v * __builtin_amdgcn_rcpf(1.0f + __expf(-v)); }
__device__ __forceinline__ float rstd_of(float ss) { return __builtin_amdgcn_rsqf(ss * (1.0f / 1024.0f) + EPS); }
__device__ __forceinline__ float rstd_row(const float* rssp, int t) {
    const f32x4* q = (const f32x4*)(rssp + (size_t)t * 16); const f32x4 a = q[0], b = q[1], c = q[2], d = q[3];
    const float s = (((a.x + a.y) + (a.z + a.w)) + ((b.x + b.y) + (b.z + b.w))) + (((c.x + c.y) + (c.z + c.w)) + ((d.x + d.y) + (d.z + d.w)));
    return __builtin_amdgcn_rsqf(s * (1.0f / 1024.0f) + EPS);
}
__device__ __forceinline__ float wave_sum(float v) {
#pragma unroll
    for (int o = 1; o < 64; o <<= 1) v += __shfl_xor(v, o);
    return v;
}
__device__ __forceinline__ float ldv_f(const float* p) { return __builtin_bit_cast(float, __hip_atomic_load((const unsigned*)p, __ATOMIC_RELAXED, __HIP_MEMORY_SCOPE_AGENT)); }
__device__ __forceinline__ int ldv_i(const int* p) { return __hip_atomic_load(p, __ATOMIC_RELAXED, __HIP_MEMORY_SCOPE_AGENT); }
__device__ __forceinline__ float bias_sum(const float* b, int idx, int s1, int s2) { return (ldv_f(b + idx) + ldv_f(b + s1 + idx)) + (ldv_f(b + s2 + idx) + ldv_f(b + s2 + s1 + idx)); }
__device__ __forceinline__ void rstd_row_ld(const float* rssp, int t, float (&r)[16]) { const f32x4* q = (const f32x4*)(rssp + (size_t)t * 16);
#pragma unroll
    for (int i = 0; i < 4; ++i) { const f32x4 v = q[i]; r[4 * i] = v.x; r[4 * i + 1] = v.y; r[4 * i + 2] = v.z; r[4 * i + 3] = v.w; } }
__device__ __forceinline__ float rstd_row_fin(const float (&r)[16]) {
    const float s = (((r[0] + r[1]) + (r[2] + r[3])) + ((r[4] + r[5]) + (r[6] + r[7]))) + (((r[8] + r[9]) + (r[10] + r[11])) + ((r[12] + r[13]) + (r[14] + r[15])));
    return __builtin_amdgcn_rsqf(s * (1.0f / 1024.0f) + EPS); }
__device__ __forceinline__ void bias_sum_ld(const float* b, int idx, int s1, int s2, float (&r)[16]) { r[0] = ldv_f(b + idx); r[1] = ldv_f(b + s1 + idx); r[2] = ldv_f(b + s2 + idx); r[3] = ldv_f(b + s2 + s1 + idx); }
__device__ __forceinline__ float bias_sum_fin(const float (&r)[16]) { return (r[0] + r[1]) + (r[2] + r[3]); }

__device__ __forceinline__ int lane_id() { int l; asm volatile("v_mbcnt_lo_u32_b32 %0, -1, 0\n\tv_mbcnt_hi_u32_b32 %0, -1, %0" : "=v"(l)); return l; }

struct Unit { const bf16_t* A; const bf16_t* B; int pm, pn, aux, rowbase, nt; };

__device__ __forceinline__ void tile_order(int L, int nM, int nN, int& pm, int& pn) {
    const int nwg = nM * nN; int wgid = L;
    { const int q = nwg / 8, r = nwg % 8, xcd = wgid % 8, off = wgid / 8; wgid = (xcd < r ? xcd * (q + 1) : r * (q + 1) + (xcd - r) * q) + off; }
    const int nig = 8 * nN, gid = wgid / nig, fm = gid * 8, gsz = (nM - fm) < 8 ? (nM - fm) : 8;
    pm = fm + ((wgid % nig) % gsz); pn = (wgid % nig) / gsz;
}

template <bool GATE> struct DescG1a {
    static constexpr bool GATHER = false; static constexpr bool FP8 = false;
    const bf16_t* xb; const bf16_t* win; const int* tok; int lda, ldb, nt, ksa, ksb;
    __device__ __forceinline__ bool get(int L, Unit& u) const {
        if (L >= 64 * 8) return false; tile_order(L, 64, 8, u.pm, u.pn); if (GATE) u.pn += 8;
        const int wrow = u.pn < 8 ? u.pn * 256 : (u.pn + 8) * 256;
        u.A = xb + (size_t)u.pm * 256 * 1024; u.B = win + (size_t)wrow * 1024; u.aux = wrow; u.rowbase = u.pm * 256; u.nt = nt; return true; }
};
struct DescG1b {
    static constexpr bool GATHER = false; static constexpr bool FP8 = false;
    const bf16_t* xb; const bf16_t* win; const int* tok; int lda, ldb, nt, ksa, ksb;
    __device__ __forceinline__ bool get(int L, Unit& u) const {
        if (L >= 8 * 64) return false; tile_order(L, 8, 64, u.pm, u.pn); u.pm += 4;
        u.A = win + (size_t)(1024 + 256 * u.pm) * 1024; u.B = xb + (size_t)u.pn * 256 * 1024; u.aux = 0; u.rowbase = 0; u.nt = nt; return true; }
};
struct DescKV {
    static constexpr bool GATHER = false; static constexpr bool FP8 = false;
    const bf16_t* vt; const bf16_t* kdt; const int* tok; int lda, ldb, nt, ksa, ksb;
    __device__ __forceinline__ bool get(int L, Unit& u) const {
        if (L >= (NRC - 1) * 8) return false; const int mt = L & 1, h = (L >> 1) & 3, n = L >> 3;
        u.A = vt + (size_t)(h * 512 + 256 * mt) * T + n * RC; u.B = kdt + (size_t)(h * 256) * T + n * RC;
        u.pm = mt; u.pn = 0; u.aux = (n * 4 + h) * 2 + mt; u.rowbase = 0; u.nt = nt; return true; }
};
struct DescOut {
    static constexpr bool GATHER = false; static constexpr bool FP8 = false;
    const bf16_t* y; const bf16_t* w; const int* tok; int lda, ldb, nt, ksa, ksb;
    __device__ __forceinline__ bool get(int L, Unit& u) const {
        if (L >= 256) return false; tile_order(L, 64, 4, u.pm, u.pn);
        u.A = y + (size_t)u.pm * 256 * 2048; u.B = w + (size_t)u.pn * 256 * 2048; u.aux = 0; u.rowbase = u.pm * 256; u.nt = nt; return true; }
};
struct DescFfnUp {
    static constexpr bool GATHER = false; static constexpr bool FP8 = false;
    const bf16_t* xb; const bf16_t* w; const int* tok; int lda, ldb, nt, ksa, ksb;
    __device__ __forceinline__ bool get(int L, Unit& u) const {
        if (L >= 64 * 22) return false; tile_order(L, 64, 22, u.pm, u.pn);
        u.A = xb + (size_t)u.pm * 256 * 1024; u.B = w + (size_t)u.pn * 256 * 1024; u.aux = 256 * u.pn; u.rowbase = u.pm * 256; u.nt = nt; return true; }
};
struct DescFfnDown {
    static constexpr bool GATHER = false; static constexpr bool FP8 = true;
    const bf16_t* h1; const bf16_t* w; const int* tok; int lda, ldb, nt, ksa, ksb;
    __device__ __forceinline__ bool get(int L, Unit& u) const {
        if (L >= 256) return false; tile_order(L, 64, 4, u.pm, u.pn);
        u.A = h1 + (size_t)u.pm * 128 * DFF; u.B = w + (size_t)u.pn * 128 * DFF; u.aux = 0; u.rowbase = u.pm * 256; u.nt = nt; return true; }
};
struct DescMoeUp {
    static constexpr bool GATHER = true; static constexpr bool FP8 = true;
    const bf16_t* xb; const bf16_t* w; const int* tok; int lda, ldb, nt, ksa, ksb; const int* blke;
    __device__ __forceinline__ bool get(int L, Unit& u) const {
        const int nused = ldv_i(blke + NBLK); if (L >= nused * 28) return false; tile_order(L, nused, 28, u.pm, u.pn);
        const int e = ldv_i(blke + u.pm);
        u.A = xb; u.B = w + (size_t)(e * 7168 + 256 * u.pn) * 512; u.aux = e * 7168 + 256 * u.pn; u.rowbase = u.pm * 256; u.nt = nt; return true; }
};
__device__ __forceinline__ int moe_tail_spu(int ntail) { const int q = 256 / ntail; return q >= 7 ? 7 : 2; }
struct DescMoeDown {
    static constexpr bool GATHER = false; static constexpr bool FP8 = true;
    const bf16_t* h1; const bf16_t* w; const int* tok; int lda, ldb, nt, ksa, ksb; const int* blke; int G;
    __device__ __forceinline__ bool get(int L, Unit& u) const {
        const int nused = ldv_i(blke + NBLK); int k0 = 0, npair = 14; u.aux = 0;
        if (G != 256) { if (L >= nused * 4) return false; tile_order(L, nused, 4, u.pm, u.pn); }
        else { const int i = L >> 8, c = L & 255;
            if (i < 2) { const int x = c & 7, j = c >> 3; u.pm = (i * 8 + x) * 8 + (j & 7); u.pn = j >> 3; }
            else { const int ntail = (nused - 128) * 4; if (i > 2 || ntail <= 0) return false; const int spu = moe_tail_spu(ntail); if (c >= ntail * spu) return false;
                const int ut = c / spu, sl = c - ut * spu; u.pm = 128 + (ut >> 2); u.pn = ut & 3; npair = 14 / spu; k0 = sl * npair; u.aux = 1 + c; } }
        const int e = ldv_i(blke + u.pm);
        u.A = h1 + (size_t)u.pm * 128 * DFE + (size_t)k0 * 2 * 16384; u.B = w + (size_t)(e * 4 + u.pn) * 128 * DFE + (size_t)k0 * 2 * 16384;
        u.rowbase = u.pm * 256; u.nt = 2 * npair; return true; }
};

typedef f32x4 Acc[2][2][4][2];

__device__ __forceinline__ void store8bf(bf16_t* p, const float* v) {
    u32x4 w; w.x = pk2(v[0], v[1]); w.y = pk2(v[2], v[3]); w.z = pk2(v[4], v[5]); w.w = pk2(v[6], v[7]); *(u32x4*)p = w; }

template <bool GATE> struct EpiG1a {
    static constexpr bool PERM = true;
    const float* rowss; const float* bias; const f32x2* taba; const f32x2* tabb; bf16_t* Q; bf16_t* KN; bf16_t* Gb; const float* gp; bf16_t* KDT;
    __device__ __forceinline__ void pre_load(const Unit& u, int tid, float (&r)[16]) const { if (tid < 256) r[0] = ldv_f(rowss + (size_t)(u.pm * 256 + tid) * 16); else bias_sum_ld(bias, u.aux + tid - 256, NIN, 2 * NIN, r); }
    __device__ __forceinline__ void pre_store(const Unit&, LAS float* aux, int tid, const float (&r)[16]) const { aux[tid] = tid < 256 ? rstd_of(r[0]) : bias_sum_fin(r); }
    __device__ __forceinline__ void init(LAS float* auxb, int tid) const {
        if (!GATE && tid < 256) { const float v = ((const float*)tabb)[16 * 256 + tid]; auxb[512 + tid] = v; auxb[768 + 512 + tid] = v; } }
    __device__ __forceinline__ void operator()(const Acc& acc, const Unit& u, int wr, int wc, int fr, int fq, const LAS float* aux) const {
        asm volatile("" : "+v"(fr), "+v"(fq));
        const int pn = u.pn, d0 = wc * 32 + 8 * fq;
        float b[2][8];
#pragma unroll
        for (int bj = 0; bj < 2; ++bj) { const f32x4 x = *(const LAS f32x4*)(aux + 256 + 128 * bj + d0), y = *(const LAS f32x4*)(aux + 256 + 128 * bj + d0 + 4);
            b[bj][0] = x.x; b[bj][1] = x.y; b[bj][2] = x.z; b[bj][3] = x.w; b[bj][4] = y.x; b[bj][5] = y.y; b[bj][6] = y.z; b[bj][7] = y.w; }
        if constexpr (!GATE) {
            bf16_t* O = pn < 4 ? Q : KN; const int hcol = (pn & 3) * 256;
            f32x2 ta[8], tn[8], tb[8]; float dec[4];
            { const f32x2* tp0 = taba + (2 * u.pm) * 128 + d0; const f32x2* tpb = tabb + (64 * wr + fr) * 128 + d0;
#pragma unroll
              for (int q = 0; q < 8; ++q) { ta[q] = tp0[q]; tb[q] = tpb[q]; }
#pragma unroll
              for (int m = 0; m < 4; ++m) dec[m] = pn >= 4 ? gp[(pn - 4) * GPS + 127 - (64 * wr + 16 * m + fr)] : 0.f; }
            const float c128 = pn >= 4 ? gp[(pn - 4) * GPS + 128] : 0.f;
#pragma unroll
            for (int it = 0; it < 8; ++it) {
                const int ai = it >> 2, m = ai ? 3 - (it & 3) : (it & 3);
                if (it == 2) { const f32x2* tp1 = taba + (2 * u.pm + 1) * 128 + d0;
#pragma unroll
                    for (int q = 0; q < 8; ++q) tn[q] = tp1[q]; }
                if (it == 4) {
#pragma unroll
                    for (int q = 0; q < 8; ++q) ta[q] = tn[q]; }
                if ((it & 3) != 0) {
                    const float sg = ai ? -1.0f : 1.0f; int dl = 2 * d0; asm volatile("" : "+v"(dl));
#pragma unroll
                    for (int q2 = 0; q2 < 4; ++q2) { const f32x4 R2 = *(const LAS f32x4*)(aux + 512 + dl + 4 * q2);
                        { const f32x2 B = tb[2 * q2]; const float ry = sg * R2.y; tb[2 * q2].x = B.x * R2.x - B.y * ry; tb[2 * q2].y = B.y * R2.x + B.x * ry; }
                        { const f32x2 B = tb[2 * q2 + 1]; const float rw = sg * R2.w; tb[2 * q2 + 1].x = B.x * R2.z - B.y * rw; tb[2 * q2 + 1].y = B.y * R2.z + B.x * rw; } } }
                const int rl = 128 * ai + 64 * wr + 16 * m + fr, t = u.pm * 256 + rl; const float rs = aux[rl];
                float o1[8], o2[8];
#pragma unroll
                for (int q = 0; q < 8; ++q) {
                    const f32x2 A = ta[q], B = tb[q]; const float cs = A.x * B.x - A.y * B.y, sn = A.y * B.x + A.x * B.y;
                    const float v1 = rs * acc[ai][0][m][q >> 2][q & 3] + b[0][q], v2 = rs * acc[ai][1][m][q >> 2][q & 3] + b[1][q];
                    o1[q] = v1 * cs - v2 * sn; o2[q] = v1 * sn + v2 * cs; }
                store8bf(O + (size_t)t * 1024 + hcol + d0, o1); store8bf(O + (size_t)t * 1024 + hcol + 128 + d0, o2);
                if (pn >= 4) {
                    bf16_t* kd = KDT + (size_t)(hcol + d0) * T + t;
                    const float dk = ai ? dec[m] : dec[m] * c128;
#pragma unroll
                    for (int q = 0; q < 8; ++q) { kd[(size_t)q * T] = (bf16_t)(pk2(o1[q] * dk, 0.f) & 0xffffu); kd[(size_t)(128 + q) * T] = (bf16_t)(pk2(o2[q] * dk, 0.f) & 0xffffu); } }
            }
        } else {
#pragma unroll
            for (int ai = 0; ai < 2; ++ai)
#pragma unroll
                for (int m = 0; m < 4; ++m) {
                    const int rl = 128 * ai + 64 * wr + 16 * m + fr, t = u.pm * 256 + rl; const float rs = aux[rl];
#pragma unroll
                    for (int bj = 0; bj < 2; ++bj) { float o[8];
#pragma unroll
                        for (int q = 0; q < 8; ++q) o[q] = silu_f(rs * acc[ai][bj][m][q >> 2][q & 3] + b[bj][q]);
                        store8bf(Gb + (size_t)t * 2048 + (pn - 8) * 256 + 128 * bj + d0, o); }
                }
        }
    }
};
struct EpiG1b {
    static constexpr bool PERM = true;
    const float* rowss; const float* bias; const f32x2* taba; const f32x2* tabb; const float* gp; bf16_t* KDT; bf16_t* VT;
    __device__ __forceinline__ void pre_load(const Unit& u, int tid, float (&r)[16]) const { if (tid < 256) bias_sum_ld(bias, 1024 + 256 * u.pm + tid, NIN, 2 * NIN, r); else r[0] = ldv_f(rowss + (size_t)(u.pn * 256 + tid - 256) * 16); }
    __device__ __forceinline__ void pre_store(const Unit&, LAS float* aux, int tid, const float (&r)[16]) const { aux[tid] = tid < 256 ? bias_sum_fin(r) : rstd_of(r[0]); }
    __device__ __forceinline__ void init(LAS float*, int) const {}
    __device__ __forceinline__ void operator()(const Acc& acc, const Unit& u, int wr, int wc, int fr, int fq, const LAS float* aux) const {
        asm volatile("" : "+v"(fr), "+v"(fq));
        const int pmf = u.pm, tl0 = 32 * wc + 8 * fq, tk0 = u.pn * 256 + tl0;
        float rs[2][8];
#pragma unroll
        for (int bj = 0; bj < 2; ++bj) { const f32x4 x = *(const LAS f32x4*)(aux + 256 + 128 * bj + tl0), y = *(const LAS f32x4*)(aux + 256 + 128 * bj + tl0 + 4);
            rs[bj][0] = x.x; rs[bj][1] = x.y; rs[bj][2] = x.z; rs[bj][3] = x.w; rs[bj][4] = y.x; rs[bj][5] = y.y; rs[bj][6] = y.z; rs[bj][7] = y.w; }
        if (pmf < 4) {
            const int h = pmf;
#pragma unroll
            for (int m = 0; m < 4; ++m) {
                const int d = 64 * wr + 16 * m + fr; const float b1 = aux[d], b2 = aux[128 + d];
#pragma unroll
                for (int bj = 0; bj < 2; ++bj) { float o1[8], o2[8]; const f32x2 A = taba[(2 * u.pn + bj) * 128 + d]; const float4 dq0 = *(const float4*)(gp + h * GPS + 120 - tl0), dq1 = *(const float4*)(gp + h * GPS + 124 - tl0);
                    const float decs[8] = {dq1.w, dq1.z, dq1.y, dq1.x, dq0.w, dq0.z, dq0.y, dq0.x};
#pragma unroll
                    for (int q = 0; q < 8; ++q) { const f32x2 B = tabb[(tl0 + q) * 128 + d]; const float cs = A.x * B.x - A.y * B.y, sn = A.y * B.x + A.x * B.y;
                        const float v1 = rs[bj][q] * acc[0][bj][m][q >> 2][q & 3] + b1, v2 = rs[bj][q] * acc[1][bj][m][q >> 2][q & 3] + b2;
                        o1[q] = (v1 * cs - v2 * sn) * decs[q]; o2[q] = (v1 * sn + v2 * cs) * decs[q]; }
                    store8bf(KDT + (size_t)(256 * h + d) * T + tk0 + 128 * bj, o1); store8bf(KDT + (size_t)(256 * h + 128 + d) * T + tk0 + 128 * bj, o2); }
            }
        } else {
#pragma unroll
            for (int ai = 0; ai < 2; ++ai)
#pragma unroll
                for (int m = 0; m < 4; ++m) {
                    const int rl = 128 * ai + 64 * wr + 16 * m + fr, f = 256 * (pmf - 4) + rl; const float bs = aux[rl];
#pragma unroll
                    for (int bj = 0; bj < 2; ++bj) { float o[8];
#pragma unroll
                        for (int q = 0; q < 8; ++q) o[q] = rs[bj][q] * acc[ai][bj][m][q >> 2][q & 3] + bs;
                        store8bf(VT + (size_t)f * T + tk0 + 128 * bj, o); }
                }
        }
    }
};
struct EpiKV {
    static constexpr bool PERM = true;
    bf16_t* SB;
    __device__ __forceinline__ void pre_load(const Unit&, int, float (&)[16]) const {}
    __device__ __forceinline__ void pre_store(const Unit&, LAS float*, int, const float (&)[16]) const {}
    __device__ __forceinline__ void init(LAS float*, int) const {}
    __device__ __forceinline__ void operator()(const Acc& acc, const Unit& u, int wr, int wc, int fr, int fq, const LAS float*) const {
        asm volatile("" : "+v"(fr), "+v"(fq));
        const int mt = u.aux & 1, nh = u.aux >> 1; bf16_t* base = SB + ((size_t)nh * 512 + 256 * mt) * 256; const int d0 = wc * 32 + 8 * fq;
#pragma unroll
        for (int ai = 0; ai < 2; ++ai)
#pragma unroll
            for (int m = 0; m < 4; ++m) { const int r = 128 * ai + 64 * wr + 16 * m + fr;
#pragma unroll
                for (int bj = 0; bj < 2; ++bj) { float o[8];
#pragma unroll
                    for (int q = 0; q < 8; ++q) o[q] = acc[ai][bj][m][q >> 2][q & 3];
                    store8bf(base + (size_t)r * 256 + 128 * bj + d0, o); } }
    }
};
template <bool BASEB> struct EpiResid {
    static constexpr bool PERM = false;
    const float* base; const bf16_t* baseb; bf16_t* xb; float* rowss; const float* g; const float* cb; const float* cs; float accscale;
    __device__ __forceinline__ void pre_load(const Unit& u, int tid, float (&r)[16]) const {
        if (tid < 256) { const int c = 256 * u.pn + tid; r[0] = ldv_f(g + c); r[1] = cs ? cs[c] : 1.0f; } else { const int c = 256 * u.pn + tid - 256; r[0] = cb ? cb[c] : 0.f; r[1] = 1.0f; } }
    __device__ __forceinline__ void pre_store(const Unit&, LAS float* aux, int tid, const float (&r)[16]) const { aux[256 + tid] = r[0] * r[1] * (tid < 256 ? accscale : 1.0f); }
    __device__ __forceinline__ void init(LAS float*, int) const {}
    __device__ __forceinline__ void operator()(const Acc& acc, const Unit& u, int wr, int wc, int fr, int fq, const LAS float* aux) const {
        asm volatile("" : "+v"(fr), "+v"(fq));
        const int cl0 = 32 * wc + 4 * fq, col0 = 256 * u.pn + cl0;
        f32x4 gv[2][2], cbv[2][2];
#pragma unroll
        for (int bj = 0; bj < 2; ++bj)
#pragma unroll
            for (int n = 0; n < 2; ++n) { gv[bj][n] = *(const LAS f32x4*)(aux + 256 + cl0 + 128 * bj + 16 * n); cbv[bj][n] = *(const LAS f32x4*)(aux + 512 + cl0 + 128 * bj + 16 * n); }
        f32x4 bsv[2][4];
        const size_t o0 = (size_t)(u.pm * 256 + 64 * wr + fr) * 1024 + col0;
#define ER_LOADB(dst, off) do { if constexpr (BASEB) { const u32x2 _w = *(const u32x2*)(baseb + (off)); dst = (f32x4){bflo(_w.x), bfhi(_w.x), bflo(_w.y), bfhi(_w.y)}; } else dst = *(const f32x4*)(base + (off)); } while (0)
#pragma unroll
        for (int j = 0; j < 4; ++j) ER_LOADB(bsv[0][j], o0 + 128 * (j >> 1) + 16 * (j & 1));
#pragma unroll
        for (int it = 0; it < 8; ++it) { const int ai = it >> 2, m = it & 3; const int t = u.pm * 256 + 128 * ai + 64 * wr + 16 * m + fr; float s = 0.f;
            if (it < 7) { const int ai2 = (it + 1) >> 2, m2 = (it + 1) & 3; const size_t o2 = o0 + (size_t)(128 * ai2 + 16 * m2) * 1024;
#pragma unroll
                for (int j = 0; j < 4; ++j) ER_LOADB(bsv[(it + 1) & 1][j], o2 + 128 * (j >> 1) + 16 * (j & 1)); }
#pragma unroll
            for (int bj = 0; bj < 2; ++bj)
#pragma unroll
                for (int n = 0; n < 2; ++n) { const size_t o = (size_t)t * 1024 + col0 + 128 * bj + 16 * n;
                    const f32x4 xo = bsv[it & 1][2 * bj + n] + (acc[ai][bj][m][n] + cbv[bj][n]) * gv[bj][n];
                    s += (xo.x * xo.x + xo.y * xo.y) + (xo.z * xo.z + xo.w * xo.w);
                    { u32x2 w; w.x = pk2(xo.x, xo.y); w.y = pk2(xo.z, xo.w); *(u32x2*)(xb + o) = w; } }
            s += __shfl_xor(s, 16); s += __shfl_xor(s, 32);
            if (fq == 0) rowss[(size_t)t * 16 + u.pn * 4 + wc] = s; }
    }
#undef ER_LOADB
};
template <bool TILED, bool F8OUT = false> struct EpiSwiglu {
    static constexpr bool PERM = true;
    const float* rowss; const float* rowrs; const float* bias; bf16_t* Hout; int ldh, bs1, bs2;
    __device__ __forceinline__ void pre_load(const Unit& u, int tid, float (&r)[16]) const {
        if (tid < 256) { if (rowrs) r[0] = ldv_f(rowrs + u.rowbase + tid); else rstd_row_ld(rowss, u.rowbase + tid, r); } else bias_sum_ld(bias, u.aux + tid - 256, bs1, bs2, r); }
    __device__ __forceinline__ void pre_store(const Unit&, LAS float* aux, int tid, const float (&r)[16]) const { aux[tid] = tid < 256 ? (rowrs ? r[0] : rstd_row_fin(r)) : bias_sum_fin(r); }
    __device__ __forceinline__ void init(LAS float*, int) const {}
    __device__ __forceinline__ void operator()(const Acc& acc, const Unit& u, int wr, int wc, int fr, int fq, const LAS float* aux) const {
        asm volatile("" : "+v"(fr), "+v"(fq));
        const int d0 = wc * 32 + 8 * fq; float bg[8], bu[8];
        { const f32x4 x = *(const LAS f32x4*)(aux + 256 + d0), y = *(const LAS f32x4*)(aux + 256 + d0 + 4), z = *(const LAS f32x4*)(aux + 384 + d0), w = *(const LAS f32x4*)(aux + 384 + d0 + 4);
          bg[0] = x.x; bg[1] = x.y; bg[2] = x.z; bg[3] = x.w; bg[4] = y.x; bg[5] = y.y; bg[6] = y.z; bg[7] = y.w; bu[0] = z.x; bu[1] = z.y; bu[2] = z.z; bu[3] = z.w; bu[4] = w.x; bu[5] = w.y; bu[6] = w.z; bu[7] = w.w; }
        constexpr float KG = -1.4426950408889634f, KU = -0.6931471805599453f * (F8OUT ? F8_HSCALE : 1.0f);
#pragma unroll
        for (int q = 0; q < 8; ++q) { bg[q] *= KG; bu[q] *= KU; }
#pragma unroll
        for (int ai = 0; ai < 2; ++ai)
#pragma unroll
            for (int m = 0; m < 4; ++m) { const int rl = 128 * ai + 64 * wr + 16 * m + fr, row = u.rowbase + rl; const float rs = aux[rl], rsg = rs * KG, rsu = rs * KU; float o[8];
#pragma unroll
                for (int q = 0; q < 8; ++q) {
                    const float x = rsg * acc[ai][0][m][q >> 2][q & 3] + bg[q], y = rsu * acc[ai][1][m][q >> 2][q & 3] + bu[q];
                    o[q] = (x * __builtin_amdgcn_rcpf(1.0f + __builtin_amdgcn_exp2f(x))) * y; }
                if constexpr (F8OUT) {
#pragma unroll
                    for (int q = 0; q < 8; ++q) o[q] = __builtin_amdgcn_fmed3f(o[q], -448.0f, 448.0f);
                    u32x2 w8; w8.x = pk4f8(o[0], o[1], o[2], o[3]); w8.y = pk4f8(o[4], o[5], o[6], o[7]);
                    if (TILED) *(u32x2*)((unsigned char*)Hout + (((size_t)(row >> 8) * (ldh >> 7) + u.pn) * 256 + (row & 255)) * 128 + d0) = w8;
                    else *(u32x2*)((unsigned char*)Hout + (size_t)row * ldh + 128 * u.pn + d0) = w8; }
                else if (TILED) store8bf(Hout + (((size_t)(row >> 8) * (ldh >> 6) + 2 * u.pn + (d0 >> 6)) * 256 + (row & 255)) * 64 + (d0 & 63), o);
                else store8bf(Hout + (size_t)row * ldh + 128 * u.pn + d0, o); }
    }
};
struct EpiMoeDown {
    static constexpr bool PERM = true;
    const float* gate; bf16_t* YB; float* YBB;
    __device__ __forceinline__ void pre_load(const Unit& u, int tid, float (&r)[16]) const { if (tid < 256) r[0] = ldv_f(gate + u.rowbase + tid); }
    __device__ __forceinline__ void pre_store(const Unit&, LAS float* aux, int tid, const float (&r)[16]) const { if (tid < 256) aux[tid] = r[0] * (1.0f / (F8_DSCALE * F8_HSCALE)); }
    __device__ __forceinline__ void init(LAS float*, int) const {}
    __device__ __forceinline__ void operator()(const Acc& acc, const Unit& u, int wr, int wc, int fr, int fq, const LAS float* aux) const {
        asm volatile("" : "+v"(fr), "+v"(fq));
        const int col0 = 256 * u.pn + 32 * wc + 8 * fq;
#pragma unroll
        for (int ai = 0; ai < 2; ++ai)
#pragma unroll
            for (int m = 0; m < 4; ++m) { const int rl = 128 * ai + 64 * wr + 16 * m + fr, row = u.rowbase + rl; const float gt = aux[rl];
#pragma unroll
                for (int bj = 0; bj < 2; ++bj) {
                    if (u.aux == 0) { float o[8];
#pragma unroll
                        for (int q = 0; q < 8; ++q) o[q] = acc[ai][bj][m][q >> 2][q & 3] * gt;
                        store8bf(YB + (size_t)row * 1024 + col0 + 128 * bj, o); }
                    else { float* d = YBB + (size_t)(u.aux - 1) * 65536 + (size_t)rl * 256 + 32 * wc + 8 * fq + 128 * bj;
                        *(f32x4*)d = acc[ai][bj][m][0] * gt; *(f32x4*)(d + 4) = acc[ai][bj][m][1] * gt; } } }
    }
};

namespace pg8 {
constexpr int BM = 256, BK = 64, HALF = 128, HTB = HALF * BK * 2, STAGE_BYTES = 8 * HTB;
__device__ __forceinline__ int lds_byte(int r, int c) { const int st = (r >> 4) * 2 + (c >> 5), rr = r & 15, cc = c & 31, ob = rr * 64 + cc * 2; return st * 1024 + (ob ^ (((ob >> 9) & 1) << 5)); }
__device__ __forceinline__ void stage_rc(int b, int& R, int& C) { const int st = b / 1024, sb = b % 1024, swz = sb ^ (((sb >> 9) & 1) << 5); R = (st >> 1) * 16 + swz / 64; C = (st & 1) * 32 + (swz % 64) / 2; }
__device__ __forceinline__ int perm32(int rho) { const int n = rho >> 4, i = rho & 15; return 8 * (i >> 2) + 4 * n + (i & 3); }
}
typedef int i32x8 __attribute__((ext_vector_type(8)));
__device__ __forceinline__ void mfma_f8_inplace(f32x4& acc, const i32x8 a, const i32x8 b, int sc) {
    asm volatile("v_mfma_scale_f32_16x16x128_f8f6f4 %0, %1, %2, %0, %3, %3 op_sel_hi:[0,0,0]" : "+v"(acc) : "v"(a), "v"(b), "v"(sc)); }
template <class Desc, class Epi>
__device__ __forceinline__ void gemm_fast(LAS unsigned char* lds, const unsigned char* wsb, const Desc& Dc, const Epi& E, int c, int G, int wave_id) {
    using namespace pg8;
    constexpr bool GATHER = Desc::GATHER; constexpr bool FP8 = Desc::FP8;
    int lane_ = lane_id(); asm volatile("" : "+v"(lane_));
    const int wid = wave_id, lane = lane_, tid = wid * 64 + lane, wr = wid >> 2, wc = wid & 3, fr = lane & 15, fq = lane >> 4;
    unsigned vA[2][2], vAn[2][2], vB[2][2];
#pragma unroll
    for (int i = 0; i < 2; ++i) { int R, C; stage_rc(tid * 16 + i * 8192, R, C); const int Rb = Epi::PERM ? ((R & ~31) + perm32(R & 31)) : R;
#pragma unroll
        for (int h = 0; h < 2; ++h) { vA[h][i] = (unsigned)((h * HALF + R) * Dc.lda + C) * 2u; vB[h][i] = (unsigned)((h * HALF + Rb) * Dc.ldb + C) * 2u; vAn[h][i] = vA[h][i]; } }
    const unsigned ksA = (unsigned)Dc.ksa, ksB = (unsigned)Dc.ksb;
    const __amdgpu_buffer_rsrc_t rs = __builtin_amdgcn_make_buffer_rsrc((void*)wsb, (short)0, 0x7fffffff, 0x00020000);
    const unsigned ldsw = (unsigned)wid * 1024u;
    const int aoff = lds_byte(wr * 64 + fr, fq * 8), boff = lds_byte(wc * 32 + fr, fq * 8);
#define PG8_SA(b, h) (((b) * 2 + (h)) * HTB)
#define PG8_SB(b, h) ((4 + (b) * 2 + (h)) * HTB)
#define PG8_STAGE(bufoff, gbase, voff) do { _Pragma("unroll") for (int _i = 0; _i < 2; ++_i) \
        __builtin_amdgcn_raw_ptr_buffer_load_lds(rs, (LAS unsigned*)(lds + (bufoff) + ldsw + _i * 8192), 16, (int)(voff)[_i], (int)(gbase), 0, 0); } while (0)
#define PG8_LDA(dst, b, h) do { _Pragma("unroll") for (int m = 0; m < 4; ++m) _Pragma("unroll") for (int k = 0; k < 2; ++k) dst[m][k] = *(const LAS bf16x8*)(lds + PG8_SA(b, h) + aoff + m * 2048 + k * 1024); } while (0)
#define PG8_LDB(dst, b, h) do { _Pragma("unroll") for (int n = 0; n < 2; ++n) _Pragma("unroll") for (int k = 0; k < 2; ++k) dst[n][k] = *(const LAS bf16x8*)(lds + PG8_SB(b, h) + boff + n * 2048 + k * 1024); } while (0)
#define PG8_CAT(x) __builtin_shufflevector(__builtin_bit_cast(i32x4, x[0]), __builtin_bit_cast(i32x4, x[1]), 0, 1, 2, 3, 4, 5, 6, 7)
#define PG8_MMA(ai, bj, At, Bt) do { __builtin_amdgcn_s_setprio(1); if constexpr (FP8) { _Pragma("unroll") for (int m = 0; m < 4; ++m) _Pragma("unroll") for (int n = 0; n < 2; ++n) \
        mfma_f8_inplace(acc[ai][bj][m][n], PG8_CAT(Bt[n]), PG8_CAT(At[m]), f8sc); } else { \
        _Pragma("unroll") for (int m = 0; m < 4; ++m) _Pragma("unroll") for (int n = 0; n < 2; ++n) _Pragma("unroll") for (int k = 0; k < 2; ++k) \
        acc[ai][bj][m][n] = __builtin_amdgcn_mfma_f32_16x16x32_bf16(Bt[n][k], At[m][k], acc[ai][bj][m][n], 0, 0, 0); } __builtin_amdgcn_s_setprio(0); } while (0)
#define PG8_WAIT_V(n) asm volatile("s_waitcnt vmcnt(" #n ")" ::: "memory")
#define PG8_WAIT_L(n) asm volatile("s_waitcnt lgkmcnt(" #n ")" ::: "memory")
#define PG8_BAR __builtin_amdgcn_s_barrier()
#define PG8_SCHED __builtin_amdgcn_sched_barrier(0)
#define PG8_GATHER_OFFS(dst, un) do { const int _t = wid * 64 + lane_id(); _Pragma("unroll") for (int _i = 0; _i < 2; ++_i) { int _R, _C; stage_rc(_t * 16 + _i * 8192, _R, _C); \
        _Pragma("unroll") for (int _h = 0; _h < 2; ++_h) dst[_h][_i] = (unsigned)(ldv_i(Dc.tok + (un).rowbase + _h * HALF + _R) * Dc.lda + _C) * 2u; } } while (0)
    int f8sc = 0x7f7f7f7f; asm volatile("" : "+v"(f8sc));
    Unit cur, nxt; int ui = 0;
    if (!Dc.get(c, cur)) return;
    LAS float* const auxb = (LAS float*)(lds + 131072 + 1024);
    E.init(auxb, tid);
    { float r0[16]; E.pre_load(cur, tid, r0); E.pre_store(cur, auxb, tid, r0); }
    Acc acc;
#pragma unroll
    for (int a = 0; a < 2; ++a)
#pragma unroll
        for (int b = 0; b < 2; ++b)
#pragma unroll
            for (int m = 0; m < 4; ++m)
#pragma unroll
                for (int n = 0; n < 2; ++n) acc[a][b][m][n] = (f32x4){0.f, 0.f, 0.f, 0.f};
    bf16x8 At[4][2], B0[2][2], B1[2][2];
    unsigned cA = (unsigned)((const unsigned char*)cur.A - wsb), cB = (unsigned)((const unsigned char*)cur.B - wsb);
    if constexpr (GATHER) { PG8_GATHER_OFFS(vA, cur); }
    PG8_STAGE(PG8_SB(0, 0), cB, vB[0]); PG8_STAGE(PG8_SB(0, 1), cB, vB[1]); PG8_STAGE(PG8_SA(0, 0), cA, vA[0]); PG8_STAGE(PG8_SA(0, 1), cA, vA[1]);
    if (wr == 1) PG8_BAR;
    PG8_WAIT_V(2); PG8_BAR;
    PG8_STAGE(PG8_SB(1, 0), cB + ksB, vB[0]); PG8_STAGE(PG8_SA(1, 0), cA + ksA, vA[0]); PG8_STAGE(PG8_SB(1, 1), cB + ksB, vB[1]);
    PG8_WAIT_V(6); PG8_BAR;
    for (;;) {
        const bool has_next = Dc.get((ui + 1) * G + c, nxt);
        const unsigned nA = has_next ? (unsigned)((const unsigned char*)nxt.A - wsb) : cA, nB = has_next ? (unsigned)((const unsigned char*)nxt.B - wsb) : cB;
        if constexpr (GATHER) { if (has_next) { PG8_GATHER_OFFS(vAn, nxt); } else {
#pragma unroll
            for (int h = 0; h < 2; ++h)
#pragma unroll
                for (int i = 0; i < 2; ++i) vAn[h][i] = vA[h][i]; } }
        const int nt = cur.nt;
        for (int t = 0; t < nt; t += 2) {
            const bool last = (t == nt - 2);
            const unsigned a1 = cA + (unsigned)(t + 1) * ksA;
            const unsigned a2 = last ? nA : cA + (unsigned)(t + 2) * ksA, b2 = last ? nB : cB + (unsigned)(t + 2) * ksB;
            const unsigned a3 = a2 + ksA, b3 = b2 + ksB;
            unsigned x0[2], x1[2];
#pragma unroll
            for (int i = 0; i < 2; ++i) { x0[i] = (GATHER && last) ? vAn[0][i] : vA[0][i]; x1[i] = (GATHER && last) ? vAn[1][i] : vA[1][i]; }
            PG8_LDB(B0, 0, 0); PG8_LDB(B1, 0, 1); PG8_SCHED; PG8_LDA(At, 0, 0); PG8_STAGE(PG8_SA(1, 1), a1, vA[1]);
            PG8_WAIT_V(8); PG8_WAIT_L(0); PG8_BAR; PG8_MMA(0, 0, At, B0); PG8_MMA(0, 1, At, B1); PG8_BAR; PG8_SCHED;
            PG8_LDA(At, 0, 1); PG8_STAGE(PG8_SB(0, 0), b2, vB[0]); PG8_STAGE(PG8_SB(0, 1), b2, vB[1]); PG8_STAGE(PG8_SA(0, 0), a2, x0);
            PG8_WAIT_V(8); PG8_WAIT_L(0); PG8_BAR; PG8_MMA(1, 0, At, B0); PG8_MMA(1, 1, At, B1); PG8_BAR; PG8_SCHED;
            PG8_LDB(B0, 1, 0); PG8_LDB(B1, 1, 1); PG8_SCHED; PG8_LDA(At, 1, 0); PG8_STAGE(PG8_SA(0, 1), a2, x1);
            PG8_WAIT_V(8); PG8_WAIT_L(0); PG8_BAR; PG8_MMA(0, 0, At, B0); PG8_MMA(0, 1, At, B1); PG8_BAR; PG8_SCHED;
            PG8_LDA(At, 1, 1); PG8_STAGE(PG8_SB(1, 0), b3, vB[0]); PG8_STAGE(PG8_SB(1, 1), b3, vB[1]); PG8_STAGE(PG8_SA(1, 0), a3, x0);
            PG8_WAIT_V(8); PG8_WAIT_L(0); PG8_BAR; PG8_MMA(1, 0, At, B0); PG8_MMA(1, 1, At, B1); PG8_BAR; PG8_SCHED;
        }
        if constexpr (FP8) asm volatile("s_nop 15\n\ts_nop 15\n\ts_nop 15\n\ts_nop 15\n\ts_nop 15" ::: "memory");
        if (wr == 0) PG8_BAR;
        { const int l2 = lane_id(); float rn[16];
          if (has_next) E.pre_load(nxt, wid * 64 + l2, rn);
          E(acc, cur, wr, wc, l2 & 15, l2 >> 4, auxb + (ui & 1) * 768);
          if (has_next) E.pre_store(nxt, auxb + ((ui + 1) & 1) * 768, wid * 64 + l2, rn); }
        if (!has_next) break;
#pragma unroll
        for (int a = 0; a < 2; ++a)
#pragma unroll
            for (int b = 0; b < 2; ++b)
#pragma unroll
                for (int m = 0; m < 4; ++m)
#pragma unroll
                    for (int n = 0; n < 2; ++n) acc[a][b][m][n] = (f32x4){0.f, 0.f, 0.f, 0.f};
        cur = nxt; cA = nA; cB = nB; ++ui;
        if constexpr (GATHER) {
#pragma unroll
            for (int h = 0; h < 2; ++h)
#pragma unroll
                for (int i = 0; i < 2; ++i) vA[h][i] = vAn[h][i]; }
        if (wr == 1) PG8_BAR;
    }
    PG8_WAIT_V(0);
    PG8_BAR;
#undef PG8_SA
#undef PG8_SB
#undef PG8_STAGE
#undef PG8_LDA
#undef PG8_LDB
#undef PG8_MMA
#undef PG8_CAT
#undef PG8_WAIT_V
#undef PG8_WAIT_L
#undef PG8_BAR
#undef PG8_SCHED
#undef PG8_GATHER_OFFS
}

struct Frame {
    Params p; unsigned char* ws; LAS unsigned char* lds; int tid, lane, wave, c, G;
    __device__ __forceinline__ float* MOD() const { return (float*)(ws + CT_MOD); }
    __device__ __forceinline__ float* BIAS_IN() const { return (float*)(ws + CT_BIAS_IN); }
    __device__ __forceinline__ float* BIAS_GU() const { return (float*)(ws + CT_BIAS_GU); }
    __device__ __forceinline__ float* BIAS_R() const { return (float*)(ws + CT_BIAS_R); }
    __device__ __forceinline__ float* BIAS_MGU() const { return (float*)(ws + CT_BIAS_MGU); }
    __device__ __forceinline__ float* ROWSS() const { return (float*)(ws + WS_ROWSSP); }
    __device__ __forceinline__ float* MODP() const { return (float*)(ws + WS_MODP); }
    __device__ __forceinline__ f32x2* TABA() const { return (f32x2*)(ws + WS_TABA); }
    __device__ __forceinline__ f32x2* TABB() const { return (f32x2*)(ws + WS_TABB); }
    __device__ __forceinline__ float* GP() const { return (float*)(ws + WS_GP); }
    __device__ __forceinline__ float* WR() const { return (float*)(ws + WS_WR); }
    __device__ __forceinline__ int* TOPE() const { return (int*)(ws + WS_TOPE); }
    __device__ __forceinline__ float* TOPG() const { return (float*)(ws + WS_TOPG); }
    __device__ __forceinline__ int* CNT() const { return (int*)(ws + WS_CNT); }
    __device__ __forceinline__ int* BUFTOK() const { return (int*)(ws + WS_BUFTOK); }
    __device__ __forceinline__ float* BUFGATE() const { return (float*)(ws + WS_BUFGATE); }
    __device__ __forceinline__ int* POS() const { return (int*)(ws + WS_POS); }
    __device__ __forceinline__ int* BLKE() const { return (int*)(ws + WS_BLKE); }
    __device__ __forceinline__ float* RSTD3() const { return (float*)(ws + WS_RSTD3); }
    __device__ __forceinline__ float* BUFRS() const { return (float*)(ws + WS_BUFRS); }
    __device__ __forceinline__ bf16_t* WIN() const { return (bf16_t*)(ws + WS_WIN); }
    __device__ __forceinline__ bf16_t* WOUT() const { return (bf16_t*)(ws + WS_WOUT); }
    __device__ __forceinline__ bf16_t* WGU() const { return (bf16_t*)(ws + WS_WGU); }
    __device__ __forceinline__ bf16_t* WD() const { return (bf16_t*)(ws + WS_WD); }
    __device__ __forceinline__ bf16_t* WP() const { return (bf16_t*)(ws + WS_WP); }
    __device__ __forceinline__ bf16_t* XB() const { return (bf16_t*)(ws + WS_XB); }
    __device__ __forceinline__ bf16_t* Q() const { return (bf16_t*)(ws + WS_Q); }
    __device__ __forceinline__ bf16_t* KN() const { return (bf16_t*)(ws + WS_KN); }
    __device__ __forceinline__ bf16_t* KDT() const { return (bf16_t*)(ws + WS_KDT); }
    __device__ __forceinline__ bf16_t* VT() const { return (bf16_t*)(ws + WS_VT); }
    __device__ __forceinline__ bf16_t* Gb() const { return (bf16_t*)(ws + WS_G); }
    __device__ __forceinline__ bf16_t* SB() const { return (bf16_t*)(ws + WS_SB); }
    __device__ __forceinline__ bf16_t* Y() const { return (bf16_t*)(ws + WS_Y); }
    __device__ __forceinline__ bf16_t* H1() const { return (bf16_t*)(ws + WS_H1); }
    __device__ __forceinline__ bf16_t* PB() const { return (bf16_t*)(ws + WS_PB); }
    __device__ __forceinline__ bf16_t* H1M() const { return (bf16_t*)(ws + WS_H1M); }
    __device__ __forceinline__ bf16_t* WMGU() const { return (bf16_t*)(ws + WS_WMGU); }
    __device__ __forceinline__ bf16_t* WMD() const { return (bf16_t*)(ws + WS_WMD); }
    __device__ __forceinline__ bf16_t* YB() const { return (bf16_t*)(ws + WS_YB); }
    __device__ __forceinline__ float* YBB() const { return (float*)(ws + WS_YBB); }
    __device__ __forceinline__ float* X2() const { return (float*)(ws + WS_X2); }
    __device__ __forceinline__ bf16_t* X3B() const { return (bf16_t*)(ws + WS_G + 32 * MiB); }
};
__device__ __forceinline__ void frame_fresh(Frame& F) { int l = lane_id(); asm volatile("" : "+v"(l)); F.lane = l; F.tid = F.wave * 64 + l; }
__device__ __forceinline__ void frame_init(Frame& F, const Params& p, LAS unsigned char* lds, int c, int G) {
    F.p = p; F.ws = p.ws; F.lds = lds; F.tid = threadIdx.x; F.lane = F.tid & 63; F.wave = __builtin_amdgcn_readfirstlane(F.tid >> 6); F.c = c; F.G = G;
}

__device__ __forceinline__ void dsincos(double x, double& s, double& c) {
    const double k = rint(x * 0.6366197723675814); double y = fma(-k, 1.5707963267948966, x); y = fma(-k, 6.123233995736766e-17, y);
    const double z = y * y;
    double sp = -7.6471637318198164759e-13; sp = fma(sp, z, 1.6059043836821614599e-10); sp = fma(sp, z, -2.5052108385441718775e-8); sp = fma(sp, z, 2.7557319223985890653e-6);
    sp = fma(sp, z, -1.9841269841269841270e-4); sp = fma(sp, z, 8.3333333333333333333e-3); sp = fma(sp, z, -1.6666666666666666667e-1); const double sy = fma(sp * z, y, y);
    double cp = 4.7794773323873852974e-14; cp = fma(cp, z, -1.1470745597729724714e-11); cp = fma(cp, z, 2.0876756987868098979e-9); cp = fma(cp, z, -2.7557319223985890653e-7);
    cp = fma(cp, z, 2.4801587301587301587e-5); cp = fma(cp, z, -1.3888888888888888889e-3); cp = fma(cp, z, 4.1666666666666666667e-2); cp = fma(cp, z, -0.5); const double cy = fma(cp, z, 1.0);
    const int q = ((int)k) & 3;
    s = (q == 0) ? sy : (q == 1) ? cy : (q == 2) ? -sy : -cy;
    c = (q == 0) ? cy : (q == 1) ? -sy : (q == 2) ? -cy : sy;
}
__device__ __forceinline__ void phase_p0(Frame& F) {
    const Params& p = F.p; const int gw = F.c * NWAVE + F.wave, NGW = F.G * NWAVE, lane = F.lane;
    LAS float* cact = (LAS float*)F.lds;
    __syncthreads();
    for (int k = F.tid; k < 1024; k += NTHR) cact[k] = silu_f(p.c[k]);
    __syncthreads();
    for (int task = gw; task < 1536; task += NGW) {
        const int i = task / 768, rem = task % 768, cb = rem >> 3, ks = rem & 7, n = cb * 64 + lane;
        const float* w = p.ada_w + (size_t)i * 1024 * NIN + (size_t)(ks * 128) * NIN + n; float a = 0.f;
#pragma unroll
        for (int k0 = 0; k0 < 128; k0 += 32) { float wv[32];
#pragma unroll
            for (int k = 0; k < 32; ++k) wv[k] = w[(size_t)(k0 + k) * NIN];
#pragma unroll
            for (int k = 0; k < 32; ++k) a = fmaf(cact[ks * 128 + k0 + k], wv[k], a); }
        if (ks == 0) a += p.ada_b[i * NIN + n];
        F.MODP()[ks * 12288 + i * NIN + n] = a;
    }
    const int gt = F.c * NTHR + F.tid, NGT = F.G * NTHR;
    for (int e = gt; e < 32768 + 4; e += NGT) {
        if (e < 32768) {
            const int which = e >> 14, ab = (e >> 7) & 127, i = e & 127; double inv = 1.0;
            for (int q = 0; q < i; ++q) inv *= 0.93057204092969897929;
            const double ang = (double)(which == 0 ? 128 * ab : ab) * inv; double s, c2; dsincos(ang, s, c2);
            (which == 0 ? F.TABA() : F.TABB())[ab * 128 + i] = (f32x2){(float)c2, (float)s};
        } else {
            const int h = e - 32768; const double g = 1.0 - 1.0 / (double)(32 << h); double v = 1.0;
            for (int j = 0; j <= 256; ++j) { F.GP()[h * GPS + j] = (float)v; v *= g; }
        }
    }
    for (int row = 2 * gw; row < T; row += 2 * NGW) {
        f32x4 v[2][4];
#pragma unroll
        for (int r = 0; r < 2; ++r) { const f32x4* xr = (const f32x4*)(p.x + (size_t)(row + r) * D) + lane;
#pragma unroll
            for (int j = 0; j < 4; ++j) v[r][j] = xr[64 * j]; }
#pragma unroll
        for (int r = 0; r < 2; ++r) { float s = 0.f;
#pragma unroll
            for (int j = 0; j < 4; ++j) s += (v[r][j].x * v[r][j].x + v[r][j].y * v[r][j].y) + (v[r][j].z * v[r][j].z + v[r][j].w * v[r][j].w);
            s = wave_sum(s); if (lane < 16) F.ROWSS()[(size_t)(row + r) * 16 + lane] = (lane == 0) ? s : 0.f;
            u32x2* o = (u32x2*)(F.XB() + (size_t)(row + r) * D) + lane;
#pragma unroll
            for (int j = 0; j < 4; ++j) { u32x2 w; w.x = pk2(v[r][j].x, v[r][j].y); w.y = pk2(v[r][j].z, v[r][j].w); o[64 * j] = w; } }
    }
}

template <bool F8 = false>
__device__ __forceinline__ void conv_strip(const float* W, int ldw, int kb0, int nkb, int n0, bf16_t* WT, int ldt, int drow0, const LAS float* gsl, const LAS float* shl,
                                           float* bias, float cscale, LAS float* scr, int lane, int tiled_nkt = 0, float wmul = 1.0f) {
    f32x4 bacc = (f32x4){0.f, 0.f, 0.f, 0.f}; f32x4 w[8];
    const int lr = lane >> 3, lc = 4 * (lane & 7);
    const float* wp = W + (size_t)(kb0 * 64 + lr) * ldw + n0 + lc;
#pragma unroll
    for (int i = 0; i < 8; ++i) w[i] = *(const f32x4*)(wp + (size_t)(8 * i) * ldw);
    for (int kb = kb0; kb < kb0 + nkb; ++kb) {
        const int k0 = kb * 64; f32x4 wn[8];
        if (kb + 1 < kb0 + nkb) {
#pragma unroll
            for (int i = 0; i < 8; ++i) wn[i] = *(const f32x4*)(wp + (size_t)(64 * (kb + 1 - kb0) + 8 * i) * ldw);
        } else {
#pragma unroll
            for (int i = 0; i < 8; ++i) wn[i] = (f32x4){0.f, 0.f, 0.f, 0.f};
        }
#pragma unroll
        for (int i = 0; i < 8; ++i) { const int kk = lr + 8 * i;
            float gsv = cscale * wmul; if (gsl) { gsv *= gsl[k0 + kk]; const float sv = shl[k0 + kk]; bacc = bacc + w[i] * sv; }
            *(LAS f32x4*)(scr + kk * 36 + 4 * ((lane & 7) ^ i)) = w[i] * gsv; }
        asm volatile("s_waitcnt lgkmcnt(0)" ::: "memory");
        const int cc = lane & 7;
#pragma unroll
        for (int j = 0; j < 4; ++j) { const int n = (lane >> 3) + 8 * j; const LAS float* s = scr + (8 * cc) * 36 + 4 * ((n >> 2) ^ cc) + (n & 3);
            const int nr = drow0 + n;
            if constexpr (F8) { u32x2 o8; o8.x = pk4f8(s[0 * 36], s[1 * 36], s[2 * 36], s[3 * 36]); o8.y = pk4f8(s[4 * 36], s[5 * 36], s[6 * 36], s[7 * 36]);
                if (tiled_nkt) *(u32x2*)((unsigned char*)WT + (((size_t)(nr >> 8) * tiled_nkt + (kb >> 1)) * 256 + (nr & 255)) * 128 + (kb & 1) * 64 + 8 * cc) = o8;
                else *(u32x2*)((unsigned char*)WT + (size_t)nr * ldt + k0 + 8 * cc) = o8;
                continue; }
            u32x4 o; o.x = pk2(s[0 * 36], s[1 * 36]); o.y = pk2(s[2 * 36], s[3 * 36]); o.z = pk2(s[4 * 36], s[5 * 36]); o.w = pk2(s[6 * 36], s[7 * 36]);
            if (tiled_nkt) *(u32x4*)(WT + (((size_t)(nr >> 8) * tiled_nkt + kb) * 256 + (nr & 255)) * 64 + 8 * cc) = o;
            else *(u32x4*)(WT + (size_t)nr * ldt + k0 + 8 * cc) = o; }
        asm volatile("s_waitcnt lgkmcnt(0)" ::: "memory");
#pragma unroll
        for (int i = 0; i < 8; ++i) w[i] = wn[i];
    }
    if (bias) {
#pragma unroll
        for (int o = 8; o < 64; o <<= 1) { bacc.x += __shfl_xor(bacc.x, o); bacc.y += __shfl_xor(bacc.y, o); bacc.z += __shfl_xor(bacc.z, o); bacc.w += __shfl_xor(bacc.w, o); }
        if (lane < 8) *(f32x4*)(bias + drow0 + lc) = bacc * cscale; }
}
__device__ __forceinline__ void phase_p1(Frame& F) {
    const Params& p = F.p; const int gw = F.c * NWAVE + F.wave, NGW = F.G * NWAVE, lane = F.lane;
    LAS float* modl = (LAS float*)F.lds;
    LAS float* scr = (LAS float*)(F.lds + 49152 + F.wave * 9216);
    __syncthreads();
    for (int idx = F.tid; idx < 12288; idx += NTHR) { float v = 0.f;
#pragma unroll
        for (int ks = 0; ks < 8; ++ks) v += F.MODP()[ks * 12288 + idx];
        modl[idx] = v; if ((idx % F.G) == F.c) F.MOD()[idx] = v; }
    __syncthreads();
    const LAS float* MOD0 = modl; const LAS float* MOD1 = modl + NIN; const LAS float* nul = nullptr;
    LAS float* gs_in = modl + 2048; LAS float* gs_ffn = modl + 5120; LAS float* gs_pool = modl + NIN + 2048;
    for (int k = F.tid; k < 1024; k += NTHR) { gs_in[k] = p.norm_gain[k] * (1.0f + MOD0[1024 + k]); gs_ffn[k] = p.norm_gain[1024 + k] * (1.0f + MOD0[4 * 1024 + k]); gs_pool[k] = p.norm_gain[2048 + k] * (1.0f + MOD1[1024 + k]); }
    __syncthreads();
    constexpr int S_IN = 192 * 4, S_G = 88 * 4, I_OUT = 32 * 32, I_D = 44 * 32, I_P = 4 * 4 * 8;
    constexpr int NIT = S_IN + 2 * S_G + I_OUT + I_D + I_P + 1;
    for (int it = gw; it < NIT; it += NGW) {
        int r = it;
        if (r < S_IN) { const int part = r / 192, n0 = (r % 192) * 32; const float cs = (n0 >= 1024 && n0 < 2048) ? 0.0625f : 1.0f;
            conv_strip(p.ret_w_in, NIN, 4 * part, 4, n0, F.WIN(), 1024, n0, gs_in, MOD0, F.BIAS_IN() + part * NIN, cs, scr, lane); continue; } r -= S_IN;
        if (r < 2 * S_G) { const int up = r >= S_G; if (up) r -= S_G; const int part = r / 88, n0 = (r % 88) * 32, drow = (n0 >> 7) * 256 + (up ? 128 : 0) + (n0 & 127);
            conv_strip(up ? p.ffn_w_up : p.ffn_w_gate, DFF, 4 * part, 4, n0, F.WGU(), 1024, drow, gs_ffn, MOD0 + 3 * 1024, F.BIAS_GU() + part * 5632, 1.0f, scr, lane); continue; } r -= 2 * S_G;
        if (r < I_OUT) { const int kb = r / 32, nb = r % 32; conv_strip(p.ret_w_out, 1024, kb, 1, nb * 32, F.WOUT(), 2048, nb * 32, nul, nul, nullptr, 1.0f, scr, lane); continue; } r -= I_OUT;
        if (r < I_D) { const int kb = r / 32, nb = r % 32; conv_strip<true>(p.ffn_w_down, 1024, kb, 1, nb * 32, F.WD(), DFF, nb * 32, nul, nul, nullptr, 1.0f, scr, lane, 22, F8_DSCALE); continue; } r -= I_D;
        if (r < I_P) { const int g = r / 32, q = r % 32, kb = q / 8, nb = q % 8;
            conv_strip(p.pool_w + (size_t)g * 65536, 256, kb, 1, nb * 32, F.WP() + (size_t)g * 65536, 256, nb * 32, gs_pool + g * 256, MOD1 + g * 256, nullptr, 1.0f, scr, lane); continue; }
        { float ba = 0.f; const int e = lane & 7;
            for (int k0 = lane >> 3; k0 < 1024; k0 += 128) { float w[16], gn[16];
#pragma unroll
                for (int j = 0; j < 16; ++j) { const int k = k0 + 8 * j; w[j] = p.moe_router[k * 8 + e]; gn[j] = p.norm_gain[3 * 1024 + k]; }
#pragma unroll
                for (int j = 0; j < 16; ++j) { const int k = k0 + 8 * j; F.WR()[k * 8 + e] = w[j] * (gn[j] * (1.0f + MOD1[4 * 1024 + k])); ba = fmaf(MOD1[3 * 1024 + k], w[j], ba); } }
            ba += __shfl_xor(ba, 8); ba += __shfl_xor(ba, 16); ba += __shfl_xor(ba, 32);
            if (lane < 8) F.BIAS_R()[lane] = ba; }
    }
}
constexpr int PX_SG = 112 * 4, PX_EARLY = 1024;
__device__ __forceinline__ void px_tables(Frame& F) {
    const Params& p = F.p;
    LAS float* gsl = (LAS float*)(F.lds + 8 * 9216 + 1024);
    LAS float* shl = gsl + 1024;
    const float* MOD1 = F.MOD() + NIN;
    for (int k = F.tid; k < 1024; k += NTHR) { gsl[k] = p.norm_gain[3 * 1024 + k] * (1.0f + ldv_f(MOD1 + 4 * 1024 + k)); shl[k] = ldv_f(MOD1 + 3 * 1024 + k); }
    __syncthreads();
}
__device__ __forceinline__ void px_gu_item(Frame& F, int it, int lane) {
    const Params& p = F.p;
    LAS float* scr = (LAS float*)(F.lds + F.wave * 9216);
    LAS float* gsl = (LAS float*)(F.lds + 8 * 9216 + 1024); LAS float* shl = gsl + 1024;
    const int e = it / (2 * PX_SG); int r = it % (2 * PX_SG); const int up = r >= PX_SG; if (up) r -= PX_SG;
    const int part = r / 112, n0 = (r % 112) * 32, drow = e * 7168 + (n0 >> 7) * 256 + (up ? 128 : 0) + (n0 & 127);
    conv_strip<true>((up ? p.moe_w_up : p.moe_w_gate) + (size_t)e * 1024 * DFE, DFE, 4 * part, 4, n0, F.WMGU(), 1024, drow, gsl, shl,
                     F.BIAS_MGU() + (part >> 1) * 262144 + (part & 1) * 57344, 1.0f, scr, lane, 0, F8_WSCALE);
}
__device__ __forceinline__ void phase_px(Frame& F) {
    const Params& p = F.p; const int gw = F.c * NWAVE + F.wave, NGW = F.G * NWAVE, lane = F.lane;
    LAS float* scr = (LAS float*)(F.lds + F.wave * 9216);
    const LAS float* nul = nullptr;
    px_tables(F);
    constexpr int I_D = 14 * 32;
    for (int it = (F.G == 256 ? PX_EARLY : 0) + gw; it < NE * 2 * PX_SG; it += NGW) px_gu_item(F, it, lane);
    const int lane2 = lane_id();
    for (int it = gw; it < NE * I_D; it += NGW) {
        const int e = it / I_D, r = it % I_D, kg = r / 32, nb = r % 32;
        conv_strip<true>(p.moe_w_down + (size_t)e * DFE * 1024, 1024, 4 * kg, 4, nb * 32, (bf16_t*)((unsigned char*)F.WMD() + (size_t)e * 1024 * DFE), DFE, nb * 32, nul, nul, nullptr, 1.0f, scr, lane2, 28, F8_DSCALE);
    }
}

__device__ __forceinline__ void phase_scan(Frame& F) {
    const int gt = F.c * NTHR + F.tid, NGT = F.G * NTHR;
    for (int v = gt; v < 131072; v += NGT) {
        const int h = v >> 15; const float dec = F.GP()[h * GPS + RC]; float s0 = 0.f, s1 = 0.f, s2 = 0.f, s3 = 0.f;
        u32x2* ptr = (u32x2*)(F.SB() + (size_t)v * 4);
        for (int n0 = 0; n0 < NRC; n0 += 16) {
            u32x2 kv[16];
#pragma unroll
            for (int j = 0; j < 16; ++j) { kv[j] = (u32x2){0u, 0u}; if (n0 + j < NRC - 1) kv[j] = ptr[(size_t)(n0 + j) * 131072]; }
#pragma unroll
            for (int j = 0; j < 16; ++j) {
                u32x2 o; o.x = pk2(s0, s1); o.y = pk2(s2, s3); ptr[(size_t)(n0 + j) * 131072] = o;
                s0 = s0 * dec + bflo(kv[j].x); s1 = s1 * dec + bfhi(kv[j].x); s2 = s2 * dec + bflo(kv[j].y); s3 = s3 * dec + bfhi(kv[j].y); }
        }
    }
}

namespace ret {
constexpr int BUFB = 40960, OFF_B = 8192, OFF_P = 81920, OFF_RED = 114688, OFF_GP = 118784;
__device__ __forceinline__ int swz(int o) { return o ^ (((o >> 9) & 1) << 5); }
}
#define RET_WAITV(n) asm volatile("s_waitcnt vmcnt(" #n ")" ::: "memory")
#define RET_WAITL0() asm volatile("s_waitcnt lgkmcnt(0)" ::: "memory")
#define RET_BAR() do { asm volatile("" ::: "memory"); __builtin_amdgcn_s_barrier(); asm volatile("" ::: "memory"); } while (0)
__device__ __forceinline__ void phase_ret_fast(Frame& F) {
    using namespace ret;
    const Params& p = F.p; LAS unsigned char* lds = F.lds;
    const int tid = F.tid, lane = tid & 63, wid = F.wave, wr = wid >> 2, wc = wid & 3, fr = lane & 15, fq = lane >> 4;
    const int foff = swz(fr * 64 + fq * 16);
    const int srow = lane >> 2, scol = ((lane & 3) * 8) ^ (((lane >> 5) & 1) * 16);
    LAS float* gps = (LAS float*)(lds + OFF_GP); LAS f32x2* red = (LAS f32x2*)(lds + OFF_RED);
    __syncthreads();
    for (int i = tid; i < 4 * GPS; i += NTHR) gps[i] = F.GP()[i];
    __syncthreads();
    const __amdgpu_buffer_rsrc_t rs = __builtin_amdgcn_make_buffer_rsrc((void*)F.ws, (short)0, 0x7fffffff, 0x00020000);
    const unsigned qoff = (unsigned)((16 * wid + srow) * 1024 + scol) * 2u;
    unsigned soff[4], voff[4];
#pragma unroll
    for (int i = 0; i < 4; ++i) { soff[i] = (unsigned)((16 * (wid + 8 * i) + srow) * 256 + scol) * 2u; voff[i] = (unsigned)((16 * (wid + 8 * i) + srow) * T + scol) * 2u; }
#define RET_GLDS(uoff, loff, dst) __builtin_amdgcn_raw_ptr_buffer_load_lds(rs, (LAS unsigned*)(lds + (dst)), 16, (int)(loff), (int)(uoff), 0, 0)
#define RET_LOADS(kind, ks, b, hh, nn, nk) do { const unsigned _qk = (unsigned)((nn) * 128 * 1024 + (hh) * 256 + 32 * (ks)) * 2u, _kk = (unsigned)((nk) * 128 * 1024 + (hh) * 256 + 32 * (ks)) * 2u; \
        if ((kind) != 2) RET_GLDS((unsigned)WS_Q + _qk, qoff, (b) * BUFB + wid * 1024); \
        if ((kind) == 0) RET_GLDS((unsigned)WS_KN + _kk, qoff, (b) * BUFB + OFF_B + wid * 1024); \
        if ((kind) == 1) { const unsigned _sb = (unsigned)WS_SB + (unsigned)((((nn) >> 1) * 4 + (hh)) * 512 * 256 + 32 * (ks)) * 2u; _Pragma("unroll") for (int _i = 0; _i < 4; ++_i) \
            RET_GLDS(_sb, soff[_i], (b) * BUFB + OFF_B + (wid + 8 * _i) * 1024); } \
        if ((kind) == 2) { const unsigned _vb = (unsigned)WS_VT + (unsigned)((hh) * 512 * T + (nk) * 128 + 32 * (ks)) * 2u; _Pragma("unroll") for (int _i = 0; _i < 4; ++_i) \
            RET_GLDS(_vb, voff[_i], (b) * BUFB + OFF_B + (wid + 8 * _i) * 1024); } } while (0)
    int u = F.c;
    if (u >= 512) return;
#define RET_NOF(uu) ((((uu) >> 4) << 2) | ((((uu) >> 2) & 1) << 1) | ((((uu) >> 3) ^ ((uu) >> 8)) & 1))
    { const int h = u & 3, n = RET_NOF(u); RET_LOADS(0, 0, 0, h, n, n); }
    for (; u < 512; u += F.G) {
        const int h = u & 3, n = RET_NOF(u), t0 = n * 128; const int un = u + F.G; const bool has_next = un < 512; const int hn = un & 3, nn = RET_NOF(un);
        const bool half = (n & 1) != 0;
        f32x4 pacc[4][2];
#pragma unroll
        for (int m = 0; m < 4; ++m)
#pragma unroll
            for (int q = 0; q < 2; ++q) pacc[m][q] = (f32x4){0.f, 0.f, 0.f, 0.f};
#pragma unroll
        for (int ks = 0; ks < 8; ++ks) {
            const int b = ks & 1;
            if (ks < 7) { RET_LOADS(0, ks + 1, b ^ 1, h, n, n); RET_WAITV(2); } else { RET_LOADS(1, 0, b ^ 1, h, n, n); RET_WAITV(5); }
            RET_BAR();
            bf16x8 af[4], bf[2];
#pragma unroll
            for (int m = 0; m < 4; ++m) af[m] = *(const LAS bf16x8*)(lds + b * BUFB + (4 * wr + m) * 1024 + foff);
#pragma unroll
            for (int q = 0; q < 2; ++q) bf[q] = *(const LAS bf16x8*)(lds + b * BUFB + OFF_B + (2 * wc + q) * 1024 + foff);
            RET_WAITL0(); RET_BAR();
#pragma unroll
            for (int m = 0; m < 4; ++m)
#pragma unroll
                for (int q = 0; q < 2; ++q) pacc[m][q] = __builtin_amdgcn_mfma_f32_16x16x32_bf16(bf[q], af[m], pacc[m][q], 0, 0, 0);
            __builtin_amdgcn_sched_barrier(0);
        }
        { int l2 = lane; asm volatile("" : "+v"(l2)); const int fr = l2 & 15, fq = l2 >> 4;
#pragma unroll
        for (int m = 0; m < 4; ++m)
#pragma unroll
            for (int q = 0; q < 2; ++q) { const int r = 64 * wr + 16 * m + fr, cc = 32 * wc + 16 * q + 4 * fq; float v[4];
#pragma unroll
                for (int j = 0; j < 4; ++j) { const int dd = r - (cc + j); v[j] = dd >= 0 ? pacc[m][q][j] * gps[h * GPS + dd] : 0.f; }
                u32x2 w; w.x = pk2(v[0], v[1]); w.y = pk2(v[2], v[3]);
                *(LAS u32x2*)(lds + OFF_P + wc * 8192 + (4 * wr + m) * 1024 + swz(fr * 64 + 32 * q + 8 * fq)) = w; } }
        f32x4 acc[4][8];
#pragma unroll
        for (int m = 0; m < 4; ++m)
#pragma unroll
            for (int q = 0; q < 8; ++q) acc[m][q] = (f32x4){0.f, 0.f, 0.f, 0.f};
#pragma unroll
        for (int ks = 0; ks < 8; ++ks) {
            const int b = ks & 1;
            if (ks < 7) { RET_LOADS(1, ks + 1, b ^ 1, h, n, n); RET_WAITV(5); } else { RET_LOADS(2, 0, b ^ 1, h, n, n); RET_WAITV(4); }
            RET_BAR();
            bf16x8 af[4], bf[8];
#pragma unroll
            for (int m = 0; m < 4; ++m) af[m] = *(const LAS bf16x8*)(lds + b * BUFB + (4 * wr + m) * 1024 + foff);
#pragma unroll
            for (int q = 0; q < 8; ++q) bf[q] = *(const LAS bf16x8*)(lds + b * BUFB + OFF_B + (8 * wc + q) * 1024 + foff);
            RET_WAITL0(); RET_BAR();
#pragma unroll
            for (int m = 0; m < 4; ++m)
#pragma unroll
                for (int q = 0; q < 8; ++q) acc[m][q] = __builtin_amdgcn_mfma_f32_16x16x32_bf16(bf[q], af[m], acc[m][q], 0, 0, 0);
            __builtin_amdgcn_sched_barrier(0);
        }
        { int l3 = lane; asm volatile("" : "+v"(l3)); const int fr = l3 & 15;
#pragma unroll
        for (int m = 0; m < 4; ++m) { const float qd = gps[h * GPS + 64 * wr + 16 * m + fr + 1] * (half ? gps[h * GPS + 128] : 1.0f);
#pragma unroll
            for (int q = 0; q < 8; ++q) acc[m][q] = acc[m][q] * qd; } }
#pragma unroll
        for (int ks = 0; ks < 4; ++ks) {
            const int b = ks & 1;
            if (ks < 3) { RET_LOADS(2, ks + 1, b ^ 1, h, n, n); RET_WAITV(4); }
            else if (half) { RET_LOADS(0, 0, b ^ 1, h, n, n - 1); RET_WAITV(2); }
            else if (has_next) { RET_LOADS(0, 0, b ^ 1, hn, nn, nn); RET_WAITV(2); }
            else { RET_WAITV(0); }
            RET_BAR();
            bf16x8 af[4], bf[8];
#pragma unroll
            for (int m = 0; m < 4; ++m) af[m] = *(const LAS bf16x8*)(lds + OFF_P + ks * 8192 + (4 * wr + m) * 1024 + foff);
#pragma unroll
            for (int q = 0; q < 8; ++q) bf[q] = *(const LAS bf16x8*)(lds + b * BUFB + OFF_B + (8 * wc + q) * 1024 + foff);
            RET_WAITL0(); RET_BAR();
#pragma unroll
            for (int m = 0; m < 4; ++m)
#pragma unroll
                for (int q = 0; q < 8; ++q) acc[m][q] = __builtin_amdgcn_mfma_f32_16x16x32_bf16(bf[q], af[m], acc[m][q], 0, 0, 0);
            __builtin_amdgcn_sched_barrier(0);
        }
        if (half) {
#pragma unroll
            for (int m = 0; m < 4; ++m)
#pragma unroll
                for (int q = 0; q < 2; ++q) pacc[m][q] = (f32x4){0.f, 0.f, 0.f, 0.f};
#pragma unroll
            for (int ks = 0; ks < 8; ++ks) {
                const int b = ks & 1;
                if (ks < 7) { RET_LOADS(0, ks + 1, b ^ 1, h, n, n - 1); RET_WAITV(2); } else { RET_LOADS(2, 0, b ^ 1, h, n, n - 1); RET_WAITV(4); }
                RET_BAR();
                bf16x8 af[4], bf[2];
#pragma unroll
                for (int m = 0; m < 4; ++m) af[m] = *(const LAS bf16x8*)(lds + b * BUFB + (4 * wr + m) * 1024 + foff);
#pragma unroll
                for (int q = 0; q < 2; ++q) bf[q] = *(const LAS bf16x8*)(lds + b * BUFB + OFF_B + (2 * wc + q) * 1024 + foff);
                RET_WAITL0(); RET_BAR();
#pragma unroll
                for (int m = 0; m < 4; ++m)
#pragma unroll
                    for (int q = 0; q < 2; ++q) pacc[m][q] = __builtin_amdgcn_mfma_f32_16x16x32_bf16(bf[q], af[m], pacc[m][q], 0, 0, 0);
                __builtin_amdgcn_sched_barrier(0);
            }
            { int l6 = lane; asm volatile("" : "+v"(l6)); const int fr = l6 & 15, fq = l6 >> 4;
#pragma unroll
            for (int m = 0; m < 4; ++m)
#pragma unroll
                for (int q = 0; q < 2; ++q) { const int r = 64 * wr + 16 * m + fr, cc = 32 * wc + 16 * q + 4 * fq; float v[4];
#pragma unroll
                    for (int j = 0; j < 4; ++j) v[j] = pacc[m][q][j] * gps[h * GPS + 128 + r - (cc + j)];
                    u32x2 w; w.x = pk2(v[0], v[1]); w.y = pk2(v[2], v[3]);
                    *(LAS u32x2*)(lds + OFF_P + wc * 8192 + (4 * wr + m) * 1024 + swz(fr * 64 + 32 * q + 8 * fq)) = w; } }
            RET_WAITL0();
#pragma unroll
            for (int ks = 0; ks < 4; ++ks) {
                const int b = ks & 1;
                if (ks < 3) { RET_LOADS(2, ks + 1, b ^ 1, h, n, n - 1); RET_WAITV(4); }
                else if (has_next) { RET_LOADS(0, 0, b ^ 1, hn, nn, nn); RET_WAITV(2); }
                else { RET_WAITV(0); }
                RET_BAR();
                bf16x8 af[4], bf[8];
    #pragma unroll
                for (int m = 0; m < 4; ++m) af[m] = *(const LAS bf16x8*)(lds + OFF_P + ks * 8192 + (4 * wr + m) * 1024 + foff);
    #pragma unroll
                for (int q = 0; q < 8; ++q) bf[q] = *(const LAS bf16x8*)(lds + b * BUFB + OFF_B + (8 * wc + q) * 1024 + foff);
                RET_WAITL0(); RET_BAR();
    #pragma unroll
                for (int m = 0; m < 4; ++m)
    #pragma unroll
                    for (int q = 0; q < 8; ++q) acc[m][q] = __builtin_amdgcn_mfma_f32_16x16x32_bf16(bf[q], af[m], acc[m][q], 0, 0, 0);
                __builtin_amdgcn_sched_barrier(0);
            }
        }
        { int l4 = lane; asm volatile("" : "+v"(l4)); const int fr = l4 & 15, fq = l4 >> 4;
#pragma unroll
        for (int m = 0; m < 4; ++m) { float s1 = 0.f, s2 = 0.f;
#pragma unroll
            for (int q = 0; q < 8; ++q) { const f32x4 v = acc[m][q]; s1 += (v.x + v.y) + (v.z + v.w); s2 += (v.x * v.x + v.y * v.y) + (v.z * v.z + v.w * v.w); }
            s1 += __shfl_xor(s1, 16); s1 += __shfl_xor(s1, 32); s2 += __shfl_xor(s2, 16); s2 += __shfl_xor(s2, 32);
            if (fq == 0) red[(64 * wr + 16 * m + fr) * 4 + wc] = (f32x2){s1, s2}; }
        RET_WAITL0(); RET_BAR();
#pragma unroll
        for (int m = 0; m < 4; ++m) { const int r = 64 * wr + 16 * m + fr; const f32x2 a = red[r * 4 + 0], b2 = red[r * 4 + 1], c2 = red[r * 4 + 2], d2 = red[r * 4 + 3];
            const float mu = ((a.x + b2.x) + (c2.x + d2.x)) * (1.0f / 512.0f), ex2 = ((a.y + b2.y) + (c2.y + d2.y)) * (1.0f / 512.0f);
            const float rs = 1.0f / sqrtf(ex2 - mu * mu + EPS); const size_t rowoff = (size_t)(t0 + r) * 2048 + h * 512 + 128 * wc + 4 * fq;
#pragma unroll
            for (int q = 0; q < 8; ++q) { const u32x2 gw = *(const u32x2*)(F.Gb() + rowoff + 16 * q); const f32x4 gn = *(const f32x4*)(p.ret_gn_gain + h * 512 + 128 * wc + 16 * q + 4 * fq);
                const f32x4 v = acc[m][q]; u32x2 w;
                w.x = pk2((v.x - mu) * rs * gn.x * bflo(gw.x), (v.y - mu) * rs * gn.y * bfhi(gw.x)); w.y = pk2((v.z - mu) * rs * gn.z * bflo(gw.y), (v.w - mu) * rs * gn.w * bfhi(gw.y));
                *(u32x2*)(F.Y() + rowoff + 16 * q) = w; }
             } }
        RET_BAR();
    }
    RET_WAITV(0); RET_BAR();
#undef RET_GLDS
#undef RET_NOF
#undef RET_LOADS
}

namespace pf { constexpr int XTP = 132, OFF_RS = 42496, OFF_PT = 43008, OFF_WB = 59392, OFF_END = 124928; }
template <int W>
__device__ __forceinline__ void pf_pool(LAS unsigned char* lds, int t0, int tid) {
    using namespace pf; const LAS float* XT = (const LAS float*)lds; const LAS float* RS = (const LAS float*)(lds + OFF_RS);
    const int cp = tid & 63, tb = tid >> 6, r0 = 8 * tb, ch = 2 * cp; float s0 = 0.f, s1 = 0.f;
#pragma unroll
    for (int i = 1; i < W; ++i) { const int rr = 16 + r0 - i; const f32x2 xv = *(const LAS f32x2*)(XT + rr * XTP + ch); const float rs = RS[rr]; s0 += xv.x * rs; s1 += xv.y * rs; }
#pragma unroll
    for (int j = 0; j < 8; ++j) { const int r = r0 + j, rr = 16 + r; const f32x2 xv = *(const LAS f32x2*)(XT + rr * XTP + ch); const float rs = RS[rr]; const float a0 = xv.x * rs, a1 = xv.y * rs;
        s0 += a0; s1 += a1; const int t = t0 + r; const float ic = 1.0f / (float)((t + 1) < W ? (t + 1) : W);
        *(LAS unsigned*)(lds + OFF_PT + (ch >> 5) * 4096 + (r >> 4) * 1024 + ret::swz((r & 15) * 64 + (ch & 31) * 2)) = pk2(s0 * ic - a0, s1 * ic - a1);
        const int ro = rr - W + 1; const f32x2 xo = *(const LAS f32x2*)(XT + ro * XTP + ch); const float rso = RS[ro]; s0 -= xo.x * rso; s1 -= xo.y * rso; }
}
__device__ __forceinline__ void phase_pool_fused(Frame& F) {
    using namespace pf;
    const Params& p = F.p; LAS unsigned char* lds = F.lds; const int tid = F.tid, lane = F.lane, wid = F.wave;
    const bf16_t* X2 = F.XB(); const float* rss = F.ROWSS();     const float* g1 = F.MOD() + NIN + 2 * 1024; const float* WRg = F.WR();
    LAS float* XT = (LAS float*)lds; LAS float* RS = (LAS float*)(lds + OFF_RS);
    const int foff = ret::swz((lane & 15) * 64 + (lane >> 4) * 16);
    const int srow = lane >> 2, scol = ((lane & 3) * 8) ^ (((lane >> 5) & 1) * 16);
    const __amdgpu_buffer_rsrc_t rs_ws = __builtin_amdgcn_make_buffer_rsrc((void*)F.ws, (short)0, 0x7fffffff, 0x00020000);
    unsigned loff[2];
#pragma unroll
    for (int i = 0; i < 2; ++i) loff[i] = (unsigned)((16 * (wid + 8 * i) + srow) * 256 + scol) * 2u;
    for (int seg = F.c; seg < 256; seg += F.G) {
        const int t0 = seg * 64;
        float ss[4], lg[4][8];
#pragma unroll
        for (int m = 0; m < 4; ++m) { ss[m] = 0.f;
#pragma unroll
            for (int e = 0; e < 8; ++e) lg[m][e] = 0.f; }
        __syncthreads();
        if (tid < 80) { const int tt = t0 - 16 + tid; RS[tid] = tt >= 0 ? rstd_row(rss, tt) : 0.f; }
        f32x4 acc[4][2]; u32x2 xv[5];
#define PF_LOADX(gg, kk) do { int _tl = tid; asm volatile("" : "+v"(_tl)); _Pragma("unroll") for (int _i = 0; _i < 5; ++_i) { const int _idx = _tl + 512 * _i, _rr = _idx >> 5, _c4 = (_idx & 31) * 4; const int _tt = t0 - 16 + _rr; \
            xv[_i] = *(const u32x2*)(X2 + (size_t)(_tt < 0 ? 0 : _tt) * 1024 + 256 * (gg) + 128 * (kk) + _c4); } } while (0)
        PF_LOADX(0, 0);
#pragma unroll 1
        for (int it = 0; it < 8; ++it) {
            const int g = it >> 1, kh = it & 1;
            if (kh == 0) {
#pragma unroll
                for (int m = 0; m < 4; ++m) { acc[m][0] = (f32x4){0.f, 0.f, 0.f, 0.f}; acc[m][1] = (f32x4){0.f, 0.f, 0.f, 0.f}; } }
            {
                __syncthreads();
                int tl = tid; asm volatile("" : "+v"(tl));
#pragma unroll
                for (int i = 0; i < 5; ++i) { const int idx = tl + 512 * i, rr = idx >> 5, c4 = (idx & 31) * 4; *(LAS f32x4*)(XT + rr * XTP + c4) = (f32x4){bflo(xv[i].x), bfhi(xv[i].x), bflo(xv[i].y), bfhi(xv[i].y)}; }
#pragma unroll
                for (int kc = 0; kc < 4; ++kc)
#pragma unroll
                    for (int i = 0; i < 2; ++i)
                        __builtin_amdgcn_raw_ptr_buffer_load_lds(rs_ws, (LAS unsigned*)(lds + OFF_WB + kc * 16384 + (wid + 8 * i) * 1024), 16, (int)loff[i], (int)((unsigned)WS_WP + (unsigned)(g * 65536 + kh * 128 + 32 * kc) * 2u), 0, 0);
                { const int itn = it < 7 ? it + 1 : 7; PF_LOADX(itn >> 1, itn & 1); }
                __syncthreads();
                if (g == 0) pf_pool<2>(lds, t0, tl); else if (g == 1) pf_pool<4>(lds, t0, tl); else if (g == 2) pf_pool<8>(lds, t0, tl); else pf_pool<16>(lds, t0, tl);
                asm volatile("s_waitcnt vmcnt(5)" ::: "memory");
                __syncthreads();
#pragma unroll
                for (int kc = 0; kc < 4; ++kc) { bf16x8 af[4], bf[2];
#pragma unroll
                    for (int m = 0; m < 4; ++m) af[m] = *(const LAS bf16x8*)(lds + OFF_PT + kc * 4096 + m * 1024 + foff);
#pragma unroll
                    for (int n = 0; n < 2; ++n) bf[n] = *(const LAS bf16x8*)(lds + OFF_WB + kc * 16384 + (2 * wid + n) * 1024 + foff);
#pragma unroll
                    for (int m = 0; m < 4; ++m)
#pragma unroll
                        for (int n = 0; n < 2; ++n) acc[m][n] = __builtin_amdgcn_mfma_f32_16x16x32_bf16(bf[n], af[m], acc[m][n], 0, 0, 0); }
            }
            if (kh == 0) continue;
            { int l5 = lane; asm volatile("" : "+v"(l5)); const int fr = l5 & 15, fq = l5 >> 4;
              f32x4 x2a[2][4];
#pragma unroll
              for (int n = 0; n < 2; ++n)
#pragma unroll
                for (int m = 0; m < 4; ++m) { const u32x2 w2 = *(const u32x2*)(X2 + (size_t)(t0 + 16 * m + fr) * 1024 + 256 * g + 32 * wid + 16 * n + 4 * fq); x2a[n][m] = (f32x4){bflo(w2.x), bfhi(w2.x), bflo(w2.y), bfhi(w2.y)}; }
              f32x4 bva[2], sva[2], gva[2], wra[2][4], wrb[2][4];
#pragma unroll
              for (int n = 0; n < 2; ++n) { const int cg = 256 * g + 32 * wid + 16 * n + 4 * fq;
                bva[n] = *(const f32x4*)(p.pool_b + cg); sva[n] = *(const f32x4*)(p.pool_scale + cg); gva[n].x = ldv_f(g1 + cg); gva[n].y = ldv_f(g1 + cg + 1); gva[n].z = ldv_f(g1 + cg + 2); gva[n].w = ldv_f(g1 + cg + 3);
#pragma unroll
                for (int j = 0; j < 4; ++j) { wra[n][j] = *(const f32x4*)(WRg + (cg + j) * 8); wrb[n][j] = *(const f32x4*)(WRg + (cg + j) * 8 + 4); } }
#pragma unroll
              for (int n = 0; n < 2; ++n) { const int cg = 256 * g + 32 * wid + 16 * n + 4 * fq;
                const f32x4 bv = bva[n], sv = sva[n], gv = gva[n];
                f32x4 wr0[4], wr1[4];
#pragma unroll
                for (int j = 0; j < 4; ++j) { wr0[j] = wra[n][j]; wr1[j] = wrb[n][j]; }
#pragma unroll
                for (int m = 0; m < 4; ++m) { const size_t o = (size_t)(t0 + 16 * m + fr) * 1024 + cg;
                    const f32x4 xo = x2a[n][m] + gv * ((acc[m][n] + bv) * sv);
                    { u32x2 w3; w3.x = pk2(xo.x, xo.y); w3.y = pk2(xo.z, xo.w); *(u32x2*)(F.X3B() + o) = w3; }
                    *(unsigned*)((unsigned char*)F.Gb() + o) = pk4f8(xo.x, xo.y, xo.z, xo.w);
                    ss[m] += (xo.x * xo.x + xo.y * xo.y) + (xo.z * xo.z + xo.w * xo.w);
                    lg[m][0] += xo.x * wr0[0].x + xo.y * wr0[1].x + xo.z * wr0[2].x + xo.w * wr0[3].x; lg[m][1] += xo.x * wr0[0].y + xo.y * wr0[1].y + xo.z * wr0[2].y + xo.w * wr0[3].y;
                    lg[m][2] += xo.x * wr0[0].z + xo.y * wr0[1].z + xo.z * wr0[2].z + xo.w * wr0[3].z; lg[m][3] += xo.x * wr0[0].w + xo.y * wr0[1].w + xo.z * wr0[2].w + xo.w * wr0[3].w;
                    lg[m][4] += xo.x * wr1[0].x + xo.y * wr1[1].x + xo.z * wr1[2].x + xo.w * wr1[3].x; lg[m][5] += xo.x * wr1[0].y + xo.y * wr1[1].y + xo.z * wr1[2].y + xo.w * wr1[3].y;
                    lg[m][6] += xo.x * wr1[0].z + xo.y * wr1[1].z + xo.z * wr1[2].z + xo.w * wr1[3].z; lg[m][7] += xo.x * wr1[0].w + xo.y * wr1[1].w + xo.z * wr1[2].w + xo.w * wr1[3].w; } } }
        }
#undef PF_LOADX
#pragma unroll
        for (int m = 0; m < 4; ++m) { ss[m] += __shfl_xor(ss[m], 16); ss[m] += __shfl_xor(ss[m], 32);
#pragma unroll
            for (int e = 0; e < 8; ++e) { lg[m][e] += __shfl_xor(lg[m][e], 16); lg[m][e] += __shfl_xor(lg[m][e], 32); } }
        __syncthreads();
        { LAS float* red = (LAS float*)lds; int l6 = lane; asm volatile("" : "+v"(l6)); const int fr = l6 & 15;
          if ((l6 >> 4) == 0) {
#pragma unroll
            for (int m = 0; m < 4; ++m) { LAS float* q = red + ((16 * m + fr) * 8 + wid) * 12; q[0] = ss[m];
#pragma unroll
                for (int e = 0; e < 8; ++e) q[1 + e] = lg[m][e]; } }
          LAS int* cnt = (LAS int*)(lds + OFF_RS);
          if (tid < 8) cnt[tid] = 0;
          __syncthreads();
          if (tid < 64) { float sq = 0.f, a[8];
#pragma unroll
            for (int e = 0; e < 8; ++e) a[e] = 0.f;
#pragma unroll
            for (int w = 0; w < 8; ++w) { const LAS float* q = red + (tid * 8 + w) * 12; sq += q[0];
#pragma unroll
                for (int e = 0; e < 8; ++e) a[e] += q[1 + e]; }
            const int t = t0 + tid; const float rs = rstd_of(sq); float lgt[8]; F.RSTD3()[t] = rs;
#pragma unroll
            for (int e = 0; e < 8; ++e) lgt[e] = rs * a[e] + ldv_f(F.BIAS_R() + e);
            int e0 = 0; float l0 = lgt[0];
#pragma unroll
            for (int e = 1; e < 8; ++e) if (lgt[e] > l0) { l0 = lgt[e]; e0 = e; }
            int e1 = -1; float l1 = -3.0e38f;
#pragma unroll
            for (int e = 0; e < 8; ++e) if (e != e0 && lgt[e] > l1) { l1 = lgt[e]; e1 = e; }
            const float g0 = 1.0f / (1.0f + __expf(l1 - l0));
            F.TOPE()[t * 2] = e0; F.TOPE()[t * 2 + 1] = e1; F.TOPG()[t * 2] = g0; F.TOPG()[t * 2 + 1] = 1.0f - g0;
            atomicAdd((int*)(cnt + e0), 1); atomicAdd((int*)(cnt + e1), 1); }
          __syncthreads();
          if (tid < 8) F.CNT()[seg * 8 + tid] = cnt[tid]; }
    }
    __syncthreads();
}

__device__ __forceinline__ void phase_route2(Frame& F) {
    const int tid = F.tid;
    LAS int* cn = (LAS int*)F.lds;
    LAS int* part = cn + 2048;
    LAS int* tot = part + 512;
    LAS int* te = tot + 32;
    __syncthreads();
    for (int i = tid; i < 2048; i += NTHR) cn[i] = ldv_i(F.CNT() + i);
    __syncthreads();
    { const int e = tid & 7, pq = tid >> 3; part[pq * 8 + e] = cn[(4 * pq) * 8 + e] + cn[(4 * pq + 1) * 8 + e] + cn[(4 * pq + 2) * 8 + e] + cn[(4 * pq + 3) * 8 + e]; }
    __syncthreads();
    if (tid < 8) { int run = 0; for (int q = 0; q < 64; ++q) { const int v = part[q * 8 + tid]; part[q * 8 + tid] = run; run += v; } tot[tid] = run; }
    __syncthreads();
    { const int e = tid & 7, pq = tid >> 3; int run = part[pq * 8 + e];
#pragma unroll
        for (int j = 0; j < 4; ++j) { const int v = cn[(4 * pq + j) * 8 + e]; cn[(4 * pq + j) * 8 + e] = run; run += v; } }
    if (tid == 0) { int sp = 0; for (int e = 0; e < 8; ++e) { const int pd = (tot[e] + 255) / 256 * 256; tot[8 + e] = sp; tot[16 + e] = pd; sp += pd; } tot[24] = sp / 256; }
    __syncthreads();
    for (int seg = F.c; seg < 256; seg += F.G) {
        int e = -1; if (tid < 128) e = ldv_i(F.TOPE() + seg * 128 + tid);
        int rank = 0;
#pragma unroll
        for (int ee = 0; ee < 8; ++ee) { const unsigned long long m = __ballot(e == ee); if (e == ee) rank = __popcll(m & ((1ull << F.lane) - 1ull)); if (tid == 0) te[ee] = __popcll(m); }
        __syncthreads();
        if (tid < 128) { if (tid >= 64) rank += te[e];
            const int pos = tot[8 + e] + cn[seg * 8 + e] + rank, idx = seg * 128 + tid;
            const float gt = ldv_f(F.TOPG() + idx), rsd = ldv_f(F.RSTD3() + (idx >> 1));
            F.BUFTOK()[pos] = idx >> 1; F.BUFGATE()[pos] = gt; F.BUFRS()[pos] = rsd * (1.0f / F8_WSCALE); F.POS()[idx] = pos; }
        __syncthreads();
    }
    if (F.c < 8) { const int e = F.c; const int b0 = tot[8 + e] + tot[e], b1 = tot[8 + e] + tot[16 + e]; for (int r = b0 + tid; r < b1; r += NTHR) { F.BUFTOK()[r] = 0; F.BUFGATE()[r] = 0.f; F.BUFRS()[r] = 0.f; } }
    if (F.c == (8 % F.G)) { if (tid < NBLK) { int e = 0; for (int q = 0; q < 8; ++q) if (tid * 256 >= tot[8 + q] + tot[16 + q]) ++e; F.BLKE()[tid] = e < 7 ? e : 7; } if (tid == NBLK) F.BLKE()[NBLK] = tot[24]; }
}

__device__ __forceinline__ void phase_final(Frame& F) {
    const Params& p = F.p; const int gw = F.c * NWAVE + F.wave, NGW = F.G * NWAVE, lane = F.lane; const float* g2 = F.MOD() + NIN + 5 * 1024;
    const int nused = ldv_i(F.BLKE() + NBLK); const int ntail = (F.G == 256) ? (nused - 128) * 4 : 0; const int spu = ntail > 0 ? moe_tail_spu(ntail) : 1;
    f32x4 gv[4], fg[4];
#pragma unroll
    for (int j = 0; j < 4; ++j) { gv[j] = *((const f32x4*)g2 + lane + 64 * j); fg[j] = *((const f32x4*)p.final_norm_gain + lane + 64 * j); }
    for (int row = 2 * gw; row < T; row += 2 * NGW) {
        f32x4 xv[2][4]; f32x4 fa[2][4]; int pos[2][2]; u32x2 xw[2][4], yw[2][2][4];
#pragma unroll
        for (int r = 0; r < 2; ++r)
#pragma unroll
            for (int a = 0; a < 2; ++a) pos[r][a] = ldv_i(F.POS() + (row + r) * 2 + a);
#pragma unroll
        for (int r = 0; r < 2; ++r) { const u32x2* xr = (const u32x2*)(F.X3B() + (size_t)(row + r) * D) + lane;
#pragma unroll
            for (int j = 0; j < 4; ++j) xw[r][j] = xr[64 * j]; }
#pragma unroll
        for (int r = 0; r < 2; ++r)
#pragma unroll
            for (int a = 0; a < 2; ++a) { const bool tl = ntail > 0 && (pos[r][a] >> 8) >= 128;
                const u32x2* y = (const u32x2*)(F.YB() + (size_t)(tl ? 0 : pos[r][a]) * D) + lane;
#pragma unroll
                for (int j = 0; j < 4; ++j) yw[r][a][j] = y[64 * j]; }
#pragma unroll
        for (int r = 0; r < 2; ++r) {
#pragma unroll
            for (int j = 0; j < 4; ++j) { const u32x2 w3 = xw[r][j]; xv[r][j] = (f32x4){bflo(w3.x), bfhi(w3.x), bflo(w3.y), bfhi(w3.y)}; fa[r][j] = (f32x4){0.f, 0.f, 0.f, 0.f}; }
#pragma unroll
            for (int a = 0; a < 2; ++a) { const int ps = pos[r][a]; const int blk = ps >> 8;
                if (ntail > 0 && blk >= 128) {
#pragma unroll
                    for (int jp = 0; jp < 2; ++jp) {
                        const float* s0 = F.YBB() + (size_t)(((blk - 128) * 4 + 2 * jp) * spu) * 65536 + (size_t)(ps & 255) * 256 + 4 * lane; const float* s1 = s0 + (size_t)spu * 65536;
                        int q0 = 0;
                        for (; q0 + 7 <= spu; q0 += 7) { f32x4 t0[7], t1[7];
#pragma unroll
                            for (int q = 0; q < 7; ++q) { t0[q] = *(const f32x4*)(s0 + (size_t)(q0 + q) * 65536); t1[q] = *(const f32x4*)(s1 + (size_t)(q0 + q) * 65536); }
#pragma unroll
                            for (int q = 0; q < 7; ++q) { fa[r][2 * jp] = fa[r][2 * jp] + t0[q]; fa[r][2 * jp + 1] = fa[r][2 * jp + 1] + t1[q]; } }
                        for (; q0 < spu; ++q0) { fa[r][2 * jp] = fa[r][2 * jp] + *(const f32x4*)(s0 + (size_t)q0 * 65536); fa[r][2 * jp + 1] = fa[r][2 * jp + 1] + *(const f32x4*)(s1 + (size_t)q0 * 65536); } }
                } else {
#pragma unroll
                    for (int j = 0; j < 4; ++j) { const u32x2 w = yw[r][a][j]; fa[r][j] = fa[r][j] + (f32x4){bflo(w.x), bfhi(w.x), bflo(w.y), bfhi(w.y)}; } } } }
#pragma unroll
        for (int r = 0; r < 2; ++r) { f32x4 v[4]; float s = 0.f;
#pragma unroll
            for (int j = 0; j < 4; ++j) { v[j] = xv[r][j] + gv[j] * fa[r][j]; s += (v[j].x * v[j].x + v[j].y * v[j].y) + (v[j].z * v[j].z + v[j].w * v[j].w); }
            s = wave_sum(s); const float rs = rstd_of(s);
            f32x4* o = (f32x4*)(p.out + (size_t)(row + r) * D) + lane;
#pragma unroll
            for (int j = 0; j < 4; ++j) o[64 * j] = v[j] * rs * fg[j]; }
    }
}

template <class Desc, class Epi> __device__ __forceinline__ void run_gemm(Frame& F, const Desc& Dc, const Epi& E) {
    gemm_fast(F.lds, F.ws, Dc, E, F.c, F.G, F.wave);
}

__device__ __forceinline__ void phase_g1(Frame& F) {
    { DescG1a<false> d{F.XB(), F.WIN(), nullptr, 1024, 1024, 16, 128, 128}; EpiG1a<false> e{F.ROWSS(), F.BIAS_IN(), F.TABA(), F.TABB(), F.Q(), F.KN(), F.Gb(), F.GP(), F.KDT()}; run_gemm(F, d, e); }
    { DescG1a<true> d{F.XB(), F.WIN(), nullptr, 1024, 1024, 16, 128, 128}; EpiG1a<true> e{F.ROWSS(), F.BIAS_IN(), F.TABA(), F.TABB(), F.Q(), F.KN(), F.Gb(), F.GP(), F.KDT()}; run_gemm(F, d, e); }
    { DescG1b d{F.XB(), F.WIN(), nullptr, 1024, 1024, 16, 128, 128}; EpiG1b e{F.ROWSS(), F.BIAS_IN(), F.TABA(), F.TABB(), F.GP(), F.KDT(), F.VT()}; run_gemm(F, d, e); }
}
__device__ __forceinline__ void phase_kv(Frame& F) { DescKV d{F.VT(), F.KDT(), nullptr, T, T, 4, 128, 128}; EpiKV e{F.SB()}; run_gemm(F, d, e); }
__device__ __forceinline__ void phase_outproj(Frame& F) {
    DescOut d{F.Y(), F.WOUT(), nullptr, 2048, 2048, 32, 128, 128}; EpiResid<false> e{F.p.x, nullptr, F.XB(), F.ROWSS(), F.MOD() + 2 * 1024, nullptr, nullptr, 1.0f}; run_gemm(F, d, e); }
__device__ __forceinline__ void phase_ffn_up(Frame& F) {
    DescFfnUp d{F.XB(), F.WGU(), nullptr, 1024, 1024, 16, 128, 128}; EpiSwiglu<true, true> e{F.ROWSS(), nullptr, F.BIAS_GU(), F.H1(), DFF, 5632, 2 * 5632}; run_gemm(F, d, e);
    if (F.G == 256 && F.c >= 128) {
        frame_fresh(F); px_tables(F); px_gu_item(F, (F.c - 128) * NWAVE + F.wave, F.lane); __syncthreads(); } }
__device__ __forceinline__ void phase_ffn_down(Frame& F) {
    DescFfnDown d{F.H1(), F.WD(), nullptr, 64, 64, 22, 32768, 32768};     EpiResid<true> e{nullptr, F.XB(), F.XB(), F.ROWSS(), F.MOD() + 5 * 1024, nullptr, nullptr, 1.0f / (F8_DSCALE * F8_HSCALE)}; run_gemm(F, d, e); }
__device__ __forceinline__ void phase_moe_up(Frame& F) {
    DescMoeUp d{F.Gb(), F.WMGU(), F.BUFTOK(), 512, 512, 8, 128, 128, F.BLKE()};     EpiSwiglu<true, true> e{F.ROWSS(), F.BUFRS(), F.BIAS_MGU(), F.H1M(), DFE, 57344, 262144}; run_gemm(F, d, e); }
__device__ __forceinline__ void phase_moe_down(Frame& F) {
    DescMoeDown d{F.H1M(), F.WMD(), nullptr, 64, 64, 28, 32768, 32768, F.BLKE(), F.G}; EpiMoeDown e{F.BUFGATE(), F.YB(), F.YBB()}; run_gemm(F, d, e); }

#define XB_TMO      128
#define XB_XCNT(j)  (256  + 64 * (j))
#define XB_XSUB(j)  (1280 + 64 * (j))
#define XB_XGEN(j)  (2304 + 64 * (j))
#define XB_TOP      3328
#define XB_TOPGEN   3392
#define XCD_BAR_WORDS 3456
#define XB_SPIN_CAP (1u << 18)
__device__ __forceinline__ unsigned xb_ld(unsigned* p)              { return __hip_atomic_load(p, __ATOMIC_RELAXED, __HIP_MEMORY_SCOPE_AGENT); }
__device__ __forceinline__ unsigned xb_add(unsigned* p, unsigned v) { return __hip_atomic_fetch_add(p, v, __ATOMIC_RELAXED, __HIP_MEMORY_SCOPE_AGENT); }
__device__ __forceinline__ unsigned xb_xcc_id() { return (unsigned)__builtin_amdgcn_s_getreg((3 << 11) | 20) & 0xFu; }
#define XB_SPIN(cond, bar) do { unsigned _sp = 0; while (cond) { __builtin_amdgcn_s_sleep(1); \
    if ((++_sp & 255u) == 0u) { if (xb_ld(&(bar)[XB_TMO])) break; if (_sp > XB_SPIN_CAP) { atomicAdd(&(bar)[XB_TMO], 1u); break; } } } } while (0)
struct XcdBarrier { unsigned* bar; unsigned x; volatile LAS unsigned* st; int wave; };
__device__ __forceinline__ XcdBarrier xcd_barrier_post(unsigned* bar, volatile LAS unsigned* st, int wave) {
    XcdBarrier b; b.bar = bar; b.x = xb_xcc_id(); b.st = st; b.wave = wave;
    if (wave == 0 && lane_id() == 0) (void)xb_add(&bar[XB_XCNT(b.x)], 1u);
    return b;
}
__device__ __forceinline__ void xcd_barrier_complete(unsigned* bar, unsigned x, unsigned& nloc, unsigned& nx) {
    const unsigned G = gridDim.x * gridDim.y * gridDim.z;
    unsigned sum, cnt, mine, sp = 0u;
    for (;;) {
        sum = 0u; cnt = 0u; mine = 0u;
#pragma unroll
        for (unsigned j = 0; j < 16; ++j) { const unsigned c = xb_ld(&bar[XB_XCNT(j)]); sum += c; cnt += (c > 0u) ? 1u : 0u; mine = (j == x) ? c : mine; }
        if (sum == G) break;
        __builtin_amdgcn_s_sleep(1);
        if ((++sp & 255u) == 0u) { if (xb_ld(&bar[XB_TMO])) break; if (sp > XB_SPIN_CAP) { atomicAdd(&bar[XB_TMO], 1u); break; } }
    }
    nloc = mine > 0u ? mine : 1u; nx = cnt > 0u ? cnt : 1u;
}
__device__ __forceinline__ void xcd_barrier(const XcdBarrier& b) {
    asm volatile("s_waitcnt vmcnt(0)" ::: "memory");
    __syncthreads();
    if (b.wave == 0 && lane_id() == 0) {
        unsigned* bar = b.bar;
        __builtin_amdgcn_s_waitcnt(0);
        unsigned nloc = b.st[0], nx = b.st[1];
        if (nloc == 0u) { xcd_barrier_complete(bar, b.x, nloc, nx); b.st[0] = nloc; b.st[1] = nx; }
        const unsigned old = xb_add(&bar[XB_XSUB(b.x)], 1u);
        const unsigned gen = old / nloc;
        if (old + 1u == (gen + 1u) * nloc) {
            __builtin_amdgcn_fence(__ATOMIC_RELEASE, "agent");
            asm volatile("s_waitcnt vmcnt(0)" ::: "memory");
            const unsigned og = xb_add(&bar[XB_TOP], 1u);
            const unsigned tg = og / nx;
            if (og + 1u == (tg + 1u) * nx) xb_add(&bar[XB_TOPGEN], 1u);
            else XB_SPIN(xb_ld(&bar[XB_TOPGEN]) == tg, bar);
            __builtin_amdgcn_fence(__ATOMIC_ACQUIRE, "agent");
            xb_add(&bar[XB_XGEN(b.x)], 1u);
            asm volatile("s_waitcnt vmcnt(0)" ::: "memory");
        } else {
            XB_SPIN(xb_ld(&bar[XB_XGEN(b.x)]) == gen, bar);
            __builtin_amdgcn_fence(__ATOMIC_ACQUIRE, "agent");
            asm volatile("s_waitcnt vmcnt(0)" ::: "memory");
        }
    }
    __syncthreads();
}

constexpr int LDSCTL_OFF = 131072;
__global__ void __launch_bounds__(NTHR, 2) k_mega(Params p) {
    extern __shared__ __attribute__((aligned(16))) unsigned char lds_raw[];
    Frame F; frame_init(F, p, (LAS unsigned char*)lds_raw, (int)blockIdx.x, (int)gridDim.x);
    for (int u = F.tid; u < (LDS_BYTES - LDSCTL_OFF) / 4; u += NTHR) ((LAS unsigned*)(F.lds + LDSCTL_OFF))[u] = 0u;
    __syncthreads();
    const XcdBarrier bar = xcd_barrier_post((unsigned*)(p.ws + CT_BAR), (volatile LAS unsigned*)(F.lds + LDSCTL_OFF + 32), F.wave);
#define GRID_BAR() xcd_barrier(bar)

    frame_fresh(F); phase_p0(F); GRID_BAR();
    frame_fresh(F); phase_p1(F); GRID_BAR();
    frame_fresh(F); phase_g1(F); GRID_BAR();
    frame_fresh(F); phase_kv(F); GRID_BAR();
    frame_fresh(F); phase_scan(F); GRID_BAR();
    frame_fresh(F); phase_ret_fast(F); GRID_BAR();
    frame_fresh(F); phase_outproj(F); GRID_BAR();
    frame_fresh(F); phase_ffn_up(F); GRID_BAR();
    frame_fresh(F); phase_ffn_down(F); GRID_BAR();
    if ((F.c >> 3) & 1) { frame_fresh(F); phase_px(F); __syncthreads(); frame_fresh(F); phase_pool_fused(F); } else { frame_fresh(F); phase_pool_fused(F); frame_fresh(F); phase_px(F); }
    GRID_BAR();
    frame_fresh(F); phase_route2(F); GRID_BAR();
    frame_fresh(F); phase_moe_up(F); GRID_BAR();
    frame_fresh(F); phase_moe_down(F); GRID_BAR();
    frame_fresh(F); phase_final(F);
#undef GRID_BAR
}

extern "C" void kernel_launch(void* const* d_in, const int* in_sizes, int n_in, void* d_out, int out_size, void* d_ws, size_t ws_size, hipStream_t stream) {
    static int grid = 0;
    if (grid == 0) {
        if (n_in != 19 || out_size != T * D || ws_size < WS_END) { fprintf(stderr, "kernel_launch: unexpected shapes (n_in %d out %d ws %zu)\n", n_in, out_size, ws_size); grid = -1; return; }
        int dev = 0, cus = 0, per_cu = 0;
        if (hipGetDevice(&dev) != hipSuccess || hipDeviceGetAttribute(&cus, hipDeviceAttributeMultiprocessorCount, dev) != hipSuccess) { grid = -1; return; }
        if (hipFuncSetAttribute((const void*)k_mega, hipFuncAttributeMaxDynamicSharedMemorySize, LDS_BYTES) != hipSuccess) { fprintf(stderr, "kernel_launch: hipFuncSetAttribute failed\n"); grid = -1; return; }
        if (hipOccupancyMaxActiveBlocksPerMultiprocessor(&per_cu, (const void*)k_mega, NTHR, LDS_BYTES) != hipSuccess || per_cu < 1) { fprintf(stderr, "kernel_launch: occupancy query says %d blocks per CU\n", per_cu); (void)hipGetLastError(); grid = -1; return; }
        grid = cus * (per_cu < 1 ? 1 : 1);
    }
    if (grid < 0) return;
    Params p{};
    const float** pp = (const float**)&p;
    for (int i = 0; i < 19; ++i) pp[i] = (const float*)d_in[i];
    p.out = (float*)d_out; p.ws = (unsigned char*)d_ws;
    (void)hipMemsetAsync((char*)d_ws + WS_CTL, 0, 64 * KiB, stream);
    void* args[] = {&p};
    hipError_t e = hipLaunchCooperativeKernel((const void*)k_mega, dim3(grid), dim3(NTHR), args, LDS_BYTES, stream);
    if (e != hipSuccess) fprintf(stderr, "kernel_launch: cooperative launch failed: %s (grid %d)\n", hipGetErrorString(e), grid);
}
```

```cpp
#include <hip/hip_runtime.h>
#include <cstdio>

#define GAS __attribute__((address_space(1)))
#define LAS __attribute__((address_space(3)))
typedef unsigned short bf16_t;
typedef short bf16x8 __attribute__((ext_vector_type(8)));
typedef float f32x4 __attribute__((ext_vector_type(4)));
typedef float f32x2 __attribute__((ext_vector_type(2)));
typedef unsigned u32x4 __attribute__((ext_vector_type(4)));
typedef int i32x4 __attribute__((ext_vector_type(4)));
typedef unsigned u32x2 __attribute__((ext_vector_type(2)));

#ifndef FAST_GEMM
#define FAST_GEMM 1
#endif

constexpr int T = 16384, D = 1024, NH = 4, DK = 256, DV = 512, CH = 128, NCH = 128;
constexpr int NIN = 6144, DFF = 2816, NE = 8, DFE = 3584, CAP = 34816, NBLK = 136;
constexpr float EPS = 1e-6f;
constexpr int GPS = 260, RC = 256, NRC = 64;
constexpr int NTHR = 512, NWAVE = 8;

constexpr size_t KiB = 1024, MiB = 1u << 20;
constexpr size_t WS_CTL = 0, CTL_BYTES = 1 * MiB;
constexpr size_t CT_BAR = 16 * KiB;
constexpr size_t CT_MOD = 64 * KiB;
constexpr size_t CT_BIAS_R = 158 * KiB;
constexpr size_t WS_ROWSSP = 2 * MiB;
constexpr size_t WS_MODP = 3 * MiB;
constexpr size_t CT_BIAS_IN = 3584 * KiB;
constexpr size_t CT_BIAS_GU = 3584 * KiB + 96 * KiB;
constexpr size_t CT_BIAS_MGU = 36 * MiB + 512 * KiB;
constexpr size_t WS_TABA = 1 * MiB;
constexpr size_t WS_TABB = WS_TABA + 128 * KiB;
constexpr size_t WS_GP = WS_TABB + 128 * KiB;
constexpr size_t WS_WR = WS_GP + 8 * KiB;
constexpr size_t WS_TOPE = WS_WR + 32 * KiB;
constexpr size_t WS_TOPG = WS_TOPE + 128 * KiB;
constexpr size_t WS_CNT = WS_TOPG + 128 * KiB;
constexpr size_t WS_BUFTOK = WS_CNT + 8 * KiB;
constexpr size_t WS_BUFGATE = WS_BUFTOK + 136 * KiB;
constexpr size_t WS_POS = WS_BUFGATE + 136 * KiB;
constexpr size_t WS_BLKE = WS_POS + 128 * KiB;
constexpr size_t WS_RSTD3 = 256 * KiB;
constexpr size_t WS_BUFRS = 320 * KiB;
constexpr size_t WS_WIN = 4 * MiB;
constexpr size_t WS_WOUT = 16 * MiB;
constexpr size_t WS_WGU = 20 * MiB;
constexpr size_t WS_WD = 31 * MiB;
constexpr size_t WS_WP = 37 * MiB;
constexpr size_t WS_XB = 38 * MiB;
constexpr size_t WS_Q = 70 * MiB;
constexpr size_t WS_KN = 102 * MiB;
constexpr size_t WS_KDT = 134 * MiB;
constexpr size_t WS_VT = 166 * MiB;
constexpr size_t WS_G = 230 * MiB;
constexpr size_t WS_SB = 294 * MiB;
constexpr size_t WS_Y = 422 * MiB;
constexpr size_t WS_H1 = 70 * MiB;
constexpr size_t WS_PB = 158 * MiB;
constexpr size_t WS_X2 = 158 * MiB;
constexpr size_t WS_H1M = 70 * MiB;
constexpr size_t WS_WMGU = 308 * MiB;
constexpr size_t WS_WMD = 456 * MiB;
constexpr size_t WS_YB = 308 * MiB;
constexpr size_t WS_YBB = 4 * MiB;
constexpr size_t WS_XV8 = 358 * MiB;
constexpr size_t WS_END = 512 * MiB;
static_assert(WS_BUFRS + 136 * KiB <= WS_TABA && WS_BLKE + 4 * KiB <= WS_ROWSSP && WS_MODP + 8 * 12288 * 4 <= CT_BIAS_IN && CT_BIAS_GU + 4 * 5632 * 4 <= WS_WIN, "small region");
static_assert(WS_YBB + (size_t)224 * 65536 * 4 <= WS_H1M && WS_H1M + (size_t)CAP * DFE * 2 <= WS_WMGU && WS_YB + (size_t)CAP * D * 4 <= WS_WMD && WS_WMD + (size_t)NE * D * DFE * 2 <= WS_END, "moe map");
static_assert(WS_Y + (size_t)T * 2048 * 2 <= WS_END && WS_SB + (size_t)128 * 4 * 512 * 256 * 2 <= WS_Y, "ret map");

constexpr int LDS_BYTES = 147456;

struct Params {
    const float *x, *c, *ada_w, *ada_b, *norm_gain, *ret_w_in, *ret_gn_gain, *ret_w_out, *ffn_w_gate, *ffn_w_up, *ffn_w_down,
        *pool_w, *pool_b, *pool_scale, *moe_router, *moe_w_gate, *moe_w_up, *moe_w_down, *final_norm_gain;
    float* out; unsigned char* ws;
};

__device__ __forceinline__ unsigned f2bf(float f) { unsigned u = __builtin_bit_cast(unsigned, f); return (u + 0x7fffu + ((u >> 16) & 1u)) >> 16; }
typedef __bf16 bf16x2_t __attribute__((ext_vector_type(2)));
__device__ __forceinline__ unsigned pk2(float lo, float hi) { const f32x2 v = {lo, hi}; return __builtin_bit_cast(unsigned, __builtin_convertvector(v, bf16x2_t)); }
constexpr float F8_WSCALE = 32.0f, F8_DSCALE = 64.0f, F8_HSCALE = 4.0f, F8_YSCALE = 16.0f;
__device__ __forceinline__ unsigned pk4f8(float a, float b, float c, float d) { int w = __builtin_amdgcn_cvt_pk_fp8_f32(a, b, 0, false); w = __builtin_amdgcn_cvt_pk_fp8_f32(c, d, w, true); return (unsigned)w; }
__device__ __forceinline__ float bf2f(unsigned b) { return __builtin_bit_cast(float, b << 16); }
__device__ __forceinline__ float bflo(unsigned w) { return __builtin_bit_cast(float, w << 16); }
__device__ __forceinline__ float bfhi(unsigned w) { return __builtin_bit_cast(float, w & 0xffff0000u); }
__device__ __forceinline__ float silu_f(float v) { return v * __builtin_amdgcn_rcpf(1.0f + __expf(-v)); }
__device__ __forceinline__ float rstd_of(float ss) { return __builtin_amdgcn_rsqf(ss * (1.0f / 1024.0f) + EPS); }
__device__ __forceinline__ float rstd_row(const float* rssp, int t) {
    const f32x4* q = (const f32x4*)(rssp + (size_t)t * 16); const f32x4 a = q[0], b = q[1], c = q[2], d = q[3];
    const float s = (((a.x + a.y) + (a.z + a.w)) + ((b.x + b.y) + (b.z + b.w))) + (((c.x + c.y) + (c.z + c.w)) + ((d.x + d.y) + (d.z + d.w)));
    return __builtin_amdgcn_rsqf(s * (1.0f / 1024.0f) + EPS);
}
__device__ __forceinline__ float wave_sum(float v) {
#pragma unroll
    for (int o = 1; o < 64; o <<= 1) v += __shfl_xor(v, o);
    return v;
}
__device__ __forceinline__ float ldv_f(const float* p) { return __builtin_bit_cast(float, __hip_atomic_load((const unsigned*)p, __ATOMIC_RELAXED, __HIP_MEMORY_SCOPE_AGENT)); }
__device__ __forceinline__ int ldv_i(const int* p) { return __hip_atomic_load(p, __ATOMIC_RELAXED, __HIP_MEMORY_SCOPE_AGENT); }
__device__ __forceinline__ float bias_sum(const float* b, int idx, int s1, int s2) { return (ldv_f(b + idx) + ldv_f(b + s1 + idx)) + (ldv_f(b + s2 + idx) + ldv_f(b + s2 + s1 + idx)); }
__device__ __forceinline__ void rstd_row_ld(const float* rssp, int t, float (&r)[16]) { const f32x4* q = (const f32x4*)(rssp + (size_t)t * 16);
#pragma unroll
    for (int i = 0; i < 4; ++i) { const f32x4 v = q[i]; r[4 * i] = v.x; r[4 * i + 1] = v.y; r[4 * i + 2] = v.z; r[4 * i + 3] = v.w; } }
__device__ __forceinline__ float rstd_row_fin(const float (&r)[16]) {
    const float s = (((r[0] + r[1]) + (r[2] + r[3])) + ((r[4] + r[5]) + (r[6] + r[7]))) + (((r[8] + r[9]) + (r[10] + r[11])) + ((r[12] + r[13]) + (r[14] + r[15])));
    return __builtin_amdgcn_rsqf(s * (1.0f / 1024.0f) + EPS); }
__device__ __forceinline__ void bias_sum_ld(const float* b, int idx, int s1, int s2, float (&r)[16]) { r[0] = ldv_f(b + idx); r[1] = ldv_f(b + s1 + idx); r[2] = ldv_f(b + s2 + idx); r[3] = ldv_f(b + s2 + s1 + idx); }
__device__ __forceinline__ float bias_sum_fin(const float (&r)[16]) { return (r[0] + r[1]) + (r[2] + r[3]); }

__device__ __forceinline__ int lane_id() { int l; asm volatile("v_mbcnt_lo_u32_b32 %0, -1, 0\n\tv_mbcnt_hi_u32_b32 %0, -1, %0" : "=v"(l)); return l; }

struct Unit { const bf16_t* A; const bf16_t* B; int pm, pn, aux, rowbase, nt; };

__device__ __forceinline__ void tile_order(int L, int nM, int nN, int& pm, int& pn) {
    const int nwg = nM * nN; int wgid = L;
    { const int q = nwg / 8, r = nwg % 8, xcd = wgid % 8, off = wgid / 8; wgid = (xcd < r ? xcd * (q + 1) : r * (q + 1) + (xcd - r) * q) + off; }
    const int nig = 8 * nN, gid = wgid / nig, fm = gid * 8, gsz = (nM - fm) < 8 ? (nM - fm) : 8;
    pm = fm + ((wgid % nig) % gsz); pn = (wgid % nig) / gsz;
}

template <bool GATE> struct DescG1a {
    static constexpr bool GATHER = false; static constexpr bool FP8 = false;
    const bf16_t* xb; const bf16_t* win; const int* tok; int lda, ldb, nt, ksa, ksb;
    __device__ __forceinline__ bool get(int L, Unit& u) const {
        if (L >= 64 * 8) return false; tile_order(L, 64, 8, u.pm, u.pn); if (GATE) u.pn += 8; else if (u.pm & 1) u.pn ^= 4;
        const int wrow = u.pn < 8 ? u.pn * 256 : (u.pn + 8) * 256;
        u.A = xb + (size_t)u.pm * 256 * 1024; u.B = win + (size_t)wrow * 1024; u.aux = wrow; u.rowbase = u.pm * 256; u.nt = nt; return true; }
};
struct DescG1b {
    static constexpr bool GATHER = false; static constexpr bool FP8 = false;
    const bf16_t* xb; const bf16_t* win; const int* tok; int lda, ldb, nt, ksa, ksb;
    __device__ __forceinline__ bool get(int L, Unit& u) const {
        if (L >= 8 * 64) return false; tile_order(L, 8, 64, u.pm, u.pn); u.pm += 4;
        u.A = win + (size_t)(1024 + 256 * u.pm) * 1024; u.B = xb + (size_t)u.pn * 256 * 1024; u.aux = 0; u.rowbase = 0; u.nt = nt; return true; }
};
struct DescG1b8 {
    static constexpr bool GATHER = false; static constexpr bool FP8 = true;
    const bf16_t* xv8; const bf16_t* win8; const int* tok; int lda, ldb, nt, ksa, ksb;
    __device__ __forceinline__ bool get(int L, Unit& u) const {
        if (L >= 8 * 64) return false; tile_order(L, 8, 64, u.pm, u.pn); u.pm += 4;
        u.A = win8 + (size_t)(256 * (u.pm - 4)) * 512; u.B = xv8 + (size_t)u.pn * 256 * 512; u.aux = 0; u.rowbase = 0; u.nt = nt; return true; }
};
struct DescKV {
    static constexpr bool GATHER = false; static constexpr bool FP8 = false;
    const bf16_t* vt; const bf16_t* kdt; const int* tok; int lda, ldb, nt, ksa, ksb;
    __device__ __forceinline__ bool get(int L, Unit& u) const {
        if (L >= (NRC - 1) * 8) return false; const int mt = L & 1, h = (L >> 1) & 3, n = L >> 3;
        u.A = vt + (size_t)(h * 512 + 256 * mt) * T + n * RC; u.B = kdt + (size_t)(h * 256) * T + n * RC;
        u.pm = mt; u.pn = 0; u.aux = (n * 4 + h) * 2 + mt; u.rowbase = 0; u.nt = nt; return true; }
};
struct DescOut {
    static constexpr bool GATHER = false; static constexpr bool FP8 = false;
    const bf16_t* y; const bf16_t* w; const int* tok; int lda, ldb, nt, ksa, ksb;
    __device__ __forceinline__ bool get(int L, Unit& u) const {
        if (L >= 256) return false; tile_order(L, 64, 4, u.pm, u.pn);
        u.A = y + (size_t)u.pm * 256 * 2048; u.B = w + (size_t)u.pn * 256 * 2048; u.aux = 0; u.rowbase = u.pm * 256; u.nt = nt; return true; }
};
struct DescFfnUp {
    static constexpr bool GATHER = false; static constexpr bool FP8 = false;
    const bf16_t* xb; const bf16_t* w; const int* tok; int lda, ldb, nt, ksa, ksb;
    __device__ __forceinline__ bool get(int L, Unit& u) const {
        if (L >= 64 * 22) return false; tile_order(L, 64, 22, u.pm, u.pn);
        u.A = xb + (size_t)u.pm * 256 * 1024; u.B = w + (size_t)u.pn * 256 * 1024; u.aux = 256 * u.pn; u.rowbase = u.pm * 256; u.nt = nt; return true; }
};
struct DescFfnDown {
    static constexpr bool GATHER = false; static constexpr bool FP8 = true;
    const bf16_t* h1; const bf16_t* w; const int* tok; int lda, ldb, nt, ksa, ksb;
    __device__ __forceinline__ bool get(int L, Unit& u) const {
        if (L >= 256) return false; tile_order(L, 64, 4, u.pm, u.pn);
        u.A = h1 + (size_t)u.pm * 128 * DFF; u.B = w + (size_t)u.pn * 128 * DFF; u.aux = 0; u.rowbase = u.pm * 256; u.nt = nt; return true; }
};
struct DescMoeUp {
    static constexpr bool GATHER = true; static constexpr bool FP8 = true;
    const bf16_t* xb; const bf16_t* w; const int* tok; int lda, ldb, nt, ksa, ksb; const int* blke;
    __device__ __forceinline__ bool get(int L, Unit& u) const {
        const int nused = ldv_i(blke + NBLK); if (L >= nused * 28) return false; tile_order(L, nused, 28, u.pm, u.pn);
        const int e = ldv_i(blke + u.pm);
        u.A = xb; u.B = w + (size_t)(e * 7168 + 256 * u.pn) * 512; u.aux = e * 7168 + 256 * u.pn; u.rowbase = u.pm * 256; u.nt = nt; return true; }
};
__device__ __forceinline__ int moe_tail_spu(int ntail) { const int q = 256 / ntail; return q >= 7 ? 7 : 2; }
struct DescMoeDown {
    static constexpr bool GATHER = false; static constexpr bool FP8 = true;
    const bf16_t* h1; const bf16_t* w; const int* tok; int lda, ldb, nt, ksa, ksb; const int* blke; int G;
    __device__ __forceinline__ bool get(int L, Unit& u) const {
        const int nused = ldv_i(blke + NBLK); int k0 = 0, npair = 14; u.aux = 0;
        if (G != 256) { if (L >= nused * 4) return false; tile_order(L, nused, 4, u.pm, u.pn); }
        else { const int i = L >> 8, c = L & 255;
            if (i < 2) { const int x = c & 7, j = c >> 3; u.pm = (i * 8 + x) * 8 + (j & 7); u.pn = j >> 3; }
            else { const int ntail = (nused - 128) * 4; if (i > 2 || ntail <= 0) return false; const int spu = moe_tail_spu(ntail); if (c >= ntail * spu) return false;
                const int ut = c / spu, sl = c - ut * spu; u.pm = 128 + (ut >> 2); u.pn = ut & 3; npair = 14 / spu; k0 = sl * npair; u.aux = 1 + c; } }
        const int e = ldv_i(blke + u.pm);
        u.A = h1 + (size_t)u.pm * 128 * DFE + (size_t)k0 * 2 * 16384; u.B = w + (size_t)(e * 4 + u.pn) * 128 * DFE + (size_t)k0 * 2 * 16384;
        u.rowbase = u.pm * 256; u.nt = 2 * npair; return true; }
};

typedef f32x4 Acc[2][2][4][2];

__device__ __forceinline__ void store8bf(bf16_t* p, const float* v) {
    u32x4 w; w.x = pk2(v[0], v[1]); w.y = pk2(v[2], v[3]); w.z = pk2(v[4], v[5]); w.w = pk2(v[6], v[7]); *(u32x4*)p = w; }

template <bool GATE> struct EpiG1a {
    static constexpr bool PERM = true;
    const float* rowss; const float* bias; const f32x2* taba; const f32x2* tabb; bf16_t* Q; bf16_t* KN; bf16_t* Gb; const float* gp; bf16_t* KDT;
    __device__ __forceinline__ void pre_load(const Unit& u, int tid, float (&r)[16]) const { if (tid < 256) r[0] = ldv_f(rowss + (size_t)(u.pm * 256 + tid) * 16); else bias_sum_ld(bias, u.aux + tid - 256, NIN, 2 * NIN, r); }
    __device__ __forceinline__ void pre_store(const Unit&, LAS float* aux, int tid, const float (&r)[16]) const { aux[tid] = tid < 256 ? rstd_of(r[0]) : bias_sum_fin(r); }
    __device__ __forceinline__ void init(LAS float* auxb, int tid) const {
        if (!GATE && tid < 256) { const float v = ((const float*)tabb)[16 * 256 + tid]; auxb[512 + tid] = v; auxb[768 + 512 + tid] = v; } }
    __device__ __forceinline__ void operator()(const Acc& acc, const Unit& u, int wr, int wc, int fr, int fq, const LAS float* aux) const {
        asm volatile("" : "+v"(fr), "+v"(fq));
        const int pn = u.pn, d0 = wc * 32 + 8 * fq;
        float b[2][8];
#pragma unroll
        for (int bj = 0; bj < 2; ++bj) { const f32x4 x = *(const LAS f32x4*)(aux + 256 + 128 * bj + d0), y = *(const LAS f32x4*)(aux + 256 + 128 * bj + d0 + 4);
            b[bj][0] = x.x; b[bj][1] = x.y; b[bj][2] = x.z; b[bj][3] = x.w; b[bj][4] = y.x; b[bj][5] = y.y; b[bj][6] = y.z; b[bj][7] = y.w; }
        if constexpr (!GATE) {
            bf16_t* O = pn < 4 ? Q : KN; const int hcol = (pn & 3) * 256;
            f32x2 ta[8], tn[8], tb[8]; float dec[4];
            { const f32x2* tp0 = taba + (2 * u.pm) * 128 + d0; const f32x2* tpb = tabb + (64 * wr + fr) * 128 + d0;
#pragma unroll
              for (int q = 0; q < 8; ++q) { ta[q] = tp0[q]; tb[q] = tpb[q]; }
#pragma unroll
              for (int m = 0; m < 4; ++m) dec[m] = pn >= 4 ? gp[(pn - 4) * GPS + 127 - (64 * wr + 16 * m + fr)] : 0.f; }
            const float c128 = pn >= 4 ? gp[(pn - 4) * GPS + 128] : 0.f;
#pragma unroll
            for (int it = 0; it < 8; ++it) {
                const int ai = it >> 2, m = ai ? 3 - (it & 3) : (it & 3);
                if (it == 2) { const f32x2* tp1 = taba + (2 * u.pm + 1) * 128 + d0;
#pragma unroll
                    for (int q = 0; q < 8; ++q) tn[q] = tp1[q]; }
                if (it == 4) {
#pragma unroll
                    for (int q = 0; q < 8; ++q) ta[q] = tn[q]; }
                if ((it & 3) != 0) {
                    const float sg = ai ? -1.0f : 1.0f; int dl = 2 * d0; asm volatile("" : "+v"(dl));
#pragma unroll
                    for (int q2 = 0; q2 < 4; ++q2) { const f32x4 R2 = *(const LAS f32x4*)(aux + 512 + dl + 4 * q2);
                        { const f32x2 B = tb[2 * q2]; const float ry = sg * R2.y; tb[2 * q2].x = B.x * R2.x - B.y * ry; tb[2 * q2].y = B.y * R2.x + B.x * ry; }
                        { const f32x2 B = tb[2 * q2 + 1]; const float rw = sg * R2.w; tb[2 * q2 + 1].x = B.x * R2.z - B.y * rw; tb[2 * q2 + 1].y = B.y * R2.z + B.x * rw; } } }
                const int rl = 128 * ai + 64 * wr + 16 * m + fr, t = u.pm * 256 + rl; const float rs = aux[rl];
                float o1[8], o2[8];
#pragma unroll
                for (int q = 0; q < 8; ++q) {
                    const f32x2 A = ta[q], B = tb[q]; const float cs = A.x * B.x - A.y * B.y, sn = A.y * B.x + A.x * B.y;
                    const float v1 = rs * acc[ai][0][m][q >> 2][q & 3] + b[0][q], v2 = rs * acc[ai][1][m][q >> 2][q & 3] + b[1][q];
                    o1[q] = v1 * cs - v2 * sn; o2[q] = v1 * sn + v2 * cs; }
                store8bf(O + (size_t)t * 1024 + hcol + d0, o1); store8bf(O + (size_t)t * 1024 + hcol + 128 + d0, o2);
                if (pn >= 4) {
                    bf16_t* kd = KDT + (size_t)(hcol + d0) * T + t;
                    const float dk = ai ? dec[m] : dec[m] * c128;
#pragma unroll
                    for (int q = 0; q < 8; ++q) { kd[(size_t)q * T] = (bf16_t)(pk2(o1[q] * dk, 0.f) & 0xffffu); kd[(size_t)(128 + q) * T] = (bf16_t)(pk2(o2[q] * dk, 0.f) & 0xffffu); } }
            }
        } else {
#pragma unroll
            for (int ai = 0; ai < 2; ++ai)
#pragma unroll
                for (int m = 0; m < 4; ++m) {
                    const int rl = 128 * ai + 64 * wr + 16 * m + fr, t = u.pm * 256 + rl; const float rs = aux[rl];
#pragma unroll
                    for (int bj = 0; bj < 2; ++bj) { float o[8];
#pragma unroll
                        for (int q = 0; q < 8; ++q) o[q] = silu_f(rs * acc[ai][bj][m][q >> 2][q & 3] + b[bj][q]);
                        store8bf(Gb + (size_t)t * 2048 + (pn - 8) * 256 + 128 * bj + d0, o); }
                }
        }
    }
};
struct EpiG1b {
    static constexpr bool PERM = true;
    const float* rowss; const float* bias; const f32x2* taba; const f32x2* tabb; const float* gp; bf16_t* KDT; bf16_t* VT; float rsc;
    __device__ __forceinline__ void pre_load(const Unit& u, int tid, float (&r)[16]) const { if (tid < 256) bias_sum_ld(bias, 1024 + 256 * u.pm + tid, NIN, 2 * NIN, r); else r[0] = ldv_f(rowss + (size_t)(u.pn * 256 + tid - 256) * 16); }
    __device__ __forceinline__ void pre_store(const Unit&, LAS float* aux, int tid, const float (&r)[16]) const { aux[tid] = tid < 256 ? bias_sum_fin(r) : rstd_of(r[0]) * rsc; }
    __device__ __forceinline__ void init(LAS float*, int) const {}
    __device__ __forceinline__ void operator()(const Acc& acc, const Unit& u, int wr, int wc, int fr, int fq, const LAS float* aux) const {
        asm volatile("" : "+v"(fr), "+v"(fq));
        const int pmf = u.pm, tl0 = 32 * wc + 8 * fq, tk0 = u.pn * 256 + tl0;
        float rs[2][8];
#pragma unroll
        for (int bj = 0; bj < 2; ++bj) { const f32x4 x = *(const LAS f32x4*)(aux + 256 + 128 * bj + tl0), y = *(const LAS f32x4*)(aux + 256 + 128 * bj + tl0 + 4);
            rs[bj][0] = x.x; rs[bj][1] = x.y; rs[bj][2] = x.z; rs[bj][3] = x.w; rs[bj][4] = y.x; rs[bj][5] = y.y; rs[bj][6] = y.z; rs[bj][7] = y.w; }
        if (pmf < 4) {
            const int h = pmf;
#pragma unroll
            for (int m = 0; m < 4; ++m) {
                const int d = 64 * wr + 16 * m + fr; const float b1 = aux[d], b2 = aux[128 + d];
#pragma unroll
                for (int bj = 0; bj < 2; ++bj) { float o1[8], o2[8]; const f32x2 A = taba[(2 * u.pn + bj) * 128 + d]; const float4 dq0 = *(const float4*)(gp + h * GPS + 120 - tl0), dq1 = *(const float4*)(gp + h * GPS + 124 - tl0);
                    const float decs[8] = {dq1.w, dq1.z, dq1.y, dq1.x, dq0.w, dq0.z, dq0.y, dq0.x};
#pragma unroll
                    for (int q = 0; q < 8; ++q) { const f32x2 B = tabb[(tl0 + q) * 128 + d]; const float cs = A.x * B.x - A.y * B.y, sn = A.y * B.x + A.x * B.y;
                        const float v1 = rs[bj][q] * acc[0][bj][m][q >> 2][q & 3] + b1, v2 = rs[bj][q] * acc[1][bj][m][q >> 2][q & 3] + b2;
                        o1[q] = (v1 * cs - v2 * sn) * decs[q]; o2[q] = (v1 * sn + v2 * cs) * decs[q]; }
                    store8bf(KDT + (size_t)(256 * h + d) * T + tk0 + 128 * bj, o1); store8bf(KDT + (size_t)(256 * h + 128 + d) * T + tk0 + 128 * bj, o2); }
            }
        } else {
#pragma unroll
            for (int ai = 0; ai < 2; ++ai)
#pragma unroll
                for (int m = 0; m < 4; ++m) {
                    const int rl = 128 * ai + 64 * wr + 16 * m + fr, f = 256 * (pmf - 4) + rl; const float bs = aux[rl];
#pragma unroll
                    for (int bj = 0; bj < 2; ++bj) { float o[8];
#pragma unroll
                        for (int q = 0; q < 8; ++q) o[q] = rs[bj][q] * acc[ai][bj][m][q >> 2][q & 3] + bs;
                        store8bf(VT + (size_t)f * T + tk0 + 128 * bj, o); }
                }
        }
    }
};
struct EpiKV {
    static constexpr bool PERM = true;
    bf16_t* SB;
    __device__ __forceinline__ void pre_load(const Unit&, int, float (&)[16]) const {}
    __device__ __forceinline__ void pre_store(const Unit&, LAS float*, int, const float (&)[16]) const {}
    __device__ __forceinline__ void init(LAS float*, int) const {}
    __device__ __forceinline__ void operator()(const Acc& acc, const Unit& u, int wr, int wc, int fr, int fq, const LAS float*) const {
        asm volatile("" : "+v"(fr), "+v"(fq));
        const int mt = u.aux & 1, nh = u.aux >> 1; bf16_t* base = SB + ((size_t)nh * 512 + 256 * mt) * 256; const int d0 = wc * 32 + 8 * fq;
#pragma unroll
        for (int ai = 0; ai < 2; ++ai)
#pragma unroll
            for (int m = 0; m < 4; ++m) { const int r = 128 * ai + 64 * wr + 16 * m + fr;
#pragma unroll
                for (int bj = 0; bj < 2; ++bj) { float o[8];
#pragma unroll
                    for (int q = 0; q < 8; ++q) o[q] = acc[ai][bj][m][q >> 2][q & 3];
                    store8bf(base + (size_t)r * 256 + 128 * bj + d0, o); } }
    }
};
template <bool BASEB> struct EpiResid {
    static constexpr bool PERM = true;
    const float* base; const bf16_t* baseb; bf16_t* xb; float* rowss; const float* g; const float* cb; const float* cs; float accscale;
    __device__ __forceinline__ void pre_load(const Unit& u, int tid, float (&r)[16]) const {
        if (tid < 256) { const int c = 256 * u.pn + tid; r[0] = ldv_f(g + c); r[1] = cs ? cs[c] : 1.0f; } else { const int c = 256 * u.pn + tid - 256; r[0] = cb ? cb[c] : 0.f; r[1] = 1.0f; } }
    __device__ __forceinline__ void pre_store(const Unit&, LAS float* aux, int tid, const float (&r)[16]) const { aux[256 + tid] = r[0] * r[1] * (tid < 256 ? accscale : 1.0f); }
    __device__ __forceinline__ void init(LAS float*, int) const {}
    __device__ __forceinline__ void operator()(const Acc& acc, const Unit& u, int wr, int wc, int fr, int fq, const LAS float* aux) const {
        asm volatile("" : "+v"(fr), "+v"(fq));
        const int d0 = 32 * wc + 8 * fq, col0 = 256 * u.pn + d0;
        f32x4 gv[2][2], cbv[2][2];
#pragma unroll
        for (int bj = 0; bj < 2; ++bj)
#pragma unroll
            for (int n = 0; n < 2; ++n) { gv[bj][n] = *(const LAS f32x4*)(aux + 256 + d0 + 128 * bj + 4 * n); cbv[bj][n] = *(const LAS f32x4*)(aux + 512 + d0 + 128 * bj + 4 * n); }
        f32x4 bsv[2][4];
        const size_t o0 = (size_t)(u.pm * 256 + 64 * wr + fr) * 1024 + col0;
#define ER_LOADB(dst, off) do { if constexpr (BASEB) { const u32x4 _w = *(const u32x4*)(baseb + (off)); dst[0] = (f32x4){bflo(_w.x), bfhi(_w.x), bflo(_w.y), bfhi(_w.y)}; dst[1] = (f32x4){bflo(_w.z), bfhi(_w.z), bflo(_w.w), bfhi(_w.w)}; } \
            else { dst[0] = *(const f32x4*)(base + (off)); dst[1] = *(const f32x4*)(base + (off) + 4); } } while (0)
#pragma unroll
        for (int bj = 0; bj < 2; ++bj) ER_LOADB((&bsv[0][2 * bj]), o0 + 128 * bj);
#pragma unroll
        for (int it = 0; it < 8; ++it) { const int ai = it >> 2, m = it & 3; const int t = u.pm * 256 + 128 * ai + 64 * wr + 16 * m + fr; float s = 0.f;
            if (it < 7) { const int ai2 = (it + 1) >> 2, m2 = (it + 1) & 3; const size_t o2 = o0 + (size_t)(128 * ai2 + 16 * m2) * 1024;
#pragma unroll
                for (int bj = 0; bj < 2; ++bj) ER_LOADB((&bsv[(it + 1) & 1][2 * bj]), o2 + 128 * bj); }
#pragma unroll
            for (int bj = 0; bj < 2; ++bj) { const size_t o = (size_t)t * 1024 + col0 + 128 * bj; f32x4 xo[2];
#pragma unroll
                for (int n = 0; n < 2; ++n) { xo[n] = bsv[it & 1][2 * bj + n] + (acc[ai][bj][m][n] + cbv[bj][n]) * gv[bj][n];
                    s += (xo[n].x * xo[n].x + xo[n].y * xo[n].y) + (xo[n].z * xo[n].z + xo[n].w * xo[n].w); }
                u32x4 w; w.x = pk2(xo[0].x, xo[0].y); w.y = pk2(xo[0].z, xo[0].w); w.z = pk2(xo[1].x, xo[1].y); w.w = pk2(xo[1].z, xo[1].w); *(u32x4*)(xb + o) = w; }
            s += __shfl_xor(s, 16); s += __shfl_xor(s, 32);
            if (fq == 0) rowss[(size_t)t * 16 + u.pn * 4 + wc] = s; }
    }
#undef ER_LOADB
};
template <bool TILED, bool F8OUT = false> struct EpiSwiglu {
    static constexpr bool PERM = true;
    const float* rowss; const float* rowrs; const float* bias; bf16_t* Hout; int ldh, bs1, bs2;
    __device__ __forceinline__ void pre_load(const Unit& u, int tid, float (&r)[16]) const {
        if (tid < 256) { if (rowrs) r[0] = ldv_f(rowrs + u.rowbase + tid); else rstd_row_ld(rowss, u.rowbase + tid, r); } else bias_sum_ld(bias, u.aux + tid - 256, bs1, bs2, r); }
    __device__ __forceinline__ void pre_store(const Unit&, LAS float* aux, int tid, const float (&r)[16]) const { aux[tid] = tid < 256 ? (rowrs ? r[0] : rstd_row_fin(r)) : bias_sum_fin(r); }
    __device__ __forceinline__ void init(LAS float*, int) const {}
    __device__ __forceinline__ void operator()(const Acc& acc, const Unit& u, int wr, int wc, int fr, int fq, const LAS float* aux) const {
        asm volatile("" : "+v"(fr), "+v"(fq));
        const int d0 = wc * 32 + 8 * fq; float bg[8], bu[8];
        { const f32x4 x = *(const LAS f32x4*)(aux + 256 + d0), y = *(const LAS f32x4*)(aux + 256 + d0 + 4), z = *(const LAS f32x4*)(aux + 384 + d0), w = *(const LAS f32x4*)(aux + 384 + d0 + 4);
          bg[0] = x.x; bg[1] = x.y; bg[2] = x.z; bg[3] = x.w; bg[4] = y.x; bg[5] = y.y; bg[6] = y.z; bg[7] = y.w; bu[0] = z.x; bu[1] = z.y; bu[2] = z.z; bu[3] = z.w; bu[4] = w.x; bu[5] = w.y; bu[6] = w.z; bu[7] = w.w; }
        constexpr float KG = -1.4426950408889634f, KU = -0.6931471805599453f * (F8OUT ? F8_HSCALE : 1.0f);
#pragma unroll
        for (int q = 0; q < 8; ++q) { bg[q] *= KG; bu[q] *= KU; }
#pragma unroll
        for (int ai = 0; ai < 2; ++ai)
#pragma unroll
            for (int m = 0; m < 4; ++m) { const int rl = 128 * ai + 64 * wr + 16 * m + fr, row = u.rowbase + rl; const float rs = aux[rl], rsg = rs * KG, rsu = rs * KU; float o[8];
#pragma unroll
                for (int q = 0; q < 8; q += 2) {
                    const f32x2 ag = {acc[ai][0][m][q >> 2][q & 3], acc[ai][0][m][q >> 2][(q & 3) + 1]}, au = {acc[ai][1][m][q >> 2][q & 3], acc[ai][1][m][q >> 2][(q & 3) + 1]};
                    const f32x2 x = ag * rsg + (f32x2){bg[q], bg[q + 1]}, y = au * rsu + (f32x2){bu[q], bu[q + 1]};
                    const f32x2 dn = (f32x2){__builtin_amdgcn_exp2f(x.x), __builtin_amdgcn_exp2f(x.y)} + 1.0f;
                    const f32x2 r = {__builtin_amdgcn_rcpf(dn.x), __builtin_amdgcn_rcpf(dn.y)};
                    const f32x2 ov = (x * r) * y; o[q] = ov.x; o[q + 1] = ov.y; }
                if constexpr (F8OUT) {
#pragma unroll
                    for (int q = 0; q < 8; ++q) o[q] = __builtin_amdgcn_fmed3f(o[q], -448.0f, 448.0f);
                    u32x2 w8; w8.x = pk4f8(o[0], o[1], o[2], o[3]); w8.y = pk4f8(o[4], o[5], o[6], o[7]);
                    if (TILED) *(u32x2*)((unsigned char*)Hout + (((size_t)(row >> 8) * (ldh >> 7) + u.pn) * 256 + (row & 255)) * 128 + d0) = w8;
                    else *(u32x2*)((unsigned char*)Hout + (size_t)row * ldh + 128 * u.pn + d0) = w8; }
                else if (TILED) store8bf(Hout + (((size_t)(row >> 8) * (ldh >> 6) + 2 * u.pn + (d0 >> 6)) * 256 + (row & 255)) * 64 + (d0 & 63), o);
                else store8bf(Hout + (size_t)row * ldh + 128 * u.pn + d0, o); }
    }
};
struct EpiMoeDown {
    static constexpr bool PERM = true;
    const float* gate; bf16_t* YB; float* YBB;
    __device__ __forceinline__ void pre_load(const Unit& u, int tid, float (&r)[16]) const { if (tid < 256) r[0] = ldv_f(gate + u.rowbase + tid); }
    __device__ __forceinline__ void pre_store(const Unit&, LAS float* aux, int tid, const float (&r)[16]) const { if (tid < 256) aux[tid] = r[0] * (1.0f / (F8_DSCALE * F8_HSCALE)); }
    __device__ __forceinline__ void init(LAS float*, int) const {}
    __device__ __forceinline__ void operator()(const Acc& acc, const Unit& u, int wr, int wc, int fr, int fq, const LAS float* aux) const {
        asm volatile("" : "+v"(fr), "+v"(fq));
        const int col0 = 256 * u.pn + 32 * wc + 8 * fq;
#pragma unroll
        for (int ai = 0; ai < 2; ++ai)
#pragma unroll
            for (int m = 0; m < 4; ++m) { const int rl = 128 * ai + 64 * wr + 16 * m + fr, row = u.rowbase + rl; const float gt = aux[rl];
#pragma unroll
                for (int bj = 0; bj < 2; ++bj) {
                    if (u.aux == 0) {
                        const f32x4 o0 = acc[ai][bj][m][0] * (gt * F8_YSCALE), o1 = acc[ai][bj][m][1] * (gt * F8_YSCALE); u32x2 w8;
                        w8.x = pk4f8(__builtin_amdgcn_fmed3f(o0.x, -448.f, 448.f), __builtin_amdgcn_fmed3f(o0.y, -448.f, 448.f), __builtin_amdgcn_fmed3f(o0.z, -448.f, 448.f), __builtin_amdgcn_fmed3f(o0.w, -448.f, 448.f));
                        w8.y = pk4f8(__builtin_amdgcn_fmed3f(o1.x, -448.f, 448.f), __builtin_amdgcn_fmed3f(o1.y, -448.f, 448.f), __builtin_amdgcn_fmed3f(o1.z, -448.f, 448.f), __builtin_amdgcn_fmed3f(o1.w, -448.f, 448.f));
                        *(u32x2*)((unsigned char*)YB + (size_t)row * 1024 + col0 + 128 * bj) = w8; }
                    else { const f32x4 p0 = acc[ai][bj][m][0] * gt, p1 = acc[ai][bj][m][1] * gt; const float pv[8] = {p0.x, p0.y, p0.z, p0.w, p1.x, p1.y, p1.z, p1.w};
                        store8bf((bf16_t*)YBB + (size_t)(u.aux - 1) * 65536 + (size_t)rl * 256 + 32 * wc + 8 * fq + 128 * bj, pv); } } }
    }
};

namespace pg8 {
constexpr int BM = 256, BK = 64, HALF = 128, HTB = HALF * BK * 2, STAGE_BYTES = 8 * HTB;
__device__ __forceinline__ int lds_byte(int r, int c) { const int st = (r >> 4) * 2 + (c >> 5), rr = r & 15, cc = c & 31, ob = rr * 64 + cc * 2; return st * 1024 + (ob ^ (((ob >> 9) & 1) << 5)); }
__device__ __forceinline__ void stage_rc(int b, int& R, int& C) { const int st = b / 1024, sb = b % 1024, swz = sb ^ (((sb >> 9) & 1) << 5); R = (st >> 1) * 16 + swz / 64; C = (st & 1) * 32 + (swz % 64) / 2; }
__device__ __forceinline__ int perm32(int rho) { const int n = rho >> 4, i = rho & 15; return 8 * (i >> 2) + 4 * n + (i & 3); }
}
typedef int i32x8 __attribute__((ext_vector_type(8)));
__device__ __forceinline__ void mfma_f8_inplace(f32x4& acc, const i32x8 a, const i32x8 b, int sc) {
    asm volatile("v_mfma_scale_f32_16x16x128_f8f6f4 %0, %1, %2, %0, %3, %3 op_sel_hi:[0,0,0]" : "+v"(acc) : "v"(a), "v"(b), "v"(sc)); }
__device__ __forceinline__ void mfma_f8_first(f32x4& acc, const i32x8 a, const i32x8 b, int sc) {
    asm volatile("v_mfma_scale_f32_16x16x128_f8f6f4 %0, %1, %2, 0, %3, %3 op_sel_hi:[0,0,0]" : "=&v"(acc) : "v"(a), "v"(b), "v"(sc)); }
template <class Desc, class Epi>
__device__ __forceinline__ void gemm_fast(LAS unsigned char* lds, const unsigned char* wsb, const Desc& Dc, const Epi& E, int c, int G, int wave_id) {
    using namespace pg8;
    constexpr bool GATHER = Desc::GATHER; constexpr bool FP8 = Desc::FP8; constexpr bool PEELSEL = (__is_same(Desc,DescKV) || __is_same(Desc,DescG1b) || __is_same(Desc,DescG1a<true>));
    int lane_ = lane_id(); asm volatile("" : "+v"(lane_));
    const int wid = wave_id, lane = lane_, tid = wid * 64 + lane, wr = wid >> 2, wc = wid & 3, fr = lane & 15, fq = lane >> 4;
    unsigned vA[2][2], vAn[2][2], vB[2][2];
#pragma unroll
    for (int i = 0; i < 2; ++i) { int R, C; stage_rc(tid * 16 + i * 8192, R, C); const int Rb = Epi::PERM ? ((R & ~31) + perm32(R & 31)) : R;
#pragma unroll
        for (int h = 0; h < 2; ++h) { vA[h][i] = (unsigned)((h * HALF + R) * Dc.lda + C) * 2u; vB[h][i] = (unsigned)((h * HALF + Rb) * Dc.ldb + C) * 2u; vAn[h][i] = vA[h][i]; } }
    const unsigned ksA = (unsigned)Dc.ksa, ksB = (unsigned)Dc.ksb;
    const __amdgpu_buffer_rsrc_t rs = __builtin_amdgcn_make_buffer_rsrc((void*)wsb, (short)0, 0x7fffffff, 0x00020000);
    const unsigned ldsw = (unsigned)wid * 1024u;
    const int aoff = lds_byte(wr * 64 + fr, fq * 8), boff = lds_byte(wc * 32 + fr, fq * 8);
#define PG8_SA(b, h) (((b) * 2 + (h)) * HTB)
#define PG8_SB(b, h) ((4 + (b) * 2 + (h)) * HTB)
#define PG8_STAGE(bufoff, gbase, voff) do { _Pragma("unroll") for (int _i = 0; _i < 2; ++_i) \
        __builtin_amdgcn_raw_ptr_buffer_load_lds(rs, (LAS unsigned*)(lds + (bufoff) + ldsw + _i * 8192), 16, (int)(voff)[_i], (int)(gbase), 0, 0); } while (0)
#define PG8_LDA(dst, b, h) do { _Pragma("unroll") for (int m = 0; m < 4; ++m) _Pragma("unroll") for (int k = 0; k < 2; ++k) dst[m][k] = *(const LAS bf16x8*)(lds + PG8_SA(b, h) + aoff + m * 2048 + k * 1024); } while (0)
#define PG8_LDB(dst, b, h) do { _Pragma("unroll") for (int n = 0; n < 2; ++n) _Pragma("unroll") for (int k = 0; k < 2; ++k) dst[n][k] = *(const LAS bf16x8*)(lds + PG8_SB(b, h) + boff + n * 2048 + k * 1024); } while (0)
#define PG8_CAT(x) __builtin_shufflevector(__builtin_bit_cast(i32x4, x[0]), __builtin_bit_cast(i32x4, x[1]), 0, 1, 2, 3, 4, 5, 6, 7)
#define PG8_MMA(ai, bj, At, Bt) do { __builtin_amdgcn_s_setprio(1); if constexpr (FP8) { _Pragma("unroll") for (int m = 0; m < 4; ++m) _Pragma("unroll") for (int n = 0; n < 2; ++n) \
        mfma_f8_inplace(acc[ai][bj][m][n], PG8_CAT(Bt[n]), PG8_CAT(At[m]), f8sc); } else { \
        _Pragma("unroll") for (int m = 0; m < 4; ++m) _Pragma("unroll") for (int n = 0; n < 2; ++n) _Pragma("unroll") for (int k = 0; k < 2; ++k) \
        acc[ai][bj][m][n] = __builtin_amdgcn_mfma_f32_16x16x32_bf16(Bt[n][k], At[m][k], acc[ai][bj][m][n], 0, 0, 0); } __builtin_amdgcn_s_setprio(0); } while (0)
#define PG8_MMA0(ai, bj, At, Bt) do { __builtin_amdgcn_s_setprio(1); if constexpr (FP8) { _Pragma("unroll") for (int m = 0; m < 4; ++m) _Pragma("unroll") for (int n = 0; n < 2; ++n) \
        mfma_f8_first(acc[ai][bj][m][n], PG8_CAT(Bt[n]), PG8_CAT(At[m]), f8sc); } else { \
        _Pragma("unroll") for (int m = 0; m < 4; ++m) _Pragma("unroll") for (int n = 0; n < 2; ++n) { \
        acc[ai][bj][m][n] = __builtin_amdgcn_mfma_f32_16x16x32_bf16(Bt[n][0], At[m][0], (f32x4){0.f, 0.f, 0.f, 0.f}, 0, 0, 0); \
        acc[ai][bj][m][n] = __builtin_amdgcn_mfma_f32_16x16x32_bf16(Bt[n][1], At[m][1], acc[ai][bj][m][n], 0, 0, 0); } } __builtin_amdgcn_s_setprio(0); } while (0)
#define PG8_WAIT_V(n) asm volatile("s_waitcnt vmcnt(" #n ")" ::: "memory")
#define PG8_WAIT_L(n) asm volatile("s_waitcnt lgkmcnt(" #n ")" ::: "memory")
#define PG8_BAR __builtin_amdgcn_s_barrier()
#define PG8_SCHED __builtin_amdgcn_sched_barrier(0)
#define PG8_GATHER_OFFS(dst, un) do { const int _t = wid * 64 + lane_id(); _Pragma("unroll") for (int _i = 0; _i < 2; ++_i) { int _R, _C; stage_rc(_t * 16 + _i * 8192, _R, _C); \
        _Pragma("unroll") for (int _h = 0; _h < 2; ++_h) dst[_h][_i] = (unsigned)(ldv_i(Dc.tok + (un).rowbase + _h * HALF + _R) * Dc.lda + _C) * 2u; } } while (0)
    int f8sc = 0x7f7f7f7f; asm volatile("" : "+v"(f8sc));
    Unit cur, nxt; int ui = 0;
    if (!Dc.get(c, cur)) return;
    LAS float* const auxb = (LAS float*)(lds + 131072 + 1024);
    E.init(auxb, tid);
    { float r0[16]; E.pre_load(cur, tid, r0); E.pre_store(cur, auxb, tid, r0); }
    Acc acc;
    bf16x8 At[4][2], B0[2][2], B1[2][2];
    unsigned cA = (unsigned)((const unsigned char*)cur.A - wsb), cB = (unsigned)((const unsigned char*)cur.B - wsb);
    if constexpr (GATHER) { PG8_GATHER_OFFS(vA, cur); }
    PG8_STAGE(PG8_SB(0, 0), cB, vB[0]); PG8_STAGE(PG8_SB(0, 1), cB, vB[1]); PG8_STAGE(PG8_SA(0, 0), cA, vA[0]); PG8_STAGE(PG8_SA(0, 1), cA, vA[1]);
    if (wr == 1) PG8_BAR;
    PG8_WAIT_V(2); PG8_BAR;
    PG8_STAGE(PG8_SB(1, 0), cB + ksB, vB[0]); PG8_STAGE(PG8_SA(1, 0), cA + ksA, vA[0]); PG8_STAGE(PG8_SB(1, 1), cB + ksB, vB[1]);
    PG8_WAIT_V(6); PG8_BAR;
    for (;;) {
        const bool has_next = Dc.get((ui + 1) * G + c, nxt);
        const unsigned nA = has_next ? (unsigned)((const unsigned char*)nxt.A - wsb) : cA, nB = has_next ? (unsigned)((const unsigned char*)nxt.B - wsb) : cB;
        if constexpr (GATHER) { if (has_next) { PG8_GATHER_OFFS(vAn, nxt); } else {
#pragma unroll
            for (int h = 0; h < 2; ++h)
#pragma unroll
                for (int i = 0; i < 2; ++i) vAn[h][i] = vA[h][i]; } }
        const int nt = cur.nt;
#define PG8_ITER(T_, LAST_, MA_) do { const int t = (T_); const bool last = (LAST_); \
            const unsigned a1 = cA + (unsigned)(t + 1) * ksA; \
            const unsigned a2 = last ? nA : cA + (unsigned)(t + 2) * ksA, b2 = last ? nB : cB + (unsigned)(t + 2) * ksB; \
            const unsigned a3 = a2 + ksA, b3 = b2 + ksB; \
            unsigned x0[2], x1[2]; \
            _Pragma("unroll") for (int i = 0; i < 2; ++i) { x0[i] = (GATHER && last) ? vAn[0][i] : vA[0][i]; x1[i] = (GATHER && last) ? vAn[1][i] : vA[1][i]; } \
              \
            PG8_LDB(B0, 0, 0); PG8_LDB(B1, 0, 1); PG8_SCHED; PG8_LDA(At, 0, 0); PG8_STAGE(PG8_SA(1, 1), a1, vA[1]); \
            PG8_WAIT_V(8); PG8_WAIT_L(0); PG8_BAR; MA_(0, 0, At, B0); MA_(0, 1, At, B1); PG8_BAR; PG8_SCHED; \
              \
            PG8_LDA(At, 0, 1); PG8_STAGE(PG8_SB(0, 0), b2, vB[0]); PG8_STAGE(PG8_SB(0, 1), b2, vB[1]); PG8_STAGE(PG8_SA(0, 0), a2, x0); \
            PG8_WAIT_V(8); PG8_WAIT_L(0); PG8_BAR; MA_(1, 0, At, B0); MA_(1, 1, At, B1); PG8_BAR; PG8_SCHED; \
              \
            PG8_LDB(B0, 1, 0); PG8_LDB(B1, 1, 1); PG8_SCHED; PG8_LDA(At, 1, 0); PG8_STAGE(PG8_SA(0, 1), a2, x1); \
            PG8_WAIT_V(8); PG8_WAIT_L(0); PG8_BAR; PG8_MMA(0, 0, At, B0); PG8_MMA(0, 1, At, B1); PG8_BAR; PG8_SCHED; \
              \
            PG8_LDA(At, 1, 1); PG8_STAGE(PG8_SB(1, 0), b3, vB[0]); PG8_STAGE(PG8_SB(1, 1), b3, vB[1]); PG8_STAGE(PG8_SA(1, 0), a3, x0); \
            PG8_WAIT_V(8); PG8_WAIT_L(0); PG8_BAR; PG8_MMA(1, 0, At, B0); PG8_MMA(1, 1, At, B1); PG8_BAR; PG8_SCHED; } while (0)
        if constexpr (FP8 || PEELSEL) {
            PG8_ITER(0, false, PG8_MMA0);
            for (int t2 = 2; t2 < nt; t2 += 2) PG8_ITER(t2, t2 == nt - 2, PG8_MMA);
        } else {
#pragma unroll
            for (int a = 0; a < 2; ++a)
#pragma unroll
                for (int b = 0; b < 2; ++b)
#pragma unroll
                    for (int m = 0; m < 4; ++m)
#pragma unroll
                        for (int n = 0; n < 2; ++n) acc[a][b][m][n] = (f32x4){0.f, 0.f, 0.f, 0.f};
            for (int t2 = 0; t2 < nt; t2 += 2) PG8_ITER(t2, t2 == nt - 2, PG8_MMA);
        }
        if constexpr (FP8) asm volatile("s_nop 15\n\ts_nop 15\n\ts_nop 15\n\ts_nop 15\n\ts_nop 15" ::: "memory");
        if (wr == 0) PG8_BAR;
        { const int l2 = lane_id(); float rn[16];
          if (has_next) E.pre_load(nxt, wid * 64 + l2, rn);
          E(acc, cur, wr, wc, l2 & 15, l2 >> 4, auxb + (ui & 1) * 768);
          if (has_next) E.pre_store(nxt, auxb + ((ui + 1) & 1) * 768, wid * 64 + l2, rn); }
        if (!has_next) break;
        cur = nxt; cA = nA; cB = nB; ++ui;
        if constexpr (GATHER) {
#pragma unroll
            for (int h = 0; h < 2; ++h)
#pragma unroll
                for (int i = 0; i < 2; ++i) vA[h][i] = vAn[h][i]; }
        if (wr == 1) PG8_BAR;
    }
    PG8_WAIT_V(0);
    PG8_BAR;
#undef PG8_SA
#undef PG8_SB
#undef PG8_STAGE
#undef PG8_LDA
#undef PG8_LDB
#undef PG8_MMA
#undef PG8_MMA0
#undef PG8_ITER
#undef PG8_CAT
#undef PG8_WAIT_V
#undef PG8_WAIT_L
#undef PG8_BAR
#undef PG8_SCHED
#undef PG8_GATHER_OFFS
}

struct Frame {
    Params p; unsigned char* ws; LAS unsigned char* lds; int tid, lane, wave, c, G;
    __device__ __forceinline__ float* MOD() const { return (float*)(ws + CT_MOD); }
    __device__ __forceinline__ float* BIAS_IN() const { return (float*)(ws + CT_BIAS_IN); }
    __device__ __forceinline__ float* BIAS_GU() const { return (float*)(ws + CT_BIAS_GU); }
    __device__ __forceinline__ float* BIAS_R() const { return (float*)(ws + CT_BIAS_R); }
    __device__ __forceinline__ float* BIAS_MGU() const { return (float*)(ws + CT_BIAS_MGU); }
    __device__ __forceinline__ float* ROWSS() const { return (float*)(ws + WS_ROWSSP); }
    __device__ __forceinline__ float* MODP() const { return (float*)(ws + WS_MODP); }
    __device__ __forceinline__ f32x2* TABA() const { return (f32x2*)(ws + WS_TABA); }
    __device__ __forceinline__ f32x2* TABB() const { return (f32x2*)(ws + WS_TABB); }
    __device__ __forceinline__ float* GP() const { return (float*)(ws + WS_GP); }
    __device__ __forceinline__ float* WR() const { return (float*)(ws + WS_WR); }
    __device__ __forceinline__ int* TOPE() const { return (int*)(ws + WS_TOPE); }
    __device__ __forceinline__ float* TOPG() const { return (float*)(ws + WS_TOPG); }
    __device__ __forceinline__ int* CNT() const { return (int*)(ws + WS_CNT); }
    __device__ __forceinline__ int* BUFTOK() const { return (int*)(ws + WS_BUFTOK); }
    __device__ __forceinline__ float* BUFGATE() const { return (float*)(ws + WS_BUFGATE); }
    __device__ __forceinline__ int* POS() const { return (int*)(ws + WS_POS); }
    __device__ __forceinline__ int* BLKE() const { return (int*)(ws + WS_BLKE); }
    __device__ __forceinline__ float* RSTD3() const { return (float*)(ws + WS_RSTD3); }
    __device__ __forceinline__ float* BUFRS() const { return (float*)(ws + WS_BUFRS); }
    __device__ __forceinline__ bf16_t* WIN() const { return (bf16_t*)(ws + WS_WIN); }
    __device__ __forceinline__ bf16_t* WOUT() const { return (bf16_t*)(ws + WS_WOUT); }
    __device__ __forceinline__ bf16_t* WGU() const { return (bf16_t*)(ws + WS_WGU); }
    __device__ __forceinline__ bf16_t* WD() const { return (bf16_t*)(ws + WS_WD); }
    __device__ __forceinline__ bf16_t* WP() const { return (bf16_t*)(ws + WS_WP); }
    __device__ __forceinline__ bf16_t* XB() const { return (bf16_t*)(ws + WS_XB); }
    __device__ __forceinline__ bf16_t* XV8() const { return (bf16_t*)(ws + WS_XV8); }
    __device__ __forceinline__ bf16_t* WIN8() const { return (bf16_t*)(ws + WS_WIN + (size_t)2048 * 2048); }
    __device__ __forceinline__ bf16_t* Q() const { return (bf16_t*)(ws + WS_Q); }
    __device__ __forceinline__ bf16_t* KN() const { return (bf16_t*)(ws + WS_KN); }
    __device__ __forceinline__ bf16_t* KDT() const { return (bf16_t*)(ws + WS_KDT); }
    __device__ __forceinline__ bf16_t* VT() const { return (bf16_t*)(ws + WS_VT); }
    __device__ __forceinline__ bf16_t* Gb() const { return (bf16_t*)(ws + WS_G); }
    __device__ __forceinline__ bf16_t* SB() const { return (bf16_t*)(ws + WS_SB); }
    __device__ __forceinline__ bf16_t* Y() const { return (bf16_t*)(ws + WS_Y); }
    __device__ __forceinline__ bf16_t* H1() const { return (bf16_t*)(ws + WS_H1); }
    __device__ __forceinline__ bf16_t* PB() const { return (bf16_t*)(ws + WS_PB); }
    __device__ __forceinline__ bf16_t* H1M() const { return (bf16_t*)(ws + WS_H1M); }
    __device__ __forceinline__ bf16_t* WMGU() const { return (bf16_t*)(ws + WS_WMGU); }
    __device__ __forceinline__ bf16_t* WMD() const { return (bf16_t*)(ws + WS_WMD); }
    __device__ __forceinline__ bf16_t* YB() const { return (bf16_t*)(ws + WS_YB); }
    __device__ __forceinline__ float* YBB() const { return (float*)(ws + WS_YBB); }
    __device__ __forceinline__ float* X2() const { return (float*)(ws + WS_X2); }
    __device__ __forceinline__ bf16_t* X3B() const { return (bf16_t*)(ws + WS_G + 32 * MiB); }
};
__device__ __forceinline__ void frame_fresh(Frame& F) { int l = lane_id(); asm volatile("" : "+v"(l)); F.lane = l; F.tid = F.wave * 64 + l; }
__device__ __forceinline__ void frame_init(Frame& F, const Params& p, LAS unsigned char* lds, int c, int G) {
    F.p = p; F.ws = p.ws; F.lds = lds; F.tid = threadIdx.x; F.lane = F.tid & 63; F.wave = __builtin_amdgcn_readfirstlane(F.tid >> 6); F.c = c; F.G = G;
}

__device__ __forceinline__ void dsincos(double x, double& s, double& c) {
    const double k = rint(x * 0.6366197723675814); double y = fma(-k, 1.5707963267948966, x); y = fma(-k, 6.123233995736766e-17, y);
    const double z = y * y;
    double sp = -7.6471637318198164759e-13; sp = fma(sp, z, 1.6059043836821614599e-10); sp = fma(sp, z, -2.5052108385441718775e-8); sp = fma(sp, z, 2.7557319223985890653e-6);
    sp = fma(sp, z, -1.9841269841269841270e-4); sp = fma(sp, z, 8.3333333333333333333e-3); sp = fma(sp, z, -1.6666666666666666667e-1); const double sy = fma(sp * z, y, y);
    double cp = 4.7794773323873852974e-14; cp = fma(cp, z, -1.1470745597729724714e-11); cp = fma(cp, z, 2.0876756987868098979e-9); cp = fma(cp, z, -2.7557319223985890653e-7);
    cp = fma(cp, z, 2.4801587301587301587e-5); cp = fma(cp, z, -1.3888888888888888889e-3); cp = fma(cp, z, 4.1666666666666666667e-2); cp = fma(cp, z, -0.5); const double cy = fma(cp, z, 1.0);
    const int q = ((int)k) & 3;
    s = (q == 0) ? sy : (q == 1) ? cy : (q == 2) ? -sy : -cy;
    c = (q == 0) ? cy : (q == 1) ? -sy : (q == 2) ? -cy : sy;
}
__device__ __forceinline__ void phase_p0(Frame& F) {
    const Params& p = F.p; const int gw = F.c * NWAVE + F.wave, NGW = F.G * NWAVE, lane = F.lane;
    LAS float* cact = (LAS float*)F.lds;
    __syncthreads();
    for (int k = F.tid; k < 1024; k += NTHR) cact[k] = silu_f(p.c[k]);
    __syncthreads();
    for (int task = gw; task < 1536; task += NGW) {
        const int i = task / 768, rem = task % 768, cb = rem >> 3, ks = rem & 7, n = cb * 64 + lane;
        const float* w = p.ada_w + (size_t)i * 1024 * NIN + (size_t)(ks * 128) * NIN + n; float a = 0.f;
        { float wv[128];
#pragma unroll
          for (int k = 0; k < 128; ++k) wv[k] = w[(size_t)k * NIN];
#pragma unroll
          for (int k = 0; k < 128; ++k) a = fmaf(cact[ks * 128 + k], wv[k], a); }
        if (ks == 0) a += p.ada_b[i * NIN + n];
        F.MODP()[ks * 12288 + i * NIN + n] = a;
    }
    const int gt = F.c * NTHR + F.tid, NGT = F.G * NTHR;
    for (int e = gt; e < 32768 + 4; e += NGT) {
        if (e < 32768) {
            const int which = e >> 14, ab = (e >> 7) & 127, i = e & 127; double inv = 1.0;
            for (int q = 0; q < i; ++q) inv *= 0.93057204092969897929;
            const double ang = (double)(which == 0 ? 128 * ab : ab) * inv; double s, c2; dsincos(ang, s, c2);
            (which == 0 ? F.TABA() : F.TABB())[ab * 128 + i] = (f32x2){(float)c2, (float)s};
        } else {
            const int h = e - 32768; const double g = 1.0 - 1.0 / (double)(32 << h); double v = 1.0;
            for (int j = 0; j <= 256; ++j) { F.GP()[h * GPS + j] = (float)v; v *= g; }
        }
    }
    for (int row = 2 * gw; row < T; row += 2 * NGW) {
        f32x4 v[2][4];
#pragma unroll
        for (int r = 0; r < 2; ++r) { const float* xr = p.x + (size_t)(row + r) * D + 8 * lane;
#pragma unroll
            for (int j = 0; j < 4; ++j) v[r][j] = *(const f32x4*)(xr + 512 * (j >> 1) + 4 * (j & 1)); }
#pragma unroll
        for (int r = 0; r < 2; ++r) { float s = 0.f;
#pragma unroll
            for (int j = 0; j < 4; ++j) s += (v[r][j].x * v[r][j].x + v[r][j].y * v[r][j].y) + (v[r][j].z * v[r][j].z + v[r][j].w * v[r][j].w);
            s = wave_sum(s); if (lane < 16) F.ROWSS()[(size_t)(row + r) * 16 + lane] = (lane == 0) ? s : 0.f;
            bf16_t* o = F.XB() + (size_t)(row + r) * D + 8 * lane;
#pragma unroll
            for (int j2 = 0; j2 < 2; ++j2) { u32x4 w; w.x = pk2(v[r][2 * j2].x, v[r][2 * j2].y); w.y = pk2(v[r][2 * j2].z, v[r][2 * j2].w); w.z = pk2(v[r][2 * j2 + 1].x, v[r][2 * j2 + 1].y); w.w = pk2(v[r][2 * j2 + 1].z, v[r][2 * j2 + 1].w);
                *(u32x4*)(o + 512 * j2) = w;
                { const f32x4 a = v[r][2 * j2] * 16.0f, b = v[r][2 * j2 + 1] * 16.0f; u32x2 w8;
                  w8.x = pk4f8(__builtin_amdgcn_fmed3f(a.x, -448.f, 448.f), __builtin_amdgcn_fmed3f(a.y, -448.f, 448.f), __builtin_amdgcn_fmed3f(a.z, -448.f, 448.f), __builtin_amdgcn_fmed3f(a.w, -448.f, 448.f));
                  w8.y = pk4f8(__builtin_amdgcn_fmed3f(b.x, -448.f, 448.f), __builtin_amdgcn_fmed3f(b.y, -448.f, 448.f), __builtin_amdgcn_fmed3f(b.z, -448.f, 448.f), __builtin_amdgcn_fmed3f(b.w, -448.f, 448.f));
                  *(u32x2*)((unsigned char*)F.XV8() + (size_t)(row + r) * D + 8 * lane + 512 * j2) = w8; } } }
    }
}

template <bool F8 = false>
__device__ __forceinline__ void conv_strip(const float* W, int ldw, int kb0, int nkb, int n0, bf16_t* WT, int ldt, int drow0, const LAS float* gsl, const LAS float* shl,
                                           float* bias, float cscale, LAS float* scr, int lane, int tiled_nkt = 0, float wmul = 1.0f) {
    f32x4 bacc = (f32x4){0.f, 0.f, 0.f, 0.f}; f32x4 w[8];
    const int lr = lane >> 3, lc = 4 * (lane & 7);
    const float* wp = W + (size_t)(kb0 * 64 + lr) * ldw + n0 + lc;
#pragma unroll
    for (int i = 0; i < 8; ++i) w[i] = *(const f32x4*)(wp + (size_t)(8 * i) * ldw);
    for (int kb = kb0; kb < kb0 + nkb; ++kb) {
        const int k0 = kb * 64; f32x4 wn[8];
        if (kb + 1 < kb0 + nkb) {
#pragma unroll
            for (int i = 0; i < 8; ++i) wn[i] = *(const f32x4*)(wp + (size_t)(64 * (kb + 1 - kb0) + 8 * i) * ldw);
        } else {
#pragma unroll
            for (int i = 0; i < 8; ++i) wn[i] = (f32x4){0.f, 0.f, 0.f, 0.f};
        }
#pragma unroll
        for (int i = 0; i < 8; ++i) { const int kk = lr + 8 * i;
            float gsv = cscale * wmul; if (gsl) { gsv *= gsl[k0 + kk]; const float sv = shl[k0 + kk]; bacc = bacc + w[i] * sv; }
            *(LAS f32x4*)(scr + kk * 36 + 4 * ((lane & 7) ^ i)) = w[i] * gsv; }
        asm volatile("s_waitcnt lgkmcnt(0)" ::: "memory");
        const int cc = lane & 7;
#pragma unroll
        for (int j = 0; j < 4; ++j) { const int n = (lane >> 3) + 8 * j; const LAS float* s = scr + (8 * cc) * 36 + 4 * ((n >> 2) ^ cc) + (n & 3);
            const int nr = drow0 + n;
            if constexpr (F8) { u32x2 o8; o8.x = pk4f8(s[0 * 36], s[1 * 36], s[2 * 36], s[3 * 36]); o8.y = pk4f8(s[4 * 36], s[5 * 36], s[6 * 36], s[7 * 36]);
                if (tiled_nkt) *(u32x2*)((unsigned char*)WT + (((size_t)(nr >> 8) * tiled_nkt + (kb >> 1)) * 256 + (nr & 255)) * 128 + (kb & 1) * 64 + 8 * cc) = o8;
                else *(u32x2*)((unsigned char*)WT + (size_t)nr * ldt + k0 + 8 * cc) = o8;
                continue; }
            u32x4 o; o.x = pk2(s[0 * 36], s[1 * 36]); o.y = pk2(s[2 * 36], s[3 * 36]); o.z = pk2(s[4 * 36], s[5 * 36]); o.w = pk2(s[6 * 36], s[7 * 36]);
            if (tiled_nkt) *(u32x4*)(WT + (((size_t)(nr >> 8) * tiled_nkt + kb) * 256 + (nr & 255)) * 64 + 8 * cc) = o;
            else *(u32x4*)(WT + (size_t)nr * ldt + k0 + 8 * cc) = o; }
        asm volatile("s_waitcnt lgkmcnt(0)" ::: "memory");
#pragma unroll
        for (int i = 0; i < 8; ++i) w[i] = wn[i];
    }
    if (bias) {
#pragma unroll
        for (int o = 8; o < 64; o <<= 1) { bacc.x += __shfl_xor(bacc.x, o); bacc.y += __shfl_xor(bacc.y, o); bacc.z += __shfl_xor(bacc.z, o); bacc.w += __shfl_xor(bacc.w, o); }
        if (lane < 8) *(f32x4*)(bias + drow0 + lc) = bacc * cscale; }
}
__device__ __forceinline__ void phase_p1(Frame& F) {
    const Params& p = F.p; const int gw = F.c * NWAVE + F.wave, NGW = F.G * NWAVE, lane = F.lane;
    LAS float* modl = (LAS float*)F.lds;
    LAS float* scr = (LAS float*)(F.lds + 49152 + F.wave * 9216);
    constexpr int S_IN = 192 * 4, S_G = 88 * 4, I_OUT = 32 * 32, I_D = 44 * 32, I_P = 4 * 4 * 8;
    constexpr int NIT = S_IN + 2 * S_G + I_OUT + I_D + I_P + 1;
    LAS int* nf = (LAS int*)(F.lds + 122880);
    __syncthreads();
    if (F.tid < 4) nf[F.tid] = 0;
    __syncthreads();
    if (lane == 0) { int m = 0;
        for (int it = gw; it < NIT; it += NGW) { if (F.G == 256 && it >= S_IN && it < S_IN + 2 * S_G + I_OUT + I_D) continue; if (it < S_IN) m |= 1; else if (it < S_IN + 2 * S_G) m |= 2; else if (it >= S_IN + 2 * S_G + I_OUT + I_D && it < NIT - 1) m |= 4; else if (it == NIT - 1) m |= 8; }
        if (m & 1) nf[0] = 1; if (m & 2) nf[1] = 1; if (m & 4) nf[2] = 1; if (m & 8) nf[3] = 1; }
    for (int idx = F.c + F.G * F.tid; idx < 12288; idx += F.G * NTHR) { float v = 0.f;
#pragma unroll
        for (int ks = 0; ks < 8; ++ks) v += F.MODP()[ks * 12288 + idx];
        F.MOD()[idx] = v; }
    __syncthreads();
#pragma unroll
    for (int kind = 0; kind < 4; ++kind) {
        if (nf[kind]) { const int r0 = kind == 0 ? 0 : (kind == 1 ? 3 : (kind == 2 ? 6 : 9)); float pv[4][8];
#pragma unroll
            for (int j = 0; j < 4; ++j)
#pragma unroll
                for (int ks = 0; ks < 8; ++ks) pv[j][ks] = F.MODP()[ks * 12288 + r0 * 1024 + F.tid + NTHR * j];
#pragma unroll
            for (int j = 0; j < 4; ++j) { float v = 0.f;
#pragma unroll
                for (int ks = 0; ks < 8; ++ks) v += pv[j][ks];
                modl[r0 * 1024 + F.tid + NTHR * j] = v; } } }
    __syncthreads();
    const LAS float* MOD0 = modl; const LAS float* MOD1 = modl + NIN; const LAS float* nul = nullptr;
    LAS float* gs_in = modl + 2048; LAS float* gs_ffn = modl + 5120; LAS float* gs_pool = modl + NIN + 2048;
    for (int k = F.tid; k < 1024; k += NTHR) { if (nf[0]) gs_in[k] = p.norm_gain[k] * (1.0f + MOD0[1024 + k]); if (nf[1]) gs_ffn[k] = p.norm_gain[1024 + k] * (1.0f + MOD0[4 * 1024 + k]); if (nf[2]) gs_pool[k] = p.norm_gain[2048 + k] * (1.0f + MOD1[1024 + k]); }
    __syncthreads();
    for (int it = gw; it < NIT; it += NGW) {
        int r = it;
        if (F.G == 256 && it >= S_IN && it < S_IN + 2 * S_G + I_OUT + I_D) continue;
        if (r < S_IN) { const int part = r / 192, n0 = (r % 192) * 32; const float cs = (n0 >= 1024 && n0 < 2048) ? 0.0625f : 1.0f;
            if (n0 >= 2048 && n0 < 4096) conv_strip<true>(p.ret_w_in, NIN, 4 * part, 4, n0, F.WIN8(), 1024, n0 - 2048, gs_in, MOD0, F.BIAS_IN() + part * NIN + 2048, 1.0f, scr, lane, 0, F8_WSCALE);
            else conv_strip(p.ret_w_in, NIN, 4 * part, 4, n0, F.WIN(), 1024, n0, gs_in, MOD0, F.BIAS_IN() + part * NIN, cs, scr, lane);
            continue; } r -= S_IN;
        if (r < 2 * S_G) { const int up = r >= S_G; if (up) r -= S_G; const int part = r / 88, n0 = (r % 88) * 32, drow = (n0 >> 7) * 256 + (up ? 128 : 0) + (n0 & 127);
            conv_strip(up ? p.ffn_w_up : p.ffn_w_gate, DFF, 4 * part, 4, n0, F.WGU(), 1024, drow, gs_ffn, MOD0 + 3 * 1024, F.BIAS_GU() + part * 5632, 1.0f, scr, lane); continue; } r -= 2 * S_G;
        if (r < I_OUT) { const int kb = r / 32, nb = r % 32; conv_strip(p.ret_w_out, 1024, kb, 1, nb * 32, F.WOUT(), 2048, nb * 32, nul, nul, nullptr, 1.0f, scr, lane); continue; } r -= I_OUT;
        if (r < I_D) { const int kb = r / 32, nb = r % 32; conv_strip<true>(p.ffn_w_down, 1024, kb, 1, nb * 32, F.WD(), DFF, nb * 32, nul, nul, nullptr, 1.0f, scr, lane, 22, F8_DSCALE); continue; } r -= I_D;
        if (r < I_P) { const int g = r / 32, q = r % 32, kb = q / 8, nb = q % 8;
            conv_strip(p.pool_w + (size_t)g * 65536, 256, kb, 1, nb * 32, F.WP() + (size_t)g * 65536, 256, nb * 32, gs_pool + g * 256, MOD1 + g * 256, nullptr, 1.0f, scr, lane); continue; }
        { float ba = 0.f; const int e = lane & 7;
            for (int k0 = lane >> 3; k0 < 1024; k0 += 128) { float w[16], gn[16];
#pragma unroll
                for (int j = 0; j < 16; ++j) { const int k = k0 + 8 * j; w[j] = p.moe_router[k * 8 + e]; gn[j] = p.norm_gain[3 * 1024 + k]; }
#pragma unroll
                for (int j = 0; j < 16; ++j) { const int k = k0 + 8 * j; F.WR()[k * 8 + e] = w[j] * (gn[j] * (1.0f + MOD1[4 * 1024 + k])); ba = fmaf(MOD1[3 * 1024 + k], w[j], ba); } }
            ba += __shfl_xor(ba, 8); ba += __shfl_xor(ba, 16); ba += __shfl_xor(ba, 32);
            if (lane < 8) F.BIAS_R()[lane] = ba; }
    }
}
__device__ __forceinline__ void p1_deferred(Frame& F, int grp) {
    const Params& p = F.p; const int lane = F.lane;
    LAS float* gs = (LAS float*)(F.lds + 1024);   LAS float* sh = gs + 1024; LAS float* scr = (LAS float*)(F.lds + 49152 + F.wave * 9216); const LAS float* nul = nullptr;
    constexpr int S_G = 88 * 4, I_OUT = 32 * 32, I_D = 44 * 32, ND = 2 * S_G + I_OUT + I_D, NH = 128 * NWAVE;
    __syncthreads();
    if (grp) { const float* MOD0 = F.MOD(); for (int k = F.tid; k < 1024; k += NTHR) { gs[k] = p.norm_gain[1024 + k] * (1.0f + ldv_f(MOD0 + 4 * 1024 + k)); sh[k] = ldv_f(MOD0 + 3 * 1024 + k); } }
    __syncthreads();
    const int gwl = (F.c & 127) * NWAVE + F.wave;
    for (int it = (grp ? 0 : NH) + gwl; it < (grp ? NH : ND); it += 128 * NWAVE) {
        int r = it;
        if (r < 2 * S_G) { const int up = r >= S_G; if (up) r -= S_G; const int part = r / 88, n0 = (r % 88) * 32, drow = (n0 >> 7) * 256 + (up ? 128 : 0) + (n0 & 127);
            conv_strip(up ? p.ffn_w_up : p.ffn_w_gate, DFF, 4 * part, 4, n0, F.WGU(), 1024, drow, gs, sh, F.BIAS_GU() + part * 5632, 1.0f, scr, lane); continue; } r -= 2 * S_G;
        if (r < I_OUT) { const int kb = r / 32, nb = r % 32; conv_strip(p.ret_w_out, 1024, kb, 1, nb * 32, F.WOUT(), 2048, nb * 32, nul, nul, nullptr, 1.0f, scr, lane); continue; } r -= I_OUT;
        { const int kb = r / 32, nb = r % 32; conv_strip<true>(p.ffn_w_down, 1024, kb, 1, nb * 32, F.WD(), DFF, nb * 32, nul, nul, nullptr, 1.0f, scr, lane, 22, F8_DSCALE); }
    }
    __syncthreads();
}
constexpr int PX_SG = 112 * 4, PX_EARLY = 1024;
__device__ __forceinline__ void px_tables(Frame& F) {
    const Params& p = F.p;
    LAS float* gsl = (LAS float*)(F.lds + 8 * 9216 + 1024);
    LAS float* shl = gsl + 1024;
    const float* MOD1 = F.MOD() + NIN;
    for (int k = F.tid; k < 1024; k += NTHR) { gsl[k] = p.norm_gain[3 * 1024 + k] * (1.0f + ldv_f(MOD1 + 4 * 1024 + k)); shl[k] = ldv_f(MOD1 + 3 * 1024 + k); }
    __syncthreads();
}
__device__ __forceinline__ void px_gu_item(Frame& F, int it, int lane) {
    const Params& p = F.p;
    LAS float* scr = (LAS float*)(F.lds + F.wave * 9216);
    LAS float* gsl = (LAS float*)(F.lds + 8 * 9216 + 1024); LAS float* shl = gsl + 1024;
    const int e = it / (2 * PX_SG); int r = it % (2 * PX_SG); const int up = r >= PX_SG; if (up) r -= PX_SG;
    const int part = r / 112, n0 = (r % 112) * 32, drow = e * 7168 + (n0 >> 7) * 256 + (up ? 128 : 0) + (n0 & 127);
    conv_strip<true>((up ? p.moe_w_up : p.moe_w_gate) + (size_t)e * 1024 * DFE, DFE, 4 * part, 4, n0, F.WMGU(), 1024, drow, gsl, shl,
                     F.BIAS_MGU() + (part >> 1) * 262144 + (part & 1) * 57344, 1.0f, scr, lane, 0, F8_WSCALE);
}
__device__ __forceinline__ void phase_px(Frame& F) {
    const Params& p = F.p; const int gw = F.c * NWAVE + F.wave, NGW = F.G * NWAVE, lane = F.lane;
    LAS float* scr = (LAS float*)(F.lds + F.wave * 9216);
    const LAS float* nul = nullptr;
    px_tables(F);
    constexpr int I_D = 14 * 32;
    for (int it = (F.G == 256 ? PX_EARLY : 0) + gw; it < NE * 2 * PX_SG; it += NGW) px_gu_item(F, it, lane);
    const int lane2 = lane_id();
    for (int it = gw; it < NE * I_D; it += NGW) {
        const int e = it / I_D, r = it % I_D, kg = r / 32, nb = r % 32;
        conv_strip<true>(p.moe_w_down + (size_t)e * DFE * 1024, 1024, 4 * kg, 4, nb * 32, (bf16_t*)((unsigned char*)F.WMD() + (size_t)e * 1024 * DFE), DFE, nb * 32, nul, nul, nullptr, 1.0f, scr, lane2, 28, F8_DSCALE);
    }
}

__device__ __forceinline__ void phase_scan(Frame& F) {
    const int gt = F.c * NTHR + F.tid, NGT = F.G * NTHR;
    for (int v = gt; v < 131072; v += NGT) {
        const int h = v >> 15; const float dec = F.GP()[h * GPS + RC]; float s0 = 0.f, s1 = 0.f, s2 = 0.f, s3 = 0.f;
        u32x2* ptr = (u32x2*)(F.SB() + (size_t)v * 4);
        for (int n0 = 0; n0 < NRC; n0 += 16) {
            u32x2 kv[16];
#pragma unroll
            for (int j = 0; j < 16; ++j) { kv[j] = (u32x2){0u, 0u}; if (n0 + j < NRC - 1) kv[j] = ptr[(size_t)(n0 + j) * 131072]; }
#pragma unroll
            for (int j = 0; j < 16; ++j) {
                u32x2 o; o.x = pk2(s0, s1); o.y = pk2(s2, s3); ptr[(size_t)(n0 + j) * 131072] = o;
                s0 = s0 * dec + bflo(kv[j].x); s1 = s1 * dec + bfhi(kv[j].x); s2 = s2 * dec + bflo(kv[j].y); s3 = s3 * dec + bfhi(kv[j].y); }
        }
    }
}

namespace ret {
constexpr int BUFB = 40960, OFF_B = 8192, OFF_P = 81920, OFF_RED = 114688, OFF_GP = 118784;
__device__ __forceinline__ int swz(int o) { return o ^ (((o >> 9) & 1) << 5); }
}
#define RET_WAITV(n) asm volatile("s_waitcnt vmcnt(" #n ")" ::: "memory")
#define RET_WAITL0() asm volatile("s_waitcnt lgkmcnt(0)" ::: "memory")
#define RET_BAR() do { asm volatile("" ::: "memory"); __builtin_amdgcn_s_barrier(); asm volatile("" ::: "memory"); } while (0)
__device__ __forceinline__ void phase_ret_fast(Frame& F) {
    using namespace ret;
    const Params& p = F.p; LAS unsigned char* lds = F.lds;
    const int tid = F.tid, lane = tid & 63, wid = F.wave, wr = wid >> 2, wc = wid & 3, fr = lane & 15, fq = lane >> 4;
    const int foff = swz(fr * 64 + fq * 16);
    const int srow = lane >> 2, scol = ((lane & 3) * 8) ^ (((lane >> 5) & 1) * 16);
    LAS float* gps = (LAS float*)(lds + OFF_GP); LAS f32x2* red = (LAS f32x2*)(lds + OFF_RED);
    __syncthreads();
    { float gvv[3];
#pragma unroll
      for (int i = 0; i < 3; ++i) { const int idx = tid + NTHR * i; gvv[i] = F.GP()[idx < 4 * GPS ? idx : 0]; }
#pragma unroll
      for (int i = 0; i < 3; ++i) { const int idx = tid + NTHR * i; if (idx < 4 * GPS) gps[idx] = gvv[i]; } }
    __syncthreads();
    const __amdgpu_buffer_rsrc_t rs = __builtin_amdgcn_make_buffer_rsrc((void*)F.ws, (short)0, 0x7fffffff, 0x00020000);
    const unsigned qoff = (unsigned)((16 * wid + srow) * 1024 + scol) * 2u;
    unsigned soff[4], voff[4];
#pragma unroll
    for (int i = 0; i < 4; ++i) { const int R = 16 * (wid + 8 * i) + srow, Rp = (R & ~31) + pg8::perm32(R & 31);
        soff[i] = (unsigned)(Rp * 256 + scol) * 2u; voff[i] = (unsigned)(Rp * T + scol) * 2u; }
#define RET_GLDS(uoff, loff, dst) __builtin_amdgcn_raw_ptr_buffer_load_lds(rs, (LAS unsigned*)(lds + (dst)), 16, (int)(loff), (int)(uoff), 0, 0)
#define RET_LOADS(kind, ks, b, hh, nn, nk) do { const unsigned _qk = (unsigned)((nn) * 128 * 1024 + (hh) * 256 + 32 * (ks)) * 2u, _kk = (unsigned)((nk) * 128 * 1024 + (hh) * 256 + 32 * (ks)) * 2u; \
        if ((kind) != 2) RET_GLDS((unsigned)WS_Q + _qk, qoff, (b) * BUFB + wid * 1024); \
        if ((kind) == 0) RET_GLDS((unsigned)WS_KN + _kk, qoff, (b) * BUFB + OFF_B + wid * 1024); \
        if ((kind) == 1) { const unsigned _sb = (unsigned)WS_SB + (unsigned)((((nn) >> 1) * 4 + (hh)) * 512 * 256 + 32 * (ks)) * 2u; _Pragma("unroll") for (int _i = 0; _i < 4; ++_i) \
            RET_GLDS(_sb, soff[_i], (b) * BUFB + OFF_B + (wid + 8 * _i) * 1024); } \
        if ((kind) == 2) { const unsigned _vb = (unsigned)WS_VT + (unsigned)((hh) * 512 * T + (nk) * 128 + 32 * (ks)) * 2u; _Pragma("unroll") for (int _i = 0; _i < 4; ++_i) \
            RET_GLDS(_vb, voff[_i], (b) * BUFB + OFF_B + (wid + 8 * _i) * 1024); } } while (0)
    int u = F.c;
    if (u >= 512) return;
#define RET_NOF(uu) ((((uu) >> 4) << 2) | ((((uu) >> 2) & 1) << 1) | ((((uu) >> 3) ^ ((uu) >> 8)) & 1))
    { const int h = u & 3, n = RET_NOF(u); RET_LOADS(0, 0, 0, h, n, n); }
    for (; u < 512; u += F.G) {
        const int h = u & 3, n = RET_NOF(u), t0 = n * 128; const int un = u + F.G; const bool has_next = un < 512; const int hn = un & 3, nn = RET_NOF(un);
        const bool half = (n & 1) != 0;
        f32x4 pacc[4][2];
#pragma unroll
        for (int m = 0; m < 4; ++m)
#pragma unroll
            for (int q = 0; q < 2; ++q) pacc[m][q] = (f32x4){0.f, 0.f, 0.f, 0.f};
#pragma unroll
        for (int ks = 0; ks < 8; ++ks) {
            const int b = ks & 1;
            if (ks < 7) { RET_LOADS(0, ks + 1, b ^ 1, h, n, n); RET_WAITV(2); } else { RET_LOADS(1, 0, b ^ 1, h, n, n); RET_WAITV(5); }
            RET_BAR();
            bf16x8 af[4], bf[2];
#pragma unroll
            for (int m = 0; m < 4; ++m) af[m] = *(const LAS bf16x8*)(lds + b * BUFB + (4 * wr + m) * 1024 + foff);
#pragma unroll
            for (int q = 0; q < 2; ++q) bf[q] = *(const LAS bf16x8*)(lds + b * BUFB + OFF_B + (2 * wc + q) * 1024 + foff);
            RET_WAITL0(); RET_BAR();
#pragma unroll
            for (int m = 0; m < 4; ++m)
#pragma unroll
                for (int q = 0; q < 2; ++q) pacc[m][q] = __builtin_amdgcn_mfma_f32_16x16x32_bf16(bf[q], af[m], pacc[m][q], 0, 0, 0);
            __builtin_amdgcn_sched_barrier(0);
        }
        { int l2 = lane; asm volatile("" : "+v"(l2)); const int fr = l2 & 15, fq = l2 >> 4;
#pragma unroll
        for (int m = 0; m < 4; ++m)
#pragma unroll
            for (int q = 0; q < 2; ++q) { const int r = 64 * wr + 16 * m + fr, cc = 32 * wc + 16 * q + 4 * fq; float v[4];
#pragma unroll
                for (int j = 0; j < 4; ++j) { const int dd = r - (cc + j); v[j] = dd >= 0 ? pacc[m][q][j] * gps[h * GPS + dd] : 0.f; }
                u32x2 w; w.x = pk2(v[0], v[1]); w.y = pk2(v[2], v[3]);
                *(LAS u32x2*)(lds + OFF_P + wc * 8192 + (4 * wr + m) * 1024 + swz(fr * 64 + 32 * q + 8 * fq)) = w; } }
        f32x4 acc[4][8];
#pragma unroll
        for (int m = 0; m < 4; ++m)
#pragma unroll
            for (int q = 0; q < 8; ++q) acc[m][q] = (f32x4){0.f, 0.f, 0.f, 0.f};
#pragma unroll
        for (int ks = 0; ks < 8; ++ks) {
            const int b = ks & 1;
            if (ks < 7) { RET_LOADS(1, ks + 1, b ^ 1, h, n, n); RET_WAITV(5); } else { RET_LOADS(2, 0, b ^ 1, h, n, n); RET_WAITV(4); }
            RET_BAR();
            bf16x8 af[4], bf[8];
#pragma unroll
            for (int m = 0; m < 4; ++m) af[m] = *(const LAS bf16x8*)(lds + b * BUFB + (4 * wr + m) * 1024 + foff);
#pragma unroll
            for (int q = 0; q < 8; ++q) bf[q] = *(const LAS bf16x8*)(lds + b * BUFB + OFF_B + (8 * wc + q) * 1024 + foff);
            RET_WAITL0(); RET_BAR();
#pragma unroll
            for (int m = 0; m < 4; ++m)
#pragma unroll
                for (int q = 0; q < 8; ++q) acc[m][q] = __builtin_amdgcn_mfma_f32_16x16x32_bf16(bf[q], af[m], acc[m][q], 0, 0, 0);
            __builtin_amdgcn_sched_barrier(0);
        }
        { int l3 = lane; asm volatile("" : "+v"(l3)); const int fr = l3 & 15;
#pragma unroll
        for (int m = 0; m < 4; ++m) { const float qd = gps[h * GPS + 64 * wr + 16 * m + fr + 1] * (half ? gps[h * GPS + 128] : 1.0f);
#pragma unroll
            for (int q = 0; q < 8; ++q) acc[m][q] = acc[m][q] * qd; } }
#pragma unroll
        for (int ks = 0; ks < 4; ++ks) {
            const int b = ks & 1;
            if (ks < 3) { RET_LOADS(2, ks + 1, b ^ 1, h, n, n); RET_WAITV(4); }
            else if (half) { RET_LOADS(0, 0, b ^ 1, h, n, n - 1); RET_WAITV(2); }
            else if (has_next) { RET_LOADS(0, 0, b ^ 1, hn, nn, nn); RET_WAITV(2); }
            else { RET_WAITV(0); }
            RET_BAR();
            bf16x8 af[4], bf[8];
#pragma unroll
            for (int m = 0; m < 4; ++m) af[m] = *(const LAS bf16x8*)(lds + OFF_P + ks * 8192 + (4 * wr + m) * 1024 + foff);
#pragma unroll
            for (int q = 0; q < 8; ++q) bf[q] = *(const LAS bf16x8*)(lds + b * BUFB + OFF_B + (8 * wc + q) * 1024 + foff);
            RET_WAITL0(); RET_BAR();
#pragma unroll
            for (int m = 0; m < 4; ++m)
#pragma unroll
                for (int q = 0; q < 8; ++q) acc[m][q] = __builtin_amdgcn_mfma_f32_16x16x32_bf16(bf[q], af[m], acc[m][q], 0, 0, 0);
            __builtin_amdgcn_sched_barrier(0);
        }
        if (half) {
#pragma unroll
            for (int m = 0; m < 4; ++m)
#pragma unroll
                for (int q = 0; q < 2; ++q) pacc[m][q] = (f32x4){0.f, 0.f, 0.f, 0.f};
#pragma unroll
            for (int ks = 0; ks < 8; ++ks) {
                const int b = ks & 1;
                if (ks < 7) { RET_LOADS(0, ks + 1, b ^ 1, h, n, n - 1); RET_WAITV(2); } else { RET_LOADS(2, 0, b ^ 1, h, n, n - 1); RET_WAITV(4); }
                RET_BAR();
                bf16x8 af[4], bf[2];
#pragma unroll
                for (int m = 0; m < 4; ++m) af[m] = *(const LAS bf16x8*)(lds + b * BUFB + (4 * wr + m) * 1024 + foff);
#pragma unroll
                for (int q = 0; q < 2; ++q) bf[q] = *(const LAS bf16x8*)(lds + b * BUFB + OFF_B + (2 * wc + q) * 1024 + foff);
                RET_WAITL0(); RET_BAR();
#pragma unroll
                for (int m = 0; m < 4; ++m)
#pragma unroll
                    for (int q = 0; q < 2; ++q) pacc[m][q] = __builtin_amdgcn_mfma_f32_16x16x32_bf16(bf[q], af[m], pacc[m][q], 0, 0, 0);
                __builtin_amdgcn_sched_barrier(0);
            }
            { int l6 = lane; asm volatile("" : "+v"(l6)); const int fr = l6 & 15, fq = l6 >> 4;
#pragma unroll
            for (int m = 0; m < 4; ++m)
#pragma unroll
                for (int q = 0; q < 2; ++q) { const int r = 64 * wr + 16 * m + fr, cc = 32 * wc + 16 * q + 4 * fq; float v[4];
#pragma unroll
                    for (int j = 0; j < 4; ++j) v[j] = pacc[m][q][j] * gps[h * GPS + 128 + r - (cc + j)];
                    u32x2 w; w.x = pk2(v[0], v[1]); w.y = pk2(v[2], v[3]);
                    *(LAS u32x2*)(lds + OFF_P + wc * 8192 + (4 * wr + m) * 1024 + swz(fr * 64 + 32 * q + 8 * fq)) = w; } }
            RET_WAITL0();
#pragma unroll
            for (int ks = 0; ks < 4; ++ks) {
                const int b = ks & 1;
                if (ks < 3) { RET_LOADS(2, ks + 1, b ^ 1, h, n, n - 1); RET_WAITV(4); }
                else if (has_next) { RET_LOADS(0, 0, b ^ 1, hn, nn, nn); RET_WAITV(2); }
                else { RET_WAITV(0); }
                RET_BAR();
                bf16x8 af[4], bf[8];
    #pragma unroll
                for (int m = 0; m < 4; ++m) af[m] = *(const LAS bf16x8*)(lds + OFF_P + ks * 8192 + (4 * wr + m) * 1024 + foff);
    #pragma unroll
                for (int q = 0; q < 8; ++q) bf[q] = *(const LAS bf16x8*)(lds + b * BUFB + OFF_B + (8 * wc + q) * 1024 + foff);
                RET_WAITL0(); RET_BAR();
    #pragma unroll
                for (int m = 0; m < 4; ++m)
    #pragma unroll
                    for (int q = 0; q < 8; ++q) acc[m][q] = __builtin_amdgcn_mfma_f32_16x16x32_bf16(bf[q], af[m], acc[m][q], 0, 0, 0);
                __builtin_amdgcn_sched_barrier(0);
            }
        }
        { int l4 = lane; asm volatile("" : "+v"(l4)); const int fr = l4 & 15, fq = l4 >> 4;
#pragma unroll
        for (int m = 0; m < 4; ++m) { float s1 = 0.f, s2 = 0.f;
#pragma unroll
            for (int q = 0; q < 8; ++q) { const f32x4 v = acc[m][q]; s1 += (v.x + v.y) + (v.z + v.w); s2 += (v.x * v.x + v.y * v.y) + (v.z * v.z + v.w * v.w); }
            s1 += __shfl_xor(s1, 16); s1 += __shfl_xor(s1, 32); s2 += __shfl_xor(s2, 16); s2 += __shfl_xor(s2, 32);
            if (fq == 0) red[(64 * wr + 16 * m + fr) * 4 + wc] = (f32x2){s1, s2}; }
        RET_WAITL0(); RET_BAR();
#pragma unroll
        for (int m = 0; m < 4; ++m) { const int r = 64 * wr + 16 * m + fr; const f32x2 a = red[r * 4 + 0], b2 = red[r * 4 + 1], c2 = red[r * 4 + 2], d2 = red[r * 4 + 3];
            const float mu = ((a.x + b2.x) + (c2.x + d2.x)) * (1.0f / 512.0f), ex2 = ((a.y + b2.y) + (c2.y + d2.y)) * (1.0f / 512.0f);
            const float rs = 1.0f / sqrtf(ex2 - mu * mu + EPS); const size_t rowoff = (size_t)(t0 + r) * 2048 + h * 512 + 128 * wc + 8 * fq;
            u32x4 gw[4];
#pragma unroll
            for (int q2 = 0; q2 < 4; ++q2) gw[q2] = *(const u32x4*)(F.Gb() + rowoff + 32 * q2);
#pragma unroll
            for (int q2 = 0; q2 < 4; ++q2) { const f32x4 gn0 = *(const f32x4*)(p.ret_gn_gain + h * 512 + 128 * wc + 32 * q2 + 8 * fq), gn1 = *(const f32x4*)(p.ret_gn_gain + h * 512 + 128 * wc + 32 * q2 + 8 * fq + 4);
                const f32x4 v0 = acc[m][2 * q2], v1 = acc[m][2 * q2 + 1]; u32x4 w;
                w.x = pk2((v0.x - mu) * rs * gn0.x * bflo(gw[q2].x), (v0.y - mu) * rs * gn0.y * bfhi(gw[q2].x)); w.y = pk2((v0.z - mu) * rs * gn0.z * bflo(gw[q2].y), (v0.w - mu) * rs * gn0.w * bfhi(gw[q2].y));
                w.z = pk2((v1.x - mu) * rs * gn1.x * bflo(gw[q2].z), (v1.y - mu) * rs * gn1.y * bfhi(gw[q2].z)); w.w = pk2((v1.z - mu) * rs * gn1.z * bflo(gw[q2].w), (v1.w - mu) * rs * gn1.w * bfhi(gw[q2].w));
                *(u32x4*)(F.Y() + rowoff + 32 * q2) = w; }
             } }
        RET_BAR();
    }
    RET_WAITV(0); RET_BAR();
#undef RET_GLDS
#undef RET_NOF
#undef RET_LOADS
}

namespace pf { constexpr int XTP = 132, OFF_RS = 42496, OFF_PT = 43008, OFF_WB = 59392, OFF_END = 124928; }
template <int W>
__device__ __forceinline__ void pf_pool(LAS unsigned char* lds, int t0, int tid) {
    using namespace pf; const LAS float* XT = (const LAS float*)lds; const LAS float* RS = (const LAS float*)(lds + OFF_RS);
    const int cp = tid & 63, tb = tid >> 6, r0 = 8 * tb, ch = 2 * cp; float s0 = 0.f, s1 = 0.f;
#pragma unroll
    for (int i = 1; i < W; ++i) { const int rr = 16 + r0 - i; const f32x2 xv = *(const LAS f32x2*)(XT + rr * XTP + ch); const float rs = RS[rr]; s0 += xv.x * rs; s1 += xv.y * rs; }
#pragma unroll
    for (int j = 0; j < 8; ++j) { const int r = r0 + j, rr = 16 + r; const f32x2 xv = *(const LAS f32x2*)(XT + rr * XTP + ch); const float rs = RS[rr]; const float a0 = xv.x * rs, a1 = xv.y * rs;
        s0 += a0; s1 += a1; const int t = t0 + r; const float ic = 1.0f / (float)((t + 1) < W ? (t + 1) : W);
        *(LAS unsigned*)(lds + OFF_PT + (ch >> 5) * 4096 + (r >> 4) * 1024 + ret::swz((r & 15) * 64 + (ch & 31) * 2)) = pk2(s0 * ic - a0, s1 * ic - a1);
        const int ro = rr - W + 1; const f32x2 xo = *(const LAS f32x2*)(XT + ro * XTP + ch); const float rso = RS[ro]; s0 -= xo.x * rso; s1 -= xo.y * rso; }
}
__device__ __forceinline__ void phase_pool_fused(Frame& F) {
    using namespace pf;
    const Params& p = F.p; LAS unsigned char* lds = F.lds; const int tid = F.tid, lane = F.lane, wid = F.wave;
    const bf16_t* X2 = F.XB(); const float* rss = F.ROWSS();     const float* g1 = F.MOD() + NIN + 2 * 1024; const float* WRg = F.WR();
    LAS float* XT = (LAS float*)lds; LAS float* RS = (LAS float*)(lds + OFF_RS);
    const int foff = ret::swz((lane & 15) * 64 + (lane >> 4) * 16);
    const int srow = lane >> 2, scol = ((lane & 3) * 8) ^ (((lane >> 5) & 1) * 16);
    const __amdgpu_buffer_rsrc_t rs_ws = __builtin_amdgcn_make_buffer_rsrc((void*)F.ws, (short)0, 0x7fffffff, 0x00020000);
    unsigned loff[2];
#pragma unroll
    for (int i = 0; i < 2; ++i) { const int R = 16 * (wid + 8 * i) + srow, Rp = (R & ~31) + pg8::perm32(R & 31);
        loff[i] = (unsigned)(Rp * 256 + scol) * 2u; }
    for (int seg = F.c; seg < 256; seg += F.G) {
        const int t0 = seg * 64;
        float ss[4], lg[4][8];
#pragma unroll
        for (int m = 0; m < 4; ++m) { ss[m] = 0.f;
#pragma unroll
            for (int e = 0; e < 8; ++e) lg[m][e] = 0.f; }
        __syncthreads();
        f32x4 acc[4][2]; u32x4 xv[3];
#define PF_LOADX(gg, kk) do { int _tl = tid; asm volatile("" : "+v"(_tl)); _Pragma("unroll") for (int _i = 0; _i < 3; ++_i) { int _idx = _tl + 512 * _i; _idx = _idx < 1280 ? _idx : _idx - 512; const int _rr = _idx >> 4, _c8 = (_idx & 15) * 8; const int _tt = t0 - 16 + _rr; \
            xv[_i] = *(const u32x4*)(X2 + (size_t)(_tt < 0 ? 0 : _tt) * 1024 + 256 * (gg) + 128 * (kk) + _c8); } } while (0)
        PF_LOADX(0, 0);
        if (tid < 80) { const int tt = t0 - 16 + tid; RS[tid] = tt >= 0 ? rstd_row(rss, tt) : 0.f; }
#pragma unroll 1
        for (int it = 0; it < 8; ++it) {
            const int g = it >> 1, kh = it & 1;
            if (kh == 0) {
#pragma unroll
                for (int m = 0; m < 4; ++m) { acc[m][0] = (f32x4){0.f, 0.f, 0.f, 0.f}; acc[m][1] = (f32x4){0.f, 0.f, 0.f, 0.f}; } }
            {
                __syncthreads();
                int tl = tid; asm volatile("" : "+v"(tl));
#pragma unroll
                for (int i = 0; i < 3; ++i) { const int idx = tl + 512 * i, rr = idx >> 4, c8 = (idx & 15) * 8; if (idx < 1280) { *(LAS f32x4*)(XT + rr * XTP + c8) = (f32x4){bflo(xv[i].x), bfhi(xv[i].x), bflo(xv[i].y), bfhi(xv[i].y)}; *(LAS f32x4*)(XT + rr * XTP + c8 + 4) = (f32x4){bflo(xv[i].z), bfhi(xv[i].z), bflo(xv[i].w), bfhi(xv[i].w)}; } }
#pragma unroll
                for (int kc = 0; kc < 4; ++kc)
#pragma unroll
                    for (int i = 0; i < 2; ++i)
                        __builtin_amdgcn_raw_ptr_buffer_load_lds(rs_ws, (LAS unsigned*)(lds + OFF_WB + kc * 16384 + (wid + 8 * i) * 1024), 16, (int)loff[i], (int)((unsigned)WS_WP + (unsigned)(g * 65536 + kh * 128 + 32 * kc) * 2u), 0, 0);
                { const int itn = it < 7 ? it + 1 : 7; PF_LOADX(itn >> 1, itn & 1); }
                __syncthreads();
                if (g == 0) pf_pool<2>(lds, t0, tl); else if (g == 1) pf_pool<4>(lds, t0, tl); else if (g == 2) pf_pool<8>(lds, t0, tl); else pf_pool<16>(lds, t0, tl);
                asm volatile("s_waitcnt vmcnt(3)" ::: "memory");
                __syncthreads();
#pragma unroll
                for (int kc = 0; kc < 4; ++kc) { bf16x8 af[4], bf[2];
#pragma unroll
                    for (int m = 0; m < 4; ++m) af[m] = *(const LAS bf16x8*)(lds + OFF_PT + kc * 4096 + m * 1024 + foff);
#pragma unroll
                    for (int n = 0; n < 2; ++n) bf[n] = *(const LAS bf16x8*)(lds + OFF_WB + kc * 16384 + (2 * wid + n) * 1024 + foff);
#pragma unroll
                    for (int m = 0; m < 4; ++m)
#pragma unroll
                        for (int n = 0; n < 2; ++n) acc[m][n] = __builtin_amdgcn_mfma_f32_16x16x32_bf16(bf[n], af[m], acc[m][n], 0, 0, 0); }
            }
            if (kh == 0) continue;
            { int l5 = lane; asm volatile("" : "+v"(l5)); const int fr = l5 & 15, fq = l5 >> 4; const int c8 = 256 * g + 32 * wid + 8 * fq;
              f32x4 x2a[2][4];
#pragma unroll
              for (int m = 0; m < 4; ++m) { const u32x4 w2 = *(const u32x4*)(X2 + (size_t)(t0 + 16 * m + fr) * 1024 + c8);
                  x2a[0][m] = (f32x4){bflo(w2.x), bfhi(w2.x), bflo(w2.y), bfhi(w2.y)}; x2a[1][m] = (f32x4){bflo(w2.z), bfhi(w2.z), bflo(w2.w), bfhi(w2.w)}; }
              f32x4 bva[2], sva[2], gva[2], wra[2][4], wrb[2][4];
#pragma unroll
              for (int n = 0; n < 2; ++n) { const int cg = c8 + 4 * n;
                bva[n] = *(const f32x4*)(p.pool_b + cg); sva[n] = *(const f32x4*)(p.pool_scale + cg); gva[n].x = ldv_f(g1 + cg); gva[n].y = ldv_f(g1 + cg + 1); gva[n].z = ldv_f(g1 + cg + 2); gva[n].w = ldv_f(g1 + cg + 3);
#pragma unroll
                for (int j = 0; j < 4; ++j) { wra[n][j] = *(const f32x4*)(WRg + (cg + j) * 8); wrb[n][j] = *(const f32x4*)(WRg + (cg + j) * 8 + 4); } }
#pragma unroll
              for (int m = 0; m < 4; ++m) { const size_t o = (size_t)(t0 + 16 * m + fr) * 1024 + c8; f32x4 xq[2];
#pragma unroll
                for (int n = 0; n < 2; ++n) { const f32x4 xo = x2a[n][m] + gva[n] * ((acc[m][n] + bva[n]) * sva[n]); xq[n] = xo;
                    ss[m] += (xo.x * xo.x + xo.y * xo.y) + (xo.z * xo.z + xo.w * xo.w);
                    lg[m][0] += xo.x * wra[n][0].x + xo.y * wra[n][1].x + xo.z * wra[n][2].x + xo.w * wra[n][3].x; lg[m][1] += xo.x * wra[n][0].y + xo.y * wra[n][1].y + xo.z * wra[n][2].y + xo.w * wra[n][3].y;
                    lg[m][2] += xo.x * wra[n][0].z + xo.y * wra[n][1].z + xo.z * wra[n][2].z + xo.w * wra[n][3].z; lg[m][3] += xo.x * wra[n][0].w + xo.y * wra[n][1].w + xo.z * wra[n][2].w + xo.w * wra[n][3].w;
                    lg[m][4] += xo.x * wrb[n][0].x + xo.y * wrb[n][1].x + xo.z * wrb[n][2].x + xo.w * wrb[n][3].x; lg[m][5] += xo.x * wrb[n][0].y + xo.y * wrb[n][1].y + xo.z * wrb[n][2].y + xo.w * wrb[n][3].y;
                    lg[m][6] += xo.x * wrb[n][0].z + xo.y * wrb[n][1].z + xo.z * wrb[n][2].z + xo.w * wrb[n][3].z; lg[m][7] += xo.x * wrb[n][0].w + xo.y * wrb[n][1].w + xo.z * wrb[n][2].w + xo.w * wrb[n][3].w; }
                { u32x4 w3; w3.x = pk2(xq[0].x, xq[0].y); w3.y = pk2(xq[0].z, xq[0].w); w3.z = pk2(xq[1].x, xq[1].y); w3.w = pk2(xq[1].z, xq[1].w); *(u32x4*)(F.X3B() + o) = w3; }
                { u32x2 w8; w8.x = pk4f8(xq[0].x, xq[0].y, xq[0].z, xq[0].w); w8.y = pk4f8(xq[1].x, xq[1].y, xq[1].z, xq[1].w); *(u32x2*)((unsigned char*)F.Gb() + o) = w8; } } }
        }
#undef PF_LOADX
#pragma unroll
        for (int m = 0; m < 4; ++m) { ss[m] += __shfl_xor(ss[m], 16); ss[m] += __shfl_xor(ss[m], 32);
#pragma unroll
            for (int e = 0; e < 8; ++e) { lg[m][e] += __shfl_xor(lg[m][e], 16); lg[m][e] += __shfl_xor(lg[m][e], 32); } }
        __syncthreads();
        { LAS float* red = (LAS float*)lds; int l6 = lane; asm volatile("" : "+v"(l6)); const int fr = l6 & 15;
          if ((l6 >> 4) == 0) {
#pragma unroll
            for (int m = 0; m < 4; ++m) { LAS float* q = red + ((16 * m + fr) * 8 + wid) * 12; q[0] = ss[m];
#pragma unroll
                for (int e = 0; e < 8; ++e) q[1 + e] = lg[m][e]; } }
          LAS int* cnt = (LAS int*)(lds + OFF_RS);
          if (tid < 8) cnt[tid] = 0;
          __syncthreads();
          if (tid < 64) { float sq = 0.f, a[8];
#pragma unroll
            for (int e = 0; e < 8; ++e) a[e] = 0.f;
#pragma unroll
            for (int w = 0; w < 8; ++w) { const LAS float* q = red + (tid * 8 + w) * 12; sq += q[0];
#pragma unroll
                for (int e = 0; e < 8; ++e) a[e] += q[1 + e]; }
            const int t = t0 + tid; const float rs = rstd_of(sq); float lgt[8]; F.RSTD3()[t] = rs;
#pragma unroll
            for (int e = 0; e < 8; ++e) lgt[e] = rs * a[e] + ldv_f(F.BIAS_R() + e);
            int e0 = 0; float l0 = lgt[0];
#pragma unroll
            for (int e = 1; e < 8; ++e) if (lgt[e] > l0) { l0 = lgt[e]; e0 = e; }
            int e1 = -1; float l1 = -3.0e38f;
#pragma unroll
            for (int e = 0; e < 8; ++e) if (e != e0 && lgt[e] > l1) { l1 = lgt[e]; e1 = e; }
            const float g0 = 1.0f / (1.0f + __expf(l1 - l0));
            F.TOPE()[t * 2] = e0; F.TOPE()[t * 2 + 1] = e1; F.TOPG()[t * 2] = g0; F.TOPG()[t * 2 + 1] = 1.0f - g0;
            atomicAdd((int*)(cnt + e0), 1); atomicAdd((int*)(cnt + e1), 1); }
          __syncthreads();
          if (tid < 8) F.CNT()[seg * 8 + tid] = cnt[tid]; }
    }
    __syncthreads();
}

__device__ __forceinline__ void phase_route2(Frame& F) {
    const int tid = F.tid;
    LAS int* cn = (LAS int*)F.lds;
    LAS int* part = cn + 2048;
    LAS int* tot = part + 512;
    LAS int* te = tot + 32;
    __syncthreads();
    for (int i = tid; i < 2048; i += NTHR) cn[i] = ldv_i(F.CNT() + i);
    __syncthreads();
    { const int e = tid & 7, pq = tid >> 3; part[pq * 8 + e] = cn[(4 * pq) * 8 + e] + cn[(4 * pq + 1) * 8 + e] + cn[(4 * pq + 2) * 8 + e] + cn[(4 * pq + 3) * 8 + e]; }
    __syncthreads();
    if (tid < 8) { int run = 0; for (int q = 0; q < 64; ++q) { const int v = part[q * 8 + tid]; part[q * 8 + tid] = run; run += v; } tot[tid] = run; }
    __syncthreads();
    { const int e = tid & 7, pq = tid >> 3; int run = part[pq * 8 + e];
#pragma unroll
        for (int j = 0; j < 4; ++j) { const int v = cn[(4 * pq + j) * 8 + e]; cn[(4 * pq + j) * 8 + e] = run; run += v; } }
    if (tid == 0) { int sp = 0; for (int e = 0; e < 8; ++e) { const int pd = (tot[e] + 255) / 256 * 256; tot[8 + e] = sp; tot[16 + e] = pd; sp += pd; } tot[24] = sp / 256; }
    __syncthreads();
    for (int seg = F.c; seg < 256; seg += F.G) {
        int e = -1; if (tid < 128) e = ldv_i(F.TOPE() + seg * 128 + tid);
        int rank = 0;
#pragma unroll
        for (int ee = 0; ee < 8; ++ee) { const unsigned long long m = __ballot(e == ee); if (e == ee) rank = __popcll(m & ((1ull << F.lane) - 1ull)); if (tid == 0) te[ee] = __popcll(m); }
        __syncthreads();
        if (tid < 128) { if (tid >= 64) rank += te[e];
            const int pos = tot[8 + e] + cn[seg * 8 + e] + rank, idx = seg * 128 + tid;
            const float gt = ldv_f(F.TOPG() + idx), rsd = ldv_f(F.RSTD3() + (idx >> 1));
            F.BUFTOK()[pos] = idx >> 1; F.BUFGATE()[pos] = gt; F.BUFRS()[pos] = rsd * (1.0f / F8_WSCALE); F.POS()[idx] = pos; }
        __syncthreads();
    }
    if (F.c < 8) { const int e = F.c; const int b0 = tot[8 + e] + tot[e], b1 = tot[8 + e] + tot[16 + e]; for (int r = b0 + tid; r < b1; r += NTHR) { F.BUFTOK()[r] = 0; F.BUFGATE()[r] = 0.f; F.BUFRS()[r] = 0.f; } }
    if (F.c == (8 % F.G)) { if (tid < NBLK) { int e = 0; for (int q = 0; q < 8; ++q) if (tid * 256 >= tot[8 + q] + tot[16 + q]) ++e; F.BLKE()[tid] = e < 7 ? e : 7; } if (tid == NBLK) F.BLKE()[NBLK] = tot[24]; }
}

__device__ __forceinline__ void phase_final(Frame& F) {
    const Params& p = F.p; const int gw = F.c * NWAVE + F.wave, NGW = F.G * NWAVE, lane = F.lane; const float* g2 = F.MOD() + NIN + 5 * 1024;
    const int nused = ldv_i(F.BLKE() + NBLK); const int ntail = (F.G == 256) ? (nused - 128) * 4 : 0; const int spu = ntail > 0 ? moe_tail_spu(ntail) : 1;
    f32x4 gv[4], fg[4];
#pragma unroll
    for (int j = 0; j < 4; ++j) { const int cc = 8 * lane + 512 * (j >> 1) + 4 * (j & 1); gv[j] = *(const f32x4*)(g2 + cc); fg[j] = *(const f32x4*)(p.final_norm_gain + cc); }
    for (int row = 2 * gw; row < T; row += 2 * NGW) {
        f32x4 xv[2][4]; f32x4 fa[2][4]; int pos[2][2]; u32x4 xw[2][2]; u32x2 yw[2][2][2];
#pragma unroll
        for (int r = 0; r < 2; ++r)
#pragma unroll
            for (int a = 0; a < 2; ++a) pos[r][a] = ldv_i(F.POS() + (row + r) * 2 + a);
#pragma unroll
        for (int r = 0; r < 2; ++r)
#pragma unroll
            for (int j2 = 0; j2 < 2; ++j2) xw[r][j2] = *(const u32x4*)(F.X3B() + (size_t)(row + r) * D + 8 * lane + 512 * j2);
#pragma unroll
        for (int r = 0; r < 2; ++r)
#pragma unroll
            for (int a = 0; a < 2; ++a) { const bool tl = ntail > 0 && (pos[r][a] >> 8) >= 128;
                const unsigned char* y = (const unsigned char*)F.YB() + (size_t)(tl ? 0 : pos[r][a]) * D + 8 * lane;
#pragma unroll
                for (int j2 = 0; j2 < 2; ++j2) yw[r][a][j2] = *(const u32x2*)(y + 512 * j2); }
#pragma unroll
        for (int r = 0; r < 2; ++r) {
#pragma unroll
            for (int j2 = 0; j2 < 2; ++j2) { const u32x4 w3 = xw[r][j2]; xv[r][2 * j2] = (f32x4){bflo(w3.x), bfhi(w3.x), bflo(w3.y), bfhi(w3.y)}; xv[r][2 * j2 + 1] = (f32x4){bflo(w3.z), bfhi(w3.z), bflo(w3.w), bfhi(w3.w)};
                fa[r][2 * j2] = (f32x4){0.f, 0.f, 0.f, 0.f}; fa[r][2 * j2 + 1] = (f32x4){0.f, 0.f, 0.f, 0.f}; }
#pragma unroll
            for (int a = 0; a < 2; ++a) { const int ps = pos[r][a]; const int blk = ps >> 8;
                if (ntail > 0 && blk >= 128) {
#pragma unroll
                    for (int jp = 0; jp < 2; ++jp) {
                        const bf16_t* s0 = (const bf16_t*)F.YBB() + (size_t)(((blk - 128) * 4 + 2 * jp + (lane >> 5)) * spu) * 65536 + (size_t)(ps & 255) * 256 + ((8 * lane) & 255);
                        int q0 = 0;
                        for (; q0 + 7 <= spu; q0 += 7) { u32x4 t0[7];
#pragma unroll
                            for (int q = 0; q < 7; ++q) t0[q] = *(const u32x4*)(s0 + (size_t)(q0 + q) * 65536);
#pragma unroll
                            for (int q = 0; q < 7; ++q) { fa[r][2 * jp] = fa[r][2 * jp] + (f32x4){bflo(t0[q].x), bfhi(t0[q].x), bflo(t0[q].y), bfhi(t0[q].y)}; fa[r][2 * jp + 1] = fa[r][2 * jp + 1] + (f32x4){bflo(t0[q].z), bfhi(t0[q].z), bflo(t0[q].w), bfhi(t0[q].w)}; } }
                        for (; q0 < spu; ++q0) { const u32x4 tq = *(const u32x4*)(s0 + (size_t)q0 * 65536); fa[r][2 * jp] = fa[r][2 * jp] + (f32x4){bflo(tq.x), bfhi(tq.x), bflo(tq.y), bfhi(tq.y)}; fa[r][2 * jp + 1] = fa[r][2 * jp + 1] + (f32x4){bflo(tq.z), bfhi(tq.z), bflo(tq.w), bfhi(tq.w)}; } }
                } else {
#pragma unroll
                    for (int j2 = 0; j2 < 2; ++j2) { const u32x2 w = yw[r][a][j2];
                        const f32x2 a0 = __builtin_amdgcn_cvt_pk_f32_fp8((int)w.x, false), a1 = __builtin_amdgcn_cvt_pk_f32_fp8((int)w.x, true), a2 = __builtin_amdgcn_cvt_pk_f32_fp8((int)w.y, false), a3 = __builtin_amdgcn_cvt_pk_f32_fp8((int)w.y, true);
                        fa[r][2 * j2] = fa[r][2 * j2] + (f32x4){a0.x, a0.y, a1.x, a1.y} * (1.0f / F8_YSCALE); fa[r][2 * j2 + 1] = fa[r][2 * j2 + 1] + (f32x4){a2.x, a2.y, a3.x, a3.y} * (1.0f / F8_YSCALE); } } } }
#pragma unroll
        for (int r = 0; r < 2; ++r) { f32x4 v[4]; float s = 0.f;
#pragma unroll
            for (int j = 0; j < 4; ++j) { v[j] = xv[r][j] + gv[j] * fa[r][j]; s += (v[j].x * v[j].x + v[j].y * v[j].y) + (v[j].z * v[j].z + v[j].w * v[j].w); }
            s = wave_sum(s); const float rs = rstd_of(s);
            float* o = p.out + (size_t)(row + r) * D + 8 * lane;
#pragma unroll
            for (int j = 0; j < 4; ++j) *(f32x4*)(o + 512 * (j >> 1) + 4 * (j & 1)) = v[j] * rs * fg[j]; }
    }
}

template <class Desc, class Epi> __device__ __forceinline__ void run_gemm(Frame& F, const Desc& Dc, const Epi& E) {
    gemm_fast(F.lds, F.ws, Dc, E, F.c, F.G, F.wave);
}

__device__ __forceinline__ void phase_g1(Frame& F) {
    if (F.G == 256 && F.c >= 128) { p1_deferred(F, 1); frame_fresh(F); }
    const bool late_v = !(F.G == 256 && F.c >= 128);
#define G1_VCALL { DescG1b8 d{F.XV8(), F.WIN8(), nullptr, 512, 512, 8, 128, 128}; EpiG1b e{F.ROWSS(), F.BIAS_IN(), F.TABA(), F.TABB(), F.GP(), F.KDT(), F.VT(), 1.0f / (F8_WSCALE * 16.0f)}; run_gemm(F, d, e); }
    if (!late_v) { G1_VCALL; }
    { DescG1a<false> d{F.XB(), F.WIN(), nullptr, 1024, 1024, 16, 128, 128}; EpiG1a<false> e{F.ROWSS(), F.BIAS_IN(), F.TABA(), F.TABB(), F.Q(), F.KN(), F.Gb(), F.GP(), F.KDT()}; run_gemm(F, d, e); }
    { DescG1a<true> d{F.XB(), F.WIN(), nullptr, 1024, 1024, 16, 128, 128}; EpiG1a<true> e{F.ROWSS(), F.BIAS_IN(), F.TABA(), F.TABB(), F.Q(), F.KN(), F.Gb(), F.GP(), F.KDT()}; run_gemm(F, d, e); }
    if (late_v) { G1_VCALL; }
#undef G1_VCALL
    if (F.G == 256 && F.c < 128) { frame_fresh(F); p1_deferred(F, 0); }
}
__device__ __forceinline__ void phase_kv(Frame& F) { DescKV d{F.VT(), F.KDT(), nullptr, T, T, 4, 128, 128}; EpiKV e{F.SB()}; run_gemm(F, d, e); }
__device__ __forceinline__ void phase_outproj(Frame& F) {
    DescOut d{F.Y(), F.WOUT(), nullptr, 2048, 2048, 32, 128, 128}; EpiResid<false> e{F.p.x, nullptr, F.XB(), F.ROWSS(), F.MOD() + 2 * 1024, nullptr, nullptr, 1.0f}; run_gemm(F, d, e); }
__device__ __forceinline__ void phase_ffn_up(Frame& F) {
    DescFfnUp d{F.XB(), F.WGU(), nullptr, 1024, 1024, 16, 128, 128}; EpiSwiglu<true, true> e{F.ROWSS(), nullptr, F.BIAS_GU(), F.H1(), DFF, 5632, 2 * 5632}; run_gemm(F, d, e);
    if (F.G == 256 && F.c >= 128) {
        frame_fresh(F); px_tables(F); px_gu_item(F, (F.c - 128) * NWAVE + F.wave, F.lane); __syncthreads(); } }
__device__ __forceinline__ void phase_ffn_down(Frame& F) {
    DescFfnDown d{F.H1(), F.WD(), nullptr, 64, 64, 22, 32768, 32768};     EpiResid<true> e{nullptr, F.XB(), F.XB(), F.ROWSS(), F.MOD() + 5 * 1024, nullptr, nullptr, 1.0f / (F8_DSCALE * F8_HSCALE)}; run_gemm(F, d, e); }
__device__ __forceinline__ void phase_moe_up(Frame& F) {
    DescMoeUp d{F.Gb(), F.WMGU(), F.BUFTOK(), 512, 512, 8, 128, 128, F.BLKE()};     EpiSwiglu<true, true> e{F.ROWSS(), F.BUFRS(), F.BIAS_MGU(), F.H1M(), DFE, 57344, 262144}; run_gemm(F, d, e); }
__device__ __forceinline__ void phase_moe_down(Frame& F) {
    DescMoeDown d{F.H1M(), F.WMD(), nullptr, 64, 64, 28, 32768, 32768, F.BLKE(), F.G}; EpiMoeDown e{F.BUFGATE(), F.YB(), F.YBB()}; run_gemm(F, d, e); }

#define XB_TMO      128
#define XB_XCNT(j)  (256  + 64 * (j))
#define XB_XSUB(j)  (1280 + 64 * (j))
#define XB_XGEN(j)  (2304 + 64 * (j))
#define XB_TOP      3328
#define XB_TOPGEN   3392
#define XCD_BAR_WORDS 3456
#define XB_SPIN_CAP (1u << 18)
__device__ __forceinline__ unsigned xb_ld(unsigned* p)              { return __hip_atomic_load(p, __ATOMIC_RELAXED, __HIP_MEMORY_SCOPE_AGENT); }
__device__ __forceinline__ unsigned xb_add(unsigned* p, unsigned v) { return __hip_atomic_fetch_add(p, v, __ATOMIC_RELAXED, __HIP_MEMORY_SCOPE_AGENT); }
__device__ __forceinline__ unsigned xb_xcc_id() { return (unsigned)__builtin_amdgcn_s_getreg((3 << 11) | 20) & 0xFu; }
#define XB_SPIN(cond, bar) do { unsigned _sp = 0; while (cond) { __builtin_amdgcn_s_sleep(1); \
    if ((++_sp & 255u) == 0u) { if (xb_ld(&(bar)[XB_TMO])) break; if (_sp > XB_SPIN_CAP) { atomicAdd(&(bar)[XB_TMO], 1u); break; } } } } while (0)
struct XcdBarrier { unsigned* bar; unsigned x; volatile LAS unsigned* st; int wave; };
__device__ __forceinline__ XcdBarrier xcd_barrier_post(unsigned* bar, volatile LAS unsigned* st, int wave) {
    XcdBarrier b; b.bar = bar; b.x = xb_xcc_id(); b.st = st; b.wave = wave;
    if (wave == 0 && lane_id() == 0) (void)xb_add(&bar[XB_XCNT(b.x)], 1u);
    return b;
}
__device__ __forceinline__ void xcd_barrier_complete(unsigned* bar, unsigned x, unsigned& nloc, unsigned& nx) {
    const unsigned G = gridDim.x * gridDim.y * gridDim.z;
    unsigned sum, cnt, mine, sp = 0u;
    for (;;) {
        sum = 0u; cnt = 0u; mine = 0u;
#pragma unroll
        for (unsigned j = 0; j < 16; ++j) { const unsigned c = xb_ld(&bar[XB_XCNT(j)]); sum += c; cnt += (c > 0u) ? 1u : 0u; mine = (j == x) ? c : mine; }
        if (sum == G) break;
        __builtin_amdgcn_s_sleep(1);
        if ((++sp & 255u) == 0u) { if (xb_ld(&bar[XB_TMO])) break; if (sp > XB_SPIN_CAP) { atomicAdd(&bar[XB_TMO], 1u); break; } }
    }
    nloc = mine > 0u ? mine : 1u; nx = cnt > 0u ? cnt : 1u;
}
__device__ __forceinline__ void xcd_barrier(const XcdBarrier& b) {
    asm volatile("s_waitcnt vmcnt(0)" ::: "memory");
    __syncthreads();
    if (b.wave == 0 && lane_id() == 0) {
        unsigned* bar = b.bar;
        __builtin_amdgcn_s_waitcnt(0);
        unsigned nloc = b.st[0], nx = b.st[1];
        if (nloc == 0u) { xcd_barrier_complete(bar, b.x, nloc, nx); b.st[0] = nloc; b.st[1] = nx; }
        const unsigned old = xb_add(&bar[XB_XSUB(b.x)], 1u);
        const unsigned gen = old / nloc;
        if (old + 1u == (gen + 1u) * nloc) {
            __builtin_amdgcn_fence(__ATOMIC_RELEASE, "agent");
            asm volatile("s_waitcnt vmcnt(0)" ::: "memory");
            const unsigned og = xb_add(&bar[XB_TOP], 1u);
            const unsigned tg = og / nx;
            if (og + 1u == (tg + 1u) * nx) xb_add(&bar[XB_TOPGEN], 1u);
            else XB_SPIN(xb_ld(&bar[XB_TOPGEN]) == tg, bar);
            __builtin_amdgcn_fence(__ATOMIC_ACQUIRE, "agent");
            xb_add(&bar[XB_XGEN(b.x)], 1u);
            asm volatile("s_waitcnt vmcnt(0)" ::: "memory");
        } else {
            XB_SPIN(xb_ld(&bar[XB_XGEN(b.x)]) == gen, bar);
            __builtin_amdgcn_fence(__ATOMIC_ACQUIRE, "agent");
            asm volatile("s_waitcnt vmcnt(0)" ::: "memory");
        }
    }
    __syncthreads();
}

constexpr int LDSCTL_OFF = 131072;
__global__ void __launch_bounds__(NTHR, 2) k_mega(Params p) {
    extern __shared__ __attribute__((aligned(16))) unsigned char lds_raw[];
    Frame F; frame_init(F, p, (LAS unsigned char*)lds_raw, (int)blockIdx.x, (int)gridDim.x);
    for (int u = F.tid; u < (LDS_BYTES - LDSCTL_OFF) / 4; u += NTHR) ((LAS unsigned*)(F.lds + LDSCTL_OFF))[u] = 0u;
    __syncthreads();
    const XcdBarrier bar = xcd_barrier_post((unsigned*)(p.ws + CT_BAR), (volatile LAS unsigned*)(F.lds + LDSCTL_OFF + 32), F.wave);
#define GRID_BAR() xcd_barrier(bar)

    frame_fresh(F); phase_p0(F); GRID_BAR();
    frame_fresh(F); phase_p1(F); GRID_BAR();
    frame_fresh(F); phase_g1(F); GRID_BAR();
    frame_fresh(F); phase_kv(F); GRID_BAR();
    frame_fresh(F); phase_scan(F); GRID_BAR();
    frame_fresh(F); phase_ret_fast(F); GRID_BAR();
    frame_fresh(F); phase_outproj(F); GRID_BAR();
    frame_fresh(F); phase_ffn_up(F); GRID_BAR();
    frame_fresh(F); phase_ffn_down(F); GRID_BAR();
    if ((F.c >> 3) & 1) { frame_fresh(F); phase_px(F); __syncthreads(); frame_fresh(F); phase_pool_fused(F); } else { frame_fresh(F); phase_pool_fused(F); frame_fresh(F); phase_px(F); }
    GRID_BAR();
    frame_fresh(F); phase_route2(F); GRID_BAR();
    frame_fresh(F); phase_moe_up(F); GRID_BAR();
    frame_fresh(F); phase_moe_down(F); GRID_BAR();
    frame_fresh(F); phase_final(F);
#undef GRID_BAR
}

extern "C" void kernel_launch(void* const* d_in, const int* in_sizes, int n_in, void* d_out, int out_size, void* d_ws, size_t ws_size, hipStream_t stream) {
    static int grid = 0;
    if (grid == 0) {
        if (n_in != 19 || out_size != T * D || ws_size < WS_END) { fprintf(stderr, "kernel_launch: unexpected shapes (n_in %d out %d ws %zu)\n", n_in, out_size, ws_size); grid = -1; return; }
        int dev = 0, cus = 0, per_cu = 0;
        if (hipGetDevice(&dev) != hipSuccess || hipDeviceGetAttribute(&cus, hipDeviceAttributeMultiprocessorCount, dev) != hipSuccess) { grid = -1; return; }
        if (hipFuncSetAttribute((const void*)k_mega, hipFuncAttributeMaxDynamicSharedMemorySize, LDS_BYTES) != hipSuccess) { fprintf(stderr, "kernel_launch: hipFuncSetAttribute failed\n"); grid = -1; return; }
        if (hipOccupancyMaxActiveBlocksPerMultiprocessor(&per_cu, (const void*)k_mega, NTHR, LDS_BYTES) != hipSuccess || per_cu < 1) { fprintf(stderr, "kernel_launch: occupancy query says %d blocks per CU\n", per_cu); (void)hipGetLastError(); grid = -1; return; }
        grid = cus * (per_cu < 1 ? 1 : 1);
    }
    if (grid < 0) return;
    Params p{};
    const float** pp = (const float**)&p;
    for (int i = 0; i < 19; ++i) pp[i] = (const float*)d_in[i];
    p.out = (float*)d_out; p.ws = (unsigned char*)d_ws;
    (void)hipMemsetAsync((char*)d_ws + WS_CTL, 0, 64 * KiB, stream);
    void* args[] = {&p};
    hipError_t e = hipLaunchCooperativeKernel((const void*)k_mega, dim3(grid), dim3(NTHR), args, LDS_BYTES, stream);
    if (e != hipSuccess) fprintf(stderr, "kernel_launch: cooperative launch failed: %s (grid %d)\n", hipGetErrorString(e), grid);
}
```
